# Optimizing an MI355X kernel written in HIP

```python
import math
import jax, jax.numpy as jnp
from jax import lax
import numpy as np

D_MODEL = 2048
BATCH = 1
SEQ = 16384
DEPTH = 1

GRID_W = 64
CTX_LEN = 256
EPS = 1e-6

A_HEADS = 16
A_KV_HEADS = 2
A_GROUP = A_HEADS // A_KV_HEADS
A_HEAD_DIM = 64
A_WIDTH = A_HEADS * A_HEAD_DIM
A_KV_WIDTH = A_KV_HEADS * A_HEAD_DIM
WINDOW = 128
A_BLOCK = 128
ROPE_BASE = 10000.0
ROPE_PAIRS_PER_AXIS = A_HEAD_DIM // 4

B_HEADS = 8
B_DK = 128
B_DV = 128
B_KEY_WIDTH = B_HEADS * B_DK
B_WIDTH = B_HEADS * B_DV
B_CHUNK = 64

BRANCH_WIDTH = D_MODEL // 2
N_BRANCHES = 2

IN_SIZES = (A_WIDTH, A_KV_WIDTH, A_KV_WIDTH, B_KEY_WIDTH, B_KEY_WIDTH, B_KEY_WIDTH,
            B_WIDTH, B_WIDTH, D_MODEL, D_MODEL)
IN_COLS = sum(IN_SIZES)
IN_SPLITS = tuple(int(s) for s in np.cumsum(IN_SIZES)[:-1])

N_EXPERTS = 32
TOP_K = 4
EXPERT_FF = 2048
SWIGLU_LIMIT = 7.0
SWIGLU_ALPHA = 1.702
MOE_BLOCK = 128

kernel_name = "hybrid_gqa_hgrn2_moe_dit_block"


def rms_norm(x, g):
    xf = x.astype(jnp.float32)
    y = xf * lax.rsqrt(jnp.mean(xf * xf, axis=-1, keepdims=True) + EPS)
    return (y * g.astype(jnp.float32)).astype(x.dtype)


def modulate(h, shift, scale):
    return h * (1.0 + scale) + shift


def axial_rope_tables(n_tokens):
    rows = n_tokens // GRID_W
    row = jnp.repeat(jnp.arange(rows, dtype=jnp.float32), GRID_W)
    col = jnp.tile(jnp.arange(GRID_W, dtype=jnp.float32), rows)
    inv_freq = ROPE_BASE ** (-jnp.arange(ROPE_PAIRS_PER_AXIS, dtype=jnp.float32) / ROPE_PAIRS_PER_AXIS)
    ang = jnp.concatenate([row[:, None] * inv_freq, col[:, None] * inv_freq], axis=-1)
    return jnp.cos(ang)[:, None, :], jnp.sin(ang)[:, None, :]


def apply_rope(t, cos, sin):
    tf = t.astype(jnp.float32)
    t1, t2 = jnp.split(tf, 2, axis=-1)
    return jnp.concatenate([t1 * cos - t2 * sin, t2 * cos + t1 * sin], axis=-1).astype(t.dtype)


def windowed_gqa_with_sink(q, k, v, k_ctx, v_ctx, sink):
    bsz, n, _, hd = q.shape
    n_ctx = k_ctx.shape[1]
    nblk = n // A_BLOCK
    scale = A_HEAD_DIM ** -0.5
    qg = q.reshape(bsz, nblk, A_BLOCK, A_KV_HEADS, A_GROUP, hd).transpose(1, 0, 2, 3, 4, 5)

    def band(t):
        tp = jnp.pad(t, ((0, 0), (A_BLOCK, A_BLOCK), (0, 0), (0, 0)))
        tp = tp.reshape(bsz, nblk + 2, A_BLOCK, A_KV_HEADS, hd)
        return jnp.concatenate([tp[:, :-2], tp[:, 1:-1], tp[:, 2:]], axis=2).transpose(1, 0, 2, 3, 4)

    k_band, v_band = band(k), band(v)
    sink_l = sink.astype(jnp.float32).reshape(1, A_KV_HEADS, A_GROUP, 1, 1)
    rel = jnp.arange(3 * A_BLOCK)[None, :] - A_BLOCK - jnp.arange(A_BLOCK)[:, None]

    def one_block(args):
        qb, kb, vb, i = args
        key_pos = (i - 1) * A_BLOCK + jnp.arange(3 * A_BLOCK)
        mask = (jnp.abs(rel) <= WINDOW) & (key_pos >= 0)[None, :] & (key_pos < n)[None, :]
        s_ctx = jnp.einsum('bqkgd,bjkd->bkgqj', qb, k_ctx).astype(jnp.float32) * scale
        s_lat = jnp.einsum('bqkgd,bjkd->bkgqj', qb, kb).astype(jnp.float32) * scale
        s_lat = jnp.where(mask, s_lat, -jnp.inf)
        s_sink = jnp.broadcast_to(sink_l, s_ctx.shape[:-1] + (1,))
        p = jax.nn.softmax(jnp.concatenate([s_ctx, s_lat, s_sink], axis=-1), axis=-1).astype(v.dtype)
        return (jnp.einsum('bkgqj,bjkd->bqkgd', p[..., :n_ctx], v_ctx)
                + jnp.einsum('bkgqj,bjkd->bqkgd', p[..., n_ctx:-1], vb))

    o = lax.map(one_block, (qg, k_band, v_band, jnp.arange(nblk)))
    return o.transpose(1, 0, 2, 3, 4, 5).reshape(bsz, n, A_WIDTH)


def context_attention(q, k, v, sink):
    bsz, m = q.shape[:2]
    qg = q.reshape(bsz, m, A_KV_HEADS, A_GROUP, A_HEAD_DIM)
    s = jnp.einsum('bqkgd,bjkd->bkgqj', qg, k).astype(jnp.float32) * (A_HEAD_DIM ** -0.5)
    s_sink = jnp.broadcast_to(sink.astype(jnp.float32).reshape(1, A_KV_HEADS, A_GROUP, 1, 1), s.shape[:-1] + (1,))
    p = jax.nn.softmax(jnp.concatenate([s, s_sink], axis=-1), axis=-1)[..., :-1].astype(v.dtype)
    return jnp.einsum('bkgqj,bjkd->bqkgd', p, v).reshape(bsz, m, A_WIDTH)


def hgrn2_chunk_scan(q, k, v, logf, s0):
    bsz, h, n, _ = q.shape
    dv = v.shape[-1]
    nc = n // B_CHUNK

    def chunks(t):
        return jnp.moveaxis(t.astype(jnp.float32).reshape(bsz, h, nc, B_CHUNK, t.shape[-1]), 2, 0)

    tril = jnp.tril(jnp.ones((B_CHUNK, B_CHUNK), dtype=bool))[:, :, None]

    def step(state, inp):
        qc, kc, vc, lf = inp
        b = jnp.cumsum(lf, axis=2)
        b_last = b[:, :, -1:, :]
        o_inter = jnp.einsum('bhtd,bhde->bhte', qc * jnp.exp(b), state)
        decay = jnp.where(tril, jnp.exp(jnp.minimum(b[:, :, :, None, :] - b[:, :, None, :, :], 0.0)), 0.0)
        scores = jnp.einsum('bhtd,bhsd,bhtsd->bhts', qc, kc, decay)
        o = o_inter + jnp.einsum('bhts,bhse->bhte', scores, vc)
        state = (jnp.exp(b_last[:, :, 0, :])[..., None] * state
                 + jnp.einsum('bhsd,bhse->bhde', kc * jnp.exp(b_last - b), vc))
        return state, o

    s_final, o = lax.scan(step, s0, (chunks(q), chunks(k), chunks(v), chunks(logf)))
    return jnp.moveaxis(o, 0, 2).reshape(bsz, h, n, dv), s_final


def hgrn2_direction(q_c, z_c, v_c, q_l, z_l, v_l, lb, reverse):
    bsz = q_l.shape[0]
    lbh = lb.reshape(1, B_HEADS, 1, B_DK)

    def gates(z):
        zf = z.astype(jnp.float32)
        logf = jnp.log(lbh + (1.0 - lbh) * jax.nn.sigmoid(zf))
        k = (1.0 - lbh) * jax.nn.sigmoid(-zf)
        return k, logf

    def flip(t):
        return jnp.flip(t, axis=2) if reverse else t

    k_c, lf_c = gates(z_c)
    k_l, lf_l = gates(z_l)
    s0 = jnp.zeros((bsz, B_HEADS, B_DK, B_DV), jnp.float32)
    o_c, s_c = hgrn2_chunk_scan(flip(q_c), flip(k_c), flip(v_c), flip(lf_c), s0)
    o_l, _ = hgrn2_chunk_scan(flip(q_l), flip(k_l), flip(v_l), flip(lf_l), s_c)
    return flip(o_l), flip(o_c)


def hybrid_mixer(h_lat, h_ctx, w_in, sink, lb_f, lb_b, hgrn_g, w_branch, w_out, cos, sin, need_ctx_out):
    bsz, n, _ = h_lat.shape
    n_ctx = h_ctx.shape[1]
    lat = jnp.split(h_lat @ w_in, IN_SPLITS, axis=-1)
    ctx = jnp.split(h_ctx @ w_in, IN_SPLITS, axis=-1)

    def attn_heads(parts, m):
        return (parts[0].reshape(bsz, m, A_HEADS, A_HEAD_DIM),
                parts[1].reshape(bsz, m, A_KV_HEADS, A_HEAD_DIM),
                parts[2].reshape(bsz, m, A_KV_HEADS, A_HEAD_DIM))

    q_l, k_l, v_l = attn_heads(lat, n)
    q_c, k_c, v_c = attn_heads(ctx, n_ctx)
    q_l = apply_rope(q_l, cos, sin)
    k_l = apply_rope(k_l, cos, sin)
    ya_lat = windowed_gqa_with_sink(q_l, k_l, v_l, k_c, v_c, sink)

    def rec_heads(parts, m):
        def to_h(t, d):
            return t.reshape(bsz, m, B_HEADS, d).transpose(0, 2, 1, 3)
        return (jax.nn.silu(to_h(parts[3], B_DK)), to_h(parts[4], B_DK), to_h(parts[5], B_DK),
                to_h(parts[6], B_DV), parts[7])

    rq_l, zf_l, zb_l, rv_l, rg_l = rec_heads(lat, n)
    rq_c, zf_c, zb_c, rv_c, rg_c = rec_heads(ctx, n_ctx)
    of_l, of_c = hgrn2_direction(rq_c, zf_c, rv_c, rq_l, zf_l, rv_l, lb_f, False)
    ob_l, ob_c = hgrn2_direction(rq_c, zb_c, rv_c, rq_l, zb_l, rv_l, lb_b, True)

    def rec_out(o, g, m):
        o = rms_norm(o.transpose(0, 2, 1, 3), hgrn_g.reshape(B_HEADS, B_DV))
        return o.reshape(bsz, m, B_WIDTH).astype(g.dtype) * jax.nn.silu(g)

    yb_lat = rec_out(of_l + ob_l, rg_l, n)

    def merge(ya, yb, parts):
        z = jnp.einsum('rbnc,rcd->rbnd', jnp.stack([ya, yb.astype(ya.dtype)]), w_branch)
        merged = jax.nn.sigmoid(parts[8]) * z[0] + jax.nn.sigmoid(parts[9]) * z[1]
        return merged @ w_out

    y_lat = merge(ya_lat, yb_lat, lat)
    if need_ctx_out:
        ya_c = context_attention(q_c, k_c, v_c, sink)
        yb_c = rec_out(of_c + ob_c, rg_c, n_ctx)
        y_ctx = merge(ya_c, yb_c, ctx)
    else:
        y_ctx = None
    return y_lat, y_ctx


def moe_ffn(h, w_router, b_router, w_e_gate, b_e_gate, w_e_up, b_e_up, w_e_down, b_e_down):
    bsz, n, d = h.shape
    xt = h.reshape(-1, d)
    t = xt.shape[0]
    logits = (xt @ w_router + b_router).astype(jnp.float32)
    top_val, top_idx = lax.top_k(logits, TOP_K)
    gates = jax.nn.softmax(top_val, axis=-1)
    n_assign = t * TOP_K
    flat_e = top_idx.reshape(-1)
    order = jnp.argsort(flat_e)
    e_sorted = flat_e[order]
    tok_sorted = (order // TOP_K).astype(jnp.int32)
    gate_sorted = gates.reshape(-1)[order]
    counts = jnp.zeros((N_EXPERTS,), jnp.int32).at[flat_e].add(1)
    padded = ((counts + MOE_BLOCK - 1) // MOE_BLOCK) * MOE_BLOCK
    start = jnp.cumsum(counts) - counts
    pend = jnp.cumsum(padded)
    pstart = pend - padded
    dest = pstart[e_sorted] + (jnp.arange(n_assign, dtype=jnp.int32) - start[e_sorted])
    n_blocks = -(-n_assign // MOE_BLOCK) + N_EXPERTS
    n_slots = n_blocks * MOE_BLOCK
    slot_tok = jnp.full((n_slots,), t, jnp.int32).at[dest].set(tok_sorted)
    slot_gate = jnp.zeros((n_slots,), jnp.float32).at[dest].set(gate_sorted)
    block_expert = jnp.minimum(jnp.searchsorted(pend, jnp.arange(n_blocks) * MOE_BLOCK, side='right'),
                               N_EXPERTS - 1)
    x_pad = jnp.concatenate([xt, jnp.zeros((1, d), xt.dtype)], axis=0)

    def one_block(args):
        tok_b, gate_b, e = args
        xb = x_pad[tok_b]
        g = jnp.minimum(xb @ w_e_gate[e] + b_e_gate[e], SWIGLU_LIMIT)
        u = jnp.clip(xb @ w_e_up[e] + b_e_up[e], -SWIGLU_LIMIT, SWIGLU_LIMIT)
        act = g * jax.nn.sigmoid(SWIGLU_ALPHA * g) * (u + 1.0)
        y = act @ w_e_down[e] + b_e_down[e]
        return y * gate_b[:, None].astype(y.dtype)

    yb = lax.map(one_block, (slot_tok.reshape(n_blocks, MOE_BLOCK), slot_gate.reshape(n_blocks, MOE_BLOCK),
                             block_expert))
    y = jax.ops.segment_sum(yb.reshape(-1, d), slot_tok, num_segments=t + 1)[:t]
    return y.reshape(bsz, n, d)


def setup_inputs(seed: int = 0) -> dict:
    key = jax.random.key(seed)
    ks = jax.random.split(key, 24)
    nrm = jax.random.normal
    f32 = jnp.float32
    D = D_MODEL
    return {
        "x": nrm(ks[0], (BATCH, SEQ, D), f32),
        "c": nrm(ks[1], (BATCH, D), f32),
        "ctx": nrm(ks[2], (BATCH, CTX_LEN, D), f32),
        "c_ctx": nrm(ks[3], (D,), f32),
        "norm_mix_g": 1.0 + 0.01 * nrm(ks[4], (DEPTH, D), f32),
        "norm_ffn_g": 1.0 + 0.01 * nrm(ks[5], (DEPTH, D), f32),
        "w_mod": nrm(ks[6], (DEPTH, D, 6 * D), f32) * (0.3 * D ** -0.5),
        "b_mod": 0.01 * nrm(ks[7], (DEPTH, 6 * D), f32),
        "w_in": nrm(ks[8], (DEPTH, D, IN_COLS), f32) * D ** -0.5,
        "attn_sinks": nrm(ks[9], (DEPTH, A_HEADS), f32),
        "lb_fwd_logits": nrm(ks[10], (DEPTH + 1, B_KEY_WIDTH), f32),
        "lb_bwd_logits": nrm(ks[11], (DEPTH + 1, B_KEY_WIDTH), f32),
        "hgrn_norm_g": 1.0 + 0.01 * nrm(ks[12], (DEPTH, B_WIDTH), f32),
        "w_branch": nrm(ks[13], (DEPTH, N_BRANCHES, BRANCH_WIDTH, D), f32) * BRANCH_WIDTH ** -0.5,
        "w_out": nrm(ks[14], (DEPTH, D, D), f32) * D ** -0.5,
        "w_router": nrm(ks[15], (DEPTH, D, N_EXPERTS), f32) * D ** -0.5,
        "b_router": 0.01 * nrm(ks[16], (DEPTH, N_EXPERTS), f32),
        "w_e_gate": nrm(ks[17], (DEPTH, N_EXPERTS, D, EXPERT_FF), f32) * D ** -0.5,
        "b_e_gate": 0.01 * nrm(ks[18], (DEPTH, N_EXPERTS, EXPERT_FF), f32),
        "w_e_up": nrm(ks[19], (DEPTH, N_EXPERTS, D, EXPERT_FF), f32) * D ** -0.5,
        "b_e_up": 0.01 * nrm(ks[20], (DEPTH, N_EXPERTS, EXPERT_FF), f32),
        "w_e_down": nrm(ks[21], (DEPTH, N_EXPERTS, EXPERT_FF, D), f32) * EXPERT_FF ** -0.5,
        "b_e_down": 0.01 * nrm(ks[22], (DEPTH, N_EXPERTS, D), f32),
        "final_norm_g": 1.0 + 0.01 * nrm(ks[23], (D,), f32),
    }


def reference(x, c, ctx, c_ctx, norm_mix_g, norm_ffn_g, w_mod, b_mod, w_in, attn_sinks,
              lb_fwd_logits, lb_bwd_logits, hgrn_norm_g, w_branch, w_out, w_router, b_router,
              w_e_gate, b_e_gate, w_e_up, b_e_up, w_e_down, b_e_down, final_norm_g):
    bsz, n, _ = x.shape
    cos, sin = axial_rope_tables(n)
    lb_f_all = jnp.cumsum(jax.nn.softmax(lb_fwd_logits.astype(jnp.float32), axis=0), axis=0)
    lb_b_all = jnp.cumsum(jax.nn.softmax(lb_bwd_logits.astype(jnp.float32), axis=0), axis=0)
    for l in range(DEPTH):
        last = l == DEPTH - 1
        mod_lat = (jax.nn.silu(c) @ w_mod[l] + b_mod[l]).reshape(bsz, 6, 1, D_MODEL)
        mod_ctx = (jax.nn.silu(c_ctx) @ w_mod[l] + b_mod[l]).reshape(6, 1, 1, D_MODEL)
        h_l = modulate(rms_norm(x, norm_mix_g[l]), mod_lat[:, 0], mod_lat[:, 1])
        h_c = modulate(rms_norm(ctx, norm_mix_g[l]), mod_ctx[0], mod_ctx[1])
        y_l, y_c = hybrid_mixer(h_l, h_c, w_in[l], attn_sinks[l], lb_f_all[l], lb_b_all[l], hgrn_norm_g[l],
                                w_branch[l], w_out[l], cos, sin, not last)
        x = x + mod_lat[:, 2] * y_l
        h2 = modulate(rms_norm(x, norm_ffn_g[l]), mod_lat[:, 3], mod_lat[:, 4])
        x = x + mod_lat[:, 5] * moe_ffn(h2, w_router[l], b_router[l], w_e_gate[l], b_e_gate[l],
                                        w_e_up[l], b_e_up[l], w_e_down[l], b_e_down[l])
        if not last:
            ctx = ctx + mod_ctx[2] * y_c
            h2c = modulate(rms_norm(ctx, norm_ffn_g[l]), mod_ctx[3], mod_ctx[4])
            ctx = ctx + mod_ctx[5] * moe_ffn(h2c, w_router[l], b_router[l], w_e_gate[l], b_e_gate[l],
                                             w_e_up[l], b_e_up[l], w_e_down[l], b_e_down[l])
    return rms_norm(x, final_norm_g)
```

```cpp
#include <hip/hip_runtime.h>
#include <cstdio>
#include <cstdint>

#define DI __device__ __forceinline__
#define LAS __attribute__((address_space(3)))
typedef unsigned short bf16;
typedef short bf16x8 __attribute__((ext_vector_type(8)));
typedef float f32x2 __attribute__((ext_vector_type(2)));
typedef float f32x4 __attribute__((ext_vector_type(4)));
typedef float f32x16 __attribute__((ext_vector_type(16)));
typedef unsigned u32x2 __attribute__((ext_vector_type(2)));
typedef unsigned u32x4 __attribute__((ext_vector_type(4)));
typedef __bf16 bf16x2_t __attribute__((ext_vector_type(2)));

DI unsigned pk2(float lo, float hi) { f32x2 v = {lo, hi}; bf16x2_t b = __builtin_convertvector(v, bf16x2_t); return __builtin_bit_cast(unsigned, b); }
DI float bf2f(unsigned short b) { return __uint_as_float(((unsigned)b) << 16); }
DI float bflo(unsigned w) { return __uint_as_float(w << 16); }
DI float bfhi(unsigned w) { return __uint_as_float(w & 0xffff0000u); }
DI unsigned short f2bf(float f) { return (unsigned short)(pk2(f, 0.f) & 0xffffu); }
DI float wave_sum(float v) {
#pragma unroll
    for (int o = 1; o < 64; o <<= 1) v += __shfl_xor(v, o);
    return v;
}
DI float sigmoidf_(float x) { return 1.0f / (1.0f + __expf(-x)); }
#define LDS_WAIT() asm volatile("s_waitcnt lgkmcnt(0)" ::: "memory")
#define VM_WAIT() asm volatile("s_waitcnt vmcnt(0)" ::: "memory")

constexpr int D = 2048, NTOK = 16384, NCTX = 256, MROWS = NTOK + NCTX;
constexpr int INC = 10496;
constexpr int C_AQ = 0, C_AK = 1024, C_AV = 1152, C_BQ = 1280, C_ZF = 2304, C_ZB = 3328, C_BV = 4352, C_BG = 5376, C_GA = 6400, C_GB = 8448;
constexpr int NEXP = 32, FF = 2048;
constexpr int MAXTILES = 288, MAXSLOTS = MAXTILES * 256;
constexpr float EPS = 1e-6f;
constexpr int NSEG = 33;
constexpr int NWAVES = 8;

constexpr size_t MiB = 1u << 20;
constexpr size_t WS_CTL = 0, CTL_ZERO_BYTES = 1 * MiB;
constexpr size_t WS_SMALL = 1 * MiB;
constexpr size_t SM_MODL = 0, SM_MODC = 49152, SM_ROPE = 65536, SM_LB = 131072, SM_WRP = 262144, SM_CVEC = 524288, SM_TILE = 528384;
constexpr size_t WS_ROUTE = 2 * MiB;
constexpr size_t RT_E = 0, RT_G = 262144, RT_R = 524288, RT_S = 786432, RT_OFF = 1048576, RT_SG = 1048576 + 294912;
constexpr size_t WS_DLOG = 4 * MiB;
constexpr size_t WS_KR = 5 * MiB, WS_VT = 10 * MiB;
constexpr size_t WS_L = 16 * MiB;
constexpr size_t WS_WIN = 50 * MiB, WS_WM = 92 * MiB, WS_WO = 100 * MiB, WS_WGU = 108 * MiB, WS_WDN = 620 * MiB;
constexpr size_t WS_H = 876 * MiB, WS_PROJ = 942 * MiB, WS_ACT = WS_PROJ, WS_YAB = 1276 * MiB, WS_OSCR = 1340 * MiB, WS_MERGED = 1468 * MiB, WS_X1 = 1532 * MiB, WS_YS = 1660 * MiB, WS_END = 1948 * MiB;
static_assert(WS_L + (size_t)16 * NSEG * 65536 <= WS_WIN, "L");
static_assert(WS_PROJ + (size_t)MROWS * INC * 2 <= WS_YAB && WS_ACT + (size_t)MAXSLOTS * FF * 2 <= WS_YAB, "proj/act");
static_assert(WS_H + (size_t)MROWS * D * 2 <= WS_PROJ, "h");
constexpr int CW_BAR = 4096, CW_CNT = 8192;

constexpr int LDS_BYTES = 163840;
constexpr int MISC_OFF = 163840 - 256;

namespace pg8 {
constexpr int BM = 256, BK = 64, HALF = 128, HTB = HALF * BK * 2, STAGE_BYTES = 8 * HTB, NXCD = 8, WGM = 8;
__host__ __device__ __forceinline__ int lds_byte(int r, int c) { const int st = (r >> 4) * 2 + (c >> 5), rr = r & 15, cc = c & 31, ob = rr * 64 + cc * 2; return st * 1024 + (ob ^ (((ob >> 9) & 1) << 5)); }
__host__ __device__ __forceinline__ void stage_rc(int b, int& R, int& C) { const int st = b / 1024, sb = b % 1024, swz = sb ^ (((sb >> 9) & 1) << 5); R = (st >> 1) * 16 + swz / 64; C = (st & 1) * 32 + (swz % 64) / 2; }
__host__ __device__ __forceinline__ int perm32(int rho) { const int n = rho >> 4, i = rho & 15; return 8 * (i >> 2) + 4 * n + (i & 3); }

struct Unit { int pm, pn, e, brow; };
struct Gemm { const bf16* A; const bf16* Bt; int K; };

struct OrderBase {
    int nM, nN, nwg, G, c;
    DI void init(int nM_, int nN_, int G_, int c_) { nM = nM_; nN = nN_; nwg = nM * nN; G = G_; c = c_; }
    DI bool tile(int i, int& pm, int& pn) const {
        const long L = (long)i * G + c; if (L >= nwg) return false;
        int wgid = (int)L; { const int q = nwg / NXCD, r = nwg % NXCD, xcd = wgid % NXCD, off = wgid / NXCD; wgid = (xcd < r ? xcd * (q + 1) : r * (q + 1) + (xcd - r) * q) + off; }
        const int nig = WGM * nN, gid = wgid / nig, fm = gid * WGM, gsz = (nM - fm) < WGM ? (nM - fm) : WGM;
        pm = fm + ((wgid % nig) % gsz); pn = (wgid % nig) / gsz; return true;
    }
};
struct PlainOrder : OrderBase {
    int K2;
    DI bool next(int i, Unit& u) const { if (!tile(i, u.pm, u.pn)) return false; u.e = 0; u.brow = u.pn * BM; return true; }
    DI unsigned rowoff(const Unit& u, int r) const { return (unsigned)(u.pm * BM + r) * (unsigned)K2; }
};
template <bool GATHER> struct MoeOrder : OrderBase {
    int K2, nper;
    const int* tile_expert; const unsigned* slot_rowoff;
    DI bool next(int i, Unit& u) const { if (!tile(i, u.pm, u.pn)) return false; u.e = tile_expert[u.pm]; u.brow = u.e * nper + u.pn * BM; return true; }
    DI unsigned rowoff(const Unit& u, int r) const { if (GATHER) return slot_rowoff[u.pm * BM + r]; else return (unsigned)(u.pm * BM + r) * (unsigned)K2; }
};

template <class Epi, class Sched, bool ALIGN_EPI = true, bool SP2 = true>
__device__ __forceinline__ void gemm_phase(LAS unsigned char* lds, const Gemm g, const Sched& S, const Epi& E) {
    const int tid = threadIdx.x, wid = __builtin_amdgcn_readfirstlane(tid >> 6), lane = tid & 63, wr = wid >> 2, wc = wid & 3, fr = lane & 15, fq = lane >> 4;
    const int K = g.K, nt = K / BK;
    int stR[2]; unsigned stC2[2], voffB[2];
#pragma unroll
    for (int i = 0; i < 2; ++i) { int R, C; stage_rc(tid * 16 + i * 8192, R, C); const int Rb = Epi::PERM ? ((R & ~31) + perm32(R & 31)) : R;
        stR[i] = R; stC2[i] = (unsigned)C * 2u; voffB[i] = (unsigned)(Rb * K + C) * 2u; }
    const size_t kstep = (size_t)(BK * 2);
    const size_t hstep = (size_t)HALF * K * 2;
    const unsigned ldsw = (unsigned)wid * 1024u;
    const int aoffL = lds_byte(wr * 64 + fr, fq * 8), boffL = lds_byte(wc * 32 + fr, fq * 8);
#define PG8_SA(b, h) (((b) * 2 + (h)) * HTB)
#define PG8_SB(b, h) ((4 + (b) * 2 + (h)) * HTB)
#define PG8_STAGE(bufoff, gbase, voff) do { _Pragma("unroll") for (int _i = 0; _i < 2; ++_i) \
        __builtin_amdgcn_global_load_lds((const unsigned*)((const char*)(gbase) + (voff)[_i]), (LAS unsigned*)(lds + (bufoff) + ldsw + _i * 8192), 16, 0, 0); } while (0)
#define PG8_LDA(dst, b, h) do { _Pragma("unroll") for (int m = 0; m < 4; ++m) _Pragma("unroll") for (int k = 0; k < 2; ++k) dst[m][k] = *(const LAS bf16x8*)(lds + PG8_SA(b, h) + aoffL + m * 2048 + k * 1024); } while (0)
#define PG8_LDB(dst, b, h) do { _Pragma("unroll") for (int n = 0; n < 2; ++n) _Pragma("unroll") for (int k = 0; k < 2; ++k) dst[n][k] = *(const LAS bf16x8*)(lds + PG8_SB(b, h) + boffL + n * 2048 + k * 1024); } while (0)
#define PG8_MMA(ai, bj, At, Bt) do { __builtin_amdgcn_s_setprio(1); _Pragma("unroll") for (int m = 0; m < 4; ++m) _Pragma("unroll") for (int n = 0; n < 2; ++n) _Pragma("unroll") for (int k = 0; k < 2; ++k) \
        acc[ai][bj][m][n] = __builtin_amdgcn_mfma_f32_16x16x32_bf16(Bt[n][k], At[m][k], acc[ai][bj][m][n], 0, 0, 0); __builtin_amdgcn_s_setprio(0); } while (0)
#define PG8_WAIT_V(n) asm volatile("s_waitcnt vmcnt(" #n ")" ::: "memory")
#define PG8_WAIT_L(n) asm volatile("s_waitcnt lgkmcnt(" #n ")" ::: "memory")
#define PG8_BAR __builtin_amdgcn_s_barrier()
#define PG8_SCHED __builtin_amdgcn_sched_barrier(0)
    Unit cur, nxt; int ui = 0;
    if (!S.next(0, cur)) return;
    f32x4 acc[2][2][4][2];
#pragma unroll
    for (int a = 0; a < 2; ++a)
#pragma unroll
        for (int b = 0; b < 2; ++b)
#pragma unroll
            for (int m = 0; m < 4; ++m)
#pragma unroll
                for (int n = 0; n < 2; ++n) acc[a][b][m][n] = (f32x4){0.f, 0.f, 0.f, 0.f};
    bf16x8 At[4][2], B0[2][2], B1[2][2];
    unsigned ao0[2], ao1[2], no0[2], no1[2];
#pragma unroll
    for (int i = 0; i < 2; ++i) { ao0[i] = S.rowoff(cur, stR[i]) + stC2[i]; ao1[i] = S.rowoff(cur, HALF + stR[i]) + stC2[i]; no0[i] = ao0[i]; no1[i] = ao1[i]; }
    const char* Ab = (const char*)g.A;
    const char* cB = (const char*)g.Bt + (size_t)cur.brow * K * 2;
    if constexpr (SP2) {
        PG8_STAGE(PG8_SB(0, 0), cB, voffB); PG8_STAGE(PG8_SB(0, 1), cB + hstep, voffB); PG8_STAGE(PG8_SA(0, 0), Ab, ao0); PG8_STAGE(PG8_SA(0, 1), Ab, ao1);
        if (wr == 1) PG8_BAR;
        PG8_WAIT_V(2); PG8_BAR;
        PG8_STAGE(PG8_SB(1, 0), cB + kstep, voffB); PG8_STAGE(PG8_SA(1, 0), Ab + kstep, ao0); PG8_STAGE(PG8_SB(1, 1), cB + hstep + kstep, voffB);
        PG8_WAIT_V(6); PG8_BAR;
    } else {
        PG8_STAGE(PG8_SB(0, 0), cB, voffB); PG8_STAGE(PG8_SA(0, 0), Ab, ao0); PG8_STAGE(PG8_SB(0, 1), cB + hstep, voffB); PG8_STAGE(PG8_SA(0, 1), Ab, ao1);
        if (wr == 1) PG8_BAR;
        PG8_WAIT_V(4); PG8_BAR;
        PG8_STAGE(PG8_SB(1, 0), cB + kstep, voffB); PG8_STAGE(PG8_SA(1, 0), Ab + kstep, ao0); PG8_STAGE(PG8_SB(1, 1), cB + hstep + kstep, voffB);
        PG8_WAIT_V(6); PG8_BAR;
    }
    for (;;) {
        const bool has_next = S.next(ui + 1, nxt);
        if (has_next) {
#pragma unroll
            for (int i = 0; i < 2; ++i) { no0[i] = S.rowoff(nxt, stR[i]) + stC2[i]; no1[i] = S.rowoff(nxt, HALF + stR[i]) + stC2[i]; }
        }
        const char* nB = has_next ? (const char*)g.Bt + (size_t)nxt.brow * K * 2 : cB;
        for (int t = 0; t < nt; t += 2) {
            const bool last = (t == nt - 2);
            if constexpr (Epi::HOOK) { if (t == nt / 2) E.hook(acc, cur, wr, wc, fr, fq); }
            const char* a1 = Ab + (size_t)(t + 1) * kstep;
            const char* a2 = last ? Ab : Ab + (size_t)(t + 2) * kstep; const char* b2 = last ? nB : cB + (size_t)(t + 2) * kstep;
            const char* a3 = a2 + kstep; const char* b3 = b2 + kstep;
            unsigned x0[2], x1[2];
#pragma unroll
            for (int i = 0; i < 2; ++i) { x0[i] = last ? no0[i] : ao0[i]; x1[i] = last ? no1[i] : ao1[i]; }
            if constexpr (SP2) {
            PG8_LDB(B0, 0, 0); PG8_LDB(B1, 0, 1); PG8_SCHED; PG8_LDA(At, 0, 0); PG8_STAGE(PG8_SA(1, 1), a1, ao1);
            PG8_WAIT_V(8); PG8_WAIT_L(0); PG8_BAR; PG8_MMA(0, 0, At, B0); PG8_MMA(0, 1, At, B1); PG8_BAR; PG8_SCHED;
            PG8_LDA(At, 0, 1); PG8_STAGE(PG8_SB(0, 0), b2, voffB); PG8_STAGE(PG8_SB(0, 1), b2 + hstep, voffB); PG8_STAGE(PG8_SA(0, 0), a2, x0);
            PG8_WAIT_V(8); PG8_WAIT_L(0); PG8_BAR; PG8_MMA(1, 0, At, B0); PG8_MMA(1, 1, At, B1); PG8_BAR; PG8_SCHED;
            PG8_LDB(B0, 1, 0); PG8_LDB(B1, 1, 1); PG8_SCHED; PG8_LDA(At, 1, 0); PG8_STAGE(PG8_SA(0, 1), a2, x1);
            PG8_WAIT_V(8); PG8_WAIT_L(0); PG8_BAR; PG8_MMA(0, 0, At, B0); PG8_MMA(0, 1, At, B1); PG8_BAR; PG8_SCHED;
            PG8_LDA(At, 1, 1); PG8_STAGE(PG8_SB(1, 0), b3, voffB); PG8_STAGE(PG8_SB(1, 1), b3 + hstep, voffB); PG8_STAGE(PG8_SA(1, 0), a3, x0);
            PG8_WAIT_V(8); PG8_WAIT_L(0); PG8_BAR; PG8_MMA(1, 0, At, B0); PG8_MMA(1, 1, At, B1); PG8_BAR; PG8_SCHED;
            } else {
            PG8_LDB(B0, 0, 0); PG8_SCHED; PG8_LDA(At, 0, 0); PG8_STAGE(PG8_SA(1, 1), a1, ao1);
            PG8_WAIT_L(8); PG8_BAR; PG8_WAIT_L(0); PG8_MMA(0, 0, At, B0); PG8_BAR; PG8_SCHED;
            PG8_LDB(B1, 0, 1); PG8_STAGE(PG8_SB(0, 0), b2, voffB);
            PG8_BAR; PG8_WAIT_L(0); PG8_MMA(0, 1, At, B1); PG8_BAR;
            PG8_LDA(At, 0, 1); PG8_STAGE(PG8_SA(0, 0), a2, x0);
            PG8_BAR; PG8_WAIT_L(0); PG8_MMA(1, 0, At, B0); PG8_BAR; PG8_SCHED;
            PG8_STAGE(PG8_SB(0, 1), b2 + hstep, voffB);
            PG8_WAIT_V(6); PG8_BAR; PG8_MMA(1, 1, At, B1); PG8_BAR;
            PG8_LDB(B0, 1, 0); PG8_SCHED; PG8_LDA(At, 1, 0); PG8_STAGE(PG8_SA(0, 1), a2, x1);
            PG8_WAIT_L(8); PG8_BAR; PG8_WAIT_L(0); PG8_MMA(0, 0, At, B0); PG8_BAR; PG8_SCHED;
            PG8_LDB(B1, 1, 1); PG8_STAGE(PG8_SB(1, 0), b3, voffB);
            PG8_BAR; PG8_WAIT_L(0); PG8_MMA(0, 1, At, B1); PG8_BAR;
            PG8_LDA(At, 1, 1); PG8_STAGE(PG8_SA(1, 0), a3, x0);
            PG8_BAR; PG8_WAIT_L(0); PG8_MMA(1, 0, At, B0); PG8_BAR; PG8_SCHED;
            PG8_STAGE(PG8_SB(1, 1), b3 + hstep, voffB);
            PG8_WAIT_V(6); PG8_BAR; PG8_MMA(1, 1, At, B1); PG8_BAR;
            }
        }
        if constexpr (ALIGN_EPI) { if (wr == 0) PG8_BAR; }
        E(acc, cur, wr, wc, fr, fq);
        if (!has_next) break;
#pragma unroll
        for (int a = 0; a < 2; ++a)
#pragma unroll
            for (int b = 0; b < 2; ++b)
#pragma unroll
                for (int m = 0; m < 4; ++m)
#pragma unroll
                    for (int n = 0; n < 2; ++n) acc[a][b][m][n] = (f32x4){0.f, 0.f, 0.f, 0.f};
        cur = nxt; cB = nB; ++ui;
#pragma unroll
        for (int i = 0; i < 2; ++i) { ao0[i] = no0[i]; ao1[i] = no1[i]; }
        if constexpr (ALIGN_EPI) { if (wr == 1) PG8_BAR; }
    }
    PG8_WAIT_V(0);
    if constexpr (!ALIGN_EPI) { if (wr == 0) PG8_BAR; }
    PG8_BAR;
#undef PG8_SA
#undef PG8_SB
#undef PG8_STAGE
#undef PG8_LDA
#undef PG8_LDB
#undef PG8_MMA
#undef PG8_WAIT_V
#undef PG8_WAIT_L
#undef PG8_BAR
#undef PG8_SCHED
}
}

using pg8::Unit; using pg8::HALF; using pg8::BM;
struct EpiProj {
    static constexpr bool PERM = true, HOOK = false;
    bf16* O; const float* lbf; const float* lbb;
    DI void hook(f32x4 (&)[2][2][4][2], const Unit&, int, int, int, int) const {}
    template <int CLS> DI void run(const f32x4 (&acc)[2][2][4][2], const Unit& u, int wr, int wc, int fr, int fq, const float* lb, int cbase) const {
        const int row0 = u.pm * BM + wr * 64 + fr, col0 = u.pn * BM + wc * 32 + 8 * fq;
        float lbv[2][8];
        if (CLS == 2) {
#pragma unroll
            for (int bj = 0; bj < 2; ++bj) { const f32x4 a = *(const f32x4*)(lb + (col0 - cbase) + bj * HALF), b = *(const f32x4*)(lb + (col0 - cbase) + bj * HALF + 4);
                lbv[bj][0] = a[0]; lbv[bj][1] = a[1]; lbv[bj][2] = a[2]; lbv[bj][3] = a[3]; lbv[bj][4] = b[0]; lbv[bj][5] = b[1]; lbv[bj][6] = b[2]; lbv[bj][7] = b[3]; }
        }
#pragma unroll
        for (int ai = 0; ai < 2; ++ai)
#pragma unroll
            for (int m = 0; m < 4; ++m) { bf16* rowp = O + (size_t)(row0 + ai * HALF + m * 16) * INC + col0;
#pragma unroll
                for (int bj = 0; bj < 2; ++bj) { float v[8];
#pragma unroll
                    for (int j = 0; j < 8; ++j) { float x = acc[ai][bj][m][j >> 2][j & 3];
                        if (CLS == 1) x = x * sigmoidf_(x);
                        if (CLS == 2) { const float l = lbv[bj][j]; x = __logf(l + (1.0f - l) * sigmoidf_(x)); }
                        if (CLS == 3) x = sigmoidf_(x);
                        v[j] = x; }
                    u32x4 w; w.x = pk2(v[0], v[1]); w.y = pk2(v[2], v[3]); w.z = pk2(v[4], v[5]); w.w = pk2(v[6], v[7]);
                    *(u32x4*)(rowp + bj * HALF) = w; } }
    }
    DI void operator()(const f32x4 (&acc)[2][2][4][2], const Unit& u, int wr, int wc, int fr, int fq) const {
        const int pn = u.pn;
        if (pn < 5) run<0>(acc, u, wr, wc, fr, fq, nullptr, 0);
        else if (pn < 9) run<1>(acc, u, wr, wc, fr, fq, nullptr, 0);
        else if (pn < 13) run<2>(acc, u, wr, wc, fr, fq, lbf, C_ZF);
        else if (pn < 17) run<2>(acc, u, wr, wc, fr, fq, lbb, C_ZB);
        else if (pn < 21) run<0>(acc, u, wr, wc, fr, fq, nullptr, 0);
        else if (pn < 25) run<1>(acc, u, wr, wc, fr, fq, nullptr, 0);
        else run<3>(acc, u, wr, wc, fr, fq, nullptr, 0);
    }
};
struct EpiMerge {
    static constexpr bool PERM = true, HOOK = true;
    bf16* O; const bf16* proj;
    DI void hook(f32x4 (&acc)[2][2][4][2], const Unit& u, int wr, int wc, int fr, int fq) const {
        int zz = 0; asm volatile("" : "+v"(zz));
        const int row0 = u.pm * BM + wr * 64 + fr + zz, col0 = u.pn * BM + wc * 32 + 8 * fq;
#pragma unroll
        for (int ai = 0; ai < 2; ++ai)
#pragma unroll
            for (int m = 0; m < 4; ++m) { const bf16* rowp = proj + (size_t)(row0 + ai * HALF + m * 16) * INC + col0;
#pragma unroll
                for (int bj = 0; bj < 2; ++bj) { const u32x4 ga = *(const u32x4*)(rowp + C_GA + bj * HALF), gb = *(const u32x4*)(rowp + C_GB + bj * HALF);
#pragma unroll
                    for (int q = 0; q < 4; ++q) { const float r0 = bflo(ga[q]) * __builtin_amdgcn_rcpf(bflo(gb[q])), r1 = bfhi(ga[q]) * __builtin_amdgcn_rcpf(bfhi(gb[q]));
                        acc[ai][bj][m][q >> 1][(q & 1) * 2] *= r0; acc[ai][bj][m][q >> 1][(q & 1) * 2 + 1] *= r1; } }
                asm volatile("" ::: "memory"); }
    }
    DI void operator()(const f32x4 (&acc)[2][2][4][2], const Unit& u, int wr, int wc, int fr, int fq) const {
        const int row0 = u.pm * BM + wr * 64 + fr, col0 = u.pn * BM + wc * 32 + 8 * fq;
#pragma unroll
        for (int ai = 0; ai < 2; ++ai)
#pragma unroll
            for (int m = 0; m < 4; ++m) { const size_t r = (size_t)(row0 + ai * HALF + m * 16);
#pragma unroll
                for (int bj = 0; bj < 2; ++bj) { const u32x4 gb = *(const u32x4*)(proj + r * INC + col0 + C_GB + bj * HALF); u32x4 w;
#pragma unroll
                    for (int q = 0; q < 4; ++q) w[q] = pk2(acc[ai][bj][m][q >> 1][(q & 1) * 2] * bflo(gb[q]), acc[ai][bj][m][q >> 1][(q & 1) * 2 + 1] * bfhi(gb[q]));
                    *(u32x4*)(O + r * D + col0 + bj * HALF) = w; } }
    }
};
struct EpiOut {
    static constexpr bool PERM = false, HOOK = false;
    float* X1; const float* x; const float* mod2;
    DI void hook(f32x4 (&)[2][2][4][2], const Unit&, int, int, int, int) const {}
    DI void operator()(const f32x4 (&acc)[2][2][4][2], const Unit& u, int wr, int wc, int fr, int fq) const {
        const int row0 = u.pm * BM + wr * 64 + fr, col0 = u.pn * BM + wc * 32 + 4 * fq;
        f32x4 mv[2][2];
#pragma unroll
        for (int bj = 0; bj < 2; ++bj)
#pragma unroll
            for (int n = 0; n < 2; ++n) mv[bj][n] = *(const f32x4*)(mod2 + col0 + bj * HALF + n * 16);
#pragma unroll
        for (int ai = 0; ai < 2; ++ai)
#pragma unroll
            for (int m = 0; m < 4; ++m) { const size_t off = (size_t)(row0 + ai * HALF + m * 16) * D + col0;
#pragma unroll
                for (int bj = 0; bj < 2; ++bj)
#pragma unroll
                    for (int n = 0; n < 2; ++n) { const f32x4 xv = *(const f32x4*)(x + off + bj * HALF + n * 16);
                        *(f32x4*)(X1 + off + bj * HALF + n * 16) = xv + mv[bj][n] * acc[ai][bj][m][n]; } }
    }
};
struct EpiAct {
    static constexpr bool PERM = true, HOOK = false;
    bf16* ACT; const float* bg; const float* bu;
    DI void hook(f32x4 (&)[2][2][4][2], const Unit&, int, int, int, int) const {}
    DI void operator()(const f32x4 (&acc)[2][2][4][2], const Unit& u, int wr, int wc, int fr, int fq) const {
        const int row0 = u.pm * BM + wr * 64 + fr, col0 = u.pn * HALF + wc * 32 + 8 * fq;
        float gbv[8], ubv[8];
        { const f32x4 a = *(const f32x4*)(bg + u.e * FF + col0), b = *(const f32x4*)(bg + u.e * FF + col0 + 4), c = *(const f32x4*)(bu + u.e * FF + col0), d = *(const f32x4*)(bu + u.e * FF + col0 + 4);
#pragma unroll
          for (int j = 0; j < 4; ++j) { gbv[j] = a[j]; gbv[4 + j] = b[j]; ubv[j] = c[j]; ubv[4 + j] = d[j]; } }
#pragma unroll
        for (int ai = 0; ai < 2; ++ai)
#pragma unroll
            for (int m = 0; m < 4; ++m) { float v[8];
#pragma unroll
                for (int j = 0; j < 8; ++j) { float gg = acc[ai][0][m][j >> 2][j & 3] + gbv[j], uu = acc[ai][1][m][j >> 2][j & 3] + ubv[j];
                    gg = fminf(gg, 7.0f); uu = fminf(fmaxf(uu, -7.0f), 7.0f);
                    v[j] = gg * sigmoidf_(1.702f * gg) * (uu + 1.0f); }
                u32x4 w; w.x = pk2(v[0], v[1]); w.y = pk2(v[2], v[3]); w.z = pk2(v[4], v[5]); w.w = pk2(v[6], v[7]);
                *(u32x4*)(ACT + (size_t)(row0 + ai * HALF + m * 16) * FF + col0) = w; }
    }
};
struct EpiDown {
    static constexpr bool PERM = true, HOOK = false;
    bf16* YS; const float* bd; const float* sgate;
    DI void hook(f32x4 (&)[2][2][4][2], const Unit&, int, int, int, int) const {}
    DI void operator()(const f32x4 (&acc)[2][2][4][2], const Unit& u, int wr, int wc, int fr, int fq) const {
        const int row0 = u.pm * BM + wr * 64 + fr, col0 = u.pn * BM + wc * 32 + 8 * fq;
        float bv[2][8];
#pragma unroll
        for (int bj = 0; bj < 2; ++bj) { const f32x4 a = *(const f32x4*)(bd + u.e * D + col0 + bj * HALF), b = *(const f32x4*)(bd + u.e * D + col0 + bj * HALF + 4);
#pragma unroll
            for (int j = 0; j < 4; ++j) { bv[bj][j] = a[j]; bv[bj][4 + j] = b[j]; } }
#pragma unroll
        for (int ai = 0; ai < 2; ++ai)
#pragma unroll
            for (int m = 0; m < 4; ++m) { const int r = row0 + ai * HALF + m * 16; const float gt = sgate[r];
#pragma unroll
                for (int bj = 0; bj < 2; ++bj) { u32x4 w;
#pragma unroll
                    for (int q = 0; q < 4; ++q) w[q] = pk2((acc[ai][bj][m][q >> 1][(q & 1) * 2] + bv[bj][2 * q]) * gt, (acc[ai][bj][m][q >> 1][(q & 1) * 2 + 1] + bv[bj][2 * q + 1]) * gt);
                    *(u32x4*)(YS + (size_t)r * D + col0 + bj * HALF) = w; } }
    }
};

#define XB_TMO      128
#define XB_XCNT(j)  (256  + 64 * (j))
#define XB_XSUB(j)  (1280 + 64 * (j))
#define XB_XGEN(j)  (2304 + 64 * (j))
#define XB_TOP      3328
#define XB_TOPGEN   3392
#define XCD_BAR_WORDS 3456
#define XB_SPIN_CAP (1u << 22)
DI unsigned xb_ld(unsigned* p)              { return __hip_atomic_load(p, __ATOMIC_RELAXED, __HIP_MEMORY_SCOPE_AGENT); }
DI unsigned xb_add(unsigned* p, unsigned v) { return __hip_atomic_fetch_add(p, v, __ATOMIC_RELAXED, __HIP_MEMORY_SCOPE_AGENT); }
DI unsigned xb_xcc_id() { return (unsigned)__builtin_amdgcn_s_getreg((3 << 11) | 20) & 0xFu; }
#define XB_SPIN(cond, bar) do { unsigned _sp = 0; while (cond) { __builtin_amdgcn_s_sleep(1); \
    if ((++_sp & 255u) == 0u) { if (xb_ld(&(bar)[XB_TMO])) break; if (_sp > XB_SPIN_CAP) { atomicAdd(&(bar)[XB_TMO], 1u); break; } } } } while (0)
struct XcdBarrier { unsigned* bar; unsigned x; volatile LAS unsigned* st; };
DI XcdBarrier xcd_barrier_post(unsigned* bar, volatile LAS unsigned* st) {
    XcdBarrier b; b.bar = bar; b.x = xb_xcc_id(); b.st = st;
    if (threadIdx.x == 0) (void)xb_add(&bar[XB_XCNT(b.x)], 1u);
    return b;
}
DI void xcd_barrier_complete(unsigned* bar, unsigned x, unsigned& nloc, unsigned& nx) {
    const unsigned G = gridDim.x * gridDim.y * gridDim.z;
    unsigned sum, cnt, mine, sp = 0u;
    for (;;) {
        sum = 0u; cnt = 0u; mine = 0u;
#pragma unroll
        for (unsigned j = 0; j < 16; ++j) { const unsigned c = xb_ld(&bar[XB_XCNT(j)]); sum += c; cnt += (c > 0u) ? 1u : 0u; mine = (j == x) ? c : mine; }
        if (sum == G) break;
        __builtin_amdgcn_s_sleep(1);
        if ((++sp & 255u) == 0u) { if (xb_ld(&bar[XB_TMO])) break; if (sp > XB_SPIN_CAP) { atomicAdd(&bar[XB_TMO], 1u); break; } }
    }
    nloc = mine > 0u ? mine : 1u; nx = cnt > 0u ? cnt : 1u;
}
DI void xcd_barrier(const XcdBarrier& b) {
    asm volatile("s_waitcnt vmcnt(0)" ::: "memory");
    __syncthreads();
    if (threadIdx.x == 0) {
        unsigned* bar = b.bar;
        __builtin_amdgcn_s_waitcnt(0);
        unsigned nloc = b.st[0], nx = b.st[1];
        if (nloc == 0u) { xcd_barrier_complete(bar, b.x, nloc, nx); b.st[0] = nloc; b.st[1] = nx; }
        const unsigned old = xb_add(&bar[XB_XSUB(b.x)], 1u);
        const unsigned gen = old / nloc;
        if (old + 1u == (gen + 1u) * nloc) {
            __builtin_amdgcn_fence(__ATOMIC_RELEASE, "agent");
            asm volatile("s_waitcnt vmcnt(0)" ::: "memory");
            const unsigned og = xb_add(&bar[XB_TOP], 1u);
            const unsigned tg = og / nx;
            if (og + 1u == (tg + 1u) * nx) xb_add(&bar[XB_TOPGEN], 1u);
            else XB_SPIN(xb_ld(&bar[XB_TOPGEN]) == tg, bar);
            __builtin_amdgcn_fence(__ATOMIC_ACQUIRE, "agent");
            xb_add(&bar[XB_XGEN(b.x)], 1u);
            asm volatile("s_waitcnt vmcnt(0)" ::: "memory");
        } else {
            XB_SPIN(xb_ld(&bar[XB_XGEN(b.x)]) == gen, bar);
            __builtin_amdgcn_fence(__ATOMIC_ACQUIRE, "agent");
            asm volatile("s_waitcnt vmcnt(0)" ::: "memory");
        }
    }
    __syncthreads();
}

struct Args {
    const float *x, *c, *ctx, *c_ctx, *norm_mix_g, *norm_ffn_g, *w_mod, *b_mod, *w_in, *sinks, *lbf_logits, *lbb_logits, *hgrn_g, *w_branch, *w_out,
                *w_router, *b_router, *w_e_gate, *b_e_gate, *w_e_up, *b_e_up, *w_e_down, *b_e_down, *final_g;
    float* out; unsigned char* ws; int ph_lo, ph_hi;
};

DI void p0_transpose_item(const float* W, int ldw, bf16* WT, int ldt, LAS float* scr, int lane) {
#pragma unroll 8
    for (int i = 0; i < 32; ++i) { const int kk = 2 * i + (lane >> 5); scr[kk * 33 + (lane & 31)] = W[(size_t)kk * ldw + (lane & 31)]; }
    LDS_WAIT(); asm volatile("" ::: "memory");
    const int c = lane & 7;
#pragma unroll
    for (int j = 0; j < 4; ++j) { const int n = (lane >> 3) + 8 * j; const LAS float* s = scr + (8 * c) * 33 + n;
        u32x4 o; o.x = pk2(s[0 * 33], s[1 * 33]); o.y = pk2(s[2 * 33], s[3 * 33]); o.z = pk2(s[4 * 33], s[5 * 33]); o.w = pk2(s[6 * 33], s[7 * 33]);
        *(u32x4*)(WT + (size_t)n * ldt + 8 * c) = o; }
    LDS_WAIT(); asm volatile("" ::: "memory");
}

constexpr int SC_QH = 0, SC_KH = 8448, SC_KT = 16896, SC_VT = 26112, SC_FAC = 35328, SC_GRP = 35840;
constexpr int RSQ = 264, RST = 72;
DI int crow(int i, int h) { return (i & 3) + 8 * (i >> 2) + 4 * h; }
DI bf16x8 pack8(float a0, float a1, float a2, float a3, float a4, float a5, float a6, float a7) {
    u32x4 p; p.x = pk2(a0, a1); p.y = pk2(a2, a3); p.z = pk2(a4, a5); p.w = pk2(a6, a7); return __builtin_bit_cast(bf16x8, p);
}
DI bf16x8 lds_frag2(const LAS unsigned char* p0, const LAS unsigned char* p1) {
    const u32x2 lo = *(const LAS u32x2*)p0, hi = *(const LAS u32x2*)p1; u32x4 v; v.x = lo.x; v.y = lo.y; v.z = hi.x; v.w = hi.y; return __builtin_bit_cast(bf16x8, v);
}
#define MFMA32(a, b, c) __builtin_amdgcn_mfma_f32_32x32x16_bf16((a), (b), (c), 0, 0, 0)

template <bool OUT>
DI void scan_segment(LAS unsigned char* ldsb, const bf16* proj, int hh, int segF, int segB, float* Lbuf, float* Dlog, float* oscr) {
    const int tid = threadIdx.x, lane = tid & 63, wave = __builtin_amdgcn_readfirstlane(tid >> 6);
    const int dir = wave >> 2, w4 = wave & 3, half = w4 >> 1, d = tid & 127, r = lane & 31, h5 = lane >> 5, e0 = 32 * w4;
    const int seg = dir ? segB : segF, scan = dir * 8 + hh;
    const int ntok = (seg == 0) ? NCTX : 512, sgn = dir ? -1 : 1;
    const int r0 = (seg == 0) ? (dir ? MROWS - 1 : NTOK) : (dir ? NTOK - 1 - (seg - 1) * 512 : (seg - 1) * 512);
    LAS unsigned char* G = ldsb + dir * SC_GRP;
    LAS unsigned char* QH = G + SC_QH; LAS unsigned char* KH = G + SC_KH; LAS unsigned char* KT = G + SC_KT; LAS unsigned char* VT = G + SC_VT; LAS float* FAC = (LAS float*)(G + SC_FAC);
    float* Lslot = Lbuf + (size_t)(scan * NSEG + seg) * 16384;
    f32x16 acc[4];
    if (OUT) {
        const float* Sin = Lbuf + (size_t)(scan * NSEG + seg - 1) * 16384;
#pragma unroll
        for (int dt = 0; dt < 4; ++dt)
#pragma unroll
            for (int i = 0; i < 16; ++i) acc[dt][i] = Sin[(32 * dt + crow(i, h5)) * 128 + e0 + r];
    } else {
#pragma unroll
        for (int dt = 0; dt < 4; ++dt)
#pragma unroll
            for (int i = 0; i < 16; ++i) acc[dt][i] = 0.f;
    }
    float tail_prev = 0.f, dlog_tot = 0.f;
    const int zcol = (dir ? C_ZB : C_ZF) + hh * 128 + d, qcol = C_BQ + hh * 128 + d, vcol = C_BV + hh * 128 + d;
    const int nch = ntok / 32;
    for (int c = 0; c < nch; ++c) {
        const int rb = r0 + sgn * 32 * c;
        float rsum = 0.f, lf[16], vv[16], qq[16];
        if (half) {
#pragma unroll
            for (int s = 0; s < 16; ++s) rsum += bf2f(proj[(size_t)(rb + sgn * s) * INC + zcol]);
        }
#pragma unroll
        for (int i = 0; i < 16; ++i) { const size_t ro = (size_t)(rb + sgn * (16 * half + i)) * INC;
            lf[i] = bf2f(proj[ro + zcol]); vv[i] = bf2f(proj[ro + vcol]); if (OUT) qq[i] = bf2f(proj[ro + qcol]); }
        if (!half) {
#pragma unroll
            for (int i = 0; i < 16; ++i) rsum += lf[i];
        }
        float b = half ? rsum : 0.f, kh[16], qh[16];
#pragma unroll
        for (int i = 0; i < 16; ++i) { b += lf[i]; const float x = b - rsum;
            kh[i] = (1.0f - __expf(lf[i])) * __expf(fminf(-x, 60.f));
            if (OUT) qh[i] = qq[i] * __expf(fminf(x, 60.f)); }
        const float tail = b - rsum;
        __syncthreads();
#pragma unroll
        for (int j = 0; j < 4; ++j) {
            u32x2 w; w.x = pk2(kh[4 * j], kh[4 * j + 1]); w.y = pk2(kh[4 * j + 2], kh[4 * j + 3]); *(LAS u32x2*)(KT + d * RST + 32 * half + 8 * j) = w;
            u32x2 v; v.x = pk2(vv[4 * j], vv[4 * j + 1]); v.y = pk2(vv[4 * j + 2], vv[4 * j + 3]); *(LAS u32x2*)(VT + d * RST + 32 * half + 8 * j) = v;
        }
        if (OUT) {
#pragma unroll
            for (int i = 0; i < 16; ++i) { const int s = 16 * half + i;
                *(LAS unsigned short*)(KH + s * RSQ + d * 2) = f2bf(kh[i]); *(LAS unsigned short*)(QH + s * RSQ + d * 2) = f2bf(qh[i]); }
        }
        if (half) { FAC[d] = __expf(tail_prev + rsum); tail_prev = tail; dlog_tot += rsum + tail; }
        __syncthreads();
#pragma unroll
        for (int dt = 0; dt < 4; ++dt)
#pragma unroll
            for (int g4 = 0; g4 < 4; ++g4) { const f32x4 f = *(const LAS f32x4*)(FAC + 32 * dt + 8 * g4 + 4 * h5);
#pragma unroll
                for (int j = 0; j < 4; ++j) acc[dt][4 * g4 + j] *= f[j]; }
        if (OUT) {
            bf16x8 qf[8];
            f32x16 pT, oT;
#pragma unroll
            for (int i = 0; i < 16; ++i) { pT[i] = 0.f; oT[i] = 0.f; }
#pragma unroll
            for (int kk = 0; kk < 8; ++kk) {
                qf[kk] = lds_frag2(QH + r * RSQ + (16 * kk + 4 * h5) * 2, QH + r * RSQ + (16 * kk + 8 + 4 * h5) * 2);
                const bf16x8 kf = lds_frag2(KH + r * RSQ + (16 * kk + 4 * h5) * 2, KH + r * RSQ + (16 * kk + 8 + 4 * h5) * 2);
                pT = MFMA32(kf, qf[kk], pT);
            }
#pragma unroll
            for (int i = 0; i < 16; ++i) if (crow(i, h5) > r) pT[i] = 0.f;
#pragma unroll
            for (int dt = 0; dt < 4; ++dt)
#pragma unroll
                for (int ks = 0; ks < 2; ++ks) {
                    const bf16x8 sa = pack8(acc[dt][8 * ks], acc[dt][8 * ks + 1], acc[dt][8 * ks + 2], acc[dt][8 * ks + 3], acc[dt][8 * ks + 4], acc[dt][8 * ks + 5], acc[dt][8 * ks + 6], acc[dt][8 * ks + 7]);
                    oT = MFMA32(sa, qf[2 * dt + ks], oT);
                }
#pragma unroll
            for (int ks = 0; ks < 2; ++ks) {
                const bf16x8 pf = pack8(pT[8 * ks], pT[8 * ks + 1], pT[8 * ks + 2], pT[8 * ks + 3], pT[8 * ks + 4], pT[8 * ks + 5], pT[8 * ks + 6], pT[8 * ks + 7]);
                const bf16x8 va = lds_frag2(VT + (e0 + r) * RST + (16 * ks + 4 * h5) * 2, VT + (e0 + r) * RST + (16 * ks + 8 + 4 * h5) * 2);
                oT = MFMA32(va, pf, oT);
            }
            float* orow = oscr + ((size_t)dir * NTOK + (rb + sgn * r)) * 1024 + hh * 128 + e0 + 4 * h5;
#pragma unroll
            for (int g4 = 0; g4 < 4; ++g4) { f32x4 o; o[0] = oT[4 * g4]; o[1] = oT[4 * g4 + 1]; o[2] = oT[4 * g4 + 2]; o[3] = oT[4 * g4 + 3]; *(f32x4*)(orow + 8 * g4) = o; }
        }
#pragma unroll
        for (int ks = 0; ks < 2; ++ks) {
            const bf16x8 vb = lds_frag2(VT + (e0 + r) * RST + (16 * ks + 8 * h5) * 2, VT + (e0 + r) * RST + (16 * ks + 8 * h5) * 2 + 8);
#pragma unroll
            for (int dt = 0; dt < 4; ++dt) {
                const bf16x8 ka = lds_frag2(KT + (32 * dt + r) * RST + (16 * ks + 8 * h5) * 2, KT + (32 * dt + r) * RST + (16 * ks + 8 * h5) * 2 + 8);
                acc[dt] = MFMA32(ka, vb, acc[dt]);
            }
        }
    }
    if (!OUT) {
        __syncthreads();
        if (half) { FAC[d] = __expf(tail_prev); Dlog[(size_t)(scan * NSEG + seg) * 128 + d] = dlog_tot; }
        __syncthreads();
#pragma unroll
        for (int dt = 0; dt < 4; ++dt)
#pragma unroll
            for (int g4 = 0; g4 < 4; ++g4) { const f32x4 f = *(const LAS f32x4*)(FAC + 32 * dt + 8 * g4 + 4 * h5);
#pragma unroll
                for (int j = 0; j < 4; ++j) Lslot[(32 * dt + 8 * g4 + 4 * h5 + j) * 128 + e0 + r] = acc[dt][4 * g4 + j] * f[j]; }
    }
    __syncthreads();
}

constexpr int AT_KC = 0, AT_VC = 36864, AT_KL = 70144, AT_VL = 111616, AT_END = 148992;
constexpr int KRS = 144, VCRS = 520, VLRS = 584;
static_assert(AT_END <= MISC_OFF, "attention LDS");
DI void attn_unit(LAS unsigned char* ldsb, const bf16* proj, const bf16* KR, const bf16* VTg, const float* rope, const float* sinks, bf16* yab, int kvh, int ab) {
    const int tid = threadIdx.x, lane = tid & 63, wave = __builtin_amdgcn_readfirstlane(tid >> 6), r = lane & 31, h5 = lane >> 5;
    const int head = kvh * 8 + wave;
    LAS unsigned char* KC = ldsb + AT_KC; LAS unsigned char* VC = ldsb + AT_VC; LAS unsigned char* KL = ldsb + AT_KL; LAS unsigned char* VL = ldsb + AT_VL;
    const float* rowcos = rope, *rowsin = rope + 4096, *colcos = rope + 8192, *colsin = rope + 8192 + 1024;
    __syncthreads();
    for (int p = tid; p < 2048; p += 512) {
        { const int key = p >> 3, c8 = p & 7; const u32x4 v = *(const u32x4*)(KR + ((size_t)(kvh * MROWS + NTOK + key)) * 64 + c8 * 8); *(LAS u32x4*)(KC + key * KRS + c8 * 16) = v; }
        { const int dd = p >> 5, c = p & 31; const u32x4 v = *(const u32x4*)(VTg + ((size_t)(kvh * 64 + dd)) * MROWS + NTOK + c * 8);
          u32x2 a; a.x = v.x; a.y = v.y; u32x2 b; b.x = v.z; b.y = v.w; *(LAS u32x2*)(VC + dd * VCRS + c * 16) = a; *(LAS u32x2*)(VC + dd * VCRS + c * 16 + 8) = b; }
    }
    const float sc = 0.125f * 1.4426950408889634f;
    for (int qt = 0; qt < 4; ++qt) {
        const int p0 = ab * 128 + 32 * qt, kb0 = p0 - 128;
        __syncthreads();
        for (int p = tid; p < 2304; p += 512) {
            { const int key = p >> 3, c8 = p & 7, pos = kb0 + key;
              if (pos >= 0 && pos < NTOK) { const u32x4 v = *(const u32x4*)(KR + ((size_t)(kvh * MROWS + pos)) * 64 + c8 * 8); *(LAS u32x4*)(KL + key * KRS + c8 * 16) = v; } }
            { const int dd = p / 36, c = p % 36, pos = kb0 + 8 * c;
              if (pos >= 0 && pos < NTOK) { const u32x4 v = *(const u32x4*)(VTg + ((size_t)(kvh * 64 + dd)) * MROWS + pos);
                u32x2 a; a.x = v.x; a.y = v.y; u32x2 b; b.x = v.z; b.y = v.w; *(LAS u32x2*)(VL + dd * VLRS + c * 16) = a; *(LAS u32x2*)(VL + dd * VLRS + c * 16 + 8) = b; } }
        }
        const int qp = p0 + r;
        bf16x8 qf[4];
        {
            const bf16* qrow = proj + (size_t)qp * INC + C_AQ + head * 64 + 8 * h5;
            u32x4 raw[4];
#pragma unroll
            for (int ks = 0; ks < 4; ++ks) raw[ks] = *(const u32x4*)(qrow + 16 * ks);
            float cs[2][8], sn[2][8];
            { const float* c0 = rowcos + (qp >> 6) * 16 + 8 * h5; const float* s0 = rowsin + (qp >> 6) * 16 + 8 * h5;
              const float* c1 = colcos + (qp & 63) * 16 + 8 * h5; const float* s1 = colsin + (qp & 63) * 16 + 8 * h5;
#pragma unroll
              for (int j = 0; j < 8; ++j) { cs[0][j] = c0[j]; sn[0][j] = s0[j]; cs[1][j] = c1[j]; sn[1][j] = s1[j]; } }
#pragma unroll
            for (int ks = 0; ks < 2; ++ks) { float o1[8], o2[8];
#pragma unroll
                for (int q = 0; q < 4; ++q) {
                    const float a0 = bflo(raw[ks][q]), a1 = bfhi(raw[ks][q]), b0 = bflo(raw[ks + 2][q]), b1 = bfhi(raw[ks + 2][q]);
                    o1[2 * q] = a0 * cs[ks][2 * q] - b0 * sn[ks][2 * q]; o2[2 * q] = b0 * cs[ks][2 * q] + a0 * sn[ks][2 * q];
                    o1[2 * q + 1] = a1 * cs[ks][2 * q + 1] - b1 * sn[ks][2 * q + 1]; o2[2 * q + 1] = b1 * cs[ks][2 * q + 1] + a1 * sn[ks][2 * q + 1]; }
                qf[ks] = pack8(o1[0], o1[1], o1[2], o1[3], o1[4], o1[5], o1[6], o1[7]);
                qf[ks + 2] = pack8(o2[0], o2[1], o2[2], o2[3], o2[4], o2[5], o2[6], o2[7]); }
        }
        float m_run = sinks[head] * 1.4426950408889634f, l_run = h5 ? 0.f : 1.f;
        f32x16 o0, o1;
#pragma unroll
        for (int i = 0; i < 16; ++i) { o0[i] = 0.f; o1[i] = 0.f; }
        __syncthreads();
        for (int kt = 0; kt < 17; ++kt) {
            const bool lat = kt >= 8; const int j = kt - 8, kb = kb0 + 32 * j;
            if (lat && (kb < 0 || kb >= NTOK)) continue;
            const LAS unsigned char* Kb = lat ? KL + (32 * j + r) * KRS : KC + (32 * kt + r) * KRS;
            const LAS unsigned char* Vb = lat ? VL + r * VLRS + 64 * j : VC + r * VCRS + 64 * kt;
            const int vrs32 = 32 * (lat ? VLRS : VCRS);
            f32x16 s;
#pragma unroll
            for (int i = 0; i < 16; ++i) s[i] = 0.f;
#pragma unroll
            for (int ks = 0; ks < 4; ++ks) { const bf16x8 kf = *(const LAS bf16x8*)(Kb + (16 * ks + 8 * h5) * 2); s = MFMA32(kf, qf[ks], s); }
            float mt = -INFINITY;
#pragma unroll
            for (int i = 0; i < 16; ++i) { float v = s[i] * sc;
                if (lat) { const int dk = kb + crow(i, h5) - qp; if (dk > 128 || dk < -128) v = -INFINITY; }
                s[i] = v; mt = fmaxf(mt, v); }
            mt = fmaxf(mt, __shfl_xor(mt, 32));
            const float mn = fmaxf(m_run, mt), alpha = __builtin_amdgcn_exp2f(m_run - mn);
            m_run = mn; l_run *= alpha;
#pragma unroll
            for (int i = 0; i < 16; ++i) { o0[i] *= alpha; o1[i] *= alpha; }
            float ps = 0.f;
#pragma unroll
            for (int i = 0; i < 16; ++i) { const float p = __builtin_amdgcn_exp2f(s[i] - mn); s[i] = p; ps += p; }
            l_run += ps;
#pragma unroll
            for (int ks = 0; ks < 2; ++ks) {
                const bf16x8 pf = pack8(s[8 * ks], s[8 * ks + 1], s[8 * ks + 2], s[8 * ks + 3], s[8 * ks + 4], s[8 * ks + 5], s[8 * ks + 6], s[8 * ks + 7]);
                const bf16x8 v0 = lds_frag2(Vb + (16 * ks + 4 * h5) * 2, Vb + (16 * ks + 8 + 4 * h5) * 2);
                const bf16x8 v1 = lds_frag2(Vb + vrs32 + (16 * ks + 4 * h5) * 2, Vb + vrs32 + (16 * ks + 8 + 4 * h5) * 2);
                o0 = MFMA32(v0, pf, o0);
                o1 = MFMA32(v1, pf, o1);
            }
        }
        const float l = l_run + __shfl_xor(l_run, 32), inv = 1.0f / l;
        bf16* orow = yab + (size_t)qp * D + head * 64 + 4 * h5;
#pragma unroll
        for (int g4 = 0; g4 < 4; ++g4) {
            u32x2 a; a.x = pk2(o0[4 * g4] * inv, o0[4 * g4 + 1] * inv); a.y = pk2(o0[4 * g4 + 2] * inv, o0[4 * g4 + 3] * inv); *(u32x2*)(orow + 8 * g4) = a;
            u32x2 b; b.x = pk2(o1[4 * g4] * inv, o1[4 * g4 + 1] * inv); b.y = pk2(o1[4 * g4 + 2] * inv, o1[4 * g4 + 3] * inv); *(u32x2*)(orow + 32 + 8 * g4) = b;
        }
    }
}

__global__ void __launch_bounds__(NWAVES * 64, 2) fwd_kernel(Args a) {
    extern __shared__ __attribute__((aligned(16))) unsigned char lds_raw[];
    LAS unsigned char* lds = (LAS unsigned char*)lds_raw;
    volatile LAS unsigned* MISC = (volatile LAS unsigned*)(lds + MISC_OFF);
    const int tid = threadIdx.x, lane = tid & 63, wave = __builtin_amdgcn_readfirstlane(tid >> 6);
    const int G = gridDim.x, bx = blockIdx.x, vcu = (G % 8 == 0) ? (bx % 8) * (G / 8) + bx / 8 : bx;
    const int gw = vcu * NWAVES + wave, NGW = G * NWAVES;
    const int gtid = vcu * 512 + tid, NGT = G * 512;
    unsigned char* ws = a.ws;
    unsigned* ctl = (unsigned*)(ws + WS_CTL);
    float* modl = (float*)(ws + WS_SMALL + SM_MODL); float* modc = (float*)(ws + WS_SMALL + SM_MODC);
    float* rope = (float*)(ws + WS_SMALL + SM_ROPE); float* lbf = (float*)(ws + WS_SMALL + SM_LB); float* lbb = lbf + 1024;
    float* wrp = (float*)(ws + WS_SMALL + SM_WRP); float* cvec = (float*)(ws + WS_SMALL + SM_CVEC);
    int* tile_expert = (int*)(ws + WS_SMALL + SM_TILE); int* ntiles_p = tile_expert + 512; int* tile_base = tile_expert + 1024;
    int* rt_e = (int*)(ws + WS_ROUTE + RT_E); float* rt_g = (float*)(ws + WS_ROUTE + RT_G); int* rt_r = (int*)(ws + WS_ROUTE + RT_R); int* rt_s = (int*)(ws + WS_ROUTE + RT_S);
    unsigned* slot_rowoff = (unsigned*)(ws + WS_ROUTE + RT_OFF); float* slot_gate = (float*)(ws + WS_ROUTE + RT_SG);
    float* Dlog = (float*)(ws + WS_DLOG); bf16* KR = (bf16*)(ws + WS_KR); bf16* VTg = (bf16*)(ws + WS_VT); float* Lbuf = (float*)(ws + WS_L);
    bf16* WIN = (bf16*)(ws + WS_WIN); bf16* WM = (bf16*)(ws + WS_WM); bf16* WO = (bf16*)(ws + WS_WO); bf16* WGU = (bf16*)(ws + WS_WGU); bf16* WDN = (bf16*)(ws + WS_WDN);
    bf16* H = (bf16*)(ws + WS_H); bf16* PROJ = (bf16*)(ws + WS_PROJ); bf16* ACT = (bf16*)(ws + WS_ACT); bf16* YAB = (bf16*)(ws + WS_YAB);
    float* OSCR = (float*)(ws + WS_OSCR); bf16* MERGED = (bf16*)(ws + WS_MERGED); float* X1 = (float*)(ws + WS_X1); bf16* YS = (bf16*)(ws + WS_YS);

    if (tid < 64) MISC[tid] = 0u;
    __syncthreads();
    XcdBarrier bar = xcd_barrier_post(ctl + CW_BAR, MISC);
    const int lo = a.ph_lo, hi = a.ph_hi;
#ifndef PH_MASK
#define PH_MASK 0x1fff
#endif
#define IN(k) ((((PH_MASK) >> (k)) & 1) && lo <= (k) && (k) < hi)
#define SEAM(k) do { if (IN(k) && IN((k) + 1)) xcd_barrier(bar); } while (0)

    if (IN(0)) {
        LAS float* sc = (LAS float*)lds; LAS float* scc = sc + 2048; LAS f32x4* red = (LAS f32x4*)(lds + 16384);
        if (vcu < 48) {
            for (int k = tid; k < 2048; k += 512) { const float v = a.c[k], u = a.c_ctx[k]; sc[k] = v * sigmoidf_(v); scc[k] = u * sigmoidf_(u); }
            __syncthreads();
            const int cb = vcu, col = 256 * cb + 4 * lane; const bool hasc = cb < 16;
            f32x4 al = {0.f, 0.f, 0.f, 0.f}, ac = {0.f, 0.f, 0.f, 0.f};
#pragma unroll 8
            for (int k = wave; k < 2048; k += 8) { const f32x4 wv = *(const f32x4*)(a.w_mod + (size_t)k * 12288 + col); al += sc[k] * wv; ac += scc[k] * wv; }
            red[wave * 64 + lane] = al; red[512 + wave * 64 + lane] = ac;
            __syncthreads();
            if (wave == 0) { f32x4 s = *(const f32x4*)(a.b_mod + col), t = s;
#pragma unroll
                for (int w = 0; w < 8; ++w) { s += red[w * 64 + lane]; t += red[512 + w * 64 + lane]; }
                *(f32x4*)(modl + col) = s; if (hasc) *(f32x4*)(modc + col) = t; }
            __syncthreads();
        }
        if (vcu == G - 1) {
            for (int i = tid; i < 4096 + 1024; i += 512) { const bool isrow = i < 4096; const int ii = isrow ? i : i - 4096, p = ii >> 4, j = ii & 15;
                const float inv = powf(10000.0f, -(float)j / 16.0f), ang = (float)p * inv; float s, c; sincosf(ang, &s, &c);
                if (isrow) { rope[ii] = c; rope[4096 + ii] = s; } else { rope[8192 + ii] = c; rope[9216 + ii] = s; } }
            for (int i = tid; i < 2048; i += 512) { const float* lg = (i < 1024) ? a.lbf_logits : a.lbb_logits; const int ch = i & 1023;
                const float v = 1.0f / (1.0f + expf(lg[1024 + ch] - lg[ch])); if (i < 1024) lbf[ch] = v; else lbb[ch] = v; }
        }
        LAS float* scr = (LAS float*)(lds + wave * 16384);
        constexpr int I_IN = 32 * 328, I_BR = 2048, I_OUT = 2048, I_E = 32 * 2048;
        constexpr int NITEMS = I_IN + I_BR + I_OUT + 3 * I_E;
        for (int it = gw; it < NITEMS; it += NGW) {
            int r = it;
            if (r < I_IN) { const int kb = r / 328, nb = r % 328; p0_transpose_item(a.w_in + (size_t)(64 * kb) * INC + 32 * nb, INC, WIN + (size_t)(32 * nb) * D + 64 * kb, D, scr, lane); continue; } r -= I_IN;
            if (r < I_BR) { const int br = r >> 10, r2 = r & 1023, kb = r2 >> 6, nb = r2 & 63;
                p0_transpose_item(a.w_branch + (size_t)br * 1024 * D + (size_t)(64 * kb) * D + 32 * nb, D, WM + (size_t)(32 * nb) * D + br * 1024 + 64 * kb, D, scr, lane); continue; } r -= I_BR;
            if (r < I_OUT) { const int kb = r >> 6, nb = r & 63; p0_transpose_item(a.w_out + (size_t)(64 * kb) * D + 32 * nb, D, WO + (size_t)(32 * nb) * D + 64 * kb, D, scr, lane); continue; } r -= I_OUT;
            const int which = r / I_E, r1 = r % I_E, e = r1 >> 11, r2 = r1 & 2047, kb = r2 >> 6, nb = r2 & 63, n0 = 32 * nb;
            const float* src = (which == 0 ? a.w_e_gate : which == 1 ? a.w_e_up : a.w_e_down) + (size_t)e * D * FF + (size_t)(64 * kb) * FF + n0;
            bf16* dst = (which == 2) ? WDN + ((size_t)e * D + n0) * FF + 64 * kb
                                     : WGU + ((size_t)e * 4096 + (n0 >> 7) * 256 + which * 128 + (n0 & 127)) * D + 64 * kb;
            p0_transpose_item(src, FF, dst, D, scr, lane);
        }
    }
    SEAM(0);

    if (IN(1)) {
        {
            f32x4 ca[8], cb[8];
#pragma unroll
            for (int j = 0; j < 8; ++j) { const int k = 4 * lane + 256 * j; const f32x4 g = *(const f32x4*)(a.norm_mix_g + k), s1 = *(const f32x4*)(modl + 2048 + k); ca[j] = g * (1.0f + s1); cb[j] = *(const f32x4*)(modl + k); }
            for (int m = gw; m < NTOK; m += NGW) {
                const float* xr = a.x + (size_t)m * D + 4 * lane; f32x4 v[8]; float ss = 0.f;
#pragma unroll
                for (int j = 0; j < 8; ++j) { v[j] = *(const f32x4*)(xr + 256 * j); ss += v[j][0] * v[j][0] + v[j][1] * v[j][1] + v[j][2] * v[j][2] + v[j][3] * v[j][3]; }
                const float rstd = rsqrtf(wave_sum(ss) * (1.0f / D) + EPS);
                bf16* hr = H + (size_t)m * D + 4 * lane;
#pragma unroll
                for (int j = 0; j < 8; ++j) { const f32x4 o = v[j] * rstd * ca[j] + cb[j]; u32x2 w; w.x = pk2(o[0], o[1]); w.y = pk2(o[2], o[3]); *(u32x2*)(hr + 256 * j) = w; }
            }
        }
        if (gw < NCTX) {
            const int m = gw; const float* xr = a.ctx + (size_t)m * D + 4 * lane; f32x4 v[8]; float ss = 0.f;
#pragma unroll
            for (int j = 0; j < 8; ++j) { v[j] = *(const f32x4*)(xr + 256 * j); ss += v[j][0] * v[j][0] + v[j][1] * v[j][1] + v[j][2] * v[j][2] + v[j][3] * v[j][3]; }
            const float rstd = rsqrtf(wave_sum(ss) * (1.0f / D) + EPS);
            bf16* hr = H + (size_t)(NTOK + m) * D + 4 * lane;
#pragma unroll
            for (int j = 0; j < 8; ++j) { const int k = 4 * lane + 256 * j; const f32x4 g = *(const f32x4*)(a.norm_mix_g + k), s1 = *(const f32x4*)(modc + 2048 + k), s0 = *(const f32x4*)(modc + k);
                const f32x4 o = v[j] * rstd * (g * (1.0f + s1)) + s0; u32x2 w; w.x = pk2(o[0], o[1]); w.y = pk2(o[2], o[3]); *(u32x2*)(hr + 256 * j) = w; }
        }
        for (int i = gtid; i < 2048 * 32; i += NGT) { const int k = i >> 5; wrp[i] = a.norm_ffn_g[k] * (1.0f + modl[4 * 2048 + k]) * a.w_router[i]; }
        if (vcu == G - 1) {
            for (int e = wave * 4; e < wave * 4 + 4; ++e) { float s = 0.f; for (int k = lane; k < 2048; k += 64) s += modl[3 * 2048 + k] * a.w_router[k * 32 + e];
                s = wave_sum(s); if (lane == 0) cvec[e] = s + a.b_router[e]; }
        }
    }
    SEAM(1);

    if (IN(2)) {
        pg8::Gemm g{H, WIN, D}; pg8::PlainOrder S; S.init(MROWS / 256, INC / 256, G, bx); S.K2 = D * 2;
        EpiProj E{PROJ, lbf, lbb};
        pg8::gemm_phase<EpiProj, pg8::PlainOrder>(lds, g, S, E);
    }
    SEAM(2);

    if (IN(3)) {
        for (int i = gtid; i < MROWS * 64; i += NGT) { const int j = i & 31, kvh = (i >> 5) & 1, pos = i >> 6;
            const bf16* kr = PROJ + (size_t)pos * INC + C_AK + kvh * 64; const float k1 = bf2f(kr[j]), k2 = bf2f(kr[j + 32]); float o1 = k1, o2 = k2;
            if (pos < NTOK) { const float cs = (j < 16) ? rope[(pos >> 6) * 16 + j] : rope[8192 + (pos & 63) * 16 + j - 16], sn = (j < 16) ? rope[4096 + (pos >> 6) * 16 + j] : rope[9216 + (pos & 63) * 16 + j - 16];
                o1 = k1 * cs - k2 * sn; o2 = k2 * cs + k1 * sn; }
            bf16* ko = KR + ((size_t)kvh * MROWS + pos) * 64; ko[j] = f2bf(o1); ko[j + 32] = f2bf(o2); }
        for (int i = gtid; i < 2 * (MROWS / 8) * 64; i += NGT) { const int dd = i & 63, pb = (i >> 6) % (MROWS / 8), kvh = (i >> 6) / (MROWS / 8);
            const bf16* vr = PROJ + (size_t)(pb * 8) * INC + C_AV + kvh * 64 + dd; unsigned short t[8];
#pragma unroll
            for (int q = 0; q < 8; ++q) t[q] = vr[(size_t)q * INC];
            u32x4 w; w.x = t[0] | ((unsigned)t[1] << 16); w.y = t[2] | ((unsigned)t[3] << 16); w.z = t[4] | ((unsigned)t[5] << 16); w.w = t[6] | ((unsigned)t[7] << 16);
            *(u32x4*)(VTg + ((size_t)kvh * 64 + dd) * MROWS + pb * 8) = w; }
        for (int it = vcu; it < 8 * NSEG; it += G) { const int hh = it / NSEG, seg = it % NSEG; scan_segment<false>(lds, PROJ, hh, seg, seg, Lbuf, Dlog, nullptr); }
    }
    SEAM(3);

    if (IN(4)) {
        for (int i = gtid; i < 16 * 16384; i += NGT) { const int scan = i >> 14, el = i & 16383, dd = el >> 7; float s = 0.f;
            for (int j = 0; j < NSEG - 1; ++j) { float* slot = Lbuf + (size_t)(scan * NSEG + j) * 16384 + el; s = __expf(Dlog[(scan * NSEG + j) * 128 + dd]) * s + *slot; *slot = s; } }
        for (int u = vcu; u < 256; u += G) attn_unit(lds, PROJ, KR, VTg, rope, a.sinks, YAB, u >> 7, u & 127);
    }
    SEAM(4);

    if (IN(5)) {
        for (int it = vcu; it < 8 * 32; it += G) { const int hh = it >> 5, segF = 1 + (it & 31);
            scan_segment<true>(lds, PROJ, hh, segF, NSEG - segF, Lbuf, Dlog, OSCR);
            VM_WAIT(); __syncthreads();
            for (int i = wave; i < 512; i += 8) { const int row = (segF - 1) * 512 + i, ch = hh * 128 + 2 * lane;
                const f32x2 of = *(const f32x2*)(OSCR + (size_t)row * 1024 + ch), ob = *(const f32x2*)(OSCR + ((size_t)NTOK + row) * 1024 + ch);
                const float o0 = of[0] + ob[0], o1 = of[1] + ob[1]; const float rstd = rsqrtf(wave_sum(o0 * o0 + o1 * o1) * (1.0f / 128.0f) + EPS);
                const unsigned gq = *(const unsigned*)(PROJ + (size_t)row * INC + C_BG + ch); const f32x2 hg = *(const f32x2*)(a.hgrn_g + ch);
                *(unsigned*)(YAB + (size_t)row * D + 1024 + ch) = pk2(o0 * rstd * hg[0] * bflo(gq), o1 * rstd * hg[1] * bfhi(gq)); }
            __syncthreads();
        }
    }
    SEAM(5);

    if (IN(6)) {
        pg8::Gemm g{YAB, WM, D}; pg8::PlainOrder S; S.init(NTOK / 256, D / 256, G, bx); S.K2 = D * 2;
        EpiMerge E{MERGED, PROJ};
        pg8::gemm_phase<EpiMerge, pg8::PlainOrder>(lds, g, S, E);
    }
    SEAM(6);

    if (IN(7)) {
        pg8::Gemm g{MERGED, WO, D}; pg8::PlainOrder S; S.init(NTOK / 256, D / 256, G, bx); S.K2 = D * 2;
        EpiOut E{X1, a.x, modl + 2 * 2048};
        pg8::gemm_phase<EpiOut, pg8::PlainOrder>(lds, g, S, E);
    }
    SEAM(7);

    if (IN(8)) {
        LAS float* part = (LAS float*)lds;
        LAS float* rsd = (LAS float*)(lds + 16384);
        const int r16 = lane & 15, kk = lane >> 4;
        float bw[16][4][2];
#pragma unroll
        for (int kg = 0; kg < 16; ++kg)
#pragma unroll
            for (int m = 0; m < 4; ++m)
#pragma unroll
                for (int eh = 0; eh < 2; ++eh) bw[kg][m][eh] = wrp[(256 * wave + 16 * kg + 4 * kk + m) * 32 + 16 * eh + r16];
        for (int tl = vcu; tl < NTOK / 16; tl += G) {
            const int row0 = tl * 16;
#pragma unroll
            for (int q = 0; q < 2; ++q) { const int m = row0 + 2 * wave + q; const float* xr = X1 + (size_t)m * D + 4 * lane; f32x4 v[8]; float ss = 0.f;
#pragma unroll
                for (int j = 0; j < 8; ++j) { v[j] = *(const f32x4*)(xr + 256 * j); ss += v[j][0] * v[j][0] + v[j][1] * v[j][1] + v[j][2] * v[j][2] + v[j][3] * v[j][3]; }
                const float rstd = rsqrtf(wave_sum(ss) * (1.0f / D) + EPS);
                if (lane == 0) rsd[2 * wave + q] = rstd;
                bf16* hr = H + (size_t)m * D + 4 * lane;
#pragma unroll
                for (int j = 0; j < 8; ++j) { const int k = 4 * lane + 256 * j; const f32x4 g = *(const f32x4*)(a.norm_ffn_g + k), s1 = *(const f32x4*)(modl + 4 * 2048 + k), s0 = *(const f32x4*)(modl + 3 * 2048 + k);
                    const f32x4 o = v[j] * rstd * (g * (1.0f + s1)) + s0; u32x2 w; w.x = pk2(o[0], o[1]); w.y = pk2(o[2], o[3]); *(u32x2*)(hr + 256 * j) = w; } }
            f32x4 acc0 = {0.f, 0.f, 0.f, 0.f}, acc1 = {0.f, 0.f, 0.f, 0.f};
            const float* xa = X1 + (size_t)(row0 + r16) * D + 256 * wave + 4 * kk;
#pragma unroll
            for (int kg = 0; kg < 16; ++kg) { const f32x4 av = *(const f32x4*)(xa + 16 * kg);
#pragma unroll
                for (int m = 0; m < 4; ++m) { acc0 = __builtin_amdgcn_mfma_f32_16x16x4f32(av[m], bw[kg][m][0], acc0, 0, 0, 0); acc1 = __builtin_amdgcn_mfma_f32_16x16x4f32(av[m], bw[kg][m][1], acc1, 0, 0, 0); } }
#pragma unroll
            for (int q = 0; q < 4; ++q) { part[(wave * 16 + 4 * kk + q) * 32 + r16] = acc0[q]; part[(wave * 16 + 4 * kk + q) * 32 + 16 + r16] = acc1[q]; }
            __syncthreads();
            { const int row = tid >> 5, e = tid & 31; float s = 0.f;
#pragma unroll
              for (int w = 0; w < 8; ++w) s += part[(w * 16 + row) * 32 + e];
              float val = rsd[row] * s + cvec[e];
              float tv[4]; int ti[4];
#pragma unroll
              for (int j = 0; j < 4; ++j) { float bv = val; int bi = e;
#pragma unroll
                  for (int off = 16; off >= 1; off >>= 1) { const float ov = __shfl_xor(bv, off); const int oi = __shfl_xor(bi, off); if (ov > bv || (ov == bv && oi < bi)) { bv = ov; bi = oi; } }
                  tv[j] = bv; ti[j] = bi; if (e == bi) val = -INFINITY; }
              const float e1 = __expf(tv[1] - tv[0]), e2 = __expf(tv[2] - tv[0]), e3 = __expf(tv[3] - tv[0]), inv = 1.0f / (1.0f + e1 + e2 + e3);
              const float gt[4] = {inv, e1 * inv, e2 * inv, e3 * inv};
#pragma unroll
              for (int j = 0; j < 4; ++j) if (e == ti[j]) { const int ai = (row0 + row) * 4 + j; const unsigned rk = atomicAdd(ctl + CW_CNT + 16 * e, 1u);
                  rt_e[ai] = e; rt_g[ai] = gt[j]; rt_r[ai] = (int)rk; } }
            __syncthreads();
        }
    }
    SEAM(8);

    if (IN(9)) {
        LAS int* tb = (LAS int*)lds;
        if (tid == 0) { int acc = 0; for (int e = 0; e < NEXP; ++e) { tb[e] = acc; acc += (int)((ctl[CW_CNT + 16 * e] + 255u) >> 8); } tb[NEXP] = acc; }
        __syncthreads();
        for (int i = gtid; i < NTOK * 4; i += NGT) { const int e = rt_e[i], slot = tb[e] * 256 + rt_r[i]; rt_s[i] = slot; slot_rowoff[slot] = (unsigned)(i >> 2) * (unsigned)(D * 2); slot_gate[slot] = rt_g[i]; }
        if (vcu == 0) {
            for (int e = 0; e < NEXP; ++e) { const int cnt = (int)ctl[CW_CNT + 16 * e], s0 = tb[e] * 256 + cnt, s1 = tb[e + 1] * 256;
                for (int s = s0 + tid; s < s1; s += 512) { slot_rowoff[s] = 0u; slot_gate[s] = 0.f; }
                for (int t = tb[e] + tid; t < tb[e + 1]; t += 512) tile_expert[t] = e; }
            if (tid == 0) *ntiles_p = tb[NEXP];
        }
        __syncthreads();
    }
    SEAM(9);

    if (IN(10)) {
        const int ntiles = *ntiles_p;
        pg8::Gemm g{H, WGU, D}; pg8::MoeOrder<true> S; S.init(ntiles, 4096 / 256, G, bx); S.K2 = D * 2; S.nper = 4096; S.tile_expert = tile_expert; S.slot_rowoff = slot_rowoff;
        EpiAct E{ACT, a.b_e_gate, a.b_e_up};
        pg8::gemm_phase<EpiAct, pg8::MoeOrder<true>>(lds, g, S, E);
    }
    SEAM(10);

    if (IN(11)) {
        const int ntiles = *ntiles_p;
        pg8::Gemm g{ACT, WDN, FF}; pg8::MoeOrder<false> S; S.init(ntiles, D / 256, G, bx); S.K2 = FF * 2; S.nper = D; S.tile_expert = tile_expert; S.slot_rowoff = slot_rowoff;
        EpiDown E{YS, a.b_e_down, slot_gate};
        pg8::gemm_phase<EpiDown, pg8::MoeOrder<false>>(lds, g, S, E);
    }
    SEAM(11);

    if (IN(12)) {
        f32x4 fg[8], m5[8];
#pragma unroll
        for (int j = 0; j < 8; ++j) { const int k = 4 * lane + 256 * j; fg[j] = *(const f32x4*)(a.final_g + k); m5[j] = *(const f32x4*)(modl + 5 * 2048 + k); }
        for (int m = gw; m < NTOK; m += NGW) {
            const float* xr = X1 + (size_t)m * D + 4 * lane; f32x4 v[8], y[8];
#pragma unroll
            for (int j = 0; j < 8; ++j) { v[j] = *(const f32x4*)(xr + 256 * j); y[j] = (f32x4){0.f, 0.f, 0.f, 0.f}; }
#pragma unroll
            for (int q = 0; q < 4; ++q) { const int slot = rt_s[m * 4 + q]; const bf16* yr = YS + (size_t)slot * D + 4 * lane;
#pragma unroll
                for (int j = 0; j < 8; ++j) { const u32x2 w = *(const u32x2*)(yr + 256 * j); y[j][0] += bflo(w.x); y[j][1] += bfhi(w.x); y[j][2] += bflo(w.y); y[j][3] += bfhi(w.y); } }
            float ss = 0.f;
#pragma unroll
            for (int j = 0; j < 8; ++j) { v[j] = v[j] + m5[j] * y[j]; ss += v[j][0] * v[j][0] + v[j][1] * v[j][1] + v[j][2] * v[j][2] + v[j][3] * v[j][3]; }
            const float rstd = rsqrtf(wave_sum(ss) * (1.0f / D) + EPS);
            float* orow = a.out + (size_t)m * D + 4 * lane;
#pragma unroll
            for (int j = 0; j < 8; ++j) *(f32x4*)(orow + 256 * j) = v[j] * rstd * fg[j];
        }
    }
#undef IN
#undef SEAM
}

extern "C" void kernel_launch(void* const* d_in, const int* in_sizes, int n_in, void* d_out, int out_size, void* d_ws, size_t ws_size, hipStream_t stream) {
    static int grid = 0;
    if (grid == 0) {
        if (n_in != 24 || out_size != NTOK * D || ws_size < WS_END) { fprintf(stderr, "kernel_launch: unexpected shapes (n_in %d out %d ws %zu)\n", n_in, out_size, ws_size); grid = -1; return; }
        int dev = 0, cus = 0, per_cu = 0;
        if (hipGetDevice(&dev) != hipSuccess || hipDeviceGetAttribute(&cus, hipDeviceAttributeMultiprocessorCount, dev) != hipSuccess) { grid = -1; return; }
        if (hipFuncSetAttribute((const void*)fwd_kernel, hipFuncAttributeMaxDynamicSharedMemorySize, LDS_BYTES) != hipSuccess) { fprintf(stderr, "kernel_launch: hipFuncSetAttribute failed\n"); grid = -1; return; }
        if (hipOccupancyMaxActiveBlocksPerMultiprocessor(&per_cu, (const void*)fwd_kernel, NWAVES * 64, LDS_BYTES) != hipSuccess || per_cu < 1) { fprintf(stderr, "kernel_launch: occupancy query says %d\n", per_cu); (void)hipGetLastError(); grid = -1; return; }
        grid = cus;
    }
    if (grid < 0) return;
    if (hipMemsetAsync((char*)d_ws + WS_CTL, 0, CTL_ZERO_BYTES, stream) != hipSuccess) return;
    Args a{};
    const float** p = (const float**)&a;
    for (int i = 0; i < 24; ++i) p[i] = (const float*)d_in[i];
    a.out = (float*)d_out; a.ws = (unsigned char*)d_ws; a.ph_lo = 0; a.ph_hi = 13;
    hipLaunchKernelGGL(fwd_kernel, dim3(grid), dim3(NWAVES * 64), LDS_BYTES, stream, a);
    const hipError_t le = hipPeekAtLastError();
    if (le != hipSuccess) fprintf(stderr, "kernel_launch: launch failed: %s\n", hipGetErrorName(le));
}
```

```cpp
#include <hip/hip_runtime.h>
#include <cstdio>
#include <cstdint>

#define DI __device__ __forceinline__
#define LAS __attribute__((address_space(3)))
typedef unsigned short bf16;
typedef short bf16x8 __attribute__((ext_vector_type(8)));
typedef float f32x2 __attribute__((ext_vector_type(2)));
typedef float f32x4 __attribute__((ext_vector_type(4)));
typedef float f32x16 __attribute__((ext_vector_type(16)));
typedef unsigned u32x2 __attribute__((ext_vector_type(2)));
typedef unsigned u32x4 __attribute__((ext_vector_type(4)));
typedef __bf16 bf16x2_t __attribute__((ext_vector_type(2)));
typedef int i32x4 __attribute__((ext_vector_type(4)));

DI unsigned pk2(float lo, float hi) { f32x2 v = {lo, hi}; bf16x2_t b = __builtin_convertvector(v, bf16x2_t); return __builtin_bit_cast(unsigned, b); }
DI float bf2f(unsigned short b) { return __uint_as_float(((unsigned)b) << 16); }
DI float bflo(unsigned w) { return __uint_as_float(w << 16); }
DI float bfhi(unsigned w) { return __uint_as_float(w & 0xffff0000u); }
DI unsigned short f2bf(float f) { return (unsigned short)(pk2(f, 0.f) & 0xffffu); }
DI float wave_sum(float v) {
#pragma unroll
    for (int o = 1; o < 64; o <<= 1) v += __shfl_xor(v, o);
    return v;
}
DI float sigmoidf_(float x) { return 1.0f / (1.0f + __expf(-x)); }
#define LDS_WAIT() asm volatile("s_waitcnt lgkmcnt(0)" ::: "memory")
#define VM_WAIT() asm volatile("s_waitcnt vmcnt(0)" ::: "memory")

constexpr int D = 2048, NTOK = 16384, NCTX = 256, MROWS = NTOK + NCTX;
constexpr int INC = 10496;
constexpr int C_AQ = 0, C_AK = 1024, C_AV = 1152, C_BQ = 1280, C_ZF = 2304, C_ZB = 3328, C_BV = 4352, C_BG = 5376, C_GA = 6400, C_GB = 8448;
constexpr int NEXP = 32, FF = 2048;
constexpr int MAXTILES = 288, MAXSLOTS = MAXTILES * 256;
constexpr float EPS = 1e-6f;
constexpr int NSEG = 33;
constexpr int NWAVES = 8;
#ifndef DUP0
#define DUP0 1
#endif
#ifndef DUP3
#define DUP3 1
#endif
#ifndef DUP4
#define DUP4 1
#endif
#ifndef DUP5
#define DUP5 1
#endif

constexpr size_t MiB = 1u << 20;
constexpr size_t WS_CTL = 0, CTL_ZERO_BYTES = 1 * MiB;
constexpr size_t WS_SMALL = 1 * MiB;
constexpr size_t SM_MODL = 0, SM_MODC = 49152, SM_ROPE = 65536, SM_LB = 131072, SM_WRP = 262144, SM_CVEC = 524288, SM_TILE = 528384;
constexpr size_t WS_ROUTE = 2 * MiB;
constexpr size_t RT_E = 0, RT_G = 262144, RT_R = 524288, RT_S = 786432, RT_OFF = 1048576, RT_SG = 1048576 + 294912;
constexpr size_t WS_DLOG = 4 * MiB;
constexpr size_t WS_KR = 5 * MiB, WS_VT = 10 * MiB;
constexpr size_t WS_CS = 15 * MiB;
constexpr size_t CS_ROW = 524288, CS_SLOT = 524288 + 65536;
constexpr size_t WS_L = 16 * MiB;
constexpr size_t WS_WIN = 50 * MiB, WS_WM = 92 * MiB, WS_WO = 100 * MiB, WS_WGU = 108 * MiB, WS_WDN = 620 * MiB;
constexpr size_t WS_H = 876 * MiB, WS_PROJ = 942 * MiB, WS_ACT = WS_PROJ, WS_YAB = 1276 * MiB, WS_OSCR = 1340 * MiB, WS_MERGED = 1468 * MiB, WS_X1 = 1532 * MiB, WS_YS = 1660 * MiB, WS_END = 1948 * MiB;
constexpr size_t PO_AQ = 0, PO_AKV = PO_AQ + (size_t)16 * MROWS * 64, PO_BQ = PO_AKV + (size_t)MROWS * 256, PO_ZF = PO_BQ + (size_t)8 * MROWS * 128, PO_ZB = PO_ZF + (size_t)8 * MROWS * 128,
                 PO_BV = PO_ZB + (size_t)8 * MROWS * 128, PO_BG = PO_BV + (size_t)8 * MROWS * 128, PO_GA = PO_BG + (size_t)8 * MROWS * 128, PO_GB = PO_GA + (size_t)MROWS * 2048, PO_END = PO_GB + (size_t)MROWS * 2048;
static_assert(PO_END == (size_t)MROWS * INC, "projection layout");
static_assert(WS_L + (size_t)16 * NSEG * 65536 <= WS_WIN, "L");
static_assert(WS_PROJ + (size_t)MROWS * INC * 2 <= WS_YAB && WS_ACT + (size_t)MAXSLOTS * FF * 2 <= WS_YAB, "proj/act");
static_assert(WS_H + (size_t)MROWS * D * 2 <= WS_PROJ, "h");
constexpr int CW_BAR = 4096, CW_CNT = 8192;

constexpr int LDS_BYTES = 163840;
constexpr int MISC_OFF = 163840 - 256;

namespace pg8 {
constexpr int BM = 256, BK = 64, HALF = 128, HTB = HALF * BK * 2, STAGE_BYTES = 8 * HTB, NXCD = 8, WGM = 8;
__host__ __device__ __forceinline__ int lds_byte(int r, int c) { const int st = (r >> 4) * 2 + (c >> 5), rr = r & 15, cc = c & 31, ob = rr * 64 + cc * 2; return st * 1024 + (ob ^ (((ob >> 9) & 1) << 5)); }
__host__ __device__ __forceinline__ void stage_rc(int b, int& R, int& C) { const int st = b / 1024, sb = b % 1024, swz = sb ^ (((sb >> 9) & 1) << 5); R = (st >> 1) * 16 + swz / 64; C = (st & 1) * 32 + (swz % 64) / 2; }
__host__ __device__ __forceinline__ int perm32(int rho) { const int n = rho >> 4, i = rho & 15; return 8 * (i >> 2) + 4 * n + (i & 3); }

struct Unit { int pm, pn, e, brow; };
struct Gemm { const bf16* A; const bf16* Bt; int K; };

struct OrderBase {
    int nM, nN, nwg, G, c;
    DI void init(int nM_, int nN_, int G_, int c_) { nM = nM_; nN = nN_; nwg = nM * nN; G = G_; c = c_; }
    DI bool tile(int i, int& pm, int& pn) const {
        const long L = (long)i * G + c; if (L >= nwg) return false;
        int wgid = (int)L; { const int q = nwg / NXCD, r = nwg % NXCD, xcd = wgid % NXCD, off = wgid / NXCD; wgid = (xcd < r ? xcd * (q + 1) : r * (q + 1) + (xcd - r) * q) + off; }
        const int nig = WGM * nN, gid = wgid / nig, fm = gid * WGM, gsz = (nM - fm) < WGM ? (nM - fm) : WGM;
        pm = fm + ((wgid % nig) % gsz); pn = (wgid % nig) / gsz; return true;
    }
};
struct PlainOrder : OrderBase {
    int K2;
    DI bool next(int i, Unit& u) const { if (!tile(i, u.pm, u.pn)) return false; u.e = 0; u.brow = u.pn * BM; return true; }
    DI unsigned rowoff(const Unit& u, int r) const { return (unsigned)(u.pm * BM + r) * (unsigned)K2; }
};
template <bool GATHER> struct MoeOrder : OrderBase {
    int K2, nper;
    const int* texp; const unsigned* sroff;
    DI bool next(int i, Unit& u) const { if (!tile(i, u.pm, u.pn)) return false; u.e = texp[u.pm]; u.brow = u.e * nper + u.pn * BM; return true; }
    DI unsigned rowoff(const Unit& u, int r) const { if (GATHER) return sroff[u.pm * BM + r]; else return (unsigned)(u.pm * BM + r) * (unsigned)K2; }
};

template <class Epi, class Sched, bool I8 = false, bool ALIGN_EPI = true, bool SP2 = true>
__device__ __forceinline__ void gemm_phase(LAS unsigned char* lds, const Gemm g, const Sched& S, const Epi& E) {
    const int tid = threadIdx.x, wid = __builtin_amdgcn_readfirstlane(tid >> 6), lane = tid & 63, wr = wid >> 2, wc = wid & 3, fr = lane & 15, fq = lane >> 4;
    const int K = g.K, nt = K / BK;
    int stR[2]; unsigned stC2[2], voffB[2];
#pragma unroll
    for (int i = 0; i < 2; ++i) { int R, C; stage_rc(tid * 16 + i * 8192, R, C); const int Rb = Epi::PERM ? ((R & ~31) + perm32(R & 31)) : R;
        stR[i] = R; stC2[i] = (unsigned)C * 2u; voffB[i] = (unsigned)(Rb * K + C) * 2u; }
    const size_t kstep = (size_t)(BK * 2);
    const size_t hstep = (size_t)HALF * K * 2;
    const unsigned ldsw = (unsigned)wid * 1024u;
    const int aoffL = lds_byte(wr * 64 + fr, fq * 8), boffL = lds_byte(wc * 32 + fr, fq * 8);
#define PG8_SA(b, h) (((b) * 2 + (h)) * HTB)
#define PG8_SB(b, h) ((4 + (b) * 2 + (h)) * HTB)
#define PG8_STAGE(bufoff, gbase, voff) do { _Pragma("unroll") for (int _i = 0; _i < 2; ++_i) \
        __builtin_amdgcn_global_load_lds((const unsigned*)((const char*)(gbase) + (voff)[_i]), (LAS unsigned*)(lds + (bufoff) + ldsw + _i * 8192), 16, 0, 0); } while (0)
#define PG8_LDA(dst, b, h) do { _Pragma("unroll") for (int m = 0; m < 4; ++m) _Pragma("unroll") for (int k = 0; k < 2; ++k) dst[m][k] = *(const LAS bf16x8*)(lds + PG8_SA(b, h) + aoffL + m * 2048 + k * 1024); } while (0)
#define PG8_LDB(dst, b, h) do { _Pragma("unroll") for (int n = 0; n < 2; ++n) _Pragma("unroll") for (int k = 0; k < 2; ++k) dst[n][k] = *(const LAS bf16x8*)(lds + PG8_SB(b, h) + boffL + n * 2048 + k * 1024); } while (0)
#define PG8_MMA(ai, bj, At, Bt) do { __builtin_amdgcn_s_setprio(1); _Pragma("unroll") for (int m = 0; m < 4; ++m) _Pragma("unroll") for (int n = 0; n < 2; ++n) _Pragma("unroll") for (int k = 0; k < 2; ++k) \
        { if constexpr (I8) acc[ai][bj][m][n] = __builtin_bit_cast(f32x4, __builtin_amdgcn_mfma_i32_16x16x64_i8(__builtin_bit_cast(i32x4, Bt[n][k]), __builtin_bit_cast(i32x4, At[m][k]), __builtin_bit_cast(i32x4, acc[ai][bj][m][n]), 0, 0, 0)); \
          else acc[ai][bj][m][n] = __builtin_amdgcn_mfma_f32_16x16x32_bf16(Bt[n][k], At[m][k], acc[ai][bj][m][n], 0, 0, 0); } __builtin_amdgcn_s_setprio(0); } while (0)
#define PG8_WAIT_V(n) asm volatile("s_waitcnt vmcnt(" #n ")" ::: "memory")
#define PG8_WAIT_L(n) asm volatile("s_waitcnt lgkmcnt(" #n ")" ::: "memory")
#define PG8_BAR __builtin_amdgcn_s_barrier()
#define PG8_SCHED __builtin_amdgcn_sched_barrier(0)
    Unit cur, nxt; int ui = 0;
    if (!S.next(0, cur)) return;
    f32x4 acc[2][2][4][2];
#pragma unroll
    for (int a = 0; a < 2; ++a)
#pragma unroll
        for (int b = 0; b < 2; ++b)
#pragma unroll
            for (int m = 0; m < 4; ++m)
#pragma unroll
                for (int n = 0; n < 2; ++n) acc[a][b][m][n] = (f32x4){0.f, 0.f, 0.f, 0.f};
    bf16x8 At[4][2], B0[2][2], B1[2][2];
    unsigned ao0[2], ao1[2], no0[2], no1[2];
#pragma unroll
    for (int i = 0; i < 2; ++i) { ao0[i] = S.rowoff(cur, stR[i]) + stC2[i]; ao1[i] = S.rowoff(cur, HALF + stR[i]) + stC2[i]; no0[i] = ao0[i]; no1[i] = ao1[i]; }
    const char* Ab = (const char*)g.A;
    const char* cB = (const char*)g.Bt + (size_t)cur.brow * K * 2;
    if constexpr (SP2) {
        PG8_STAGE(PG8_SB(0, 0), cB, voffB); PG8_STAGE(PG8_SB(0, 1), cB + hstep, voffB); PG8_STAGE(PG8_SA(0, 0), Ab, ao0); PG8_STAGE(PG8_SA(0, 1), Ab, ao1);
        if (wr == 1) PG8_BAR;
        PG8_WAIT_V(2); PG8_BAR;
        PG8_STAGE(PG8_SB(1, 0), cB + kstep, voffB); PG8_STAGE(PG8_SA(1, 0), Ab + kstep, ao0); PG8_STAGE(PG8_SB(1, 1), cB + hstep + kstep, voffB);
        PG8_WAIT_V(6); PG8_BAR;
    } else {
        PG8_STAGE(PG8_SB(0, 0), cB, voffB); PG8_STAGE(PG8_SA(0, 0), Ab, ao0); PG8_STAGE(PG8_SB(0, 1), cB + hstep, voffB); PG8_STAGE(PG8_SA(0, 1), Ab, ao1);
        if (wr == 1) PG8_BAR;
        PG8_WAIT_V(4); PG8_BAR;
        PG8_STAGE(PG8_SB(1, 0), cB + kstep, voffB); PG8_STAGE(PG8_SA(1, 0), Ab + kstep, ao0); PG8_STAGE(PG8_SB(1, 1), cB + hstep + kstep, voffB);
        PG8_WAIT_V(6); PG8_BAR;
    }
    for (;;) {
        const bool has_next = S.next(ui + 1, nxt);
        if (has_next) {
#pragma unroll
            for (int i = 0; i < 2; ++i) { no0[i] = S.rowoff(nxt, stR[i]) + stC2[i]; no1[i] = S.rowoff(nxt, HALF + stR[i]) + stC2[i]; }
        }
        const char* nB = has_next ? (const char*)g.Bt + (size_t)nxt.brow * K * 2 : cB;
        for (int t = 0; t < nt; t += 2) {
            const bool last = (t == nt - 2);
            if constexpr (Epi::HOOK) { if (t == nt / 2) E.hook(acc, cur, wr, wc, fr, fq); }
            const char* a1 = Ab + (size_t)(t + 1) * kstep;
            const char* a2 = last ? Ab : Ab + (size_t)(t + 2) * kstep; const char* b2 = last ? nB : cB + (size_t)(t + 2) * kstep;
            const char* a3 = a2 + kstep; const char* b3 = b2 + kstep;
            unsigned x0[2], x1[2];
#pragma unroll
            for (int i = 0; i < 2; ++i) { x0[i] = last ? no0[i] : ao0[i]; x1[i] = last ? no1[i] : ao1[i]; }
            if constexpr (SP2) {
            PG8_LDB(B0, 0, 0); PG8_LDB(B1, 0, 1); PG8_SCHED; PG8_LDA(At, 0, 0); PG8_STAGE(PG8_SA(1, 1), a1, ao1);
            PG8_WAIT_V(8); PG8_WAIT_L(0); PG8_BAR; PG8_MMA(0, 0, At, B0); PG8_MMA(0, 1, At, B1); PG8_BAR; PG8_SCHED;
            PG8_LDA(At, 0, 1); PG8_STAGE(PG8_SB(0, 0), b2, voffB); PG8_STAGE(PG8_SB(0, 1), b2 + hstep, voffB); PG8_STAGE(PG8_SA(0, 0), a2, x0);
            PG8_WAIT_V(8); PG8_WAIT_L(0); PG8_BAR; PG8_MMA(1, 0, At, B0); PG8_MMA(1, 1, At, B1); PG8_BAR; PG8_SCHED;
            PG8_LDB(B0, 1, 0); PG8_LDB(B1, 1, 1); PG8_SCHED; PG8_LDA(At, 1, 0); PG8_STAGE(PG8_SA(0, 1), a2, x1);
            PG8_WAIT_V(8); PG8_WAIT_L(0); PG8_BAR; PG8_MMA(0, 0, At, B0); PG8_MMA(0, 1, At, B1); PG8_BAR; PG8_SCHED;
            PG8_LDA(At, 1, 1); PG8_STAGE(PG8_SB(1, 0), b3, voffB); PG8_STAGE(PG8_SB(1, 1), b3 + hstep, voffB); PG8_STAGE(PG8_SA(1, 0), a3, x0);
            PG8_WAIT_V(8); PG8_WAIT_L(0); PG8_BAR; PG8_MMA(1, 0, At, B0); PG8_MMA(1, 1, At, B1); PG8_BAR; PG8_SCHED;
            } else {
            PG8_LDB(B0, 0, 0); PG8_SCHED; PG8_LDA(At, 0, 0); PG8_STAGE(PG8_SA(1, 1), a1, ao1);
            PG8_WAIT_L(8); PG8_BAR; PG8_WAIT_L(0); PG8_MMA(0, 0, At, B0); PG8_BAR; PG8_SCHED;
            PG8_LDB(B1, 0, 1); PG8_STAGE(PG8_SB(0, 0), b2, voffB);
            PG8_BAR; PG8_WAIT_L(0); PG8_MMA(0, 1, At, B1); PG8_BAR;
            PG8_LDA(At, 0, 1); PG8_STAGE(PG8_SA(0, 0), a2, x0);
            PG8_BAR; PG8_WAIT_L(0); PG8_MMA(1, 0, At, B0); PG8_BAR; PG8_SCHED;
            PG8_STAGE(PG8_SB(0, 1), b2 + hstep, voffB);
            PG8_WAIT_V(6); PG8_BAR; PG8_MMA(1, 1, At, B1); PG8_BAR;
            PG8_LDB(B0, 1, 0); PG8_SCHED; PG8_LDA(At, 1, 0); PG8_STAGE(PG8_SA(0, 1), a2, x1);
            PG8_WAIT_L(8); PG8_BAR; PG8_WAIT_L(0); PG8_MMA(0, 0, At, B0); PG8_BAR; PG8_SCHED;
            PG8_LDB(B1, 1, 1); PG8_STAGE(PG8_SB(1, 0), b3, voffB);
            PG8_BAR; PG8_WAIT_L(0); PG8_MMA(0, 1, At, B1); PG8_BAR;
            PG8_LDA(At, 1, 1); PG8_STAGE(PG8_SA(1, 0), a3, x0);
            PG8_BAR; PG8_WAIT_L(0); PG8_MMA(1, 0, At, B0); PG8_BAR; PG8_SCHED;
            PG8_STAGE(PG8_SB(1, 1), b3 + hstep, voffB);
            PG8_WAIT_V(6); PG8_BAR; PG8_MMA(1, 1, At, B1); PG8_BAR;
            }
        }
        if constexpr (ALIGN_EPI) { if (wr == 0) PG8_BAR; }
        E(acc, cur, wr, wc, fr, fq);
        if (!has_next) break;
#pragma unroll
        for (int a = 0; a < 2; ++a)
#pragma unroll
            for (int b = 0; b < 2; ++b)
#pragma unroll
                for (int m = 0; m < 4; ++m)
#pragma unroll
                    for (int n = 0; n < 2; ++n) acc[a][b][m][n] = (f32x4){0.f, 0.f, 0.f, 0.f};
        cur = nxt; cB = nB; ++ui;
#pragma unroll
        for (int i = 0; i < 2; ++i) { ao0[i] = no0[i]; ao1[i] = no1[i]; }
        if constexpr (ALIGN_EPI) { if (wr == 1) PG8_BAR; }
    }
    PG8_WAIT_V(0);
    if constexpr (!ALIGN_EPI) { if (wr == 0) PG8_BAR; }
    PG8_BAR;
#undef PG8_SA
#undef PG8_SB
#undef PG8_STAGE
#undef PG8_LDA
#undef PG8_LDB
#undef PG8_MMA
#undef PG8_WAIT_V
#undef PG8_WAIT_L
#undef PG8_BAR
#undef PG8_SCHED
}
}

using pg8::Unit; using pg8::HALF; using pg8::BM;
struct EpiProj {
    static constexpr bool PERM = true, HOOK = false;
    bf16* P; const float* lbf; const float* lbb;
    DI void hook(f32x4 (&)[2][2][4][2], const Unit&, int, int, int, int) const {}
    DI void operator()(const f32x4 (&acc)[2][2][4][2], const Unit& u, int wr, int wc, int fr, int fq) const {
        const int pn = u.pn; int cls, cbase, hs, pitch; size_t po; const float* lb = lbf;
        if (pn < 4)       { cls = 0; cbase = C_AQ; po = PO_AQ;  hs = 6;  pitch = 64; }
        else if (pn < 5)  { cls = 0; cbase = C_AK; po = PO_AKV; hs = 30; pitch = 256; }
        else if (pn < 9)  { cls = 1; cbase = C_BQ; po = PO_BQ;  hs = 7;  pitch = 128; }
        else if (pn < 13) { cls = 2; cbase = C_ZF; po = PO_ZF;  hs = 7;  pitch = 128; }
        else if (pn < 17) { cls = 2; cbase = C_ZB; po = PO_ZB;  hs = 7;  pitch = 128; lb = lbb; }
        else if (pn < 21) { cls = 0; cbase = C_BV; po = PO_BV;  hs = 7;  pitch = 128; }
        else if (pn < 25) { cls = 1; cbase = C_BG; po = PO_BG;  hs = 7;  pitch = 128; }
        else if (pn < 33) { cls = 3; cbase = C_GA; po = PO_GA;  hs = 30; pitch = 2048; }
        else              { cls = 3; cbase = C_GB; po = PO_GB;  hs = 30; pitch = 2048; }
        int zz = 0; asm volatile("" : "+v"(zz));
        const int row0 = u.pm * BM + wr * 64 + fr + zz, cin0 = u.pn * BM + wc * 32 + 8 * fq - cbase;
        bf16* base = P + po;
#pragma unroll
        for (int bj = 0; bj < 2; ++bj) {
            float lbv[8];
            const int cin = cin0 + bj * HALF;
            { const int ci = (cls == 2) ? cin : 0; const f32x4 a = *(const f32x4*)(lb + ci), b = *(const f32x4*)(lb + ci + 4);
#pragma unroll
              for (int j = 0; j < 4; ++j) { lbv[j] = (cls == 2) ? a[j] : 0.f; lbv[4 + j] = (cls == 2) ? b[j] : 0.f; } }
            bf16* colp = base + (size_t)(cin >> hs) * MROWS * pitch + (cin & ((1 << hs) - 1));
#pragma unroll
            for (int ai = 0; ai < 2; ++ai)
#pragma unroll
                for (int m = 0; m < 4; ++m) { const size_t ro = (size_t)(row0 + ai * HALF + m * 16) * pitch; float v[8];
#pragma unroll
                    for (int j = 0; j < 8; ++j) { const float x = acc[ai][bj][m][j >> 2][j & 3], sg = sigmoidf_(x), l = lbv[j], lg = __logf(l + (1.0f - l) * sg);
                        v[j] = (cls == 0) ? x : (cls == 1) ? x * sg : (cls == 2) ? lg : sg; }
                    u32x4 w; w.x = pk2(v[0], v[1]); w.y = pk2(v[2], v[3]); w.z = pk2(v[4], v[5]); w.w = pk2(v[6], v[7]);
                    *(u32x4*)(colp + ro) = w; }
        }
    }
};
struct EpiMerge {
    static constexpr bool PERM = true, HOOK = true;
    bf16* O; const bf16* proj;
    DI void hook(f32x4 (&acc)[2][2][4][2], const Unit& u, int wr, int wc, int fr, int fq) const {
        int zz = 0; asm volatile("" : "+v"(zz));
        const int row0 = u.pm * BM + wr * 64 + fr + zz, col0 = u.pn * BM + wc * 32 + 8 * fq;
#pragma unroll
        for (int ai = 0; ai < 2; ++ai)
#pragma unroll
            for (int m = 0; m < 4; ++m) { const size_t rowp = (size_t)(row0 + ai * HALF + m * 16) * D + col0;
#pragma unroll
                for (int bj = 0; bj < 2; ++bj) { const u32x4 ga = *(const u32x4*)(proj + PO_GA + rowp + bj * HALF), gb = *(const u32x4*)(proj + PO_GB + rowp + bj * HALF);
#pragma unroll
                    for (int q = 0; q < 4; ++q) { const float r0 = bflo(ga[q]) * __builtin_amdgcn_rcpf(bflo(gb[q])), r1 = bfhi(ga[q]) * __builtin_amdgcn_rcpf(bfhi(gb[q]));
                        acc[ai][bj][m][q >> 1][(q & 1) * 2] *= r0; acc[ai][bj][m][q >> 1][(q & 1) * 2 + 1] *= r1; } }
                asm volatile("" ::: "memory"); }
    }
    DI void operator()(const f32x4 (&acc)[2][2][4][2], const Unit& u, int wr, int wc, int fr, int fq) const {
        const int row0 = u.pm * BM + wr * 64 + fr, col0 = u.pn * BM + wc * 32 + 8 * fq;
#pragma unroll
        for (int ai = 0; ai < 2; ++ai)
#pragma unroll
            for (int m = 0; m < 4; ++m) { const size_t r = (size_t)(row0 + ai * HALF + m * 16);
#pragma unroll
                for (int bj = 0; bj < 2; ++bj) { const u32x4 gb = *(const u32x4*)(proj + PO_GB + r * D + col0 + bj * HALF); u32x4 w;
#pragma unroll
                    for (int q = 0; q < 4; ++q) w[q] = pk2(acc[ai][bj][m][q >> 1][(q & 1) * 2] * bflo(gb[q]), acc[ai][bj][m][q >> 1][(q & 1) * 2 + 1] * bfhi(gb[q]));
                    *(u32x4*)(O + r * D + col0 + bj * HALF) = w; } }
    }
};
struct EpiOut {
    static constexpr bool PERM = false, HOOK = false;
    float* X1; const float* x; const float* mod2;
    DI void hook(f32x4 (&)[2][2][4][2], const Unit&, int, int, int, int) const {}
    DI void operator()(const f32x4 (&acc)[2][2][4][2], const Unit& u, int wr, int wc, int fr, int fq) const {
        const int row0 = u.pm * BM + wr * 64 + fr, col0 = u.pn * BM + wc * 32 + 4 * fq;
        f32x4 mv[2][2];
#pragma unroll
        for (int bj = 0; bj < 2; ++bj)
#pragma unroll
            for (int n = 0; n < 2; ++n) mv[bj][n] = *(const f32x4*)(mod2 + col0 + bj * HALF + n * 16);
#pragma unroll
        for (int ai = 0; ai < 2; ++ai)
#pragma unroll
            for (int m = 0; m < 4; ++m) { const size_t off = (size_t)(row0 + ai * HALF + m * 16) * D + col0;
#pragma unroll
                for (int bj = 0; bj < 2; ++bj)
#pragma unroll
                    for (int n = 0; n < 2; ++n) { const f32x4 xv = *(const f32x4*)(x + off + bj * HALF + n * 16);
                        *(f32x4*)(X1 + off + bj * HALF + n * 16) = xv + mv[bj][n] * acc[ai][bj][m][n]; } }
    }
};
struct EpiAct {
    static constexpr bool PERM = true, HOOK = false;
    bf16* ACTp; const float* bg; const float* bu; const float* cs; const float* srs;
    DI void hook(f32x4 (&)[2][2][4][2], const Unit&, int, int, int, int) const {}
    DI void operator()(const f32x4 (&acc)[2][2][4][2], const Unit& u, int wr, int wc, int fr, int fq) const {
        int zz = 0; asm volatile("" : "+v"(zz));
        const int row0 = u.pm * BM + wr * 64 + fr + zz, col0 = u.pn * HALF + wc * 32 + 8 * fq, nb = u.e * 4096 + u.pn * BM + wc * 32 + 8 * fq;
        float gbv[8], ubv[8], gsc[8], usc[8];
        { const f32x4 a = *(const f32x4*)(bg + u.e * FF + col0), b = *(const f32x4*)(bg + u.e * FF + col0 + 4), c = *(const f32x4*)(bu + u.e * FF + col0), d = *(const f32x4*)(bu + u.e * FF + col0 + 4);
          const f32x4 sa = *(const f32x4*)(cs + nb), sb = *(const f32x4*)(cs + nb + 4), sc = *(const f32x4*)(cs + nb + HALF), sd = *(const f32x4*)(cs + nb + HALF + 4);
#pragma unroll
          for (int j = 0; j < 4; ++j) { gbv[j] = a[j]; gbv[4 + j] = b[j]; ubv[j] = c[j]; ubv[4 + j] = d[j]; gsc[j] = sa[j]; gsc[4 + j] = sb[j]; usc[j] = sc[j]; usc[4 + j] = sd[j]; } }
#pragma unroll
        for (int ai = 0; ai < 2; ++ai)
#pragma unroll
            for (int m = 0; m < 4; ++m) { float v[8]; const int r = row0 + ai * HALF + m * 16; const float rs = srs[r];
#pragma unroll
                for (int j = 0; j < 8; ++j) { const i32x4 ga = __builtin_bit_cast(i32x4, acc[ai][0][m][j >> 2]), ua = __builtin_bit_cast(i32x4, acc[ai][1][m][j >> 2]);
                    float gg = (float)ga[j & 3] * (rs * gsc[j]) + gbv[j], uu = (float)ua[j & 3] * (rs * usc[j]) + ubv[j];
                    gg = fminf(gg, 7.0f); uu = fminf(fmaxf(uu, -7.0f), 7.0f);
                    v[j] = gg * sigmoidf_(1.702f * gg) * (uu + 1.0f); }
                u32x4 w; w.x = pk2(v[0], v[1]); w.y = pk2(v[2], v[3]); w.z = pk2(v[4], v[5]); w.w = pk2(v[6], v[7]);
                *(u32x4*)(ACTp + (size_t)r * FF + col0) = w; }
    }
};
struct EpiDown {
    static constexpr bool PERM = true, HOOK = false;
    bf16* YS; const float* bd; const float* sgate;
    DI void hook(f32x4 (&)[2][2][4][2], const Unit&, int, int, int, int) const {}
    DI void operator()(const f32x4 (&acc)[2][2][4][2], const Unit& u, int wr, int wc, int fr, int fq) const {
        const int row0 = u.pm * BM + wr * 64 + fr, col0 = u.pn * BM + wc * 32 + 8 * fq;
        float bv[2][8];
#pragma unroll
        for (int bj = 0; bj < 2; ++bj) { const f32x4 a = *(const f32x4*)(bd + u.e * D + col0 + bj * HALF), b = *(const f32x4*)(bd + u.e * D + col0 + bj * HALF + 4);
#pragma unroll
            for (int j = 0; j < 4; ++j) { bv[bj][j] = a[j]; bv[bj][4 + j] = b[j]; } }
#pragma unroll
        for (int ai = 0; ai < 2; ++ai)
#pragma unroll
            for (int m = 0; m < 4; ++m) { const int r = row0 + ai * HALF + m * 16; const float gt = sgate[r];
#pragma unroll
                for (int bj = 0; bj < 2; ++bj) { u32x4 w;
#pragma unroll
                    for (int q = 0; q < 4; ++q) w[q] = pk2((acc[ai][bj][m][q >> 1][(q & 1) * 2] + bv[bj][2 * q]) * gt, (acc[ai][bj][m][q >> 1][(q & 1) * 2 + 1] + bv[bj][2 * q + 1]) * gt);
                    *(u32x4*)(YS + (size_t)r * D + col0 + bj * HALF) = w; } }
    }
};

#define XB_TMO      128
#define XB_XCNT(j)  (256  + 64 * (j))
#define XB_XSUB(j)  (1280 + 64 * (j))
#define XB_XGEN(j)  (2304 + 64 * (j))
#define XB_TOP      3328
#define XB_TOPGEN   3392
#define XCD_BAR_WORDS 3456
#define XB_SPIN_CAP (1u << 22)
DI unsigned xb_ld(unsigned* p)              { return __hip_atomic_load(p, __ATOMIC_RELAXED, __HIP_MEMORY_SCOPE_AGENT); }
DI unsigned xb_add(unsigned* p, unsigned v) { return __hip_atomic_fetch_add(p, v, __ATOMIC_RELAXED, __HIP_MEMORY_SCOPE_AGENT); }
DI unsigned xb_xcc_id() { return (unsigned)__builtin_amdgcn_s_getreg((3 << 11) | 20) & 0xFu; }
#define XB_SPIN(cond, bar) do { unsigned _sp = 0; while (cond) { __builtin_amdgcn_s_sleep(1); \
    if ((++_sp & 255u) == 0u) { if (xb_ld(&(bar)[XB_TMO])) break; if (_sp > XB_SPIN_CAP) { atomicAdd(&(bar)[XB_TMO], 1u); break; } } } } while (0)
struct XcdBarrier { unsigned* bar; unsigned x; volatile LAS unsigned* st; };
DI XcdBarrier xcd_barrier_post(unsigned* bar, volatile LAS unsigned* st) {
    XcdBarrier b; b.bar = bar; b.x = xb_xcc_id(); b.st = st;
    if (threadIdx.x == 0) (void)xb_add(&bar[XB_XCNT(b.x)], 1u);
    return b;
}
DI void xcd_barrier_complete(unsigned* bar, unsigned x, unsigned& nloc, unsigned& nx) {
    const unsigned G = gridDim.x * gridDim.y * gridDim.z;
    unsigned sum, cnt, mine, sp = 0u;
    for (;;) {
        sum = 0u; cnt = 0u; mine = 0u;
#pragma unroll
        for (unsigned j = 0; j < 16; ++j) { const unsigned c = xb_ld(&bar[XB_XCNT(j)]); sum += c; cnt += (c > 0u) ? 1u : 0u; mine = (j == x) ? c : mine; }
        if (sum == G) break;
        __builtin_amdgcn_s_sleep(1);
        if ((++sp & 255u) == 0u) { if (xb_ld(&bar[XB_TMO])) break; if (sp > XB_SPIN_CAP) { atomicAdd(&bar[XB_TMO], 1u); break; } }
    }
    nloc = mine > 0u ? mine : 1u; nx = cnt > 0u ? cnt : 1u;
}
DI void xcd_barrier(const XcdBarrier& b) {
    asm volatile("s_waitcnt vmcnt(0)" ::: "memory");
    __syncthreads();
    if (threadIdx.x == 0) {
        unsigned* bar = b.bar;
        __builtin_amdgcn_s_waitcnt(0);
        unsigned nloc = b.st[0], nx = b.st[1];
        if (nloc == 0u) { xcd_barrier_complete(bar, b.x, nloc, nx); b.st[0] = nloc; b.st[1] = nx; }
        const unsigned old = xb_add(&bar[XB_XSUB(b.x)], 1u);
        const unsigned gen = old / nloc;
        if (old + 1u == (gen + 1u) * nloc) {
            __builtin_amdgcn_fence(__ATOMIC_RELEASE, "agent");
            asm volatile("s_waitcnt vmcnt(0)" ::: "memory");
            const unsigned og = xb_add(&bar[XB_TOP], 1u);
            const unsigned tg = og / nx;
            if (og + 1u == (tg + 1u) * nx) xb_add(&bar[XB_TOPGEN], 1u);
            else XB_SPIN(xb_ld(&bar[XB_TOPGEN]) == tg, bar);
            __builtin_amdgcn_fence(__ATOMIC_ACQUIRE, "agent");
            xb_add(&bar[XB_XGEN(b.x)], 1u);
            asm volatile("s_waitcnt vmcnt(0)" ::: "memory");
        } else {
            XB_SPIN(xb_ld(&bar[XB_XGEN(b.x)]) == gen, bar);
            __builtin_amdgcn_fence(__ATOMIC_ACQUIRE, "agent");
            asm volatile("s_waitcnt vmcnt(0)" ::: "memory");
        }
    }
    __syncthreads();
}

struct Args {
    const float *x, *c, *ctx, *c_ctx, *norm_mix_g, *norm_ffn_g, *w_mod, *b_mod, *w_in, *sinks, *lbf_logits, *lbb_logits, *hgrn_g, *w_branch, *w_out,
                *w_router, *b_router, *w_e_gate, *b_e_gate, *w_e_up, *b_e_up, *w_e_down, *b_e_down, *final_g;
    float* out; unsigned char* ws; int ph_lo, ph_hi;
};

DI void p0_transpose64(const float* W, int ldw, bf16* WT, int ldt, LAS unsigned char* scr, int lane) {
    const int kq = lane >> 4, n4 = lane & 15;
    f32x4 v[16];
#pragma unroll
    for (int i = 0; i < 16; ++i) v[i] = *(const f32x4*)(W + (size_t)(16 * kq + i) * ldw + 4 * n4);
#pragma unroll
    for (int c = 0; c < 4; ++c)
#pragma unroll
        for (int h = 0; h < 2; ++h) { u32x4 w; w.x = pk2(v[8 * h][c], v[8 * h + 1][c]); w.y = pk2(v[8 * h + 2][c], v[8 * h + 3][c]); w.z = pk2(v[8 * h + 4][c], v[8 * h + 5][c]); w.w = pk2(v[8 * h + 6][c], v[8 * h + 7][c]);
            *(LAS u32x4*)(scr + (4 * n4 + c) * 144 + (16 * kq + 8 * h) * 2) = w; }
    LDS_WAIT(); asm volatile("" ::: "memory");
#pragma unroll
    for (int j = 0; j < 8; ++j) { const int row = (lane >> 3) + 8 * j, pc = lane & 7; const u32x4 o = *(const LAS u32x4*)(scr + row * 144 + pc * 16); *(u32x4*)(WT + (size_t)row * ldt + pc * 8) = o; }
    LDS_WAIT(); asm volatile("" ::: "memory");
}
DI void p0_quant_item(const float* W  , signed char* Q  , float* csp  , LAS unsigned char* lds, int tid) {
    const int lane = tid & 63, w = tid >> 6, n4 = lane & 7, kr = lane >> 3;
    LAS float* smax = (LAS float*)(lds + 32 * 2064);
    f32x4 v[8][4]; f32x4 mx = {0.f, 0.f, 0.f, 0.f};
#pragma unroll
    for (int g = 0; g < 8; ++g)
#pragma unroll
        for (int r = 0; r < 4; ++r) { v[g][r] = *(const f32x4*)(W + (size_t)(256 * g + 32 * w + 4 * kr + r) * FF + 4 * n4);
            mx[0] = fmaxf(mx[0], fabsf(v[g][r][0])); mx[1] = fmaxf(mx[1], fabsf(v[g][r][1])); mx[2] = fmaxf(mx[2], fabsf(v[g][r][2])); mx[3] = fmaxf(mx[3], fabsf(v[g][r][3])); }
#pragma unroll
    for (int c = 0; c < 4; ++c) { float m = mx[c]; m = fmaxf(m, __shfl_xor(m, 8)); m = fmaxf(m, __shfl_xor(m, 16)); m = fmaxf(m, __shfl_xor(m, 32)); mx[c] = m; }
    __syncthreads();
    if (kr == 0) *(LAS f32x4*)(smax + w * 32 + 4 * n4) = mx;
    __syncthreads();
    f32x4 cm = *(const LAS f32x4*)(smax + 4 * n4);
#pragma unroll
    for (int ww = 1; ww < 8; ++ww) { const f32x4 o = *(const LAS f32x4*)(smax + ww * 32 + 4 * n4); cm[0] = fmaxf(cm[0], o[0]); cm[1] = fmaxf(cm[1], o[1]); cm[2] = fmaxf(cm[2], o[2]); cm[3] = fmaxf(cm[3], o[3]); }
    f32x4 inv;
#pragma unroll
    for (int c = 0; c < 4; ++c) { if (cm[c] == 0.f) cm[c] = 1.f; inv[c] = 127.0f / cm[c]; }
    if (w == 0 && kr == 0) { f32x4 sc; sc[0] = cm[0] * (1.0f / 127.0f); sc[1] = cm[1] * (1.0f / 127.0f); sc[2] = cm[2] * (1.0f / 127.0f); sc[3] = cm[3] * (1.0f / 127.0f); *(f32x4*)(csp + 4 * n4) = sc; }
#pragma unroll
    for (int g = 0; g < 8; ++g)
#pragma unroll
        for (int c = 0; c < 4; ++c) { unsigned pk = 0u;
#pragma unroll
            for (int r = 0; r < 4; ++r) { const int q = (int)rintf(v[g][r][c] * inv[c]); pk |= ((unsigned)q & 0xffu) << (8 * r); }
            *(LAS unsigned*)(lds + (4 * n4 + c) * 2064 + 4 * (64 * g + 8 * w + kr)) = pk; }
    __syncthreads();
#pragma unroll
    for (int i = 0; i < 8; ++i) { const int p = tid + 512 * i, row = p >> 7, pc = p & 127; const u32x4 o = *(const LAS u32x4*)(lds + row * 2064 + pc * 16); *(u32x4*)(Q + (size_t)row * 2048 + pc * 16) = o; }
}

constexpr int SC_QH = 0, SC_KH = 8448, SC_KT = 16896, SC_VT = 26112, SC_FAC = 35328, SC_RZ = 35840, SC_RV = 44032, SC_RQ = 52224, SC_GRP = 60416;
constexpr int RSQ = 264, RST = 72;
DI int crow(int i, int h) { return (i & 3) + 8 * (i >> 2) + 4 * h; }
DI bf16x8 pack8(float a0, float a1, float a2, float a3, float a4, float a5, float a6, float a7) {
    u32x4 p; p.x = pk2(a0, a1); p.y = pk2(a2, a3); p.z = pk2(a4, a5); p.w = pk2(a6, a7); return __builtin_bit_cast(bf16x8, p);
}
DI bf16x8 lds_frag2(const LAS unsigned char* p0, const LAS unsigned char* p1) {
    const u32x2 lo = *(const LAS u32x2*)p0, hi = *(const LAS u32x2*)p1; u32x4 v; v.x = lo.x; v.y = lo.y; v.z = hi.x; v.w = hi.y; return __builtin_bit_cast(bf16x8, v);
}
#define MFMA32(a, b, c) __builtin_amdgcn_mfma_f32_32x32x16_bf16((a), (b), (c), 0, 0, 0)

template <bool OUT>
DI void scan_segment(LAS unsigned char* ldsb, const bf16* proj, int hh, int segF, int segB, float* Lbuf, float* Dlog, float* oscr) {
    const int tid = threadIdx.x, lane = tid & 63, wave = __builtin_amdgcn_readfirstlane(tid >> 6);
    const int dir = wave >> 2, w4 = wave & 3, half = w4 >> 1, d = tid & 127, r = lane & 31, h5 = lane >> 5, e0 = 32 * w4;
    const int seg = dir ? segB : segF, scan = dir * 8 + hh;
    const int ntok = (seg == 0) ? NCTX : 512, sgn = dir ? -1 : 1;
    const int r0 = (seg == 0) ? (dir ? MROWS - 1 : NTOK) : (dir ? NTOK - 1 - (seg - 1) * 512 : (seg - 1) * 512);
    LAS unsigned char* G = ldsb + dir * SC_GRP;
    LAS unsigned char* QH = G + SC_QH; LAS unsigned char* KH = G + SC_KH; LAS unsigned char* KT = G + SC_KT; LAS unsigned char* VT = G + SC_VT; LAS float* FAC = (LAS float*)(G + SC_FAC);
    float* Lslot = Lbuf + (size_t)(scan * NSEG + seg) * 16384;
    f32x16 acc[4];
    if (OUT) {
        const float* Sin = Lbuf + (size_t)(scan * NSEG + seg - 1) * 16384;
#pragma unroll
        for (int dt = 0; dt < 4; ++dt)
#pragma unroll
            for (int i = 0; i < 16; ++i) acc[dt][i] = Sin[(32 * dt + crow(i, h5)) * 128 + e0 + r];
    } else {
#pragma unroll
        for (int dt = 0; dt < 4; ++dt)
#pragma unroll
            for (int i = 0; i < 16; ++i) acc[dt][i] = 0.f;
    }
    float tail_prev = 0.f, dlog_tot = 0.f;
    const bf16* zsrc = proj + (dir ? PO_ZB : PO_ZF) + (size_t)hh * MROWS * 128; const bf16* vsrc = proj + PO_BV + (size_t)hh * MROWS * 128; const bf16* qsrc = proj + PO_BQ + (size_t)hh * MROWS * 128;
    const int nch = ntok / 32;
    LAS unsigned char* RZ = G + SC_RZ; LAS unsigned char* RV = G + SC_RV; LAS unsigned char* RQ = G + SC_RQ;
#define SC_DMA(cc) do { const int rb_ = r0 + sgn * 32 * (cc); \
        _Pragma("unroll") for (int i_ = 0; i_ < 2; ++i_) { const int s_ = 8 * w4 + 4 * i_ + (lane >> 4); const size_t so_ = (size_t)(rb_ + sgn * s_) * 128 + 8 * (lane & 15); \
            __builtin_amdgcn_global_load_lds((const unsigned*)(zsrc + so_), (LAS unsigned*)(RZ + (8 * w4 + 4 * i_) * 256), 16, 0, 0); \
            __builtin_amdgcn_global_load_lds((const unsigned*)(vsrc + so_), (LAS unsigned*)(RV + (8 * w4 + 4 * i_) * 256), 16, 0, 0); \
            if (OUT) __builtin_amdgcn_global_load_lds((const unsigned*)(qsrc + so_), (LAS unsigned*)(RQ + (8 * w4 + 4 * i_) * 256), 16, 0, 0); } } while (0)
    SC_DMA(0);
    for (int c = 0; c < nch; ++c) {
        const int rb = r0 + sgn * 32 * c;
        VM_WAIT(); __syncthreads();
        float rsum = 0.f, lf[16], vv[16], qq[16];
        if (half) {
#pragma unroll
            for (int s = 0; s < 16; ++s) rsum += bf2f(*(const LAS unsigned short*)(RZ + s * 256 + d * 2));
        }
#pragma unroll
        for (int i = 0; i < 16; ++i) { const int so = (16 * half + i) * 256 + d * 2;
            lf[i] = bf2f(*(const LAS unsigned short*)(RZ + so)); vv[i] = bf2f(*(const LAS unsigned short*)(RV + so)); if (OUT) qq[i] = bf2f(*(const LAS unsigned short*)(RQ + so)); }
        if (!half) {
#pragma unroll
            for (int i = 0; i < 16; ++i) rsum += lf[i];
        }
        float b = half ? rsum : 0.f, kh[16], qh[16];
#pragma unroll
        for (int i = 0; i < 16; ++i) { b += lf[i]; const float x = b - rsum;
            kh[i] = (1.0f - __expf(lf[i])) * __expf(fminf(-x, 60.f));
            if (OUT) qh[i] = qq[i] * __expf(fminf(x, 60.f)); }
        const float tail = b - rsum;
#pragma unroll
        for (int j = 0; j < 4; ++j) {
            u32x2 w; w.x = pk2(kh[4 * j], kh[4 * j + 1]); w.y = pk2(kh[4 * j + 2], kh[4 * j + 3]); *(LAS u32x2*)(KT + d * RST + 32 * half + 8 * j) = w;
            u32x2 v; v.x = pk2(vv[4 * j], vv[4 * j + 1]); v.y = pk2(vv[4 * j + 2], vv[4 * j + 3]); *(LAS u32x2*)(VT + d * RST + 32 * half + 8 * j) = v;
        }
        if (OUT) {
#pragma unroll
            for (int i = 0; i < 16; ++i) { const int s = 16 * half + i;
                *(LAS unsigned short*)(KH + s * RSQ + d * 2) = f2bf(kh[i]); *(LAS unsigned short*)(QH + s * RSQ + d * 2) = f2bf(qh[i]); }
        }
        if (half) { FAC[d] = __expf(tail_prev + rsum); tail_prev = tail; dlog_tot += rsum + tail; }
        __syncthreads();
        if (c + 1 < nch) SC_DMA(c + 1);
#pragma unroll
        for (int dt = 0; dt < 4; ++dt)
#pragma unroll
            for (int g4 = 0; g4 < 4; ++g4) { const f32x4 f = *(const LAS f32x4*)(FAC + 32 * dt + 8 * g4 + 4 * h5);
#pragma unroll
                for (int j = 0; j < 4; ++j) acc[dt][4 * g4 + j] *= f[j]; }
        if (OUT) {
            bf16x8 qf[8];
            f32x16 pT, oT;
#pragma unroll
            for (int i = 0; i < 16; ++i) { pT[i] = 0.f; oT[i] = 0.f; }
#pragma unroll
            for (int kk = 0; kk < 8; ++kk) {
                qf[kk] = lds_frag2(QH + r * RSQ + (16 * kk + 4 * h5) * 2, QH + r * RSQ + (16 * kk + 8 + 4 * h5) * 2);
                const bf16x8 kf = lds_frag2(KH + r * RSQ + (16 * kk + 4 * h5) * 2, KH + r * RSQ + (16 * kk + 8 + 4 * h5) * 2);
                pT = MFMA32(kf, qf[kk], pT);
            }
#pragma unroll
            for (int i = 0; i < 16; ++i) if (crow(i, h5) > r) pT[i] = 0.f;
#pragma unroll
            for (int dt = 0; dt < 4; ++dt)
#pragma unroll
                for (int ks = 0; ks < 2; ++ks) {
                    const bf16x8 sa = pack8(acc[dt][8 * ks], acc[dt][8 * ks + 1], acc[dt][8 * ks + 2], acc[dt][8 * ks + 3], acc[dt][8 * ks + 4], acc[dt][8 * ks + 5], acc[dt][8 * ks + 6], acc[dt][8 * ks + 7]);
                    oT = MFMA32(sa, qf[2 * dt + ks], oT);
                }
#pragma unroll
            for (int ks = 0; ks < 2; ++ks) {
                const bf16x8 pf = pack8(pT[8 * ks], pT[8 * ks + 1], pT[8 * ks + 2], pT[8 * ks + 3], pT[8 * ks + 4], pT[8 * ks + 5], pT[8 * ks + 6], pT[8 * ks + 7]);
                const bf16x8 va = lds_frag2(VT + (e0 + r) * RST + (16 * ks + 4 * h5) * 2, VT + (e0 + r) * RST + (16 * ks + 8 + 4 * h5) * 2);
                oT = MFMA32(va, pf, oT);
            }
            float* orow = oscr + ((size_t)(dir * 8 + hh) * NTOK + (rb + sgn * r)) * 128 + e0 + 4 * h5;
#pragma unroll
            for (int g4 = 0; g4 < 4; ++g4) { f32x4 o; o[0] = oT[4 * g4]; o[1] = oT[4 * g4 + 1]; o[2] = oT[4 * g4 + 2]; o[3] = oT[4 * g4 + 3]; *(f32x4*)(orow + 8 * g4) = o; }
        }
#pragma unroll
        for (int ks = 0; ks < 2; ++ks) {
            const bf16x8 vb = lds_frag2(VT + (e0 + r) * RST + (16 * ks + 8 * h5) * 2, VT + (e0 + r) * RST + (16 * ks + 8 * h5) * 2 + 8);
#pragma unroll
            for (int dt = 0; dt < 4; ++dt) {
                const bf16x8 ka = lds_frag2(KT + (32 * dt + r) * RST + (16 * ks + 8 * h5) * 2, KT + (32 * dt + r) * RST + (16 * ks + 8 * h5) * 2 + 8);
                acc[dt] = MFMA32(ka, vb, acc[dt]);
            }
        }
    }
#undef SC_DMA
    if (!OUT) {
        __syncthreads();
        if (half) { FAC[d] = __expf(tail_prev); Dlog[(size_t)(scan * NSEG + seg) * 128 + d] = dlog_tot; }
        __syncthreads();
#pragma unroll
        for (int dt = 0; dt < 4; ++dt)
#pragma unroll
            for (int g4 = 0; g4 < 4; ++g4) { const f32x4 f = *(const LAS f32x4*)(FAC + 32 * dt + 8 * g4 + 4 * h5);
#pragma unroll
                for (int j = 0; j < 4; ++j) Lslot[(32 * dt + 8 * g4 + 4 * h5 + j) * 128 + e0 + r] = acc[dt][4 * g4 + j] * f[j]; }
    }
    __syncthreads();
}

constexpr int AT_KC = 0, AT_VC = 36864, AT_KL = 70144, AT_VL = 116224, AT_END = 157696;
constexpr int KRS = 144, VCRS = 520, VLRS = 648, NSLOT = 10;
static_assert(AT_END <= MISC_OFF, "attention LDS");
DI void attn_unit(LAS unsigned char* ldsb, const bf16* proj, const bf16* KR, const bf16* VTg, const float* rope, const float* sinks, bf16* yab, int kvh, int ab) {
    const int tid = threadIdx.x, lane = tid & 63, wave = __builtin_amdgcn_readfirstlane(tid >> 6), r = lane & 31, h5 = lane >> 5;
    const int head = kvh * 8 + wave;
    LAS unsigned char* KC = ldsb + AT_KC; LAS unsigned char* VC = ldsb + AT_VC; LAS unsigned char* KL = ldsb + AT_KL; LAS unsigned char* VL = ldsb + AT_VL;
    const float* rowcos = rope, *rowsin = rope + 4096, *colcos = rope + 8192, *colsin = rope + 8192 + 1024;
    __syncthreads();
    for (int p = tid; p < 2048; p += 512) {
        { const int key = p >> 3, c8 = p & 7; const u32x4 v = *(const u32x4*)(KR + ((size_t)(kvh * MROWS + NTOK + key)) * 64 + c8 * 8); *(LAS u32x4*)(KC + key * KRS + c8 * 16) = v; }
        { const int dd = p >> 5, c = p & 31; const u32x4 v = *(const u32x4*)(VTg + ((size_t)(kvh * 64 + dd)) * MROWS + NTOK + c * 8);
          u32x2 a; a.x = v.x; a.y = v.y; u32x2 b; b.x = v.z; b.y = v.w; *(LAS u32x2*)(VC + dd * VCRS + c * 16) = a; *(LAS u32x2*)(VC + dd * VCRS + c * 16 + 8) = b; }
    }
    const int T0 = ab * 4 - 4;
    for (int p = tid; p < 2304; p += 512) {
        { const int key = p >> 3, c8 = p & 7, T = T0 + (key >> 5), slot = (T + 2 * NSLOT) % NSLOT;
          if (T >= 0 && T < NTOK / 32) { const u32x4 v = *(const u32x4*)(KR + ((size_t)(kvh * MROWS + T * 32 + (key & 31))) * 64 + c8 * 8); *(LAS u32x4*)(KL + (slot * 32 + (key & 31)) * KRS + c8 * 16) = v; } }
        { const int dd = p / 36, c = p % 36, T = T0 + (c >> 2), slot = (T + 2 * NSLOT) % NSLOT;
          if (T >= 0 && T < NTOK / 32) { const u32x4 v = *(const u32x4*)(VTg + ((size_t)(kvh * 64 + dd)) * MROWS + T * 32 + (c & 3) * 8);
            u32x2 a; a.x = v.x; a.y = v.y; u32x2 b; b.x = v.z; b.y = v.w; LAS unsigned char* dst = VL + dd * VLRS + slot * 64 + (c & 3) * 16; *(LAS u32x2*)dst = a; *(LAS u32x2*)(dst + 8) = b; } }
    }
    const float sc = 0.125f * 1.4426950408889634f;
    u32x4 raw[4]; float cs[2][8], sn[2][8];
#define AT_LOADQ(P0) do { const int qp_ = (P0) + r; const bf16* qrow_ = proj + PO_AQ + ((size_t)head * MROWS + qp_) * 64 + 8 * h5; \
        _Pragma("unroll") for (int ks = 0; ks < 4; ++ks) raw[ks] = *(const u32x4*)(qrow_ + 16 * ks); \
        const float* c0_ = rowcos + (qp_ >> 6) * 16 + 8 * h5; const float* s0_ = rowsin + (qp_ >> 6) * 16 + 8 * h5; \
        const float* c1_ = colcos + (qp_ & 63) * 16 + 8 * h5; const float* s1_ = colsin + (qp_ & 63) * 16 + 8 * h5; \
        _Pragma("unroll") for (int j = 0; j < 8; ++j) { cs[0][j] = c0_[j]; sn[0][j] = s0_[j]; cs[1][j] = c1_[j]; sn[1][j] = s1_[j]; } } while (0)
    AT_LOADQ(ab * 128);
    __syncthreads();
    for (int qt = 0; qt < 4; ++qt) {
        const int p0 = ab * 128 + 32 * qt, kb0 = p0 - 128, qp = p0 + r, Tq = ab * 4 + qt - 4;
        bf16x8 qf[4];
#pragma unroll
        for (int ks = 0; ks < 2; ++ks) { float o1[8], o2[8];
#pragma unroll
            for (int q = 0; q < 4; ++q) {
                const float a0 = bflo(raw[ks][q]), a1 = bfhi(raw[ks][q]), b0 = bflo(raw[ks + 2][q]), b1 = bfhi(raw[ks + 2][q]);
                o1[2 * q] = a0 * cs[ks][2 * q] - b0 * sn[ks][2 * q]; o2[2 * q] = b0 * cs[ks][2 * q] + a0 * sn[ks][2 * q];
                o1[2 * q + 1] = a1 * cs[ks][2 * q + 1] - b1 * sn[ks][2 * q + 1]; o2[2 * q + 1] = b1 * cs[ks][2 * q + 1] + a1 * sn[ks][2 * q + 1]; }
            qf[ks] = pack8(o1[0], o1[1], o1[2], o1[3], o1[4], o1[5], o1[6], o1[7]);
            qf[ks + 2] = pack8(o2[0], o2[1], o2[2], o2[3], o2[4], o2[5], o2[6], o2[7]); }
        const int Tn = Tq + 9; const bool pre = (qt < 3) && Tn >= 0 && Tn < NTOK / 32; u32x4 nk = {0u, 0u, 0u, 0u};
        if (pre) { if (tid < 256) nk = *(const u32x4*)(KR + ((size_t)(kvh * MROWS + Tn * 32 + (tid >> 3))) * 64 + (tid & 7) * 8);
                   else { const int t2 = tid - 256; nk = *(const u32x4*)(VTg + ((size_t)(kvh * 64 + (t2 >> 2))) * MROWS + Tn * 32 + (t2 & 3) * 8); } }
        if (qt < 3) AT_LOADQ(p0 + 32);
        float m_run = sinks[head] * 1.4426950408889634f, l_run = h5 ? 0.f : 1.f;
        f32x16 o0, o1;
#pragma unroll
        for (int i = 0; i < 16; ++i) { o0[i] = 0.f; o1[i] = 0.f; }
        for (int kt = 0; kt < 17; ++kt) {
            const bool lat = kt >= 8; const int j = kt - 8, T = Tq + j, kb = kb0 + 32 * j, slot = (T + 2 * NSLOT) % NSLOT;
            if (lat && (T < 0 || T >= NTOK / 32)) continue;
            const LAS unsigned char* Kb = lat ? KL + (32 * slot + r) * KRS : KC + (32 * kt + r) * KRS;
            const LAS unsigned char* Vb = lat ? VL + r * VLRS + 64 * slot : VC + r * VCRS + 64 * kt;
            const int vrs32 = 32 * (lat ? VLRS : VCRS);
            f32x16 s;
#pragma unroll
            for (int i = 0; i < 16; ++i) s[i] = 0.f;
#pragma unroll
            for (int ks = 0; ks < 4; ++ks) { const bf16x8 kf = *(const LAS bf16x8*)(Kb + (16 * ks + 8 * h5) * 2); s = MFMA32(kf, qf[ks], s); }
            float mt = -INFINITY;
#pragma unroll
            for (int i = 0; i < 16; ++i) { float v = s[i] * sc;
                if (lat) { const int dk = kb + crow(i, h5) - qp; if (dk > 128 || dk < -128) v = -INFINITY; }
                s[i] = v; mt = fmaxf(mt, v); }
            mt = fmaxf(mt, __shfl_xor(mt, 32));
            const float mn = fmaxf(m_run, mt), alpha = __builtin_amdgcn_exp2f(m_run - mn);
            m_run = mn; l_run *= alpha;
#pragma unroll
            for (int i = 0; i < 16; ++i) { o0[i] *= alpha; o1[i] *= alpha; }
            float ps = 0.f;
#pragma unroll
            for (int i = 0; i < 16; ++i) { const float p = __builtin_amdgcn_exp2f(s[i] - mn); s[i] = p; ps += p; }
            l_run += ps;
#pragma unroll
            for (int ks = 0; ks < 2; ++ks) {
                const bf16x8 pf = pack8(s[8 * ks], s[8 * ks + 1], s[8 * ks + 2], s[8 * ks + 3], s[8 * ks + 4], s[8 * ks + 5], s[8 * ks + 6], s[8 * ks + 7]);
                const bf16x8 v0 = lds_frag2(Vb + (16 * ks + 4 * h5) * 2, Vb + (16 * ks + 8 + 4 * h5) * 2);
                const bf16x8 v1 = lds_frag2(Vb + vrs32 + (16 * ks + 4 * h5) * 2, Vb + vrs32 + (16 * ks + 8 + 4 * h5) * 2);
                o0 = MFMA32(v0, pf, o0);
                o1 = MFMA32(v1, pf, o1);
            }
        }
        const float l = l_run + __shfl_xor(l_run, 32), inv = 1.0f / l;
        bf16* orow = yab + (size_t)qp * D + head * 64 + 4 * h5;
#pragma unroll
        for (int g4 = 0; g4 < 4; ++g4) {
            u32x2 a; a.x = pk2(o0[4 * g4] * inv, o0[4 * g4 + 1] * inv); a.y = pk2(o0[4 * g4 + 2] * inv, o0[4 * g4 + 3] * inv); *(u32x2*)(orow + 8 * g4) = a;
            u32x2 b; b.x = pk2(o1[4 * g4] * inv, o1[4 * g4 + 1] * inv); b.y = pk2(o1[4 * g4 + 2] * inv, o1[4 * g4 + 3] * inv); *(u32x2*)(orow + 32 + 8 * g4) = b;
        }
        if (pre) { const int slot = (Tn + 2 * NSLOT) % NSLOT;
            if (tid < 256) *(LAS u32x4*)(KL + (slot * 32 + (tid >> 3)) * KRS + (tid & 7) * 16) = nk;
            else { const int t2 = tid - 256; u32x2 a; a.x = nk.x; a.y = nk.y; u32x2 b; b.x = nk.z; b.y = nk.w; LAS unsigned char* dst = VL + (t2 >> 2) * VLRS + slot * 64 + (t2 & 3) * 16; *(LAS u32x2*)dst = a; *(LAS u32x2*)(dst + 8) = b; } }
        __syncthreads();
    }
#undef AT_LOADQ
}

typedef const Args __attribute__((address_space(4))) ArgsC;
DI ArgsC* args_ptr() { ArgsC* p = (ArgsC*)__builtin_amdgcn_kernarg_segment_ptr(); asm volatile("" : "+s"(p)); return p; }
#define PH_BEGIN ArgsC* A = args_ptr(); unsigned char* const ws = A->ws; (void)ws
#define modl ((float*)(ws + WS_SMALL + SM_MODL))
#define modc ((float*)(ws + WS_SMALL + SM_MODC))
#define rope ((float*)(ws + WS_SMALL + SM_ROPE))
#define lbf ((float*)(ws + WS_SMALL + SM_LB))
#define lbb (lbf + 1024)
#define wrp ((float*)(ws + WS_SMALL + SM_WRP))
#define cvec ((float*)(ws + WS_SMALL + SM_CVEC))
#define tile_expert ((int*)(ws + WS_SMALL + SM_TILE))
#define ntiles_p (tile_expert + 512)
#define rt_e ((int*)(ws + WS_ROUTE + RT_E))
#define rt_g ((float*)(ws + WS_ROUTE + RT_G))
#define rt_r ((int*)(ws + WS_ROUTE + RT_R))
#define rt_s ((int*)(ws + WS_ROUTE + RT_S))
#define slot_rowoff ((unsigned*)(ws + WS_ROUTE + RT_OFF))
#define slot_gate ((float*)(ws + WS_ROUTE + RT_SG))
#define Dlog ((float*)(ws + WS_DLOG))
#define KR ((bf16*)(ws + WS_KR))
#define VTg ((bf16*)(ws + WS_VT))
#define Lbuf ((float*)(ws + WS_L))
#define WIN ((bf16*)(ws + WS_WIN))
#define WM ((bf16*)(ws + WS_WM))
#define WO ((bf16*)(ws + WS_WO))
#define WGU ((bf16*)(ws + WS_WGU))
#define WDN ((bf16*)(ws + WS_WDN))
#define H ((bf16*)(ws + WS_H))
#define PROJ ((bf16*)(ws + WS_PROJ))
#define ACT ((bf16*)(ws + WS_ACT))
#define YAB ((bf16*)(ws + WS_YAB))
#define OSCR ((float*)(ws + WS_OSCR))
#define MERGED ((bf16*)(ws + WS_MERGED))
#define X1 ((float*)(ws + WS_X1))
#define YS ((bf16*)(ws + WS_YS))

__global__ void __launch_bounds__(NWAVES * 64, 2) fwd_kernel(Args a_unused) {
    extern __shared__ __attribute__((aligned(16))) unsigned char lds_raw[];
    LAS unsigned char* lds = (LAS unsigned char*)lds_raw;
    volatile LAS unsigned* MISC = (volatile LAS unsigned*)(lds + MISC_OFF);
    const int tid = threadIdx.x, lane = tid & 63, wave = __builtin_amdgcn_readfirstlane(tid >> 6);
    const int G = gridDim.x, bx = blockIdx.x, vcu = (G % 8 == 0) ? (bx % 8) * (G / 8) + bx / 8 : bx;
    const int gw = vcu * NWAVES + wave, NGW = G * NWAVES;
    const int gtid = vcu * 512 + tid, NGT = G * 512;
    unsigned* ctl; { const ArgsC* A0 = args_ptr(); ctl = (unsigned*)(A0->ws + WS_CTL); }
    if (tid < 64) MISC[tid] = 0u;
    __syncthreads();
    XcdBarrier bar = xcd_barrier_post(ctl + CW_BAR, MISC);
    int lo, hi; { const ArgsC* A0 = args_ptr(); lo = A0->ph_lo; hi = A0->ph_hi; }
#ifndef PH_MASK
#define PH_MASK 0x1fff
#endif
#define IN(k) ((((PH_MASK) >> (k)) & 1) && lo <= (k) && (k) < hi)
#define SEAM(k) do { if (IN(k) && IN((k) + 1)) xcd_barrier(bar); } while (0)

    for (int rep_ = 0; rep_ < DUP0; ++rep_) { if (rep_) xcd_barrier(bar);
    if (IN(0)) {
        PH_BEGIN;
        LAS float* sc = (LAS float*)lds; LAS float* scc = sc + 2048; LAS f32x4* red = (LAS f32x4*)(lds + 16384);
        if (vcu < 48) {
            for (int k = tid; k < 2048; k += 512) { const float v = A->c[k], u = A->c_ctx[k]; sc[k] = v * sigmoidf_(v); scc[k] = u * sigmoidf_(u); }
            __syncthreads();
            const int cb = vcu, col = 256 * cb + 4 * lane; const bool hasc = cb < 16;
            f32x4 al = {0.f, 0.f, 0.f, 0.f}, ac = {0.f, 0.f, 0.f, 0.f};
#pragma unroll 8
            for (int k = wave; k < 2048; k += 8) { const f32x4 wv = *(const f32x4*)(A->w_mod + (size_t)k * 12288 + col); al += sc[k] * wv; ac += scc[k] * wv; }
            red[wave * 64 + lane] = al; red[512 + wave * 64 + lane] = ac;
            __syncthreads();
            if (wave == 0) { f32x4 s = *(const f32x4*)(A->b_mod + col), t = s;
#pragma unroll
                for (int w = 0; w < 8; ++w) { s += red[w * 64 + lane]; t += red[512 + w * 64 + lane]; }
                *(f32x4*)(modl + col) = s; if (hasc) *(f32x4*)(modc + col) = t; }
            __syncthreads();
        }
        if (vcu == G - 1) {
            for (int i = tid; i < 4096 + 1024; i += 512) { const bool isrow = i < 4096; const int ii = isrow ? i : i - 4096, p = ii >> 4, j = ii & 15;
                const float inv = powf(10000.0f, -(float)j / 16.0f), ang = (float)p * inv; float s, c; sincosf(ang, &s, &c);
                if (isrow) { rope[ii] = c; rope[4096 + ii] = s; } else { rope[8192 + ii] = c; rope[9216 + ii] = s; } }
            for (int i = tid; i < 2048; i += 512) { const float* lg = (i < 1024) ? A->lbf_logits : A->lbb_logits; const int ch = i & 1023;
                const float v = 1.0f / (1.0f + expf(lg[1024 + ch] - lg[ch])); if (i < 1024) lbf[ch] = v; else lbb[ch] = v; }
        }
        __syncthreads();
        for (int it = vcu; it < 32 * 2 * 64; it += G) { const int e = it >> 7, which = (it >> 6) & 1, jb = it & 63, n0 = 32 * jb, np = e * 4096 + (n0 >> 7) * 256 + which * 128 + (n0 & 127);
            p0_quant_item((which ? A->w_e_up : A->w_e_gate) + (size_t)e * D * FF + n0, (signed char*)(ws + WS_WGU) + (size_t)np * 2048, (float*)(ws + WS_CS) + np, lds, tid); }
        __syncthreads();
        LAS unsigned char* scr = lds + wave * 9216;
        constexpr int I_IN = 32 * 164, I_BR = 1024, I_OUT = 1024, I_E = 32 * 1024;
        constexpr int NITEMS = I_IN + I_BR + I_OUT + I_E;
        for (int it = gw; it < NITEMS; it += NGW) {
            int r = it;
            if (r < I_IN) { const int kb = r / 164, nb = r % 164; p0_transpose64(A->w_in + (size_t)(64 * kb) * INC + 64 * nb, INC, WIN + (size_t)(64 * nb) * D + 64 * kb, D, scr, lane); continue; } r -= I_IN;
            if (r < I_BR) { const int br = r >> 9, r2 = r & 511, kb = r2 >> 5, nb = r2 & 31;
                p0_transpose64(A->w_branch + (size_t)br * 1024 * D + (size_t)(64 * kb) * D + 64 * nb, D, WM + (size_t)(64 * nb) * D + br * 1024 + 64 * kb, D, scr, lane); continue; } r -= I_BR;
            if (r < I_OUT) { const int kb = r >> 5, nb = r & 31; p0_transpose64(A->w_out + (size_t)(64 * kb) * D + 64 * nb, D, WO + (size_t)(64 * nb) * D + 64 * kb, D, scr, lane); continue; } r -= I_OUT;
            const int e = r >> 10, r2 = r & 1023, kb = r2 >> 5, nb = r2 & 31;
            p0_transpose64(A->w_e_down + (size_t)e * D * FF + (size_t)(64 * kb) * FF + 64 * nb, FF, WDN + ((size_t)e * D + 64 * nb) * FF + 64 * kb, FF, scr, lane);
        }
    }
    }
    SEAM(0);

    if (IN(1)) {
        PH_BEGIN;
        {
            f32x4 ca[8], cb[8];
#pragma unroll
            for (int j = 0; j < 8; ++j) { const int k = 4 * lane + 256 * j; const f32x4 g = *(const f32x4*)(A->norm_mix_g + k), s1 = *(const f32x4*)(modl + 2048 + k); ca[j] = g * (1.0f + s1); cb[j] = *(const f32x4*)(modl + k); }
            f32x4 v[8], vn[8];
            { const float* xr = A->x + (size_t)gw * D + 4 * lane;
#pragma unroll
              for (int j = 0; j < 8; ++j) v[j] = *(const f32x4*)(xr + 256 * j); }
            for (int m = gw; m < NTOK; m += NGW) {
                if (m + NGW < NTOK) { const float* xn = A->x + (size_t)(m + NGW) * D + 4 * lane;
#pragma unroll
                    for (int j = 0; j < 8; ++j) vn[j] = *(const f32x4*)(xn + 256 * j); }
                float ss = 0.f;
#pragma unroll
                for (int j = 0; j < 8; ++j) ss += v[j][0] * v[j][0] + v[j][1] * v[j][1] + v[j][2] * v[j][2] + v[j][3] * v[j][3];
                const float rstd = rsqrtf(wave_sum(ss) * (1.0f / D) + EPS);
                bf16* hr = H + (size_t)m * D + 4 * lane;
#pragma unroll
                for (int j = 0; j < 8; ++j) { const f32x4 o = v[j] * rstd * ca[j] + cb[j]; u32x2 w; w.x = pk2(o[0], o[1]); w.y = pk2(o[2], o[3]); *(u32x2*)(hr + 256 * j) = w; }
#pragma unroll
                for (int j = 0; j < 8; ++j) v[j] = vn[j];
            }
        }
        if (gw < NCTX) {
            const int m = gw; const float* xr = A->ctx + (size_t)m * D + 4 * lane; f32x4 v[8]; float ss = 0.f;
#pragma unroll
            for (int j = 0; j < 8; ++j) { v[j] = *(const f32x4*)(xr + 256 * j); ss += v[j][0] * v[j][0] + v[j][1] * v[j][1] + v[j][2] * v[j][2] + v[j][3] * v[j][3]; }
            const float rstd = rsqrtf(wave_sum(ss) * (1.0f / D) + EPS);
            bf16* hr = H + (size_t)(NTOK + m) * D + 4 * lane;
#pragma unroll
            for (int j = 0; j < 8; ++j) { const int k = 4 * lane + 256 * j; const f32x4 g = *(const f32x4*)(A->norm_mix_g + k), s1 = *(const f32x4*)(modc + 2048 + k), s0 = *(const f32x4*)(modc + k);
                const f32x4 o = v[j] * rstd * (g * (1.0f + s1)) + s0; u32x2 w; w.x = pk2(o[0], o[1]); w.y = pk2(o[2], o[3]); *(u32x2*)(hr + 256 * j) = w; }
        }
        for (int i = gtid; i < 2048 * 32; i += NGT) { const int k = i >> 5; wrp[i] = A->norm_ffn_g[k] * (1.0f + modl[4 * 2048 + k]) * A->w_router[i]; }
        if (vcu == G - 1) {
            for (int e = wave * 4; e < wave * 4 + 4; ++e) { float s = 0.f; for (int k = lane; k < 2048; k += 64) s += modl[3 * 2048 + k] * A->w_router[k * 32 + e];
                s = wave_sum(s); if (lane == 0) cvec[e] = s + A->b_router[e]; }
        }
    }
    SEAM(1);

    if (IN(2)) {
        PH_BEGIN;
        pg8::Gemm g{H, WIN, D}; pg8::PlainOrder S; S.init(MROWS / 256, INC / 256, G, bx); S.K2 = D * 2;
        EpiProj E{PROJ, lbf, lbb};
        pg8::gemm_phase<EpiProj, pg8::PlainOrder>(lds, g, S, E);
    }
    SEAM(2);

    for (int rep_ = 0; rep_ < DUP3; ++rep_) { if (rep_) xcd_barrier(bar);
    if (IN(3)) {
        PH_BEGIN;
        for (int i = gtid; i < MROWS * 8; i += NGT) { const int jg = i & 3, kvh = (i >> 2) & 1, pos = i >> 3, j0 = 8 * jg;
            const bf16* kr = PROJ + PO_AKV + (size_t)pos * 256 + kvh * 64 + j0; const u32x4 a1 = *(const u32x4*)kr, a2 = *(const u32x4*)(kr + 32); u32x4 w1 = a1, w2 = a2;
            if (pos < NTOK) { const float* ct = (jg < 2) ? rope + (pos >> 6) * 16 + j0 : rope + 8192 + (pos & 63) * 16 + j0 - 16; const float* st = ct + ((jg < 2) ? 4096 : 1024);
                const f32x4 c0 = *(const f32x4*)ct, c1 = *(const f32x4*)(ct + 4), s0 = *(const f32x4*)st, s1 = *(const f32x4*)(st + 4);
#pragma unroll
                for (int q = 0; q < 4; ++q) { const float cl = q < 2 ? c0[2 * q] : c1[2 * q - 4], ch = q < 2 ? c0[2 * q + 1] : c1[2 * q - 3], sl = q < 2 ? s0[2 * q] : s1[2 * q - 4], sh = q < 2 ? s0[2 * q + 1] : s1[2 * q - 3];
                    const float k1l = bflo(a1[q]), k1h = bfhi(a1[q]), k2l = bflo(a2[q]), k2h = bfhi(a2[q]);
                    w1[q] = pk2(k1l * cl - k2l * sl, k1h * ch - k2h * sh); w2[q] = pk2(k2l * cl + k1l * sl, k2h * ch + k1h * sh); } }
            bf16* ko = KR + ((size_t)kvh * MROWS + pos) * 64 + j0; *(u32x4*)ko = w1; *(u32x4*)(ko + 32) = w2; }
        for (int i = gtid; i < 2 * (MROWS / 8) * 64; i += NGT) { const int dd = i & 63, pb = (i >> 6) % (MROWS / 8), kvh = (i >> 6) / (MROWS / 8);
            const bf16* vr = PROJ + PO_AKV + (size_t)(pb * 8) * 256 + 128 + kvh * 64 + dd; unsigned short t[8];
#pragma unroll
            for (int q = 0; q < 8; ++q) t[q] = vr[(size_t)q * 256];
            u32x4 w; w.x = t[0] | ((unsigned)t[1] << 16); w.y = t[2] | ((unsigned)t[3] << 16); w.z = t[4] | ((unsigned)t[5] << 16); w.w = t[6] | ((unsigned)t[7] << 16);
            *(u32x4*)(VTg + ((size_t)kvh * 64 + dd) * MROWS + pb * 8) = w; }
        for (int it = vcu; it < 8 * (NSEG - 1); it += G) { const int hh = it >> 5, seg = it & 31; scan_segment<false>(lds, PROJ, hh, seg, seg, Lbuf, Dlog, nullptr); }
    }
    }
    SEAM(3);

    if (IN(4)) {
        PH_BEGIN;
        for (int i = gtid; i < 16 * 16384; i += NGT) { const int scan = i >> 14, el = i & 16383, dd = el >> 7; float s = 0.f, lv[NSEG - 1], dv[NSEG - 1];
#pragma unroll
            for (int j = 0; j < NSEG - 1; ++j) { lv[j] = Lbuf[(size_t)(scan * NSEG + j) * 16384 + el]; dv[j] = Dlog[(scan * NSEG + j) * 128 + dd]; }
#pragma unroll
            for (int j = 0; j < NSEG - 1; ++j) { s = __expf(dv[j]) * s + lv[j]; Lbuf[(size_t)(scan * NSEG + j) * 16384 + el] = s; } }
        for (int rep_ = 0; rep_ < DUP4; ++rep_) for (int u = vcu; u < 256; u += G) attn_unit(lds, PROJ, KR, VTg, rope, A->sinks, YAB, u >> 7, u & 127);
    }
    SEAM(4);

    for (int rep_ = 0; rep_ < DUP5; ++rep_) { if (rep_) xcd_barrier(bar);
    if (IN(5)) {
        PH_BEGIN;
        for (int it = vcu; it < 8 * 32; it += G) { const int hh = it >> 5, segF = 1 + (it & 31);
            scan_segment<true>(lds, PROJ, hh, segF, NSEG - segF, Lbuf, Dlog, OSCR);
            VM_WAIT(); __syncthreads();
            { const int l16 = lane & 15, tq = lane >> 4; const f32x4 hg0 = *(const f32x4*)(A->hgrn_g + hh * 128 + 8 * l16), hg1 = *(const f32x4*)(A->hgrn_g + hh * 128 + 8 * l16 + 4);
              for (int i0 = wave * 64; i0 < wave * 64 + 64; i0 += 16) {
                f32x4 of0[4], of1[4], ob0[4], ob1[4]; u32x4 gq[4];
#pragma unroll
                for (int b = 0; b < 4; ++b) { const int row = (segF - 1) * 512 + i0 + 4 * b + tq; const float* pf = OSCR + ((size_t)hh * NTOK + row) * 128 + 8 * l16; const float* pb = OSCR + ((size_t)(8 + hh) * NTOK + row) * 128 + 8 * l16;
                    of0[b] = *(const f32x4*)pf; of1[b] = *(const f32x4*)(pf + 4); ob0[b] = *(const f32x4*)pb; ob1[b] = *(const f32x4*)(pb + 4);
                    gq[b] = *(const u32x4*)(PROJ + PO_BG + ((size_t)hh * MROWS + row) * 128 + 8 * l16); }
#pragma unroll
                for (int b = 0; b < 4; ++b) { const int row = (segF - 1) * 512 + i0 + 4 * b + tq; const f32x4 o0 = of0[b] + ob0[b], o1 = of1[b] + ob1[b];
                    float ss = o0[0] * o0[0] + o0[1] * o0[1] + o0[2] * o0[2] + o0[3] * o0[3] + o1[0] * o1[0] + o1[1] * o1[1] + o1[2] * o1[2] + o1[3] * o1[3];
                    ss += __shfl_xor(ss, 1); ss += __shfl_xor(ss, 2); ss += __shfl_xor(ss, 4); ss += __shfl_xor(ss, 8);
                    const float rstd = rsqrtf(ss * (1.0f / 128.0f) + EPS);
                    u32x4 w; w.x = pk2(o0[0] * rstd * hg0[0] * bflo(gq[b].x), o0[1] * rstd * hg0[1] * bfhi(gq[b].x)); w.y = pk2(o0[2] * rstd * hg0[2] * bflo(gq[b].y), o0[3] * rstd * hg0[3] * bfhi(gq[b].y));
                    w.z = pk2(o1[0] * rstd * hg1[0] * bflo(gq[b].z), o1[1] * rstd * hg1[1] * bfhi(gq[b].z)); w.w = pk2(o1[2] * rstd * hg1[2] * bflo(gq[b].w), o1[3] * rstd * hg1[3] * bfhi(gq[b].w));
                    *(u32x4*)(YAB + (size_t)row * D + 1024 + hh * 128 + 8 * l16) = w; } } }
            __syncthreads();
        }
    }
    }
    SEAM(5);

    if (IN(6)) {
        PH_BEGIN;
        pg8::Gemm g{YAB, WM, D}; pg8::PlainOrder S; S.init(NTOK / 256, D / 256, G, bx); S.K2 = D * 2;
        EpiMerge E{MERGED, PROJ};
        pg8::gemm_phase<EpiMerge, pg8::PlainOrder>(lds, g, S, E);
    }
    SEAM(6);

    if (IN(7)) {
        PH_BEGIN;
        pg8::Gemm g{MERGED, WO, D}; pg8::PlainOrder S; S.init(NTOK / 256, D / 256, G, bx); S.K2 = D * 2;
        EpiOut E{X1, A->x, modl + 2 * 2048};
        pg8::gemm_phase<EpiOut, pg8::PlainOrder>(lds, g, S, E);
    }
    SEAM(7);

    if (IN(8)) {
        PH_BEGIN;
        LAS float* part = (LAS float*)lds;
        LAS float* rsd = (LAS float*)(lds + 16384);
        const int r16 = lane & 15, kk = lane >> 4;
        float bw[16][4][2];
#pragma unroll
        for (int kg = 0; kg < 16; ++kg)
#pragma unroll
            for (int m = 0; m < 4; ++m)
#pragma unroll
                for (int eh = 0; eh < 2; ++eh) bw[kg][m][eh] = wrp[(256 * wave + 16 * kg + 4 * kk + m) * 32 + 16 * eh + r16];
        for (int tl = vcu; tl < NTOK / 16; tl += G) {
            const int row0 = tl * 16;
#pragma unroll
            for (int q = 0; q < 2; ++q) { const int m = row0 + 2 * wave + q; const float* xr = X1 + (size_t)m * D + 4 * lane; f32x4 v[8]; float ss = 0.f;
#pragma unroll
                for (int j = 0; j < 8; ++j) { v[j] = *(const f32x4*)(xr + 256 * j); ss += v[j][0] * v[j][0] + v[j][1] * v[j][1] + v[j][2] * v[j][2] + v[j][3] * v[j][3]; }
                const float rstd = rsqrtf(wave_sum(ss) * (1.0f / D) + EPS);
                if (lane == 0) rsd[2 * wave + q] = rstd;
                float am = 0.f;
#pragma unroll
                for (int j = 0; j < 8; ++j) { const int k = 4 * lane + 256 * j; const f32x4 g = *(const f32x4*)(A->norm_ffn_g + k), s1 = *(const f32x4*)(modl + 4 * 2048 + k), s0 = *(const f32x4*)(modl + 3 * 2048 + k);
                    v[j] = v[j] * rstd * (g * (1.0f + s1)) + s0; am = fmaxf(am, fmaxf(fmaxf(fabsf(v[j][0]), fabsf(v[j][1])), fmaxf(fabsf(v[j][2]), fabsf(v[j][3])))); }
#pragma unroll
                for (int o = 1; o < 64; o <<= 1) am = fmaxf(am, __shfl_xor(am, o));
                if (am == 0.f) am = 1.f;
                const float qi = 127.0f / am;
                if (lane == 0) ((float*)(ws + WS_CS + CS_ROW))[m] = am * (1.0f / 127.0f);
                unsigned* hq = (unsigned*)((signed char*)(ws + WS_H) + (size_t)m * D + 4 * lane);
#pragma unroll
                for (int j = 0; j < 8; ++j) { const int q0 = (int)rintf(v[j][0] * qi), q1 = (int)rintf(v[j][1] * qi), q2 = (int)rintf(v[j][2] * qi), q3 = (int)rintf(v[j][3] * qi);
                    hq[64 * j] = ((unsigned)q0 & 0xffu) | (((unsigned)q1 & 0xffu) << 8) | (((unsigned)q2 & 0xffu) << 16) | (((unsigned)q3 & 0xffu) << 24); } }
            f32x4 acc0 = {0.f, 0.f, 0.f, 0.f}, acc1 = {0.f, 0.f, 0.f, 0.f};
            const float* xa = X1 + (size_t)(row0 + r16) * D + 256 * wave + 4 * kk;
#pragma unroll
            for (int kg = 0; kg < 16; ++kg) { const f32x4 av = *(const f32x4*)(xa + 16 * kg);
#pragma unroll
                for (int m = 0; m < 4; ++m) { acc0 = __builtin_amdgcn_mfma_f32_16x16x4f32(av[m], bw[kg][m][0], acc0, 0, 0, 0); acc1 = __builtin_amdgcn_mfma_f32_16x16x4f32(av[m], bw[kg][m][1], acc1, 0, 0, 0); } }
#pragma unroll
            for (int q = 0; q < 4; ++q) { part[(wave * 16 + 4 * kk + q) * 32 + r16] = acc0[q]; part[(wave * 16 + 4 * kk + q) * 32 + 16 + r16] = acc1[q]; }
            __syncthreads();
            { const int row = tid >> 5, e = tid & 31; float s = 0.f;
#pragma unroll
              for (int w = 0; w < 8; ++w) s += part[(w * 16 + row) * 32 + e];
              float val = rsd[row] * s + cvec[e];
              float tv[4]; int ti[4];
#pragma unroll
              for (int j = 0; j < 4; ++j) { float bv = val; int bi = e;
#pragma unroll
                  for (int off = 16; off >= 1; off >>= 1) { const float ov = __shfl_xor(bv, off); const int oi = __shfl_xor(bi, off); if (ov > bv || (ov == bv && oi < bi)) { bv = ov; bi = oi; } }
                  tv[j] = bv; ti[j] = bi; if (e == bi) val = -INFINITY; }
              const float e1 = __expf(tv[1] - tv[0]), e2 = __expf(tv[2] - tv[0]), e3 = __expf(tv[3] - tv[0]), inv = 1.0f / (1.0f + e1 + e2 + e3);
              const float gt[4] = {inv, e1 * inv, e2 * inv, e3 * inv};
#pragma unroll
              for (int j = 0; j < 4; ++j) if (e == ti[j]) { const int ai = (row0 + row) * 4 + j; const unsigned rk = atomicAdd(ctl + CW_CNT + 16 * e, 1u);
                  rt_e[ai] = e; rt_g[ai] = gt[j]; rt_r[ai] = (int)rk; } }
            __syncthreads();
        }
    }
    SEAM(8);

    if (IN(9)) {
        PH_BEGIN;
        LAS int* tb = (LAS int*)lds;
        if (tid == 0) { int acc = 0; for (int e = 0; e < NEXP; ++e) { tb[e] = acc; acc += (int)((ctl[CW_CNT + 16 * e] + 255u) >> 8); } tb[NEXP] = acc; }
        __syncthreads();
        for (int i = gtid; i < NTOK * 4; i += NGT) { const int e = rt_e[i], slot = tb[e] * 256 + rt_r[i]; rt_s[i] = slot; slot_rowoff[slot] = (unsigned)(i >> 2) * (unsigned)D; slot_gate[slot] = rt_g[i]; ((float*)(ws + WS_CS + CS_SLOT))[slot] = ((const float*)(ws + WS_CS + CS_ROW))[i >> 2]; }
        if (vcu == 0) {
            for (int e = 0; e < NEXP; ++e) { const int cnt = (int)ctl[CW_CNT + 16 * e], s0 = tb[e] * 256 + cnt, s1 = tb[e + 1] * 256;
                for (int s = s0 + tid; s < s1; s += 512) { slot_rowoff[s] = 0u; slot_gate[s] = 0.f; ((float*)(ws + WS_CS + CS_SLOT))[s] = 0.f; }
                for (int t = tb[e] + tid; t < tb[e + 1]; t += 512) tile_expert[t] = e; }
            if (tid == 0) *ntiles_p = tb[NEXP];
        }
        __syncthreads();
    }
    SEAM(9);

    if (IN(10)) {
        PH_BEGIN;
        const int ntiles = *ntiles_p;
        pg8::Gemm g{H, WGU, D / 2}; pg8::MoeOrder<true> S; S.init(ntiles, 4096 / 256, G, bx); S.K2 = D; S.nper = 4096; S.texp = tile_expert; S.sroff = slot_rowoff;
        EpiAct E{ACT, A->b_e_gate, A->b_e_up, (const float*)(ws + WS_CS), (const float*)(ws + WS_CS + CS_SLOT)};
        pg8::gemm_phase<EpiAct, pg8::MoeOrder<true>, true>(lds, g, S, E);
    }
    SEAM(10);

    if (IN(11)) {
        PH_BEGIN;
        const int ntiles = *ntiles_p;
        pg8::Gemm g{ACT, WDN, FF}; pg8::MoeOrder<false> S; S.init(ntiles, D / 256, G, bx); S.K2 = FF * 2; S.nper = D; S.texp = tile_expert; S.sroff = slot_rowoff;
        EpiDown E{YS, A->b_e_down, slot_gate};
        pg8::gemm_phase<EpiDown, pg8::MoeOrder<false>>(lds, g, S, E);
    }
    SEAM(11);

    if (IN(12)) {
        PH_BEGIN;
        f32x4 v[8], vn[8]; u32x2 yr[4][8], yn[4][8]; int sl[4];
#define P12_LOAD(VV, YY, M) do { const float* xr_ = X1 + (size_t)(M) * D + 4 * lane; \
            _Pragma("unroll") for (int j = 0; j < 8; ++j) VV[j] = *(const f32x4*)(xr_ + 256 * j); \
            _Pragma("unroll") for (int q = 0; q < 4; ++q) { const bf16* yp_ = YS + (size_t)sl[q] * D + 4 * lane; _Pragma("unroll") for (int j = 0; j < 8; ++j) YY[q][j] = *(const u32x2*)(yp_ + 256 * j); } } while (0)
#pragma unroll
        for (int q = 0; q < 4; ++q) sl[q] = rt_s[gw * 4 + q];
        P12_LOAD(v, yr, gw);
        if (gw + NGW < NTOK) {
#pragma unroll
            for (int q = 0; q < 4; ++q) sl[q] = rt_s[(gw + NGW) * 4 + q];
        }
        for (int m = gw; m < NTOK; m += NGW) {
            if (m + NGW < NTOK) { P12_LOAD(vn, yn, m + NGW);
                if (m + 2 * NGW < NTOK) {
#pragma unroll
                    for (int q = 0; q < 4; ++q) sl[q] = rt_s[(m + 2 * NGW) * 4 + q]; } }
            f32x4 y[8];
#pragma unroll
            for (int j = 0; j < 8; ++j) { y[j] = (f32x4){0.f, 0.f, 0.f, 0.f};
#pragma unroll
                for (int q = 0; q < 4; ++q) { const u32x2 w = yr[q][j]; y[j][0] += bflo(w.x); y[j][1] += bfhi(w.x); y[j][2] += bflo(w.y); y[j][3] += bfhi(w.y); } }
            float ss = 0.f;
#pragma unroll
            for (int j = 0; j < 8; ++j) { const f32x4 m5 = *(const f32x4*)(modl + 5 * 2048 + 4 * lane + 256 * j); v[j] = v[j] + m5 * y[j]; ss += v[j][0] * v[j][0] + v[j][1] * v[j][1] + v[j][2] * v[j][2] + v[j][3] * v[j][3]; }
            const float rstd = rsqrtf(wave_sum(ss) * (1.0f / D) + EPS);
            float* orow = A->out + (size_t)m * D + 4 * lane;
#pragma unroll
            for (int j = 0; j < 8; ++j) { const f32x4 fg = *(const f32x4*)(A->final_g + 4 * lane + 256 * j); *(f32x4*)(orow + 256 * j) = v[j] * rstd * fg; }
#pragma unroll
            for (int j = 0; j < 8; ++j) { v[j] = vn[j];
#pragma unroll
                for (int q = 0; q < 4; ++q) yr[q][j] = yn[q][j]; }
        }
#undef P12_LOAD
    }
#undef IN
#undef SEAM
}

#undef modl
#undef modc
#undef rope
#undef lbf
#undef lbb
#undef wrp
#undef cvec
#undef tile_expert
#undef ntiles_p
#undef rt_e
#undef rt_g
#undef rt_r
#undef rt_s
#undef slot_rowoff
#undef slot_gate
#undef Dlog
#undef KR
#undef VTg
#undef Lbuf
#undef WIN
#undef WM
#undef WO
#undef WGU
#undef WDN
#undef H
#undef PROJ
#undef ACT
#undef YAB
#undef OSCR
#undef MERGED
#undef X1
#undef YS
extern "C" void kernel_launch(void* const* d_in, const int* in_sizes, int n_in, void* d_out, int out_size, void* d_ws, size_t ws_size, hipStream_t stream) {
    static int grid = 0;
    if (grid == 0) {
        if (n_in != 24 || out_size != NTOK * D || ws_size < WS_END) { fprintf(stderr, "kernel_launch: unexpected shapes (n_in %d out %d ws %zu)\n", n_in, out_size, ws_size); grid = -1; return; }
        int dev = 0, cus = 0, per_cu = 0;
        if (hipGetDevice(&dev) != hipSuccess || hipDeviceGetAttribute(&cus, hipDeviceAttributeMultiprocessorCount, dev) != hipSuccess) { grid = -1; return; }
        if (hipFuncSetAttribute((const void*)fwd_kernel, hipFuncAttributeMaxDynamicSharedMemorySize, LDS_BYTES) != hipSuccess) { fprintf(stderr, "kernel_launch: hipFuncSetAttribute failed\n"); grid = -1; return; }
        if (hipOccupancyMaxActiveBlocksPerMultiprocessor(&per_cu, (const void*)fwd_kernel, NWAVES * 64, LDS_BYTES) != hipSuccess || per_cu < 1) { fprintf(stderr, "kernel_launch: occupancy query says %d\n", per_cu); (void)hipGetLastError(); grid = -1; return; }
        grid = cus;
    }
    if (grid < 0) return;
    if (hipMemsetAsync((char*)d_ws + WS_CTL, 0, CTL_ZERO_BYTES, stream) != hipSuccess) return;
    Args a{};
    const float** p = (const float**)&a;
    for (int i = 0; i < 24; ++i) p[i] = (const float*)d_in[i];
    a.out = (float*)d_out; a.ws = (unsigned char*)d_ws; a.ph_lo = 0; a.ph_hi = 13;
    hipLaunchKernelGGL(fwd_kernel, dim3(grid), dim3(NWAVES * 64), LDS_BYTES, stream, a);
    const hipError_t le = hipPeekAtLastError();
    if (le != hipSuccess) fprintf(stderr, "kernel_launch: launch failed: %s\n", hipGetErrorName(le));
}
```

```cpp
#include <hip/hip_runtime.h>
#include <cstdio>
#include <cstdint>

#define DI __device__ __forceinline__
#define LAS __attribute__((address_space(3)))
typedef unsigned short bf16;
typedef short bf16x8 __attribute__((ext_vector_type(8)));
typedef float f32x2 __attribute__((ext_vector_type(2)));
typedef float f32x4 __attribute__((ext_vector_type(4)));
typedef float f32x16 __attribute__((ext_vector_type(16)));
typedef unsigned u32x2 __attribute__((ext_vector_type(2)));
typedef unsigned u32x4 __attribute__((ext_vector_type(4)));
typedef __bf16 bf16x2_t __attribute__((ext_vector_type(2)));
typedef int i32x4 __attribute__((ext_vector_type(4)));

DI unsigned pk2(float lo, float hi) { f32x2 v = {lo, hi}; bf16x2_t b = __builtin_convertvector(v, bf16x2_t); return __builtin_bit_cast(unsigned, b); }
DI float bf2f(unsigned short b) { return __uint_as_float(((unsigned)b) << 16); }
DI float bflo(unsigned w) { return __uint_as_float(w << 16); }
DI float bfhi(unsigned w) { return __uint_as_float(w & 0xffff0000u); }
DI unsigned short f2bf(float f) { return (unsigned short)(pk2(f, 0.f) & 0xffffu); }
DI float wave_sum(float v) {
#pragma unroll
    for (int o = 1; o < 64; o <<= 1) v += __shfl_xor(v, o);
    return v;
}
DI float sigmoidf_(float x) { return 1.0f / (1.0f + __expf(-x)); }
#define LDS_WAIT() asm volatile("s_waitcnt lgkmcnt(0)" ::: "memory")
#define VM_WAIT() asm volatile("s_waitcnt vmcnt(0)" ::: "memory")

constexpr int D = 2048, NTOK = 16384, NCTX = 256, MROWS = NTOK + NCTX;
constexpr int INC = 10496;
constexpr int C_AQ = 0, C_AK = 1024, C_AV = 1152, C_BQ = 1280, C_ZF = 2304, C_ZB = 3328, C_BV = 4352, C_BG = 5376, C_GA = 6400, C_GB = 8448;
constexpr int NEXP = 32, FF = 2048;
constexpr int MAXTILES = 288, MAXSLOTS = MAXTILES * 256;
constexpr float EPS = 1e-6f;
constexpr int NSEG = 33;
constexpr int NWAVES = 8;
#ifndef DUP0
#define DUP0 1
#endif
#ifndef DUP3
#define DUP3 1
#endif
#ifndef DUP4
#define DUP4 1
#endif
#ifndef DUP5
#define DUP5 1
#endif

constexpr size_t MiB = 1u << 20;
constexpr size_t WS_CTL = 0, CTL_ZERO_BYTES = 1 * MiB;
constexpr size_t WS_SMALL = 1 * MiB;
constexpr size_t SM_MODL = 0, SM_MODC = 49152, SM_ROPE = 65536, SM_LB = 131072, SM_WRP = 262144, SM_CVEC = 524288, SM_TILE = 528384;
constexpr size_t WS_ROUTE = 2 * MiB;
constexpr size_t RT_E = 0, RT_G = 262144, RT_R = 524288, RT_S = 786432, RT_OFF = 1048576, RT_SG = 1048576 + 294912;
constexpr size_t WS_DLOG = 4 * MiB;
constexpr size_t WS_KR = 5 * MiB, WS_VT = 10 * MiB;
constexpr size_t WS_CS = 15 * MiB;
constexpr size_t CS_ROW = 524288, CS_SLOT = 524288 + 65536, CS_WIN = 917504, CS_HROW = 966656;
static_assert(CS_SLOT + (size_t)MAXSLOTS * 4 <= CS_WIN && CS_WIN + (size_t)INC * 4 <= CS_HROW && CS_HROW + (size_t)MROWS * 4 <= MiB, "scale arrays");
constexpr size_t WS_L = 16 * MiB;
constexpr size_t WS_WIN = 50 * MiB, WS_WM = 92 * MiB, WS_WO = 100 * MiB, WS_WGU = 108 * MiB, WS_WDN = 620 * MiB;
constexpr size_t WS_H = 876 * MiB, WS_PROJ = 942 * MiB, WS_ACT = WS_PROJ, WS_YAB = 1276 * MiB, WS_OSCR = 1340 * MiB, WS_MERGED = 1468 * MiB, WS_X1 = 1532 * MiB, WS_YS = 1660 * MiB, WS_END = 1948 * MiB;
constexpr size_t PO_AQ = 0, PO_AKV = PO_AQ + (size_t)16 * MROWS * 64, PO_BQ = PO_AKV + (size_t)MROWS * 256, PO_ZF = PO_BQ + (size_t)8 * MROWS * 128, PO_ZB = PO_ZF + (size_t)8 * MROWS * 128,
                 PO_BV = PO_ZB + (size_t)8 * MROWS * 128, PO_BG = PO_BV + (size_t)8 * MROWS * 128, PO_GA = PO_BG + (size_t)8 * MROWS * 128, PO_GB = PO_GA + (size_t)MROWS * 2048, PO_END = PO_GB + (size_t)MROWS * 2048;
static_assert(PO_END == (size_t)MROWS * INC, "projection layout");
static_assert(WS_L + (size_t)16 * NSEG * 65536 <= WS_WIN, "L");
static_assert(WS_PROJ + (size_t)MROWS * INC * 2 <= WS_YAB && WS_ACT + (size_t)MAXSLOTS * FF * 2 <= WS_YAB, "proj/act");
static_assert(WS_H + (size_t)MROWS * D * 2 <= WS_PROJ, "h");
constexpr int CW_BAR = 4096, CW_CNT = 8192;

constexpr int LDS_BYTES = 163840;
constexpr int MISC_OFF = 163840 - 256;

namespace pg8 {
constexpr int BM = 256, BK = 64, HALF = 128, HTB = HALF * BK * 2, STAGE_BYTES = 8 * HTB, NXCD = 8, WGM = 8;
__host__ __device__ __forceinline__ int lds_byte(int r, int c) { const int st = (r >> 4) * 2 + (c >> 5), rr = r & 15, cc = c & 31, ob = rr * 64 + cc * 2; return st * 1024 + (ob ^ (((ob >> 9) & 1) << 5)); }
__host__ __device__ __forceinline__ void stage_rc(int b, int& R, int& C) { const int st = b / 1024, sb = b % 1024, swz = sb ^ (((sb >> 9) & 1) << 5); R = (st >> 1) * 16 + swz / 64; C = (st & 1) * 32 + (swz % 64) / 2; }
__host__ __device__ __forceinline__ int perm32(int rho) { const int n = rho >> 4, i = rho & 15; return 8 * (i >> 2) + 4 * n + (i & 3); }

struct Unit { int pm, pn, e, brow; };
struct Gemm { const bf16* A; const bf16* Bt; int K; };

struct OrderBase {
    int nM, nN, nwg, G, c;
    DI void init(int nM_, int nN_, int G_, int c_) { nM = nM_; nN = nN_; nwg = nM * nN; G = G_; c = c_; }
    DI bool tile(int i, int& pm, int& pn) const {
        const long L = (long)i * G + c; if (L >= nwg) return false;
        int wgid = (int)L; { const int q = nwg / NXCD, r = nwg % NXCD, xcd = wgid % NXCD, off = wgid / NXCD; wgid = (xcd < r ? xcd * (q + 1) : r * (q + 1) + (xcd - r) * q) + off; }
        const int nig = WGM * nN, gid = wgid / nig, fm = gid * WGM, gsz = (nM - fm) < WGM ? (nM - fm) : WGM;
        pm = fm + ((wgid % nig) % gsz); pn = (wgid % nig) / gsz; return true;
    }
};
struct PlainOrder : OrderBase {
    int K2;
    DI bool next(int i, Unit& u) const { if (!tile(i, u.pm, u.pn)) return false; u.e = 0; u.brow = u.pn * BM; return true; }
    DI unsigned rowoff(const Unit& u, int r) const { return (unsigned)(u.pm * BM + r) * (unsigned)K2; }
};
template <bool GATHER> struct MoeOrder : OrderBase {
    int K2, nper;
    const int* texp; const unsigned* sroff;
    DI bool next(int i, Unit& u) const { if (!tile(i, u.pm, u.pn)) return false; u.e = texp[u.pm]; u.brow = u.e * nper + u.pn * BM; return true; }
    DI unsigned rowoff(const Unit& u, int r) const { if (GATHER) return sroff[u.pm * BM + r]; else return (unsigned)(u.pm * BM + r) * (unsigned)K2; }
};

template <class Epi, class Sched, bool I8 = false, bool ALIGN_EPI = true, bool SP2 = true>
__device__ __forceinline__ void gemm_phase(LAS unsigned char* lds, const Gemm g, const Sched& S, const Epi& E) {
    const int tid = threadIdx.x, wid = __builtin_amdgcn_readfirstlane(tid >> 6), lane = tid & 63, wr = wid >> 2, wc = wid & 3, fr = lane & 15, fq = lane >> 4;
    const int K = g.K, nt = K / BK;
    int stR[2]; unsigned stC2[2], voffB[2];
#pragma unroll
    for (int i = 0; i < 2; ++i) { int R, C; stage_rc(tid * 16 + i * 8192, R, C); const int Rb = Epi::PERM ? ((R & ~31) + perm32(R & 31)) : R;
        stR[i] = R; stC2[i] = (unsigned)C * 2u; voffB[i] = (unsigned)(Rb * K + C) * 2u; }
    const size_t kstep = (size_t)(BK * 2);
    const size_t hstep = (size_t)HALF * K * 2;
    const unsigned ldsw = (unsigned)wid * 1024u;
    const int aoffL = lds_byte(wr * 64 + fr, fq * 8), boffL = lds_byte(wc * 32 + fr, fq * 8);
#define PG8_SA(b, h) (((b) * 2 + (h)) * HTB)
#define PG8_SB(b, h) ((4 + (b) * 2 + (h)) * HTB)
#define PG8_STAGE(bufoff, gbase, voff) do { _Pragma("unroll") for (int _i = 0; _i < 2; ++_i) \
        __builtin_amdgcn_global_load_lds((const unsigned*)((const char*)(gbase) + (voff)[_i]), (LAS unsigned*)(lds + (bufoff) + ldsw + _i * 8192), 16, 0, 0); } while (0)
#define PG8_LDA(dst, b, h) do { _Pragma("unroll") for (int m = 0; m < 4; ++m) _Pragma("unroll") for (int k = 0; k < 2; ++k) dst[m][k] = *(const LAS bf16x8*)(lds + PG8_SA(b, h) + aoffL + m * 2048 + k * 1024); } while (0)
#define PG8_LDB(dst, b, h) do { _Pragma("unroll") for (int n = 0; n < 2; ++n) _Pragma("unroll") for (int k = 0; k < 2; ++k) dst[n][k] = *(const LAS bf16x8*)(lds + PG8_SB(b, h) + boffL + n * 2048 + k * 1024); } while (0)
#define PG8_MMA(ai, bj, At, Bt) do { __builtin_amdgcn_s_setprio(1); _Pragma("unroll") for (int m = 0; m < 4; ++m) _Pragma("unroll") for (int n = 0; n < 2; ++n) _Pragma("unroll") for (int k = 0; k < 2; ++k) \
        { if constexpr (I8) acc[ai][bj][m][n] = __builtin_bit_cast(f32x4, __builtin_amdgcn_mfma_i32_16x16x64_i8(__builtin_bit_cast(i32x4, Bt[n][k]), __builtin_bit_cast(i32x4, At[m][k]), __builtin_bit_cast(i32x4, acc[ai][bj][m][n]), 0, 0, 0)); \
          else acc[ai][bj][m][n] = __builtin_amdgcn_mfma_f32_16x16x32_bf16(Bt[n][k], At[m][k], acc[ai][bj][m][n], 0, 0, 0); } __builtin_amdgcn_s_setprio(0); } while (0)
#define PG8_WAIT_V(n) asm volatile("s_waitcnt vmcnt(" #n ")" ::: "memory")
#define PG8_WAIT_L(n) asm volatile("s_waitcnt lgkmcnt(" #n ")" ::: "memory")
#define PG8_BAR __builtin_amdgcn_s_barrier()
#define PG8_SCHED __builtin_amdgcn_sched_barrier(0)
    Unit cur, nxt; int ui = 0;
    if (!S.next(0, cur)) return;
    f32x4 acc[2][2][4][2];
#pragma unroll
    for (int a = 0; a < 2; ++a)
#pragma unroll
        for (int b = 0; b < 2; ++b)
#pragma unroll
            for (int m = 0; m < 4; ++m)
#pragma unroll
                for (int n = 0; n < 2; ++n) acc[a][b][m][n] = (f32x4){0.f, 0.f, 0.f, 0.f};
    bf16x8 At[4][2], B0[2][2], B1[2][2];
    unsigned ao0[2], ao1[2], no0[2], no1[2];
#pragma unroll
    for (int i = 0; i < 2; ++i) { ao0[i] = S.rowoff(cur, stR[i]) + stC2[i]; ao1[i] = S.rowoff(cur, HALF + stR[i]) + stC2[i]; no0[i] = ao0[i]; no1[i] = ao1[i]; }
    const char* Ab = (const char*)g.A;
    const char* cB = (const char*)g.Bt + (size_t)cur.brow * K * 2;
    if constexpr (SP2) {
        PG8_STAGE(PG8_SB(0, 0), cB, voffB); PG8_STAGE(PG8_SB(0, 1), cB + hstep, voffB); PG8_STAGE(PG8_SA(0, 0), Ab, ao0); PG8_STAGE(PG8_SA(0, 1), Ab, ao1);
        if (wr == 1) PG8_BAR;
        PG8_WAIT_V(2); PG8_BAR;
        PG8_STAGE(PG8_SB(1, 0), cB + kstep, voffB); PG8_STAGE(PG8_SA(1, 0), Ab + kstep, ao0); PG8_STAGE(PG8_SB(1, 1), cB + hstep + kstep, voffB);
        PG8_WAIT_V(6); PG8_BAR;
    } else {
        PG8_STAGE(PG8_SB(0, 0), cB, voffB); PG8_STAGE(PG8_SA(0, 0), Ab, ao0); PG8_STAGE(PG8_SB(0, 1), cB + hstep, voffB); PG8_STAGE(PG8_SA(0, 1), Ab, ao1);
        if (wr == 1) PG8_BAR;
        PG8_WAIT_V(4); PG8_BAR;
        PG8_STAGE(PG8_SB(1, 0), cB + kstep, voffB); PG8_STAGE(PG8_SA(1, 0), Ab + kstep, ao0); PG8_STAGE(PG8_SB(1, 1), cB + hstep + kstep, voffB);
        PG8_WAIT_V(6); PG8_BAR;
    }
    for (;;) {
        const bool has_next = S.next(ui + 1, nxt);
        if (has_next) {
#pragma unroll
            for (int i = 0; i < 2; ++i) { no0[i] = S.rowoff(nxt, stR[i]) + stC2[i]; no1[i] = S.rowoff(nxt, HALF + stR[i]) + stC2[i]; }
        }
        const char* nB = has_next ? (const char*)g.Bt + (size_t)nxt.brow * K * 2 : cB;
        for (int t = 0; t < nt; t += 2) {
            const bool last = (t == nt - 2);
            if constexpr (Epi::HOOK) { if (t == nt / 2) E.hook(acc, cur, wr, wc, fr, fq); }
            const char* a1 = Ab + (size_t)(t + 1) * kstep;
            const char* a2 = last ? Ab : Ab + (size_t)(t + 2) * kstep; const char* b2 = last ? nB : cB + (size_t)(t + 2) * kstep;
            const char* a3 = a2 + kstep; const char* b3 = b2 + kstep;
            unsigned x0[2], x1[2];
#pragma unroll
            for (int i = 0; i < 2; ++i) { x0[i] = last ? no0[i] : ao0[i]; x1[i] = last ? no1[i] : ao1[i]; }
            if constexpr (SP2) {
            PG8_LDB(B0, 0, 0); PG8_LDB(B1, 0, 1); PG8_SCHED; PG8_LDA(At, 0, 0); PG8_STAGE(PG8_SA(1, 1), a1, ao1);
            PG8_WAIT_V(8); PG8_WAIT_L(0); PG8_BAR; PG8_MMA(0, 0, At, B0); PG8_MMA(0, 1, At, B1); PG8_BAR; PG8_SCHED;
            PG8_LDA(At, 0, 1); PG8_STAGE(PG8_SB(0, 0), b2, voffB); PG8_STAGE(PG8_SB(0, 1), b2 + hstep, voffB); PG8_STAGE(PG8_SA(0, 0), a2, x0);
            PG8_WAIT_V(8); PG8_WAIT_L(0); PG8_BAR; PG8_MMA(1, 0, At, B0); PG8_MMA(1, 1, At, B1); PG8_BAR; PG8_SCHED;
            PG8_LDB(B0, 1, 0); PG8_LDB(B1, 1, 1); PG8_SCHED; PG8_LDA(At, 1, 0); PG8_STAGE(PG8_SA(0, 1), a2, x1);
            PG8_WAIT_V(8); PG8_WAIT_L(0); PG8_BAR; PG8_MMA(0, 0, At, B0); PG8_MMA(0, 1, At, B1); PG8_BAR; PG8_SCHED;
            PG8_LDA(At, 1, 1); PG8_STAGE(PG8_SB(1, 0), b3, voffB); PG8_STAGE(PG8_SB(1, 1), b3 + hstep, voffB); PG8_STAGE(PG8_SA(1, 0), a3, x0);
            PG8_WAIT_V(8); PG8_WAIT_L(0); PG8_BAR; PG8_MMA(1, 0, At, B0); PG8_MMA(1, 1, At, B1); PG8_BAR; PG8_SCHED;
            } else {
            PG8_LDB(B0, 0, 0); PG8_SCHED; PG8_LDA(At, 0, 0); PG8_STAGE(PG8_SA(1, 1), a1, ao1);
            PG8_WAIT_L(8); PG8_BAR; PG8_WAIT_L(0); PG8_MMA(0, 0, At, B0); PG8_BAR; PG8_SCHED;
            PG8_LDB(B1, 0, 1); PG8_STAGE(PG8_SB(0, 0), b2, voffB);
            PG8_BAR; PG8_WAIT_L(0); PG8_MMA(0, 1, At, B1); PG8_BAR;
            PG8_LDA(At, 0, 1); PG8_STAGE(PG8_SA(0, 0), a2, x0);
            PG8_BAR; PG8_WAIT_L(0); PG8_MMA(1, 0, At, B0); PG8_BAR; PG8_SCHED;
            PG8_STAGE(PG8_SB(0, 1), b2 + hstep, voffB);
            PG8_WAIT_V(6); PG8_BAR; PG8_MMA(1, 1, At, B1); PG8_BAR;
            PG8_LDB(B0, 1, 0); PG8_SCHED; PG8_LDA(At, 1, 0); PG8_STAGE(PG8_SA(0, 1), a2, x1);
            PG8_WAIT_L(8); PG8_BAR; PG8_WAIT_L(0); PG8_MMA(0, 0, At, B0); PG8_BAR; PG8_SCHED;
            PG8_LDB(B1, 1, 1); PG8_STAGE(PG8_SB(1, 0), b3, voffB);
            PG8_BAR; PG8_WAIT_L(0); PG8_MMA(0, 1, At, B1); PG8_BAR;
            PG8_LDA(At, 1, 1); PG8_STAGE(PG8_SA(1, 0), a3, x0);
            PG8_BAR; PG8_WAIT_L(0); PG8_MMA(1, 0, At, B0); PG8_BAR; PG8_SCHED;
            PG8_STAGE(PG8_SB(1, 1), b3 + hstep, voffB);
            PG8_WAIT_V(6); PG8_BAR; PG8_MMA(1, 1, At, B1); PG8_BAR;
            }
        }
        if constexpr (ALIGN_EPI) { if (wr == 0) PG8_BAR; }
        E(acc, cur, wr, wc, fr, fq);
        if (!has_next) break;
#pragma unroll
        for (int a = 0; a < 2; ++a)
#pragma unroll
            for (int b = 0; b < 2; ++b)
#pragma unroll
                for (int m = 0; m < 4; ++m)
#pragma unroll
                    for (int n = 0; n < 2; ++n) acc[a][b][m][n] = (f32x4){0.f, 0.f, 0.f, 0.f};
        cur = nxt; cB = nB; ++ui;
#pragma unroll
        for (int i = 0; i < 2; ++i) { ao0[i] = no0[i]; ao1[i] = no1[i]; }
        if constexpr (ALIGN_EPI) { if (wr == 1) PG8_BAR; }
    }
    PG8_WAIT_V(0);
    if constexpr (!ALIGN_EPI) { if (wr == 0) PG8_BAR; }
    PG8_BAR;
#undef PG8_SA
#undef PG8_SB
#undef PG8_STAGE
#undef PG8_LDA
#undef PG8_LDB
#undef PG8_MMA
#undef PG8_WAIT_V
#undef PG8_WAIT_L
#undef PG8_BAR
#undef PG8_SCHED
}
}

using pg8::Unit; using pg8::HALF; using pg8::BM;
struct EpiProj {
    static constexpr bool PERM = true, HOOK = false;
    bf16* P; const float* lbf; const float* lbb; const float* hrs; const float* wcs;
    DI void hook(f32x4 (&)[2][2][4][2], const Unit&, int, int, int, int) const {}
    DI void operator()(const f32x4 (&acc)[2][2][4][2], const Unit& u, int wr, int wc, int fr, int fq) const {
        const int pn = u.pn; int cls, cbase, hs, pitch; size_t po; const float* lb = lbf;
        if (pn < 4)       { cls = 0; cbase = C_AQ; po = PO_AQ;  hs = 6;  pitch = 64; }
        else if (pn < 5)  { cls = 0; cbase = C_AK; po = PO_AKV; hs = 30; pitch = 256; }
        else if (pn < 9)  { cls = 1; cbase = C_BQ; po = PO_BQ;  hs = 7;  pitch = 128; }
        else if (pn < 13) { cls = 2; cbase = C_ZF; po = PO_ZF;  hs = 7;  pitch = 128; }
        else if (pn < 17) { cls = 2; cbase = C_ZB; po = PO_ZB;  hs = 7;  pitch = 128; lb = lbb; }
        else if (pn < 21) { cls = 0; cbase = C_BV; po = PO_BV;  hs = 7;  pitch = 128; }
        else if (pn < 25) { cls = 1; cbase = C_BG; po = PO_BG;  hs = 7;  pitch = 128; }
        else if (pn < 33) { cls = 3; cbase = C_GA; po = PO_GA;  hs = 30; pitch = 2048; }
        else              { cls = 3; cbase = C_GB; po = PO_GB;  hs = 30; pitch = 2048; }
        int zz = 0; asm volatile("" : "+v"(zz));
        const int row0 = u.pm * BM + wr * 64 + fr + zz, cin0 = u.pn * BM + wc * 32 + 8 * fq - cbase;
        bf16* base = P + po;
#pragma unroll
        for (int bj = 0; bj < 2; ++bj) {
            float lbv[8];
            const int cin = cin0 + bj * HALF;
            { const int ci = (cls == 2) ? cin : 0; const f32x4 a = *(const f32x4*)(lb + ci), b = *(const f32x4*)(lb + ci + 4);
#pragma unroll
              for (int j = 0; j < 4; ++j) { lbv[j] = (cls == 2) ? a[j] : 0.f; lbv[4 + j] = (cls == 2) ? b[j] : 0.f; } }
            bf16* colp = base + (size_t)(cin >> hs) * MROWS * pitch + (cin & ((1 << hs) - 1));
            float csv[8];
            { const f32x4 a = *(const f32x4*)(wcs + cin + cbase), b = *(const f32x4*)(wcs + cin + cbase + 4);
#pragma unroll
              for (int j = 0; j < 4; ++j) { csv[j] = a[j]; csv[4 + j] = b[j]; } }
#pragma unroll
            for (int ai = 0; ai < 2; ++ai)
#pragma unroll
                for (int m = 0; m < 4; ++m) { const int rr = row0 + ai * HALF + m * 16; const size_t ro = (size_t)rr * pitch; float v[8]; const float rs = hrs[rr];
#pragma unroll
                    for (int j = 0; j < 8; ++j) { const float x = (float)__builtin_bit_cast(i32x4, acc[ai][bj][m][j >> 2])[j & 3] * (rs * csv[j]), sg = sigmoidf_(x), l = lbv[j], lg = __logf(l + (1.0f - l) * sg);
                        v[j] = (cls == 0) ? x : (cls == 1) ? x * sg : (cls == 2) ? lg : sg; }
                    u32x4 w; w.x = pk2(v[0], v[1]); w.y = pk2(v[2], v[3]); w.z = pk2(v[4], v[5]); w.w = pk2(v[6], v[7]);
                    *(u32x4*)(colp + ro) = w; }
        }
    }
};
struct EpiMerge {
    static constexpr bool PERM = true, HOOK = true;
    bf16* O; const bf16* proj;
    DI void hook(f32x4 (&acc)[2][2][4][2], const Unit& u, int wr, int wc, int fr, int fq) const {
        int zz = 0; asm volatile("" : "+v"(zz));
        const int row0 = u.pm * BM + wr * 64 + fr + zz, col0 = u.pn * BM + wc * 32 + 8 * fq;
#pragma unroll
        for (int ai = 0; ai < 2; ++ai)
#pragma unroll
            for (int m = 0; m < 4; ++m) { const size_t rowp = (size_t)(row0 + ai * HALF + m * 16) * D + col0;
#pragma unroll
                for (int bj = 0; bj < 2; ++bj) { const u32x4 ga = *(const u32x4*)(proj + PO_GA + rowp + bj * HALF), gb = *(const u32x4*)(proj + PO_GB + rowp + bj * HALF);
#pragma unroll
                    for (int q = 0; q < 4; ++q) { const float r0 = bflo(ga[q]) * __builtin_amdgcn_rcpf(bflo(gb[q])), r1 = bfhi(ga[q]) * __builtin_amdgcn_rcpf(bfhi(gb[q]));
                        acc[ai][bj][m][q >> 1][(q & 1) * 2] *= r0; acc[ai][bj][m][q >> 1][(q & 1) * 2 + 1] *= r1; } }
                asm volatile("" ::: "memory"); }
    }
    DI void operator()(const f32x4 (&acc)[2][2][4][2], const Unit& u, int wr, int wc, int fr, int fq) const {
        const int row0 = u.pm * BM + wr * 64 + fr, col0 = u.pn * BM + wc * 32 + 8 * fq;
#pragma unroll
        for (int ai = 0; ai < 2; ++ai)
#pragma unroll
            for (int m = 0; m < 4; ++m) { const size_t r = (size_t)(row0 + ai * HALF + m * 16);
#pragma unroll
                for (int bj = 0; bj < 2; ++bj) { const u32x4 gb = *(const u32x4*)(proj + PO_GB + r * D + col0 + bj * HALF); u32x4 w;
#pragma unroll
                    for (int q = 0; q < 4; ++q) w[q] = pk2(acc[ai][bj][m][q >> 1][(q & 1) * 2] * bflo(gb[q]), acc[ai][bj][m][q >> 1][(q & 1) * 2 + 1] * bfhi(gb[q]));
                    *(u32x4*)(O + r * D + col0 + bj * HALF) = w; } }
    }
};
struct EpiOut {
    static constexpr bool PERM = false, HOOK = false;
    float* X1; const float* x; const float* mod2;
    DI void hook(f32x4 (&)[2][2][4][2], const Unit&, int, int, int, int) const {}
    DI void operator()(const f32x4 (&acc)[2][2][4][2], const Unit& u, int wr, int wc, int fr, int fq) const {
        const int row0 = u.pm * BM + wr * 64 + fr, col0 = u.pn * BM + wc * 32 + 4 * fq;
        f32x4 mv[2][2];
#pragma unroll
        for (int bj = 0; bj < 2; ++bj)
#pragma unroll
            for (int n = 0; n < 2; ++n) mv[bj][n] = *(const f32x4*)(mod2 + col0 + bj * HALF + n * 16);
#pragma unroll
        for (int ai = 0; ai < 2; ++ai)
#pragma unroll
            for (int m = 0; m < 4; ++m) { const size_t off = (size_t)(row0 + ai * HALF + m * 16) * D + col0;
#pragma unroll
                for (int bj = 0; bj < 2; ++bj)
#pragma unroll
                    for (int n = 0; n < 2; ++n) { const f32x4 xv = *(const f32x4*)(x + off + bj * HALF + n * 16);
                        *(f32x4*)(X1 + off + bj * HALF + n * 16) = xv + mv[bj][n] * acc[ai][bj][m][n]; } }
    }
};
struct EpiAct {
    static constexpr bool PERM = true, HOOK = false;
    bf16* ACTp; const float* bg; const float* bu; const float* cs; const float* srs;
    DI void hook(f32x4 (&)[2][2][4][2], const Unit&, int, int, int, int) const {}
    DI void operator()(const f32x4 (&acc)[2][2][4][2], const Unit& u, int wr, int wc, int fr, int fq) const {
        int zz = 0; asm volatile("" : "+v"(zz));
        const int row0 = u.pm * BM + wr * 64 + fr + zz, col0 = u.pn * HALF + wc * 32 + 8 * fq, nb = u.e * 4096 + u.pn * BM + wc * 32 + 8 * fq;
        float gbv[8], ubv[8], gsc[8], usc[8];
        { const f32x4 a = *(const f32x4*)(bg + u.e * FF + col0), b = *(const f32x4*)(bg + u.e * FF + col0 + 4), c = *(const f32x4*)(bu + u.e * FF + col0), d = *(const f32x4*)(bu + u.e * FF + col0 + 4);
          const f32x4 sa = *(const f32x4*)(cs + nb), sb = *(const f32x4*)(cs + nb + 4), sc = *(const f32x4*)(cs + nb + HALF), sd = *(const f32x4*)(cs + nb + HALF + 4);
#pragma unroll
          for (int j = 0; j < 4; ++j) { gbv[j] = a[j]; gbv[4 + j] = b[j]; ubv[j] = c[j]; ubv[4 + j] = d[j]; gsc[j] = sa[j]; gsc[4 + j] = sb[j]; usc[j] = sc[j]; usc[4 + j] = sd[j]; } }
#pragma unroll
        for (int ai = 0; ai < 2; ++ai)
#pragma unroll
            for (int m = 0; m < 4; ++m) { float v[8]; const int r = row0 + ai * HALF + m * 16; const float rs = srs[r];
#pragma unroll
                for (int j = 0; j < 8; ++j) { const i32x4 ga = __builtin_bit_cast(i32x4, acc[ai][0][m][j >> 2]), ua = __builtin_bit_cast(i32x4, acc[ai][1][m][j >> 2]);
                    float gg = (float)ga[j & 3] * (rs * gsc[j]) + gbv[j], uu = (float)ua[j & 3] * (rs * usc[j]) + ubv[j];
                    gg = fminf(gg, 7.0f); uu = fminf(fmaxf(uu, -7.0f), 7.0f);
                    v[j] = gg * sigmoidf_(1.702f * gg) * (uu + 1.0f); }
                u32x4 w; w.x = pk2(v[0], v[1]); w.y = pk2(v[2], v[3]); w.z = pk2(v[4], v[5]); w.w = pk2(v[6], v[7]);
                *(u32x4*)(ACTp + (size_t)r * FF + col0) = w; }
    }
};
struct EpiDown {
    static constexpr bool PERM = true, HOOK = false;
    bf16* YS; const float* bd; const float* sgate;
    DI void hook(f32x4 (&)[2][2][4][2], const Unit&, int, int, int, int) const {}
    DI void operator()(const f32x4 (&acc)[2][2][4][2], const Unit& u, int wr, int wc, int fr, int fq) const {
        const int row0 = u.pm * BM + wr * 64 + fr, col0 = u.pn * BM + wc * 32 + 8 * fq;
        float bv[2][8];
#pragma unroll
        for (int bj = 0; bj < 2; ++bj) { const f32x4 a = *(const f32x4*)(bd + u.e * D + col0 + bj * HALF), b = *(const f32x4*)(bd + u.e * D + col0 + bj * HALF + 4);
#pragma unroll
            for (int j = 0; j < 4; ++j) { bv[bj][j] = a[j]; bv[bj][4 + j] = b[j]; } }
#pragma unroll
        for (int ai = 0; ai < 2; ++ai)
#pragma unroll
            for (int m = 0; m < 4; ++m) { const int r = row0 + ai * HALF + m * 16; const float gt = sgate[r];
#pragma unroll
                for (int bj = 0; bj < 2; ++bj) { u32x4 w;
#pragma unroll
                    for (int q = 0; q < 4; ++q) w[q] = pk2((acc[ai][bj][m][q >> 1][(q & 1) * 2] + bv[bj][2 * q]) * gt, (acc[ai][bj][m][q >> 1][(q & 1) * 2 + 1] + bv[bj][2 * q + 1]) * gt);
                    *(u32x4*)(YS + (size_t)r * D + col0 + bj * HALF) = w; } }
    }
};

#define XB_TMO      128
#define XB_XCNT(j)  (256  + 64 * (j))
#define XB_XSUB(j)  (1280 + 64 * (j))
#define XB_XGEN(j)  (2304 + 64 * (j))
#define XB_TOP      3328
#define XB_TOPGEN   3392
#define XCD_BAR_WORDS 3456
#define XB_SPIN_CAP (1u << 22)
DI unsigned xb_ld(unsigned* p)              { return __hip_atomic_load(p, __ATOMIC_RELAXED, __HIP_MEMORY_SCOPE_AGENT); }
DI unsigned xb_add(unsigned* p, unsigned v) { return __hip_atomic_fetch_add(p, v, __ATOMIC_RELAXED, __HIP_MEMORY_SCOPE_AGENT); }
DI unsigned xb_xcc_id() { return (unsigned)__builtin_amdgcn_s_getreg((3 << 11) | 20) & 0xFu; }
#define XB_SPIN(cond, bar) do { unsigned _sp = 0; while (cond) { __builtin_amdgcn_s_sleep(1); \
    if ((++_sp & 255u) == 0u) { if (xb_ld(&(bar)[XB_TMO])) break; if (_sp > XB_SPIN_CAP) { atomicAdd(&(bar)[XB_TMO], 1u); break; } } } } while (0)
struct XcdBarrier { unsigned* bar; unsigned x; volatile LAS unsigned* st; };
DI XcdBarrier xcd_barrier_post(unsigned* bar, volatile LAS unsigned* st) {
    XcdBarrier b; b.bar = bar; b.x = xb_xcc_id(); b.st = st;
    if (threadIdx.x == 0) (void)xb_add(&bar[XB_XCNT(b.x)], 1u);
    return b;
}
DI void xcd_barrier_complete(unsigned* bar, unsigned x, unsigned& nloc, unsigned& nx) {
    const unsigned G = gridDim.x * gridDim.y * gridDim.z;
    unsigned sum, cnt, mine, sp = 0u;
    for (;;) {
        sum = 0u; cnt = 0u; mine = 0u;
#pragma unroll
        for (unsigned j = 0; j < 16; ++j) { const unsigned c = xb_ld(&bar[XB_XCNT(j)]); sum += c; cnt += (c > 0u) ? 1u : 0u; mine = (j == x) ? c : mine; }
        if (sum == G) break;
        __builtin_amdgcn_s_sleep(1);
        if ((++sp & 255u) == 0u) { if (xb_ld(&bar[XB_TMO])) break; if (sp > XB_SPIN_CAP) { atomicAdd(&bar[XB_TMO], 1u); break; } }
    }
    nloc = mine > 0u ? mine : 1u; nx = cnt > 0u ? cnt : 1u;
}
DI void xcd_barrier(const XcdBarrier& b) {
    asm volatile("s_waitcnt vmcnt(0)" ::: "memory");
    __syncthreads();
    if (threadIdx.x == 0) {
        unsigned* bar = b.bar;
        __builtin_amdgcn_s_waitcnt(0);
        unsigned nloc = b.st[0], nx = b.st[1];
        if (nloc == 0u) { xcd_barrier_complete(bar, b.x, nloc, nx); b.st[0] = nloc; b.st[1] = nx; }
        const unsigned old = xb_add(&bar[XB_XSUB(b.x)], 1u);
        const unsigned gen = old / nloc;
        if (old + 1u == (gen + 1u) * nloc) {
            __builtin_amdgcn_fence(__ATOMIC_RELEASE, "agent");
            asm volatile("s_waitcnt vmcnt(0)" ::: "memory");
            const unsigned og = xb_add(&bar[XB_TOP], 1u);
            const unsigned tg = og / nx;
            if (og + 1u == (tg + 1u) * nx) xb_add(&bar[XB_TOPGEN], 1u);
            else XB_SPIN(xb_ld(&bar[XB_TOPGEN]) == tg, bar);
            __builtin_amdgcn_fence(__ATOMIC_ACQUIRE, "agent");
            xb_add(&bar[XB_XGEN(b.x)], 1u);
            asm volatile("s_waitcnt vmcnt(0)" ::: "memory");
        } else {
            XB_SPIN(xb_ld(&bar[XB_XGEN(b.x)]) == gen, bar);
            __builtin_amdgcn_fence(__ATOMIC_ACQUIRE, "agent");
            asm volatile("s_waitcnt vmcnt(0)" ::: "memory");
        }
    }
    __syncthreads();
}

struct Args {
    const float *x, *c, *ctx, *c_ctx, *norm_mix_g, *norm_ffn_g, *w_mod, *b_mod, *w_in, *sinks, *lbf_logits, *lbb_logits, *hgrn_g, *w_branch, *w_out,
                *w_router, *b_router, *w_e_gate, *b_e_gate, *w_e_up, *b_e_up, *w_e_down, *b_e_down, *final_g;
    float* out; unsigned char* ws; int ph_lo, ph_hi;
};

DI void p0_transpose64(const float* W, int ldw, bf16* WT, int ldt, LAS unsigned char* scr, int lane) {
    const int kq = lane >> 4, n4 = lane & 15;
    f32x4 v[16];
#pragma unroll
    for (int i = 0; i < 16; ++i) v[i] = *(const f32x4*)(W + (size_t)(16 * kq + i) * ldw + 4 * n4);
#pragma unroll
    for (int c = 0; c < 4; ++c)
#pragma unroll
        for (int h = 0; h < 2; ++h) { u32x4 w; w.x = pk2(v[8 * h][c], v[8 * h + 1][c]); w.y = pk2(v[8 * h + 2][c], v[8 * h + 3][c]); w.z = pk2(v[8 * h + 4][c], v[8 * h + 5][c]); w.w = pk2(v[8 * h + 6][c], v[8 * h + 7][c]);
            *(LAS u32x4*)(scr + (4 * n4 + c) * 144 + (16 * kq + 8 * h) * 2) = w; }
    LDS_WAIT(); asm volatile("" ::: "memory");
#pragma unroll
    for (int j = 0; j < 8; ++j) { const int row = (lane >> 3) + 8 * j, pc = lane & 7; const u32x4 o = *(const LAS u32x4*)(scr + row * 144 + pc * 16); *(u32x4*)(WT + (size_t)row * ldt + pc * 8) = o; }
    LDS_WAIT(); asm volatile("" ::: "memory");
}
DI void p0_quant_item(const float* W  , int ldw, signed char* Q  , float* csp  , LAS unsigned char* lds, int tid) {
    const int lane = tid & 63, w = tid >> 6, n4 = lane & 7, kr = lane >> 3;
    LAS float* smax = (LAS float*)(lds + 32 * 2064);
    f32x4 v[8][4]; f32x4 mx = {0.f, 0.f, 0.f, 0.f};
#pragma unroll
    for (int g = 0; g < 8; ++g)
#pragma unroll
        for (int r = 0; r < 4; ++r) { v[g][r] = *(const f32x4*)(W + (size_t)(256 * g + 32 * w + 4 * kr + r) * ldw + 4 * n4);
            mx[0] = fmaxf(mx[0], fabsf(v[g][r][0])); mx[1] = fmaxf(mx[1], fabsf(v[g][r][1])); mx[2] = fmaxf(mx[2], fabsf(v[g][r][2])); mx[3] = fmaxf(mx[3], fabsf(v[g][r][3])); }
#pragma unroll
    for (int c = 0; c < 4; ++c) { float m = mx[c]; m = fmaxf(m, __shfl_xor(m, 8)); m = fmaxf(m, __shfl_xor(m, 16)); m = fmaxf(m, __shfl_xor(m, 32)); mx[c] = m; }
    __syncthreads();
    if (kr == 0) *(LAS f32x4*)(smax + w * 32 + 4 * n4) = mx;
    __syncthreads();
    f32x4 cm = *(const LAS f32x4*)(smax + 4 * n4);
#pragma unroll
    for (int ww = 1; ww < 8; ++ww) { const f32x4 o = *(const LAS f32x4*)(smax + ww * 32 + 4 * n4); cm[0] = fmaxf(cm[0], o[0]); cm[1] = fmaxf(cm[1], o[1]); cm[2] = fmaxf(cm[2], o[2]); cm[3] = fmaxf(cm[3], o[3]); }
    f32x4 inv;
#pragma unroll
    for (int c = 0; c < 4; ++c) { if (cm[c] == 0.f) cm[c] = 1.f; inv[c] = 127.0f / cm[c]; }
    if (w == 0 && kr == 0) { f32x4 sc; sc[0] = cm[0] * (1.0f / 127.0f); sc[1] = cm[1] * (1.0f / 127.0f); sc[2] = cm[2] * (1.0f / 127.0f); sc[3] = cm[3] * (1.0f / 127.0f); *(f32x4*)(csp + 4 * n4) = sc; }
#pragma unroll
    for (int g = 0; g < 8; ++g)
#pragma unroll
        for (int c = 0; c < 4; ++c) { unsigned pk = 0u;
#pragma unroll
            for (int r = 0; r < 4; ++r) { const int q = (int)rintf(v[g][r][c] * inv[c]); pk |= ((unsigned)q & 0xffu) << (8 * r); }
            *(LAS unsigned*)(lds + (4 * n4 + c) * 2064 + 4 * (64 * g + 8 * w + kr)) = pk; }
    __syncthreads();
#pragma unroll
    for (int i = 0; i < 8; ++i) { const int p = tid + 512 * i, row = p >> 7, pc = p & 127; const u32x4 o = *(const LAS u32x4*)(lds + row * 2064 + pc * 16); *(u32x4*)(Q + (size_t)row * 2048 + pc * 16) = o; }
}

constexpr int SC_QH = 0, SC_KH = 8448, SC_KT = 16896, SC_VT = 26112, SC_FAC = 35328, SC_RZ = 35840, SC_RV = 44032, SC_RQ = 52224, SC_GRP = 60416;
constexpr int RSQ = 264, RST = 72;
DI int crow(int i, int h) { return (i & 3) + 8 * (i >> 2) + 4 * h; }
DI bf16x8 pack8(float a0, float a1, float a2, float a3, float a4, float a5, float a6, float a7) {
    u32x4 p; p.x = pk2(a0, a1); p.y = pk2(a2, a3); p.z = pk2(a4, a5); p.w = pk2(a6, a7); return __builtin_bit_cast(bf16x8, p);
}
DI bf16x8 lds_frag2(const LAS unsigned char* p0, const LAS unsigned char* p1) {
    const u32x2 lo = *(const LAS u32x2*)p0, hi = *(const LAS u32x2*)p1; u32x4 v; v.x = lo.x; v.y = lo.y; v.z = hi.x; v.w = hi.y; return __builtin_bit_cast(bf16x8, v);
}
#define MFMA32(a, b, c) __builtin_amdgcn_mfma_f32_32x32x16_bf16((a), (b), (c), 0, 0, 0)

template <bool OUT>
DI void scan_segment(LAS unsigned char* ldsb, const bf16* proj, int hh, int segF, int segB, float* Lbuf, float* Dlog, float* oscr) {
    const int tid = threadIdx.x, lane = tid & 63, wave = __builtin_amdgcn_readfirstlane(tid >> 6);
    const int dir = wave >> 2, w4 = wave & 3, half = w4 >> 1, d = tid & 127, r = lane & 31, h5 = lane >> 5, e0 = 32 * w4;
    const int seg = dir ? segB : segF, scan = dir * 8 + hh;
    const int ntok = (seg == 0) ? NCTX : 512, sgn = dir ? -1 : 1;
    const int r0 = (seg == 0) ? (dir ? MROWS - 1 : NTOK) : (dir ? NTOK - 1 - (seg - 1) * 512 : (seg - 1) * 512);
    LAS unsigned char* G = ldsb + dir * SC_GRP;
    LAS unsigned char* QH = G + SC_QH; LAS unsigned char* KH = G + SC_KH; LAS unsigned char* KT = G + SC_KT; LAS unsigned char* VT = G + SC_VT; LAS float* FAC = (LAS float*)(G + SC_FAC);
    float* Lslot = Lbuf + (size_t)(scan * NSEG + seg) * 16384;
    f32x16 acc[4];
    if (OUT) {
        const float* Sin = Lbuf + (size_t)(scan * NSEG + seg - 1) * 16384;
#pragma unroll
        for (int dt = 0; dt < 4; ++dt)
#pragma unroll
            for (int i = 0; i < 16; ++i) acc[dt][i] = Sin[(32 * dt + crow(i, h5)) * 128 + e0 + r];
    } else {
#pragma unroll
        for (int dt = 0; dt < 4; ++dt)
#pragma unroll
            for (int i = 0; i < 16; ++i) acc[dt][i] = 0.f;
    }
    float tail_prev = 0.f, dlog_tot = 0.f;
    const bf16* zsrc = proj + (dir ? PO_ZB : PO_ZF) + (size_t)hh * MROWS * 128; const bf16* vsrc = proj + PO_BV + (size_t)hh * MROWS * 128; const bf16* qsrc = proj + PO_BQ + (size_t)hh * MROWS * 128;
    const int nch = ntok / 32;
    LAS unsigned char* RZ = G + SC_RZ; LAS unsigned char* RV = G + SC_RV; LAS unsigned char* RQ = G + SC_RQ;
#define SC_DMA(cc) do { const int rb_ = r0 + sgn * 32 * (cc); \
        _Pragma("unroll") for (int i_ = 0; i_ < 2; ++i_) { const int s_ = 8 * w4 + 4 * i_ + (lane >> 4); const size_t so_ = (size_t)(rb_ + sgn * s_) * 128 + 8 * (lane & 15); \
            __builtin_amdgcn_global_load_lds((const unsigned*)(zsrc + so_), (LAS unsigned*)(RZ + (8 * w4 + 4 * i_) * 256), 16, 0, 0); \
            __builtin_amdgcn_global_load_lds((const unsigned*)(vsrc + so_), (LAS unsigned*)(RV + (8 * w4 + 4 * i_) * 256), 16, 0, 0); \
            if (OUT) __builtin_amdgcn_global_load_lds((const unsigned*)(qsrc + so_), (LAS unsigned*)(RQ + (8 * w4 + 4 * i_) * 256), 16, 0, 0); } } while (0)
    SC_DMA(0);
    for (int c = 0; c < nch; ++c) {
        const int rb = r0 + sgn * 32 * c;
        if (OUT && c > 0) asm volatile("s_waitcnt vmcnt(4)" ::: "memory"); else asm volatile("s_waitcnt vmcnt(0)" ::: "memory");
        asm volatile("s_waitcnt lgkmcnt(0)" ::: "memory"); __builtin_amdgcn_s_barrier(); asm volatile("" ::: "memory");
        float rsum = 0.f, lf[16], vv[16], qq[16];
        if (half) {
#pragma unroll
            for (int s = 0; s < 16; ++s) rsum += bf2f(*(const LAS unsigned short*)(RZ + s * 256 + d * 2));
        }
#pragma unroll
        for (int i = 0; i < 16; ++i) { const int so = (16 * half + i) * 256 + d * 2;
            lf[i] = bf2f(*(const LAS unsigned short*)(RZ + so)); vv[i] = bf2f(*(const LAS unsigned short*)(RV + so)); if (OUT) qq[i] = bf2f(*(const LAS unsigned short*)(RQ + so)); }
        if (!half) {
#pragma unroll
            for (int i = 0; i < 16; ++i) rsum += lf[i];
        }
        float b = half ? rsum : 0.f, kh[16], qh[16];
#pragma unroll
        for (int i = 0; i < 16; ++i) { b += lf[i]; const float x = b - rsum;
            kh[i] = (1.0f - __expf(lf[i])) * __expf(fminf(-x, 60.f));
            if (OUT) qh[i] = qq[i] * __expf(fminf(x, 60.f)); }
        const float tail = b - rsum;
#pragma unroll
        for (int j = 0; j < 4; ++j) {
            u32x2 w; w.x = pk2(kh[4 * j], kh[4 * j + 1]); w.y = pk2(kh[4 * j + 2], kh[4 * j + 3]); *(LAS u32x2*)(KT + d * RST + 32 * half + 8 * j) = w;
            u32x2 v; v.x = pk2(vv[4 * j], vv[4 * j + 1]); v.y = pk2(vv[4 * j + 2], vv[4 * j + 3]); *(LAS u32x2*)(VT + d * RST + 32 * half + 8 * j) = v;
        }
        if (OUT) {
#pragma unroll
            for (int i = 0; i < 16; ++i) { const int s = 16 * half + i;
                *(LAS unsigned short*)(KH + s * RSQ + d * 2) = f2bf(kh[i]); *(LAS unsigned short*)(QH + s * RSQ + d * 2) = f2bf(qh[i]); }
        }
        if (half) { FAC[d] = __expf(tail_prev + rsum); tail_prev = tail; dlog_tot += rsum + tail; }
        asm volatile("s_waitcnt lgkmcnt(0)" ::: "memory"); __builtin_amdgcn_s_barrier(); asm volatile("" ::: "memory");
        if (c + 1 < nch) SC_DMA(c + 1);
        asm volatile("" ::: "memory");
#pragma unroll
        for (int dt = 0; dt < 4; ++dt)
#pragma unroll
            for (int g4 = 0; g4 < 4; ++g4) { const f32x4 f = *(const LAS f32x4*)(FAC + 32 * dt + 8 * g4 + 4 * h5);
#pragma unroll
                for (int j = 0; j < 4; ++j) acc[dt][4 * g4 + j] *= f[j]; }
        if (OUT) {
            bf16x8 qf[8];
            f32x16 pT, oT;
#pragma unroll
            for (int i = 0; i < 16; ++i) { pT[i] = 0.f; oT[i] = 0.f; }
#pragma unroll
            for (int kk = 0; kk < 8; ++kk) {
                qf[kk] = lds_frag2(QH + r * RSQ + (16 * kk + 4 * h5) * 2, QH + r * RSQ + (16 * kk + 8 + 4 * h5) * 2);
                const bf16x8 kf = lds_frag2(KH + r * RSQ + (16 * kk + 4 * h5) * 2, KH + r * RSQ + (16 * kk + 8 + 4 * h5) * 2);
                pT = MFMA32(kf, qf[kk], pT);
            }
#pragma unroll
            for (int i = 0; i < 16; ++i) if (crow(i, h5) > r) pT[i] = 0.f;
#pragma unroll
            for (int dt = 0; dt < 4; ++dt)
#pragma unroll
                for (int ks = 0; ks < 2; ++ks) {
                    const bf16x8 sa = pack8(acc[dt][8 * ks], acc[dt][8 * ks + 1], acc[dt][8 * ks + 2], acc[dt][8 * ks + 3], acc[dt][8 * ks + 4], acc[dt][8 * ks + 5], acc[dt][8 * ks + 6], acc[dt][8 * ks + 7]);
                    oT = MFMA32(sa, qf[2 * dt + ks], oT);
                }
#pragma unroll
            for (int ks = 0; ks < 2; ++ks) {
                const bf16x8 pf = pack8(pT[8 * ks], pT[8 * ks + 1], pT[8 * ks + 2], pT[8 * ks + 3], pT[8 * ks + 4], pT[8 * ks + 5], pT[8 * ks + 6], pT[8 * ks + 7]);
                const bf16x8 va = lds_frag2(VT + (e0 + r) * RST + (16 * ks + 4 * h5) * 2, VT + (e0 + r) * RST + (16 * ks + 8 + 4 * h5) * 2);
                oT = MFMA32(va, pf, oT);
            }
            float* orow = oscr + ((size_t)(dir * 8 + hh) * NTOK + (rb + sgn * r)) * 128 + e0 + 4 * h5;
#pragma unroll
            for (int g4 = 0; g4 < 4; ++g4) { f32x4 o; o[0] = oT[4 * g4]; o[1] = oT[4 * g4 + 1]; o[2] = oT[4 * g4 + 2]; o[3] = oT[4 * g4 + 3]; *(f32x4*)(orow + 8 * g4) = o; }
        }
#pragma unroll
        for (int ks = 0; ks < 2; ++ks) {
            const bf16x8 vb = lds_frag2(VT + (e0 + r) * RST + (16 * ks + 8 * h5) * 2, VT + (e0 + r) * RST + (16 * ks + 8 * h5) * 2 + 8);
#pragma unroll
            for (int dt = 0; dt < 4; ++dt) {
                const bf16x8 ka = lds_frag2(KT + (32 * dt + r) * RST + (16 * ks + 8 * h5) * 2, KT + (32 * dt + r) * RST + (16 * ks + 8 * h5) * 2 + 8);
                acc[dt] = MFMA32(ka, vb, acc[dt]);
            }
        }
    }
#undef SC_DMA
    if (!OUT) {
        __syncthreads();
        if (half) { FAC[d] = __expf(tail_prev); Dlog[(size_t)(scan * NSEG + seg) * 128 + d] = dlog_tot; }
        __syncthreads();
#pragma unroll
        for (int dt = 0; dt < 4; ++dt)
#pragma unroll
            for (int g4 = 0; g4 < 4; ++g4) { const f32x4 f = *(const LAS f32x4*)(FAC + 32 * dt + 8 * g4 + 4 * h5);
#pragma unroll
                for (int j = 0; j < 4; ++j) Lslot[(32 * dt + 8 * g4 + 4 * h5 + j) * 128 + e0 + r] = acc[dt][4 * g4 + j] * f[j]; }
    }
    __syncthreads();
}

constexpr int AT_KC = 0, AT_VC = 36864, AT_KL = 70144, AT_VL = 116224, AT_END = 157696;
constexpr int KRS = 144, VCRS = 520, VLRS = 648, NSLOT = 10;
static_assert(AT_END <= MISC_OFF, "attention LDS");
DI void attn_unit(LAS unsigned char* ldsb, const bf16* proj, const bf16* KR, const bf16* VTg, const float* rope, const float* sinks, bf16* yab, int kvh, int ab) {
    const int tid = threadIdx.x, lane = tid & 63, wave = __builtin_amdgcn_readfirstlane(tid >> 6), r = lane & 31, h5 = lane >> 5;
    const int head = kvh * 8 + wave;
    LAS unsigned char* KC = ldsb + AT_KC; LAS unsigned char* VC = ldsb + AT_VC; LAS unsigned char* KL = ldsb + AT_KL; LAS unsigned char* VL = ldsb + AT_VL;
    const float* rowcos = rope, *rowsin = rope + 4096, *colcos = rope + 8192, *colsin = rope + 8192 + 1024;
    __syncthreads();
    for (int p = tid; p < 2048; p += 512) {
        { const int key = p >> 3, c8 = p & 7; const u32x4 v = *(const u32x4*)(KR + ((size_t)(kvh * MROWS + NTOK + key)) * 64 + c8 * 8); *(LAS u32x4*)(KC + key * KRS + c8 * 16) = v; }
        { const int dd = p >> 5, c = p & 31; const u32x4 v = *(const u32x4*)(VTg + ((size_t)(kvh * 64 + dd)) * MROWS + NTOK + c * 8);
          u32x2 a; a.x = v.x; a.y = v.y; u32x2 b; b.x = v.z; b.y = v.w; *(LAS u32x2*)(VC + dd * VCRS + c * 16) = a; *(LAS u32x2*)(VC + dd * VCRS + c * 16 + 8) = b; }
    }
    const int T0 = ab * 4 - 4;
    for (int p = tid; p < 2304; p += 512) {
        { const int key = p >> 3, c8 = p & 7, T = T0 + (key >> 5), slot = (T + 2 * NSLOT) % NSLOT;
          if (T >= 0 && T < NTOK / 32) { const u32x4 v = *(const u32x4*)(KR + ((size_t)(kvh * MROWS + T * 32 + (key & 31))) * 64 + c8 * 8); *(LAS u32x4*)(KL + (slot * 32 + (key & 31)) * KRS + c8 * 16) = v; } }
        { const int dd = p / 36, c = p % 36, T = T0 + (c >> 2), slot = (T + 2 * NSLOT) % NSLOT;
          if (T >= 0 && T < NTOK / 32) { const u32x4 v = *(const u32x4*)(VTg + ((size_t)(kvh * 64 + dd)) * MROWS + T * 32 + (c & 3) * 8);
            u32x2 a; a.x = v.x; a.y = v.y; u32x2 b; b.x = v.z; b.y = v.w; LAS unsigned char* dst = VL + dd * VLRS + slot * 64 + (c & 3) * 16; *(LAS u32x2*)dst = a; *(LAS u32x2*)(dst + 8) = b; } }
    }
    const float sc = 0.125f * 1.4426950408889634f;
    u32x4 raw[4]; float cs[2][8], sn[2][8];
#define AT_LOADQ(P0) do { const int qp_ = (P0) + r; const bf16* qrow_ = proj + PO_AQ + ((size_t)head * MROWS + qp_) * 64 + 8 * h5; \
        _Pragma("unroll") for (int ks = 0; ks < 4; ++ks) raw[ks] = *(const u32x4*)(qrow_ + 16 * ks); \
        const float* c0_ = rowcos + (qp_ >> 6) * 16 + 8 * h5; const float* s0_ = rowsin + (qp_ >> 6) * 16 + 8 * h5; \
        const float* c1_ = colcos + (qp_ & 63) * 16 + 8 * h5; const float* s1_ = colsin + (qp_ & 63) * 16 + 8 * h5; \
        _Pragma("unroll") for (int j = 0; j < 8; ++j) { cs[0][j] = c0_[j]; sn[0][j] = s0_[j]; cs[1][j] = c1_[j]; sn[1][j] = s1_[j]; } } while (0)
    AT_LOADQ(ab * 128);
    __syncthreads();
    for (int qt = 0; qt < 4; ++qt) {
        const int p0 = ab * 128 + 32 * qt, kb0 = p0 - 128, qp = p0 + r, Tq = ab * 4 + qt - 4;
        bf16x8 qf[4];
#pragma unroll
        for (int ks = 0; ks < 2; ++ks) { float o1[8], o2[8];
#pragma unroll
            for (int q = 0; q < 4; ++q) {
                const float a0 = bflo(raw[ks][q]), a1 = bfhi(raw[ks][q]), b0 = bflo(raw[ks + 2][q]), b1 = bfhi(raw[ks + 2][q]);
                o1[2 * q] = a0 * cs[ks][2 * q] - b0 * sn[ks][2 * q]; o2[2 * q] = b0 * cs[ks][2 * q] + a0 * sn[ks][2 * q];
                o1[2 * q + 1] = a1 * cs[ks][2 * q + 1] - b1 * sn[ks][2 * q + 1]; o2[2 * q + 1] = b1 * cs[ks][2 * q + 1] + a1 * sn[ks][2 * q + 1]; }
            qf[ks] = pack8(o1[0], o1[1], o1[2], o1[3], o1[4], o1[5], o1[6], o1[7]);
            qf[ks + 2] = pack8(o2[0], o2[1], o2[2], o2[3], o2[4], o2[5], o2[6], o2[7]); }
        const int Tn = Tq + 9; const bool pre = (qt < 3) && Tn >= 0 && Tn < NTOK / 32; u32x4 nk = {0u, 0u, 0u, 0u};
        if (pre) { if (tid < 256) nk = *(const u32x4*)(KR + ((size_t)(kvh * MROWS + Tn * 32 + (tid >> 3))) * 64 + (tid & 7) * 8);
                   else { const int t2 = tid - 256; nk = *(const u32x4*)(VTg + ((size_t)(kvh * 64 + (t2 >> 2))) * MROWS + Tn * 32 + (t2 & 3) * 8); } }
        if (qt < 3) AT_LOADQ(p0 + 32);
        float m_run = sinks[head] * 1.4426950408889634f, l_run = h5 ? 0.f : 1.f;
        f32x16 o0, o1;
#pragma unroll
        for (int i = 0; i < 16; ++i) { o0[i] = 0.f; o1[i] = 0.f; }
        for (int kt = 0; kt < 17; ++kt) {
            const bool lat = kt >= 8; const int j = kt - 8, T = Tq + j, kb = kb0 + 32 * j, slot = (T + 2 * NSLOT) % NSLOT;
            if (lat && (T < 0 || T >= NTOK / 32)) continue;
            const LAS unsigned char* Kb = lat ? KL + (32 * slot + r) * KRS : KC + (32 * kt + r) * KRS;
            const LAS unsigned char* Vb = lat ? VL + r * VLRS + 64 * slot : VC + r * VCRS + 64 * kt;
            const int vrs32 = 32 * (lat ? VLRS : VCRS);
            f32x16 s;
#pragma unroll
            for (int i = 0; i < 16; ++i) s[i] = 0.f;
#pragma unroll
            for (int ks = 0; ks < 4; ++ks) { const bf16x8 kf = *(const LAS bf16x8*)(Kb + (16 * ks + 8 * h5) * 2); s = MFMA32(kf, qf[ks], s); }
            float mt = -INFINITY;
#pragma unroll
            for (int i = 0; i < 16; ++i) { float v = s[i] * sc;
                if (lat) { const int dk = kb + crow(i, h5) - qp; if (dk > 128 || dk < -128) v = -INFINITY; }
                s[i] = v; mt = fmaxf(mt, v); }
            mt = fmaxf(mt, __shfl_xor(mt, 32));
            const float mn = fmaxf(m_run, mt), alpha = __builtin_amdgcn_exp2f(m_run - mn);
            m_run = mn; l_run *= alpha;
#pragma unroll
            for (int i = 0; i < 16; ++i) { o0[i] *= alpha; o1[i] *= alpha; }
            float ps = 0.f;
#pragma unroll
            for (int i = 0; i < 16; ++i) { const float p = __builtin_amdgcn_exp2f(s[i] - mn); s[i] = p; ps += p; }
            l_run += ps;
#pragma unroll
            for (int ks = 0; ks < 2; ++ks) {
                const bf16x8 pf = pack8(s[8 * ks], s[8 * ks + 1], s[8 * ks + 2], s[8 * ks + 3], s[8 * ks + 4], s[8 * ks + 5], s[8 * ks + 6], s[8 * ks + 7]);
                const bf16x8 v0 = lds_frag2(Vb + (16 * ks + 4 * h5) * 2, Vb + (16 * ks + 8 + 4 * h5) * 2);
                const bf16x8 v1 = lds_frag2(Vb + vrs32 + (16 * ks + 4 * h5) * 2, Vb + vrs32 + (16 * ks + 8 + 4 * h5) * 2);
                o0 = MFMA32(v0, pf, o0);
                o1 = MFMA32(v1, pf, o1);
            }
        }
        const float l = l_run + __shfl_xor(l_run, 32), inv = 1.0f / l;
        bf16* orow = yab + (size_t)qp * D + head * 64 + 4 * h5;
#pragma unroll
        for (int g4 = 0; g4 < 4; ++g4) {
            u32x2 a; a.x = pk2(o0[4 * g4] * inv, o0[4 * g4 + 1] * inv); a.y = pk2(o0[4 * g4 + 2] * inv, o0[4 * g4 + 3] * inv); *(u32x2*)(orow + 8 * g4) = a;
            u32x2 b; b.x = pk2(o1[4 * g4] * inv, o1[4 * g4 + 1] * inv); b.y = pk2(o1[4 * g4 + 2] * inv, o1[4 * g4 + 3] * inv); *(u32x2*)(orow + 32 + 8 * g4) = b;
        }
        if (pre) { const int slot = (Tn + 2 * NSLOT) % NSLOT;
            if (tid < 256) *(LAS u32x4*)(KL + (slot * 32 + (tid >> 3)) * KRS + (tid & 7) * 16) = nk;
            else { const int t2 = tid - 256; u32x2 a; a.x = nk.x; a.y = nk.y; u32x2 b; b.x = nk.z; b.y = nk.w; LAS unsigned char* dst = VL + (t2 >> 2) * VLRS + slot * 64 + (t2 & 3) * 16; *(LAS u32x2*)dst = a; *(LAS u32x2*)(dst + 8) = b; } }
        __syncthreads();
    }
#undef AT_LOADQ
}

typedef const Args __attribute__((address_space(4))) ArgsC;
DI ArgsC* args_ptr() { ArgsC* p = (ArgsC*)__builtin_amdgcn_kernarg_segment_ptr(); asm volatile("" : "+s"(p)); return p; }
#define PH_BEGIN ArgsC* A = args_ptr(); unsigned char* const ws = A->ws; (void)ws
#define modl ((float*)(ws + WS_SMALL + SM_MODL))
#define modc ((float*)(ws + WS_SMALL + SM_MODC))
#define rope ((float*)(ws + WS_SMALL + SM_ROPE))
#define lbf ((float*)(ws + WS_SMALL + SM_LB))
#define lbb (lbf + 1024)
#define wrp ((float*)(ws + WS_SMALL + SM_WRP))
#define cvec ((float*)(ws + WS_SMALL + SM_CVEC))
#define tile_expert ((int*)(ws + WS_SMALL + SM_TILE))
#define ntiles_p (tile_expert + 512)
#define rt_e ((int*)(ws + WS_ROUTE + RT_E))
#define rt_g ((float*)(ws + WS_ROUTE + RT_G))
#define rt_r ((int*)(ws + WS_ROUTE + RT_R))
#define rt_s ((int*)(ws + WS_ROUTE + RT_S))
#define slot_rowoff ((unsigned*)(ws + WS_ROUTE + RT_OFF))
#define slot_gate ((float*)(ws + WS_ROUTE + RT_SG))
#define Dlog ((float*)(ws + WS_DLOG))
#define KR ((bf16*)(ws + WS_KR))
#define VTg ((bf16*)(ws + WS_VT))
#define Lbuf ((float*)(ws + WS_L))
#define WIN ((bf16*)(ws + WS_WIN))
#define WM ((bf16*)(ws + WS_WM))
#define WO ((bf16*)(ws + WS_WO))
#define WGU ((bf16*)(ws + WS_WGU))
#define WDN ((bf16*)(ws + WS_WDN))
#define H ((bf16*)(ws + WS_H))
#define PROJ ((bf16*)(ws + WS_PROJ))
#define ACT ((bf16*)(ws + WS_ACT))
#define YAB ((bf16*)(ws + WS_YAB))
#define OSCR ((float*)(ws + WS_OSCR))
#define MERGED ((bf16*)(ws + WS_MERGED))
#define X1 ((float*)(ws + WS_X1))
#define YS ((bf16*)(ws + WS_YS))

__global__ void __launch_bounds__(NWAVES * 64, 2) fwd_kernel(Args a_unused) {
    extern __shared__ __attribute__((aligned(16))) unsigned char lds_raw[];
    LAS unsigned char* lds = (LAS unsigned char*)lds_raw;
    volatile LAS unsigned* MISC = (volatile LAS unsigned*)(lds + MISC_OFF);
    const int tid = threadIdx.x, lane = tid & 63, wave = __builtin_amdgcn_readfirstlane(tid >> 6);
    const int G = gridDim.x, bx = blockIdx.x, vcu = (G % 8 == 0) ? (bx % 8) * (G / 8) + bx / 8 : bx;
    const int gw = vcu * NWAVES + wave, NGW = G * NWAVES;
    const int gtid = vcu * 512 + tid, NGT = G * 512;
    unsigned* ctl; { const ArgsC* A0 = args_ptr(); ctl = (unsigned*)(A0->ws + WS_CTL); }
    if (tid < 64) MISC[tid] = 0u;
    __syncthreads();
    XcdBarrier bar = xcd_barrier_post(ctl + CW_BAR, MISC);
    int lo, hi; { const ArgsC* A0 = args_ptr(); lo = A0->ph_lo; hi = A0->ph_hi; }
#ifndef PH_MASK
#define PH_MASK 0x1fff
#endif
#define IN(k) ((((PH_MASK) >> (k)) & 1) && lo <= (k) && (k) < hi)
#define SEAM(k) do { if (IN(k) && IN((k) + 1)) xcd_barrier(bar); } while (0)

    for (int rep_ = 0; rep_ < DUP0; ++rep_) { if (rep_) xcd_barrier(bar);
    if (IN(0)) {
        PH_BEGIN;
        LAS float* sc = (LAS float*)lds; LAS float* scc = sc + 2048; LAS f32x4* red = (LAS f32x4*)(lds + 16384);
        if (vcu < 48) {
            for (int k = tid; k < 2048; k += 512) { const float v = A->c[k], u = A->c_ctx[k]; sc[k] = v * sigmoidf_(v); scc[k] = u * sigmoidf_(u); }
            __syncthreads();
            const int cb = vcu, col = 256 * cb + 4 * lane; const bool hasc = cb < 16;
            f32x4 al = {0.f, 0.f, 0.f, 0.f}, ac = {0.f, 0.f, 0.f, 0.f};
#pragma unroll 8
            for (int k = wave; k < 2048; k += 8) { const f32x4 wv = *(const f32x4*)(A->w_mod + (size_t)k * 12288 + col); al += sc[k] * wv; ac += scc[k] * wv; }
            red[wave * 64 + lane] = al; red[512 + wave * 64 + lane] = ac;
            __syncthreads();
            if (wave == 0) { f32x4 s = *(const f32x4*)(A->b_mod + col), t = s;
#pragma unroll
                for (int w = 0; w < 8; ++w) { s += red[w * 64 + lane]; t += red[512 + w * 64 + lane]; }
                *(f32x4*)(modl + col) = s; if (hasc) *(f32x4*)(modc + col) = t; }
            __syncthreads();
        }
        if (vcu == G - 1) {
            for (int i = tid; i < 4096 + 1024; i += 512) { const bool isrow = i < 4096; const int ii = isrow ? i : i - 4096, p = ii >> 4, j = ii & 15;
                const float inv = powf(10000.0f, -(float)j / 16.0f), ang = (float)p * inv; float s, c; sincosf(ang, &s, &c);
                if (isrow) { rope[ii] = c; rope[4096 + ii] = s; } else { rope[8192 + ii] = c; rope[9216 + ii] = s; } }
            for (int i = tid; i < 2048; i += 512) { const float* lg = (i < 1024) ? A->lbf_logits : A->lbb_logits; const int ch = i & 1023;
                const float v = 1.0f / (1.0f + expf(lg[1024 + ch] - lg[ch])); if (i < 1024) lbf[ch] = v; else lbb[ch] = v; }
        }
        __syncthreads();
        for (int it = vcu; it < INC / 32; it += G) p0_quant_item(A->w_in + 32 * it, INC, (signed char*)(ws + WS_WIN) + (size_t)(32 * it) * 2048, (float*)(ws + WS_CS + CS_WIN) + 32 * it, lds, tid);
        for (int it = vcu; it < 32 * 2 * 64; it += G) { const int e = it >> 7, which = (it >> 6) & 1, jb = it & 63, n0 = 32 * jb, np = e * 4096 + (n0 >> 7) * 256 + which * 128 + (n0 & 127);
            p0_quant_item((which ? A->w_e_up : A->w_e_gate) + (size_t)e * D * FF + n0, FF, (signed char*)(ws + WS_WGU) + (size_t)np * 2048, (float*)(ws + WS_CS) + np, lds, tid); }
        __syncthreads();
        LAS unsigned char* scr = lds + wave * 9216;
        constexpr int I_BR = 1024, I_OUT = 1024, I_E = 32 * 1024;
        constexpr int NITEMS = I_BR + I_OUT + I_E;
        for (int it = gw; it < NITEMS; it += NGW) {
            int r = it;
            if (r < I_BR) { const int br = r >> 9, r2 = r & 511, kb = r2 >> 5, nb = r2 & 31;
                p0_transpose64(A->w_branch + (size_t)br * 1024 * D + (size_t)(64 * kb) * D + 64 * nb, D, WM + (size_t)(64 * nb) * D + br * 1024 + 64 * kb, D, scr, lane); continue; } r -= I_BR;
            if (r < I_OUT) { const int kb = r >> 5, nb = r & 31; p0_transpose64(A->w_out + (size_t)(64 * kb) * D + 64 * nb, D, WO + (size_t)(64 * nb) * D + 64 * kb, D, scr, lane); continue; } r -= I_OUT;
            const int e = r >> 10, r2 = r & 1023, kb = r2 >> 5, nb = r2 & 31;
            p0_transpose64(A->w_e_down + (size_t)e * D * FF + (size_t)(64 * kb) * FF + 64 * nb, FF, WDN + ((size_t)e * D + 64 * nb) * FF + 64 * kb, FF, scr, lane);
        }
    }
    }
    SEAM(0);

    if (IN(1)) {
        PH_BEGIN;
        {
            f32x4 ca[8], cb[8];
#pragma unroll
            for (int j = 0; j < 8; ++j) { const int k = 4 * lane + 256 * j; const f32x4 g = *(const f32x4*)(A->norm_mix_g + k), s1 = *(const f32x4*)(modl + 2048 + k); ca[j] = g * (1.0f + s1); cb[j] = *(const f32x4*)(modl + k); }
            f32x4 v[8], vn[8];
            { const float* xr = A->x + (size_t)gw * D + 4 * lane;
#pragma unroll
              for (int j = 0; j < 8; ++j) v[j] = *(const f32x4*)(xr + 256 * j); }
            for (int m = gw; m < NTOK; m += NGW) {
                if (m + NGW < NTOK) { const float* xn = A->x + (size_t)(m + NGW) * D + 4 * lane;
#pragma unroll
                    for (int j = 0; j < 8; ++j) vn[j] = *(const f32x4*)(xn + 256 * j); }
                float ss = 0.f;
#pragma unroll
                for (int j = 0; j < 8; ++j) ss += v[j][0] * v[j][0] + v[j][1] * v[j][1] + v[j][2] * v[j][2] + v[j][3] * v[j][3];
                const float rstd = rsqrtf(wave_sum(ss) * (1.0f / D) + EPS);
                float am = 0.f;
#pragma unroll
                for (int j = 0; j < 8; ++j) { v[j] = v[j] * rstd * ca[j] + cb[j]; am = fmaxf(am, fmaxf(fmaxf(fabsf(v[j][0]), fabsf(v[j][1])), fmaxf(fabsf(v[j][2]), fabsf(v[j][3])))); }
#pragma unroll
                for (int o = 1; o < 64; o <<= 1) am = fmaxf(am, __shfl_xor(am, o));
                if (am == 0.f) am = 1.f;
                const float qi = 127.0f / am;
                if (lane == 0) ((float*)(ws + WS_CS + CS_HROW))[m] = am * (1.0f / 127.0f);
                unsigned* hq = (unsigned*)((signed char*)(ws + WS_H) + (size_t)m * D + 4 * lane);
#pragma unroll
                for (int j = 0; j < 8; ++j) { const int q0 = (int)rintf(v[j][0] * qi), q1 = (int)rintf(v[j][1] * qi), q2 = (int)rintf(v[j][2] * qi), q3 = (int)rintf(v[j][3] * qi);
                    hq[64 * j] = ((unsigned)q0 & 0xffu) | (((unsigned)q1 & 0xffu) << 8) | (((unsigned)q2 & 0xffu) << 16) | (((unsigned)q3 & 0xffu) << 24); }
#pragma unroll
                for (int j = 0; j < 8; ++j) v[j] = vn[j];
            }
        }
        if (gw < NCTX) {
            const int m = gw; const float* xr = A->ctx + (size_t)m * D + 4 * lane; f32x4 v[8]; float ss = 0.f;
#pragma unroll
            for (int j = 0; j < 8; ++j) { v[j] = *(const f32x4*)(xr + 256 * j); ss += v[j][0] * v[j][0] + v[j][1] * v[j][1] + v[j][2] * v[j][2] + v[j][3] * v[j][3]; }
            const float rstd = rsqrtf(wave_sum(ss) * (1.0f / D) + EPS);
            float am = 0.f;
#pragma unroll
            for (int j = 0; j < 8; ++j) { const int k = 4 * lane + 256 * j; const f32x4 g = *(const f32x4*)(A->norm_mix_g + k), s1 = *(const f32x4*)(modc + 2048 + k), s0 = *(const f32x4*)(modc + k);
                v[j] = v[j] * rstd * (g * (1.0f + s1)) + s0; am = fmaxf(am, fmaxf(fmaxf(fabsf(v[j][0]), fabsf(v[j][1])), fmaxf(fabsf(v[j][2]), fabsf(v[j][3])))); }
#pragma unroll
            for (int o = 1; o < 64; o <<= 1) am = fmaxf(am, __shfl_xor(am, o));
            if (am == 0.f) am = 1.f;
            const float qi = 127.0f / am;
            if (lane == 0) ((float*)(ws + WS_CS + CS_HROW))[NTOK + m] = am * (1.0f / 127.0f);
            unsigned* hq = (unsigned*)((signed char*)(ws + WS_H) + (size_t)(NTOK + m) * D + 4 * lane);
#pragma unroll
            for (int j = 0; j < 8; ++j) { const int q0 = (int)rintf(v[j][0] * qi), q1 = (int)rintf(v[j][1] * qi), q2 = (int)rintf(v[j][2] * qi), q3 = (int)rintf(v[j][3] * qi);
                hq[64 * j] = ((unsigned)q0 & 0xffu) | (((unsigned)q1 & 0xffu) << 8) | (((unsigned)q2 & 0xffu) << 16) | (((unsigned)q3 & 0xffu) << 24); }
        }
        for (int i = gtid; i < 2048 * 32; i += NGT) { const int k = i >> 5; wrp[i] = A->norm_ffn_g[k] * (1.0f + modl[4 * 2048 + k]) * A->w_router[i]; }
        if (vcu == G - 1) {
            for (int e = wave * 4; e < wave * 4 + 4; ++e) { float s = 0.f; for (int k = lane; k < 2048; k += 64) s += modl[3 * 2048 + k] * A->w_router[k * 32 + e];
                s = wave_sum(s); if (lane == 0) cvec[e] = s + A->b_router[e]; }
        }
    }
    SEAM(1);

    if (IN(2)) {
        PH_BEGIN;
        pg8::Gemm g{H, WIN, D / 2}; pg8::PlainOrder S; S.init(MROWS / 256, INC / 256, G, bx); S.K2 = D;
        EpiProj E{PROJ, lbf, lbb, (const float*)(ws + WS_CS + CS_HROW), (const float*)(ws + WS_CS + CS_WIN)};
        pg8::gemm_phase<EpiProj, pg8::PlainOrder, true>(lds, g, S, E);
    }
    SEAM(2);

    for (int rep_ = 0; rep_ < DUP3; ++rep_) { if (rep_) xcd_barrier(bar);
    if (IN(3)) {
        PH_BEGIN;
        for (int i = gtid; i < MROWS * 8; i += NGT) { const int jg = i & 3, kvh = (i >> 2) & 1, pos = i >> 3, j0 = 8 * jg;
            const bf16* kr = PROJ + PO_AKV + (size_t)pos * 256 + kvh * 64 + j0; const u32x4 a1 = *(const u32x4*)kr, a2 = *(const u32x4*)(kr + 32); u32x4 w1 = a1, w2 = a2;
            if (pos < NTOK) { const float* ct = (jg < 2) ? rope + (pos >> 6) * 16 + j0 : rope + 8192 + (pos & 63) * 16 + j0 - 16; const float* st = ct + ((jg < 2) ? 4096 : 1024);
                const f32x4 c0 = *(const f32x4*)ct, c1 = *(const f32x4*)(ct + 4), s0 = *(const f32x4*)st, s1 = *(const f32x4*)(st + 4);
#pragma unroll
                for (int q = 0; q < 4; ++q) { const float cl = q < 2 ? c0[2 * q] : c1[2 * q - 4], ch = q < 2 ? c0[2 * q + 1] : c1[2 * q - 3], sl = q < 2 ? s0[2 * q] : s1[2 * q - 4], sh = q < 2 ? s0[2 * q + 1] : s1[2 * q - 3];
                    const float k1l = bflo(a1[q]), k1h = bfhi(a1[q]), k2l = bflo(a2[q]), k2h = bfhi(a2[q]);
                    w1[q] = pk2(k1l * cl - k2l * sl, k1h * ch - k2h * sh); w2[q] = pk2(k2l * cl + k1l * sl, k2h * ch + k1h * sh); } }
            bf16* ko = KR + ((size_t)kvh * MROWS + pos) * 64 + j0; *(u32x4*)ko = w1; *(u32x4*)(ko + 32) = w2; }
        for (int i = gtid; i < 2 * (MROWS / 8) * 64; i += NGT) { const int dd = i & 63, pb = (i >> 6) % (MROWS / 8), kvh = (i >> 6) / (MROWS / 8);
            const bf16* vr = PROJ + PO_AKV + (size_t)(pb * 8) * 256 + 128 + kvh * 64 + dd; unsigned short t[8];
#pragma unroll
            for (int q = 0; q < 8; ++q) t[q] = vr[(size_t)q * 256];
            u32x4 w; w.x = t[0] | ((unsigned)t[1] << 16); w.y = t[2] | ((unsigned)t[3] << 16); w.z = t[4] | ((unsigned)t[5] << 16); w.w = t[6] | ((unsigned)t[7] << 16);
            *(u32x4*)(VTg + ((size_t)kvh * 64 + dd) * MROWS + pb * 8) = w; }
        for (int it = vcu; it < 8 * (NSEG - 1); it += G) { const int hh = it >> 5, seg = it & 31; scan_segment<false>(lds, PROJ, hh, seg, seg, Lbuf, Dlog, nullptr); }
    }
    }
    SEAM(3);

    if (IN(4)) {
        PH_BEGIN;
        for (int i = gtid; i < 16 * 16384; i += NGT) { const int scan = i >> 14, el = i & 16383, dd = el >> 7; float s = 0.f, lv[NSEG - 1], dv[NSEG - 1];
#pragma unroll
            for (int j = 0; j < NSEG - 1; ++j) { lv[j] = Lbuf[(size_t)(scan * NSEG + j) * 16384 + el]; dv[j] = Dlog[(scan * NSEG + j) * 128 + dd]; }
#pragma unroll
            for (int j = 0; j < NSEG - 1; ++j) { s = __expf(dv[j]) * s + lv[j]; Lbuf[(size_t)(scan * NSEG + j) * 16384 + el] = s; } }
        for (int rep_ = 0; rep_ < DUP4; ++rep_) for (int u = vcu; u < 256; u += G) attn_unit(lds, PROJ, KR, VTg, rope, A->sinks, YAB, u >> 7, u & 127);
    }
    SEAM(4);

    for (int rep_ = 0; rep_ < DUP5; ++rep_) { if (rep_) xcd_barrier(bar);
    if (IN(5)) {
        PH_BEGIN;
        for (int it = vcu; it < 8 * 32; it += G) { const int hh = it >> 5, segF = 1 + (it & 31);
            scan_segment<true>(lds, PROJ, hh, segF, NSEG - segF, Lbuf, Dlog, OSCR);
            VM_WAIT(); __syncthreads();
            { const int l16 = lane & 15, tq = lane >> 4; const f32x4 hg0 = *(const f32x4*)(A->hgrn_g + hh * 128 + 8 * l16), hg1 = *(const f32x4*)(A->hgrn_g + hh * 128 + 8 * l16 + 4);
              for (int i0 = wave * 64; i0 < wave * 64 + 64; i0 += 16) {
                f32x4 of0[4], of1[4], ob0[4], ob1[4]; u32x4 gq[4];
#pragma unroll
                for (int b = 0; b < 4; ++b) { const int row = (segF - 1) * 512 + i0 + 4 * b + tq; const float* pf = OSCR + ((size_t)hh * NTOK + row) * 128 + 8 * l16; const float* pb = OSCR + ((size_t)(8 + hh) * NTOK + row) * 128 + 8 * l16;
                    of0[b] = *(const f32x4*)pf; of1[b] = *(const f32x4*)(pf + 4); ob0[b] = *(const f32x4*)pb; ob1[b] = *(const f32x4*)(pb + 4);
                    gq[b] = *(const u32x4*)(PROJ + PO_BG + ((size_t)hh * MROWS + row) * 128 + 8 * l16); }
#pragma unroll
                for (int b = 0; b < 4; ++b) { const int row = (segF - 1) * 512 + i0 + 4 * b + tq; const f32x4 o0 = of0[b] + ob0[b], o1 = of1[b] + ob1[b];
                    float ss = o0[0] * o0[0] + o0[1] * o0[1] + o0[2] * o0[2] + o0[3] * o0[3] + o1[0] * o1[0] + o1[1] * o1[1] + o1[2] * o1[2] + o1[3] * o1[3];
                    ss += __shfl_xor(ss, 1); ss += __shfl_xor(ss, 2); ss += __shfl_xor(ss, 4); ss += __shfl_xor(ss, 8);
                    const float rstd = rsqrtf(ss * (1.0f / 128.0f) + EPS);
                    u32x4 w; w.x = pk2(o0[0] * rstd * hg0[0] * bflo(gq[b].x), o0[1] * rstd * hg0[1] * bfhi(gq[b].x)); w.y = pk2(o0[2] * rstd * hg0[2] * bflo(gq[b].y), o0[3] * rstd * hg0[3] * bfhi(gq[b].y));
                    w.z = pk2(o1[0] * rstd * hg1[0] * bflo(gq[b].z), o1[1] * rstd * hg1[1] * bfhi(gq[b].z)); w.w = pk2(o1[2] * rstd * hg1[2] * bflo(gq[b].w), o1[3] * rstd * hg1[3] * bfhi(gq[b].w));
                    *(u32x4*)(YAB + (size_t)row * D + 1024 + hh * 128 + 8 * l16) = w; } } }
            __syncthreads();
        }
    }
    }
    SEAM(5);

    if (IN(6)) {
        PH_BEGIN;
        pg8::Gemm g{YAB, WM, D}; pg8::PlainOrder S; S.init(NTOK / 256, D / 256, G, bx); S.K2 = D * 2;
        EpiMerge E{MERGED, PROJ};
        pg8::gemm_phase<EpiMerge, pg8::PlainOrder>(lds, g, S, E);
    }
    SEAM(6);

    if (IN(7)) {
        PH_BEGIN;
        pg8::Gemm g{MERGED, WO, D}; pg8::PlainOrder S; S.init(NTOK / 256, D / 256, G, bx); S.K2 = D * 2;
        EpiOut E{X1, A->x, modl + 2 * 2048};
        pg8::gemm_phase<EpiOut, pg8::PlainOrder>(lds, g, S, E);
    }
    SEAM(7);

    if (IN(8)) {
        PH_BEGIN;
        LAS float* part = (LAS float*)lds;
        LAS float* rsd = (LAS float*)(lds + 16384);
        const int r16 = lane & 15, kk = lane >> 4;
        float bw[16][4][2];
#pragma unroll
        for (int kg = 0; kg < 16; ++kg)
#pragma unroll
            for (int m = 0; m < 4; ++m)
#pragma unroll
                for (int eh = 0; eh < 2; ++eh) bw[kg][m][eh] = wrp[(256 * wave + 16 * kg + 4 * kk + m) * 32 + 16 * eh + r16];
        for (int tl = vcu; tl < NTOK / 16; tl += G) {
            const int row0 = tl * 16;
#pragma unroll
            for (int q = 0; q < 2; ++q) { const int m = row0 + 2 * wave + q; const float* xr = X1 + (size_t)m * D + 4 * lane; f32x4 v[8]; float ss = 0.f;
#pragma unroll
                for (int j = 0; j < 8; ++j) { v[j] = *(const f32x4*)(xr + 256 * j); ss += v[j][0] * v[j][0] + v[j][1] * v[j][1] + v[j][2] * v[j][2] + v[j][3] * v[j][3]; }
                const float rstd = rsqrtf(wave_sum(ss) * (1.0f / D) + EPS);
                if (lane == 0) rsd[2 * wave + q] = rstd;
                float am = 0.f;
#pragma unroll
                for (int j = 0; j < 8; ++j) { const int k = 4 * lane + 256 * j; const f32x4 g = *(const f32x4*)(A->norm_ffn_g + k), s1 = *(const f32x4*)(modl + 4 * 2048 + k), s0 = *(const f32x4*)(modl + 3 * 2048 + k);
                    v[j] = v[j] * rstd * (g * (1.0f + s1)) + s0; am = fmaxf(am, fmaxf(fmaxf(fabsf(v[j][0]), fabsf(v[j][1])), fmaxf(fabsf(v[j][2]), fabsf(v[j][3])))); }
#pragma unroll
                for (int o = 1; o < 64; o <<= 1) am = fmaxf(am, __shfl_xor(am, o));
                if (am == 0.f) am = 1.f;
                const float qi = 127.0f / am;
                if (lane == 0) ((float*)(ws + WS_CS + CS_ROW))[m] = am * (1.0f / 127.0f);
                unsigned* hq = (unsigned*)((signed char*)(ws + WS_H) + (size_t)m * D + 4 * lane);
#pragma unroll
                for (int j = 0; j < 8; ++j) { const int q0 = (int)rintf(v[j][0] * qi), q1 = (int)rintf(v[j][1] * qi), q2 = (int)rintf(v[j][2] * qi), q3 = (int)rintf(v[j][3] * qi);
                    hq[64 * j] = ((unsigned)q0 & 0xffu) | (((unsigned)q1 & 0xffu) << 8) | (((unsigned)q2 & 0xffu) << 16) | (((unsigned)q3 & 0xffu) << 24); } }
            f32x4 acc0 = {0.f, 0.f, 0.f, 0.f}, acc1 = {0.f, 0.f, 0.f, 0.f};
            const float* xa = X1 + (size_t)(row0 + r16) * D + 256 * wave + 4 * kk;
#pragma unroll
            for (int kg = 0; kg < 16; ++kg) { const f32x4 av = *(const f32x4*)(xa + 16 * kg);
#pragma unroll
                for (int m = 0; m < 4; ++m) { acc0 = __builtin_amdgcn_mfma_f32_16x16x4f32(av[m], bw[kg][m][0], acc0, 0, 0, 0); acc1 = __builtin_amdgcn_mfma_f32_16x16x4f32(av[m], bw[kg][m][1], acc1, 0, 0, 0); } }
#pragma unroll
            for (int q = 0; q < 4; ++q) { part[(wave * 16 + 4 * kk + q) * 32 + r16] = acc0[q]; part[(wave * 16 + 4 * kk + q) * 32 + 16 + r16] = acc1[q]; }
            __syncthreads();
            { const int row = tid >> 5, e = tid & 31; float s = 0.f;
#pragma unroll
              for (int w = 0; w < 8; ++w) s += part[(w * 16 + row) * 32 + e];
              float val = rsd[row] * s + cvec[e];
              float tv[4]; int ti[4];
#pragma unroll
              for (int j = 0; j < 4; ++j) { float bv = val; int bi = e;
#pragma unroll
                  for (int off = 16; off >= 1; off >>= 1) { const float ov = __shfl_xor(bv, off); const int oi = __shfl_xor(bi, off); if (ov > bv || (ov == bv && oi < bi)) { bv = ov; bi = oi; } }
                  tv[j] = bv; ti[j] = bi; if (e == bi) val = -INFINITY; }
              const float e1 = __expf(tv[1] - tv[0]), e2 = __expf(tv[2] - tv[0]), e3 = __expf(tv[3] - tv[0]), inv = 1.0f / (1.0f + e1 + e2 + e3);
              const float gt[4] = {inv, e1 * inv, e2 * inv, e3 * inv};
#pragma unroll
              for (int j = 0; j < 4; ++j) if (e == ti[j]) { const int ai = (row0 + row) * 4 + j; const unsigned rk = atomicAdd(ctl + CW_CNT + 16 * e, 1u);
                  rt_e[ai] = e; rt_g[ai] = gt[j]; rt_r[ai] = (int)rk; } }
            __syncthreads();
        }
    }
    SEAM(8);

    if (IN(9)) {
        PH_BEGIN;
        LAS int* tb = (LAS int*)lds;
        if (tid == 0) { int acc = 0; for (int e = 0; e < NEXP; ++e) { tb[e] = acc; acc += (int)((ctl[CW_CNT + 16 * e] + 255u) >> 8); } tb[NEXP] = acc; }
        __syncthreads();
        for (int i = gtid; i < NTOK * 4; i += NGT) { const int e = rt_e[i], slot = tb[e] * 256 + rt_r[i]; rt_s[i] = slot; slot_rowoff[slot] = (unsigned)(i >> 2) * (unsigned)D; slot_gate[slot] = rt_g[i]; ((float*)(ws + WS_CS + CS_SLOT))[slot] = ((const float*)(ws + WS_CS + CS_ROW))[i >> 2]; }
        if (vcu == 0) {
            for (int e = 0; e < NEXP; ++e) { const int cnt = (int)ctl[CW_CNT + 16 * e], s0 = tb[e] * 256 + cnt, s1 = tb[e + 1] * 256;
                for (int s = s0 + tid; s < s1; s += 512) { slot_rowoff[s] = 0u; slot_gate[s] = 0.f; ((float*)(ws + WS_CS + CS_SLOT))[s] = 0.f; }
                for (int t = tb[e] + tid; t < tb[e + 1]; t += 512) tile_expert[t] = e; }
            if (tid == 0) *ntiles_p = tb[NEXP];
        }
        __syncthreads();
    }
    SEAM(9);

    if (IN(10)) {
        PH_BEGIN;
        const int ntiles = *ntiles_p;
        pg8::Gemm g{H, WGU, D / 2}; pg8::MoeOrder<true> S; S.init(ntiles, 4096 / 256, G, bx); S.K2 = D; S.nper = 4096; S.texp = tile_expert; S.sroff = slot_rowoff;
        EpiAct E{ACT, A->b_e_gate, A->b_e_up, (const float*)(ws + WS_CS), (const float*)(ws + WS_CS + CS_SLOT)};
        pg8::gemm_phase<EpiAct, pg8::MoeOrder<true>, true>(lds, g, S, E);
    }
    SEAM(10);

    if (IN(11)) {
        PH_BEGIN;
        const int ntiles = *ntiles_p;
        pg8::Gemm g{ACT, WDN, FF}; pg8::MoeOrder<false> S; S.init(ntiles, D / 256, G, bx); S.K2 = FF * 2; S.nper = D; S.texp = tile_expert; S.sroff = slot_rowoff;
        EpiDown E{YS, A->b_e_down, slot_gate};
        pg8::gemm_phase<EpiDown, pg8::MoeOrder<false>>(lds, g, S, E);
    }
    SEAM(11);

    if (IN(12)) {
        PH_BEGIN;
        f32x4 v[8], vn[8]; u32x2 yr[4][8], yn[4][8]; int sl[4];
#define P12_LOAD(VV, YY, M) do { const float* xr_ = X1 + (size_t)(M) * D + 4 * lane; \
            _Pragma("unroll") for (int j = 0; j < 8; ++j) VV[j] = *(const f32x4*)(xr_ + 256 * j); \
            _Pragma("unroll") for (int q = 0; q < 4; ++q) { const bf16* yp_ = YS + (size_t)sl[q] * D + 4 * lane; _Pragma("unroll") for (int j = 0; j < 8; ++j) YY[q][j] = *(const u32x2*)(yp_ + 256 * j); } } while (0)
#pragma unroll
        for (int q = 0; q < 4; ++q) sl[q] = rt_s[gw * 4 + q];
        P12_LOAD(v, yr, gw);
        if (gw + NGW < NTOK) {
#pragma unroll
            for (int q = 0; q < 4; ++q) sl[q] = rt_s[(gw + NGW) * 4 + q];
        }
        for (int m = gw; m < NTOK; m += NGW) {
            if (m + NGW < NTOK) { P12_LOAD(vn, yn, m + NGW);
                if (m + 2 * NGW < NTOK) {
#pragma unroll
                    for (int q = 0; q < 4; ++q) sl[q] = rt_s[(m + 2 * NGW) * 4 + q]; } }
            f32x4 y[8];
#pragma unroll
            for (int j = 0; j < 8; ++j) { y[j] = (f32x4){0.f, 0.f, 0.f, 0.f};
#pragma unroll
                for (int q = 0; q < 4; ++q) { const u32x2 w = yr[q][j]; y[j][0] += bflo(w.x); y[j][1] += bfhi(w.x); y[j][2] += bflo(w.y); y[j][3] += bfhi(w.y); } }
            float ss = 0.f;
#pragma unroll
            for (int j = 0; j < 8; ++j) { const f32x4 m5 = *(const f32x4*)(modl + 5 * 2048 + 4 * lane + 256 * j); v[j] = v[j] + m5 * y[j]; ss += v[j][0] * v[j][0] + v[j][1] * v[j][1] + v[j][2] * v[j][2] + v[j][3] * v[j][3]; }
            const float rstd = rsqrtf(wave_sum(ss) * (1.0f / D) + EPS);
            float* orow = A->out + (size_t)m * D + 4 * lane;
#pragma unroll
            for (int j = 0; j < 8; ++j) { const f32x4 fg = *(const f32x4*)(A->final_g + 4 * lane + 256 * j); *(f32x4*)(orow + 256 * j) = v[j] * rstd * fg; }
#pragma unroll
            for (int j = 0; j < 8; ++j) { v[j] = vn[j];
#pragma unroll
                for (int q = 0; q < 4; ++q) yr[q][j] = yn[q][j]; }
        }
#undef P12_LOAD
    }
#undef IN
#undef SEAM
}

#undef modl
#undef modc
#undef rope
#undef lbf
#undef lbb
#undef wrp
#undef cvec
#undef tile_expert
#undef ntiles_p
#undef rt_e
#undef rt_g
#undef rt_r
#undef rt_s
#undef slot_rowoff
#undef slot_gate
#undef Dlog
#undef KR
#undef VTg
#undef Lbuf
#undef WIN
#undef WM
#undef WO
#undef WGU
#undef WDN
#undef H
#undef PROJ
#undef ACT
#undef YAB
#undef OSCR
#undef MERGED
#undef X1
#undef YS
extern "C" void kernel_launch(void* const* d_in, const int* in_sizes, int n_in, void* d_out, int out_size, void* d_ws, size_t ws_size, hipStream_t stream) {
    static int grid = 0;
    if (grid == 0) {
        if (n_in != 24 || out_size != NTOK * D || ws_size < WS_END) { fprintf(stderr, "kernel_launch: unexpected shapes (n_in %d out %d ws %zu)\n", n_in, out_size, ws_size); grid = -1; return; }
        int dev = 0, cus = 0, per_cu = 0;
        if (hipGetDevice(&dev) != hipSuccess || hipDeviceGetAttribute(&cus, hipDeviceAttributeMultiprocessorCount, dev) != hipSuccess) { grid = -1; return; }
        if (hipFuncSetAttribute((const void*)fwd_kernel, hipFuncAttributeMaxDynamicSharedMemorySize, LDS_BYTES) != hipSuccess) { fprintf(stderr, "kernel_launch: hipFuncSetAttribute failed\n"); grid = -1; return; }
        if (hipOccupancyMaxActiveBlocksPerMultiprocessor(&per_cu, (const void*)fwd_kernel, NWAVES * 64, LDS_BYTES) != hipSuccess || per_cu < 1) { fprintf(stderr, "kernel_launch: occupancy query says %d\n", per_cu); (void)hipGetLastError(); grid = -1; return; }
        grid = cus;
    }
    if (grid < 0) return;
    if (hipMemsetAsync((char*)d_ws + WS_CTL, 0, CTL_ZERO_BYTES, stream) != hipSuccess) return;
    Args a{};
    const float** p = (const float**)&a;
    for (int i = 0; i < 24; ++i) p[i] = (const float*)d_in[i];
    a.out = (float*)d_out; a.ws = (unsigned char*)d_ws; a.ph_lo = 0; a.ph_hi = 13;
    hipLaunchKernelGGL(fwd_kernel, dim3(grid), dim3(NWAVES * 64), LDS_BYTES, stream, a);
    const hipError_t le = hipPeekAtLastError();
    if (le != hipSuccess) fprintf(stderr, "kernel_launch: launch failed: %s\n", hipGetErrorName(le));
}
```

```cpp
#include <hip/hip_runtime.h>
#include <cstdio>
#include <cstdint>

#define DI __device__ __forceinline__
#define LAS __attribute__((address_space(3)))
typedef unsigned short bf16;
typedef short bf16x8 __attribute__((ext_vector_type(8)));
typedef float f32x2 __attribute__((ext_vector_type(2)));
typedef float f32x4 __attribute__((ext_vector_type(4)));
typedef float f32x16 __attribute__((ext_vector_type(16)));
typedef unsigned u32x2 __attribute__((ext_vector_type(2)));
typedef unsigned u32x4 __attribute__((ext_vector_type(4)));
typedef __bf16 bf16x2_t __attribute__((ext_vector_type(2)));
typedef int i32x4 __attribute__((ext_vector_type(4)));

DI unsigned pk2(float lo, float hi) { f32x2 v = {lo, hi}; bf16x2_t b = __builtin_convertvector(v, bf16x2_t); return __builtin_bit_cast(unsigned, b); }
DI float bf2f(unsigned short b) { return __uint_as_float(((unsigned)b) << 16); }
DI float bflo(unsigned w) { return __uint_as_float(w << 16); }
DI float bfhi(unsigned w) { return __uint_as_float(w & 0xffff0000u); }
DI unsigned short f2bf(float f) { return (unsigned short)(pk2(f, 0.f) & 0xffffu); }
DI float wave_sum(float v) {
#pragma unroll
    for (int o = 1; o < 64; o <<= 1) v += __shfl_xor(v, o);
    return v;
}
DI float sigmoidf_(float x) { return 1.0f / (1.0f + __expf(-x)); }
#define LDS_WAIT() asm volatile("s_waitcnt lgkmcnt(0)" ::: "memory")
#define VM_WAIT() asm volatile("s_waitcnt vmcnt(0)" ::: "memory")

constexpr int D = 2048, NTOK = 16384, NCTX = 256, MROWS = NTOK + NCTX;
constexpr int INC = 10496;
constexpr int C_AQ = 0, C_AK = 1024, C_AV = 1152, C_BQ = 1280, C_ZF = 2304, C_ZB = 3328, C_BV = 4352, C_BG = 5376, C_GA = 6400, C_GB = 8448;
constexpr int NEXP = 32, FF = 2048;
constexpr int MAXTILES = 288, MAXSLOTS = MAXTILES * 256;
constexpr float EPS = 1e-6f;
constexpr int NSEG = 33;
constexpr int NWAVES = 8;
#ifndef DUP0
#define DUP0 1
#endif
#ifndef DUP3
#define DUP3 1
#endif
#ifndef DUP4
#define DUP4 1
#endif
#ifndef DUP5
#define DUP5 1
#endif

constexpr size_t MiB = 1u << 20;
constexpr size_t WS_CTL = 0, CTL_ZERO_BYTES = 1 * MiB;
constexpr size_t WS_SMALL = 1 * MiB;
constexpr size_t SM_MODL = 0, SM_MODC = 49152, SM_ROPE = 65536, SM_LB = 131072, SM_WRP = 262144, SM_CVEC = 524288, SM_TILE = 528384;
constexpr size_t WS_ROUTE = 2 * MiB;
constexpr size_t RT_E = 0, RT_G = 262144, RT_R = 524288, RT_S = 786432, RT_OFF = 1048576, RT_SG = 1048576 + 294912;
constexpr size_t WS_DLOG = 4 * MiB;
constexpr size_t WS_KR = 5 * MiB, WS_VT = 10 * MiB;
constexpr size_t WS_CS = 15 * MiB;
constexpr size_t CS_ROW = 524288, CS_SLOT = 524288 + 65536, CS_WIN = 917504, CS_HROW = 966656;
static_assert(CS_SLOT + (size_t)MAXSLOTS * 4 <= CS_WIN && CS_WIN + (size_t)INC * 4 <= CS_HROW && CS_HROW + (size_t)MROWS * 4 <= MiB, "scale arrays");
constexpr size_t WS_L = 16 * MiB;
constexpr size_t WS_WIN = 50 * MiB, WS_WM = 92 * MiB, WS_WO = 100 * MiB, WS_WGU = 108 * MiB, WS_WDN = 620 * MiB;
constexpr size_t WS_H = 876 * MiB, WS_PROJ = 942 * MiB, WS_ACT = WS_PROJ, WS_YAB = 1276 * MiB, WS_OSCR = 1340 * MiB, WS_MERGED = 1468 * MiB, WS_X1 = 1532 * MiB, WS_YS = 1660 * MiB, WS_END = 1948 * MiB;
constexpr size_t PO_AQ = 0, PO_AKV = PO_AQ + (size_t)16 * MROWS * 64, PO_BQ = PO_AKV + (size_t)MROWS * 256, PO_ZF = PO_BQ + (size_t)8 * MROWS * 128, PO_ZB = PO_ZF + (size_t)8 * MROWS * 128,
                 PO_BV = PO_ZB + (size_t)8 * MROWS * 128, PO_BG = PO_BV + (size_t)8 * MROWS * 128, PO_GA = PO_BG + (size_t)8 * MROWS * 128, PO_GB = PO_GA + (size_t)MROWS * 2048, PO_END = PO_GB + (size_t)MROWS * 2048;
static_assert(PO_END == (size_t)MROWS * INC, "projection layout");
static_assert(WS_L + (size_t)16 * NSEG * 65536 <= WS_WIN, "L");
static_assert(WS_PROJ + (size_t)MROWS * INC * 2 <= WS_YAB && WS_ACT + (size_t)MAXSLOTS * FF * 2 <= WS_YAB, "proj/act");
static_assert(WS_H + (size_t)MROWS * D * 2 <= WS_PROJ, "h");
constexpr int CW_BAR = 4096, CW_CNT = 8192, CW_Q = 9216;

constexpr int LDS_BYTES = 163840;
constexpr int MISC_OFF = 163840 - 256;

namespace pg8 {
constexpr int BM = 256, BK = 64, HALF = 128, HTB = HALF * BK * 2, STAGE_BYTES = 8 * HTB, NXCD = 8, WGM = 8;
__host__ __device__ __forceinline__ int lds_byte(int r, int c) { const int st = (r >> 4) * 2 + (c >> 5), rr = r & 15, cc = c & 31, ob = rr * 64 + cc * 2; return st * 1024 + (ob ^ (((ob >> 9) & 1) << 5)); }
__host__ __device__ __forceinline__ void stage_rc(int b, int& R, int& C) { const int st = b / 1024, sb = b % 1024, swz = sb ^ (((sb >> 9) & 1) << 5); R = (st >> 1) * 16 + swz / 64; C = (st & 1) * 32 + (swz % 64) / 2; }
__host__ __device__ __forceinline__ int perm32(int rho) { const int n = rho >> 4, i = rho & 15; return 8 * (i >> 2) + 4 * n + (i & 3); }

struct Unit { int pm, pn, e, brow; };
struct Gemm { const bf16* A; const bf16* Bt; int K; };

struct OrderBase {
    int nM, nN, nwg, G, c;
    DI void init(int nM_, int nN_, int G_, int c_) { nM = nM_; nN = nN_; nwg = nM * nN; G = G_; c = c_; }
    DI bool tile(int i, int& pm, int& pn) const {
        const long L = (long)i * G + c; if (L >= nwg) return false;
        int wgid = (int)L; { const int q = nwg / NXCD, r = nwg % NXCD, xcd = wgid % NXCD, off = wgid / NXCD; wgid = (xcd < r ? xcd * (q + 1) : r * (q + 1) + (xcd - r) * q) + off; }
        const int nig = WGM * nN, gid = wgid / nig, fm = gid * WGM, gsz = (nM - fm) < WGM ? (nM - fm) : WGM;
        pm = fm + ((wgid % nig) % gsz); pn = (wgid % nig) / gsz; return true;
    }
};
struct PlainOrder : OrderBase {
    int K2;
    DI bool next(int i, Unit& u) const { if (!tile(i, u.pm, u.pn)) return false; u.e = 0; u.brow = u.pn * BM; return true; }
    DI unsigned rowoff(const Unit& u, int r) const { return (unsigned)(u.pm * BM + r) * (unsigned)K2; }
};
template <bool GATHER> struct MoeOrder : OrderBase {
    int K2, nper;
    const int* texp; const unsigned* sroff;
    DI bool next(int i, Unit& u) const { if (!tile(i, u.pm, u.pn)) return false; u.e = texp[u.pm]; u.brow = u.e * nper + u.pn * BM; return true; }
    DI unsigned rowoff(const Unit& u, int r) const { if (GATHER) return sroff[u.pm * BM + r]; else return (unsigned)(u.pm * BM + r) * (unsigned)K2; }
};

template <class Epi, class Sched, bool I8 = false, bool ALIGN_EPI = true, bool SP2 = true>
__device__ __forceinline__ void gemm_phase(LAS unsigned char* lds, const Gemm g, const Sched& S, const Epi& E) {
    const int tid = threadIdx.x, wid = __builtin_amdgcn_readfirstlane(tid >> 6), lane = tid & 63, wr = wid >> 2, wc = wid & 3, fr = lane & 15, fq = lane >> 4;
    const int K = g.K, nt = K / BK;
    int stR[2]; unsigned stC2[2], voffB[2];
#pragma unroll
    for (int i = 0; i < 2; ++i) { int R, C; stage_rc(tid * 16 + i * 8192, R, C); const int Rb = Epi::PERM ? ((R & ~31) + perm32(R & 31)) : R;
        stR[i] = R; stC2[i] = (unsigned)C * 2u; voffB[i] = (unsigned)(Rb * K + C) * 2u; }
    const size_t kstep = (size_t)(BK * 2);
    const size_t hstep = (size_t)HALF * K * 2;
    const unsigned ldsw = (unsigned)wid * 1024u;
    const int aoffL = lds_byte(wr * 64 + fr, fq * 8), boffL = lds_byte(wc * 32 + fr, fq * 8);
#define PG8_SA(b, h) (((b) * 2 + (h)) * HTB)
#define PG8_SB(b, h) ((4 + (b) * 2 + (h)) * HTB)
#define PG8_STAGE(bufoff, gbase, voff) do { _Pragma("unroll") for (int _i = 0; _i < 2; ++_i) \
        __builtin_amdgcn_global_load_lds((const unsigned*)((const char*)(gbase) + (voff)[_i]), (LAS unsigned*)(lds + (bufoff) + ldsw + _i * 8192), 16, 0, 0); } while (0)
#define PG8_LDA(dst, b, h) do { _Pragma("unroll") for (int m = 0; m < 4; ++m) _Pragma("unroll") for (int k = 0; k < 2; ++k) dst[m][k] = *(const LAS bf16x8*)(lds + PG8_SA(b, h) + aoffL + m * 2048 + k * 1024); } while (0)
#define PG8_LDB(dst, b, h) do { _Pragma("unroll") for (int n = 0; n < 2; ++n) _Pragma("unroll") for (int k = 0; k < 2; ++k) dst[n][k] = *(const LAS bf16x8*)(lds + PG8_SB(b, h) + boffL + n * 2048 + k * 1024); } while (0)
#define PG8_MMA(ai, bj, At, Bt) do { __builtin_amdgcn_s_setprio(1); _Pragma("unroll") for (int m = 0; m < 4; ++m) _Pragma("unroll") for (int n = 0; n < 2; ++n) _Pragma("unroll") for (int k = 0; k < 2; ++k) \
        { if constexpr (I8) acc[ai][bj][m][n] = __builtin_bit_cast(f32x4, __builtin_amdgcn_mfma_i32_16x16x64_i8(__builtin_bit_cast(i32x4, Bt[n][k]), __builtin_bit_cast(i32x4, At[m][k]), __builtin_bit_cast(i32x4, acc[ai][bj][m][n]), 0, 0, 0)); \
          else acc[ai][bj][m][n] = __builtin_amdgcn_mfma_f32_16x16x32_bf16(Bt[n][k], At[m][k], acc[ai][bj][m][n], 0, 0, 0); } __builtin_amdgcn_s_setprio(0); } while (0)
#define PG8_WAIT_V(n) asm volatile("s_waitcnt vmcnt(" #n ")" ::: "memory")
#define PG8_WAIT_L(n) asm volatile("s_waitcnt lgkmcnt(" #n ")" ::: "memory")
#define PG8_BAR __builtin_amdgcn_s_barrier()
#define PG8_SCHED __builtin_amdgcn_sched_barrier(0)
    Unit cur, nxt; int ui = 0;
    if (!S.next(0, cur)) return;
    f32x4 acc[2][2][4][2];
#pragma unroll
    for (int a = 0; a < 2; ++a)
#pragma unroll
        for (int b = 0; b < 2; ++b)
#pragma unroll
            for (int m = 0; m < 4; ++m)
#pragma unroll
                for (int n = 0; n < 2; ++n) acc[a][b][m][n] = (f32x4){0.f, 0.f, 0.f, 0.f};
    bf16x8 At[4][2], B0[2][2], B1[2][2];
    unsigned ao0[2], ao1[2], no0[2], no1[2];
#pragma unroll
    for (int i = 0; i < 2; ++i) { ao0[i] = S.rowoff(cur, stR[i]) + stC2[i]; ao1[i] = S.rowoff(cur, HALF + stR[i]) + stC2[i]; no0[i] = ao0[i]; no1[i] = ao1[i]; }
    const char* Ab = (const char*)g.A;
    const char* cB = (const char*)g.Bt + (size_t)cur.brow * K * 2;
    if constexpr (SP2) {
        PG8_STAGE(PG8_SB(0, 0), cB, voffB); PG8_STAGE(PG8_SB(0, 1), cB + hstep, voffB); PG8_STAGE(PG8_SA(0, 0), Ab, ao0); PG8_STAGE(PG8_SA(0, 1), Ab, ao1);
        if (wr == 1) PG8_BAR;
        PG8_WAIT_V(2); PG8_BAR;
        PG8_STAGE(PG8_SB(1, 0), cB + kstep, voffB); PG8_STAGE(PG8_SA(1, 0), Ab + kstep, ao0); PG8_STAGE(PG8_SB(1, 1), cB + hstep + kstep, voffB);
        PG8_WAIT_V(6); PG8_BAR;
    } else {
        PG8_STAGE(PG8_SB(0, 0), cB, voffB); PG8_STAGE(PG8_SA(0, 0), Ab, ao0); PG8_STAGE(PG8_SB(0, 1), cB + hstep, voffB); PG8_STAGE(PG8_SA(0, 1), Ab, ao1);
        if (wr == 1) PG8_BAR;
        PG8_WAIT_V(4); PG8_BAR;
        PG8_STAGE(PG8_SB(1, 0), cB + kstep, voffB); PG8_STAGE(PG8_SA(1, 0), Ab + kstep, ao0); PG8_STAGE(PG8_SB(1, 1), cB + hstep + kstep, voffB);
        PG8_WAIT_V(6); PG8_BAR;
    }
    for (;;) {
        const bool has_next = S.next(ui + 1, nxt);
        if (has_next) {
#pragma unroll
            for (int i = 0; i < 2; ++i) { no0[i] = S.rowoff(nxt, stR[i]) + stC2[i]; no1[i] = S.rowoff(nxt, HALF + stR[i]) + stC2[i]; }
        }
        const char* nB = has_next ? (const char*)g.Bt + (size_t)nxt.brow * K * 2 : cB;
        for (int t = 0; t < nt; t += 2) {
            const bool last = (t == nt - 2);
            if constexpr (Epi::HOOK) { if (t == nt / 2) E.hook(acc, cur, wr, wc, fr, fq); }
            const char* a1 = Ab + (size_t)(t + 1) * kstep;
            const char* a2 = last ? Ab : Ab + (size_t)(t + 2) * kstep; const char* b2 = last ? nB : cB + (size_t)(t + 2) * kstep;
            const char* a3 = a2 + kstep; const char* b3 = b2 + kstep;
            unsigned x0[2], x1[2];
#pragma unroll
            for (int i = 0; i < 2; ++i) { x0[i] = last ? no0[i] : ao0[i]; x1[i] = last ? no1[i] : ao1[i]; }
            if constexpr (SP2) {
            PG8_LDB(B0, 0, 0); PG8_LDB(B1, 0, 1); PG8_SCHED; PG8_LDA(At, 0, 0); PG8_STAGE(PG8_SA(1, 1), a1, ao1);
            PG8_WAIT_V(8); PG8_WAIT_L(0); PG8_BAR; PG8_MMA(0, 0, At, B0); PG8_MMA(0, 1, At, B1); PG8_BAR; PG8_SCHED;
            PG8_LDA(At, 0, 1); PG8_STAGE(PG8_SB(0, 0), b2, voffB); PG8_STAGE(PG8_SB(0, 1), b2 + hstep, voffB); PG8_STAGE(PG8_SA(0, 0), a2, x0);
            PG8_WAIT_V(8); PG8_WAIT_L(0); PG8_BAR; PG8_MMA(1, 0, At, B0); PG8_MMA(1, 1, At, B1); PG8_BAR; PG8_SCHED;
            PG8_LDB(B0, 1, 0); PG8_LDB(B1, 1, 1); PG8_SCHED; PG8_LDA(At, 1, 0); PG8_STAGE(PG8_SA(0, 1), a2, x1);
            PG8_WAIT_V(8); PG8_WAIT_L(0); PG8_BAR; PG8_MMA(0, 0, At, B0); PG8_MMA(0, 1, At, B1); PG8_BAR; PG8_SCHED;
            PG8_LDA(At, 1, 1); PG8_STAGE(PG8_SB(1, 0), b3, voffB); PG8_STAGE(PG8_SB(1, 1), b3 + hstep, voffB); PG8_STAGE(PG8_SA(1, 0), a3, x0);
            PG8_WAIT_V(8); PG8_WAIT_L(0); PG8_BAR; PG8_MMA(1, 0, At, B0); PG8_MMA(1, 1, At, B1); PG8_BAR; PG8_SCHED;
            } else {
            PG8_LDB(B0, 0, 0); PG8_SCHED; PG8_LDA(At, 0, 0); PG8_STAGE(PG8_SA(1, 1), a1, ao1);
            PG8_WAIT_L(8); PG8_BAR; PG8_WAIT_L(0); PG8_MMA(0, 0, At, B0); PG8_BAR; PG8_SCHED;
            PG8_LDB(B1, 0, 1); PG8_STAGE(PG8_SB(0, 0), b2, voffB);
            PG8_BAR; PG8_WAIT_L(0); PG8_MMA(0, 1, At, B1); PG8_BAR;
            PG8_LDA(At, 0, 1); PG8_STAGE(PG8_SA(0, 0), a2, x0);
            PG8_BAR; PG8_WAIT_L(0); PG8_MMA(1, 0, At, B0); PG8_BAR; PG8_SCHED;
            PG8_STAGE(PG8_SB(0, 1), b2 + hstep, voffB);
            PG8_WAIT_V(6); PG8_BAR; PG8_MMA(1, 1, At, B1); PG8_BAR;
            PG8_LDB(B0, 1, 0); PG8_SCHED; PG8_LDA(At, 1, 0); PG8_STAGE(PG8_SA(0, 1), a2, x1);
            PG8_WAIT_L(8); PG8_BAR; PG8_WAIT_L(0); PG8_MMA(0, 0, At, B0); PG8_BAR; PG8_SCHED;
            PG8_LDB(B1, 1, 1); PG8_STAGE(PG8_SB(1, 0), b3, voffB);
            PG8_BAR; PG8_WAIT_L(0); PG8_MMA(0, 1, At, B1); PG8_BAR;
            PG8_LDA(At, 1, 1); PG8_STAGE(PG8_SA(1, 0), a3, x0);
            PG8_BAR; PG8_WAIT_L(0); PG8_MMA(1, 0, At, B0); PG8_BAR; PG8_SCHED;
            PG8_STAGE(PG8_SB(1, 1), b3 + hstep, voffB);
            PG8_WAIT_V(6); PG8_BAR; PG8_MMA(1, 1, At, B1); PG8_BAR;
            }
        }
        if constexpr (ALIGN_EPI) { if (wr == 0) PG8_BAR; }
        E(acc, cur, wr, wc, fr, fq);
        if (!has_next) break;
#pragma unroll
        for (int a = 0; a < 2; ++a)
#pragma unroll
            for (int b = 0; b < 2; ++b)
#pragma unroll
                for (int m = 0; m < 4; ++m)
#pragma unroll
                    for (int n = 0; n < 2; ++n) acc[a][b][m][n] = (f32x4){0.f, 0.f, 0.f, 0.f};
        cur = nxt; cB = nB; ++ui;
#pragma unroll
        for (int i = 0; i < 2; ++i) { ao0[i] = no0[i]; ao1[i] = no1[i]; }
        if constexpr (ALIGN_EPI) { if (wr == 1) PG8_BAR; }
    }
    PG8_WAIT_V(0);
    if constexpr (!ALIGN_EPI) { if (wr == 0) PG8_BAR; }
    PG8_BAR;
#undef PG8_SA
#undef PG8_SB
#undef PG8_STAGE
#undef PG8_LDA
#undef PG8_LDB
#undef PG8_MMA
#undef PG8_WAIT_V
#undef PG8_WAIT_L
#undef PG8_BAR
#undef PG8_SCHED
}
}

using pg8::Unit; using pg8::HALF; using pg8::BM;
struct EpiProj {
    static constexpr bool PERM = true, HOOK = false;
    bf16* P; const float* lbf; const float* lbb; const float* hrs; const float* wcs;
    DI void hook(f32x4 (&)[2][2][4][2], const Unit&, int, int, int, int) const {}
    DI void operator()(const f32x4 (&acc)[2][2][4][2], const Unit& u, int wr, int wc, int fr, int fq) const {
        const int pn = u.pn; int cls, cbase, hs, pitch; size_t po; const float* lb = lbf;
        if (pn < 4)       { cls = 0; cbase = C_AQ; po = PO_AQ;  hs = 6;  pitch = 64; }
        else if (pn < 5)  { cls = 0; cbase = C_AK; po = PO_AKV; hs = 30; pitch = 256; }
        else if (pn < 9)  { cls = 1; cbase = C_BQ; po = PO_BQ;  hs = 7;  pitch = 128; }
        else if (pn < 13) { cls = 2; cbase = C_ZF; po = PO_ZF;  hs = 7;  pitch = 128; }
        else if (pn < 17) { cls = 2; cbase = C_ZB; po = PO_ZB;  hs = 7;  pitch = 128; lb = lbb; }
        else if (pn < 21) { cls = 0; cbase = C_BV; po = PO_BV;  hs = 7;  pitch = 128; }
        else if (pn < 25) { cls = 1; cbase = C_BG; po = PO_BG;  hs = 7;  pitch = 128; }
        else if (pn < 33) { cls = 3; cbase = C_GA; po = PO_GA;  hs = 30; pitch = 2048; }
        else              { cls = 3; cbase = C_GB; po = PO_GB;  hs = 30; pitch = 2048; }
        int zz = 0; asm volatile("" : "+v"(zz));
        const int row0 = u.pm * BM + wr * 64 + fr + zz, cin0 = u.pn * BM + wc * 32 + 8 * fq - cbase;
        bf16* base = P + po;
#pragma unroll
        for (int bj = 0; bj < 2; ++bj) {
            float lbv[8];
            const int cin = cin0 + bj * HALF;
            { const int ci = (cls == 2) ? cin : 0; const f32x4 a = *(const f32x4*)(lb + ci), b = *(const f32x4*)(lb + ci + 4);
#pragma unroll
              for (int j = 0; j < 4; ++j) { lbv[j] = (cls == 2) ? a[j] : 0.f; lbv[4 + j] = (cls == 2) ? b[j] : 0.f; } }
            bf16* colp = base + (size_t)(cin >> hs) * MROWS * pitch + (cin & ((1 << hs) - 1));
            float csv[8];
            { const f32x4 a = *(const f32x4*)(wcs + cin + cbase), b = *(const f32x4*)(wcs + cin + cbase + 4);
#pragma unroll
              for (int j = 0; j < 4; ++j) { csv[j] = a[j]; csv[4 + j] = b[j]; } }
#pragma unroll
            for (int ai = 0; ai < 2; ++ai)
#pragma unroll
                for (int m = 0; m < 4; ++m) { const int rr = row0 + ai * HALF + m * 16; const size_t ro = (size_t)rr * pitch; float v[8]; const float rs = hrs[rr];
#pragma unroll
                    for (int j = 0; j < 8; ++j) v[j] = (float)__builtin_bit_cast(i32x4, acc[ai][bj][m][j >> 2])[j & 3] * (rs * csv[j]);
                    if (cls != 0) {
#pragma unroll
                        for (int j = 0; j < 8; ++j) { const float sg = sigmoidf_(v[j]); v[j] = (cls == 1) ? v[j] * sg : sg; }
                        if (cls == 2) {
#pragma unroll
                            for (int j = 0; j < 8; ++j) { const float l = lbv[j]; v[j] = __logf(l + (1.0f - l) * v[j]); } }
                    }
                    u32x4 w; w.x = pk2(v[0], v[1]); w.y = pk2(v[2], v[3]); w.z = pk2(v[4], v[5]); w.w = pk2(v[6], v[7]);
                    *(u32x4*)(colp + ro) = w; }
        }
    }
};
struct EpiMerge {
    static constexpr bool PERM = true, HOOK = true;
    bf16* O; const bf16* proj;
    DI void hook(f32x4 (&acc)[2][2][4][2], const Unit& u, int wr, int wc, int fr, int fq) const {
        int zz = 0; asm volatile("" : "+v"(zz));
        const int row0 = u.pm * BM + wr * 64 + fr + zz, col0 = u.pn * BM + wc * 32 + 8 * fq;
#pragma unroll
        for (int ai = 0; ai < 2; ++ai)
#pragma unroll
            for (int m = 0; m < 4; ++m) { const size_t rowp = (size_t)(row0 + ai * HALF + m * 16) * D + col0;
#pragma unroll
                for (int bj = 0; bj < 2; ++bj) { const u32x4 ga = *(const u32x4*)(proj + PO_GA + rowp + bj * HALF), gb = *(const u32x4*)(proj + PO_GB + rowp + bj * HALF);
#pragma unroll
                    for (int q = 0; q < 4; ++q) { const float r0 = bflo(ga[q]) * __builtin_amdgcn_rcpf(bflo(gb[q])), r1 = bfhi(ga[q]) * __builtin_amdgcn_rcpf(bfhi(gb[q]));
                        acc[ai][bj][m][q >> 1][(q & 1) * 2] *= r0; acc[ai][bj][m][q >> 1][(q & 1) * 2 + 1] *= r1; } }
                asm volatile("" ::: "memory"); }
    }
    DI void operator()(const f32x4 (&acc)[2][2][4][2], const Unit& u, int wr, int wc, int fr, int fq) const {
        const int row0 = u.pm * BM + wr * 64 + fr, col0 = u.pn * BM + wc * 32 + 8 * fq;
#pragma unroll
        for (int ai = 0; ai < 2; ++ai)
#pragma unroll
            for (int m = 0; m < 4; ++m) { const size_t r = (size_t)(row0 + ai * HALF + m * 16);
#pragma unroll
                for (int bj = 0; bj < 2; ++bj) { const u32x4 gb = *(const u32x4*)(proj + PO_GB + r * D + col0 + bj * HALF); u32x4 w;
#pragma unroll
                    for (int q = 0; q < 4; ++q) w[q] = pk2(acc[ai][bj][m][q >> 1][(q & 1) * 2] * bflo(gb[q]), acc[ai][bj][m][q >> 1][(q & 1) * 2 + 1] * bfhi(gb[q]));
                    *(u32x4*)(O + r * D + col0 + bj * HALF) = w; } }
    }
};
struct EpiOut {
    static constexpr bool PERM = false, HOOK = false;
    float* X1; const float* x; const float* mod2;
    DI void hook(f32x4 (&)[2][2][4][2], const Unit&, int, int, int, int) const {}
    DI void operator()(const f32x4 (&acc)[2][2][4][2], const Unit& u, int wr, int wc, int fr, int fq) const {
        const int row0 = u.pm * BM + wr * 64 + fr, col0 = u.pn * BM + wc * 32 + 4 * fq;
        f32x4 mv[2][2];
#pragma unroll
        for (int bj = 0; bj < 2; ++bj)
#pragma unroll
            for (int n = 0; n < 2; ++n) mv[bj][n] = *(const f32x4*)(mod2 + col0 + bj * HALF + n * 16);
#pragma unroll
        for (int ai = 0; ai < 2; ++ai)
#pragma unroll
            for (int m = 0; m < 4; ++m) { const size_t off = (size_t)(row0 + ai * HALF + m * 16) * D + col0;
#pragma unroll
                for (int bj = 0; bj < 2; ++bj)
#pragma unroll
                    for (int n = 0; n < 2; ++n) { const f32x4 xv = *(const f32x4*)(x + off + bj * HALF + n * 16);
                        *(f32x4*)(X1 + off + bj * HALF + n * 16) = xv + mv[bj][n] * acc[ai][bj][m][n]; } }
    }
};
struct EpiAct {
    static constexpr bool PERM = true, HOOK = false;
    bf16* ACTp; const float* bg; const float* bu; const float* cs; const float* srs;
    DI void hook(f32x4 (&)[2][2][4][2], const Unit&, int, int, int, int) const {}
    DI void operator()(const f32x4 (&acc)[2][2][4][2], const Unit& u, int wr, int wc, int fr, int fq) const {
        int zz = 0; asm volatile("" : "+v"(zz));
        const int row0 = u.pm * BM + wr * 64 + fr + zz, col0 = u.pn * HALF + wc * 32 + 8 * fq, nb = u.e * 4096 + u.pn * BM + wc * 32 + 8 * fq;
        float gbv[8], ubv[8], gsc[8], usc[8];
        { const f32x4 a = *(const f32x4*)(bg + u.e * FF + col0), b = *(const f32x4*)(bg + u.e * FF + col0 + 4), c = *(const f32x4*)(bu + u.e * FF + col0), d = *(const f32x4*)(bu + u.e * FF + col0 + 4);
          const f32x4 sa = *(const f32x4*)(cs + nb), sb = *(const f32x4*)(cs + nb + 4), sc = *(const f32x4*)(cs + nb + HALF), sd = *(const f32x4*)(cs + nb + HALF + 4);
#pragma unroll
          for (int j = 0; j < 4; ++j) { gbv[j] = a[j]; gbv[4 + j] = b[j]; ubv[j] = c[j]; ubv[4 + j] = d[j]; gsc[j] = sa[j]; gsc[4 + j] = sb[j]; usc[j] = sc[j]; usc[4 + j] = sd[j]; } }
#pragma unroll
        for (int ai = 0; ai < 2; ++ai)
#pragma unroll
            for (int m = 0; m < 4; ++m) { float v[8]; const int r = row0 + ai * HALF + m * 16; const float rs = srs[r];
#pragma unroll
                for (int j = 0; j < 8; ++j) { const i32x4 ga = __builtin_bit_cast(i32x4, acc[ai][0][m][j >> 2]), ua = __builtin_bit_cast(i32x4, acc[ai][1][m][j >> 2]);
                    float gg = (float)ga[j & 3] * (rs * gsc[j]) + gbv[j], uu = (float)ua[j & 3] * (rs * usc[j]) + ubv[j];
                    gg = fminf(gg, 7.0f); uu = fminf(fmaxf(uu, -7.0f), 7.0f);
                    v[j] = gg * sigmoidf_(1.702f * gg) * (uu + 1.0f); }
                u32x4 w; w.x = pk2(v[0], v[1]); w.y = pk2(v[2], v[3]); w.z = pk2(v[4], v[5]); w.w = pk2(v[6], v[7]);
                *(u32x4*)(ACTp + (size_t)r * FF + col0) = w; }
    }
};
struct EpiDown {
    static constexpr bool PERM = true, HOOK = false;
    bf16* YS; const float* bd; const float* sgate;
    DI void hook(f32x4 (&)[2][2][4][2], const Unit&, int, int, int, int) const {}
    DI void operator()(const f32x4 (&acc)[2][2][4][2], const Unit& u, int wr, int wc, int fr, int fq) const {
        const int row0 = u.pm * BM + wr * 64 + fr, col0 = u.pn * BM + wc * 32 + 8 * fq;
        float bv[2][8];
#pragma unroll
        for (int bj = 0; bj < 2; ++bj) { const f32x4 a = *(const f32x4*)(bd + u.e * D + col0 + bj * HALF), b = *(const f32x4*)(bd + u.e * D + col0 + bj * HALF + 4);
#pragma unroll
            for (int j = 0; j < 4; ++j) { bv[bj][j] = a[j]; bv[bj][4 + j] = b[j]; } }
#pragma unroll
        for (int ai = 0; ai < 2; ++ai)
#pragma unroll
            for (int m = 0; m < 4; ++m) { const int r = row0 + ai * HALF + m * 16; const float gt = sgate[r];
#pragma unroll
                for (int bj = 0; bj < 2; ++bj) { u32x4 w;
#pragma unroll
                    for (int q = 0; q < 4; ++q) w[q] = pk2((acc[ai][bj][m][q >> 1][(q & 1) * 2] + bv[bj][2 * q]) * gt, (acc[ai][bj][m][q >> 1][(q & 1) * 2 + 1] + bv[bj][2 * q + 1]) * gt);
                    *(u32x4*)(YS + (size_t)r * D + col0 + bj * HALF) = w; } }
    }
};

#define XB_TMO      128
#define XB_XCNT(j)  (256  + 64 * (j))
#define XB_XSUB(j)  (1280 + 64 * (j))
#define XB_XGEN(j)  (2304 + 64 * (j))
#define XB_TOP      3328
#define XB_TOPGEN   3392
#define XCD_BAR_WORDS 3456
#define XB_SPIN_CAP (1u << 22)
DI unsigned xb_ld(unsigned* p)              { return __hip_atomic_load(p, __ATOMIC_RELAXED, __HIP_MEMORY_SCOPE_AGENT); }
DI unsigned xb_add(unsigned* p, unsigned v) { return __hip_atomic_fetch_add(p, v, __ATOMIC_RELAXED, __HIP_MEMORY_SCOPE_AGENT); }
DI unsigned xb_xcc_id() { return (unsigned)__builtin_amdgcn_s_getreg((3 << 11) | 20) & 0xFu; }
#define XB_SPIN(cond, bar) do { unsigned _sp = 0; while (cond) { __builtin_amdgcn_s_sleep(1); \
    if ((++_sp & 255u) == 0u) { if (xb_ld(&(bar)[XB_TMO])) break; if (_sp > XB_SPIN_CAP) { atomicAdd(&(bar)[XB_TMO], 1u); break; } } } } while (0)
struct XcdBarrier { unsigned* bar; unsigned x; volatile LAS unsigned* st; };
DI XcdBarrier xcd_barrier_post(unsigned* bar, volatile LAS unsigned* st) {
    XcdBarrier b; b.bar = bar; b.x = xb_xcc_id(); b.st = st;
    if (threadIdx.x == 0) (void)xb_add(&bar[XB_XCNT(b.x)], 1u);
    return b;
}
DI void xcd_barrier_complete(unsigned* bar, unsigned x, unsigned& nloc, unsigned& nx) {
    const unsigned G = gridDim.x * gridDim.y * gridDim.z;
    unsigned sum, cnt, mine, sp = 0u;
    for (;;) {
        sum = 0u; cnt = 0u; mine = 0u;
#pragma unroll
        for (unsigned j = 0; j < 16; ++j) { const unsigned c = xb_ld(&bar[XB_XCNT(j)]); sum += c; cnt += (c > 0u) ? 1u : 0u; mine = (j == x) ? c : mine; }
        if (sum == G) break;
        __builtin_amdgcn_s_sleep(1);
        if ((++sp & 255u) == 0u) { if (xb_ld(&bar[XB_TMO])) break; if (sp > XB_SPIN_CAP) { atomicAdd(&bar[XB_TMO], 1u); break; } }
    }
    nloc = mine > 0u ? mine : 1u; nx = cnt > 0u ? cnt : 1u;
}
DI void xcd_barrier(const XcdBarrier& b) {
    asm volatile("s_waitcnt vmcnt(0)" ::: "memory");
    __syncthreads();
    if (threadIdx.x == 0) {
        unsigned* bar = b.bar;
        __builtin_amdgcn_s_waitcnt(0);
        unsigned nloc = b.st[0], nx = b.st[1];
        if (nloc == 0u) { xcd_barrier_complete(bar, b.x, nloc, nx); b.st[0] = nloc; b.st[1] = nx; }
        const unsigned old = xb_add(&bar[XB_XSUB(b.x)], 1u);
        const unsigned gen = old / nloc;
        if (old + 1u == (gen + 1u) * nloc) {
            __builtin_amdgcn_fence(__ATOMIC_RELEASE, "agent");
            asm volatile("s_waitcnt vmcnt(0)" ::: "memory");
            const unsigned og = xb_add(&bar[XB_TOP], 1u);
            const unsigned tg = og / nx;
            if (og + 1u == (tg + 1u) * nx) xb_add(&bar[XB_TOPGEN], 1u);
            else XB_SPIN(xb_ld(&bar[XB_TOPGEN]) == tg, bar);
            __builtin_amdgcn_fence(__ATOMIC_ACQUIRE, "agent");
            xb_add(&bar[XB_XGEN(b.x)], 1u);
            asm volatile("s_waitcnt vmcnt(0)" ::: "memory");
        } else {
            XB_SPIN(xb_ld(&bar[XB_XGEN(b.x)]) == gen, bar);
            __builtin_amdgcn_fence(__ATOMIC_ACQUIRE, "agent");
            asm volatile("s_waitcnt vmcnt(0)" ::: "memory");
        }
    }
    __syncthreads();
}

struct Args {
    const float *x, *c, *ctx, *c_ctx, *norm_mix_g, *norm_ffn_g, *w_mod, *b_mod, *w_in, *sinks, *lbf_logits, *lbb_logits, *hgrn_g, *w_branch, *w_out,
                *w_router, *b_router, *w_e_gate, *b_e_gate, *w_e_up, *b_e_up, *w_e_down, *b_e_down, *final_g;
    float* out; unsigned char* ws; int ph_lo, ph_hi;
};

DI void p0_transpose64(const float* W, int ldw, bf16* WT, int ldt, LAS unsigned char* scr, int lane) {
    const int kq = lane >> 4, n4 = lane & 15;
    f32x4 v[16];
#pragma unroll
    for (int i = 0; i < 16; ++i) v[i] = *(const f32x4*)(W + (size_t)(16 * kq + i) * ldw + 4 * n4);
#pragma unroll
    for (int c = 0; c < 4; ++c)
#pragma unroll
        for (int h = 0; h < 2; ++h) { u32x4 w; w.x = pk2(v[8 * h][c], v[8 * h + 1][c]); w.y = pk2(v[8 * h + 2][c], v[8 * h + 3][c]); w.z = pk2(v[8 * h + 4][c], v[8 * h + 5][c]); w.w = pk2(v[8 * h + 6][c], v[8 * h + 7][c]);
            *(LAS u32x4*)(scr + (4 * n4 + c) * 144 + (16 * kq + 8 * h) * 2) = w; }
    LDS_WAIT(); asm volatile("" ::: "memory");
#pragma unroll
    for (int j = 0; j < 8; ++j) { const int row = (lane >> 3) + 8 * j, pc = lane & 7; const u32x4 o = *(const LAS u32x4*)(scr + row * 144 + pc * 16); *(u32x4*)(WT + (size_t)row * ldt + pc * 8) = o; }
    LDS_WAIT(); asm volatile("" ::: "memory");
}
DI void p0_quant_item(const float* W  , int ldw, signed char* Q  , float* csp  , LAS unsigned char* lds, int tid) {
    const int lane = tid & 63, w = tid >> 6, n4 = lane & 7, kr = lane >> 3;
    LAS float* smax = (LAS float*)(lds + 32 * 2064);
    f32x4 v[8][4]; f32x4 mx = {0.f, 0.f, 0.f, 0.f};
#pragma unroll
    for (int g = 0; g < 8; ++g)
#pragma unroll
        for (int r = 0; r < 4; ++r) { v[g][r] = *(const f32x4*)(W + (size_t)(256 * g + 32 * w + 4 * kr + r) * ldw + 4 * n4);
            mx[0] = fmaxf(mx[0], fabsf(v[g][r][0])); mx[1] = fmaxf(mx[1], fabsf(v[g][r][1])); mx[2] = fmaxf(mx[2], fabsf(v[g][r][2])); mx[3] = fmaxf(mx[3], fabsf(v[g][r][3])); }
#pragma unroll
    for (int c = 0; c < 4; ++c) { float m = mx[c]; m = fmaxf(m, __shfl_xor(m, 8)); m = fmaxf(m, __shfl_xor(m, 16)); m = fmaxf(m, __shfl_xor(m, 32)); mx[c] = m; }
    __syncthreads();
    if (kr == 0) *(LAS f32x4*)(smax + w * 32 + 4 * n4) = mx;
    __syncthreads();
    f32x4 cm = *(const LAS f32x4*)(smax + 4 * n4);
#pragma unroll
    for (int ww = 1; ww < 8; ++ww) { const f32x4 o = *(const LAS f32x4*)(smax + ww * 32 + 4 * n4); cm[0] = fmaxf(cm[0], o[0]); cm[1] = fmaxf(cm[1], o[1]); cm[2] = fmaxf(cm[2], o[2]); cm[3] = fmaxf(cm[3], o[3]); }
    f32x4 inv;
#pragma unroll
    for (int c = 0; c < 4; ++c) { if (cm[c] == 0.f) cm[c] = 1.f; inv[c] = 127.0f / cm[c]; }
    if (w == 0 && kr == 0) { f32x4 sc; sc[0] = cm[0] * (1.0f / 127.0f); sc[1] = cm[1] * (1.0f / 127.0f); sc[2] = cm[2] * (1.0f / 127.0f); sc[3] = cm[3] * (1.0f / 127.0f); *(f32x4*)(csp + 4 * n4) = sc; }
#pragma unroll
    for (int g = 0; g < 8; ++g)
#pragma unroll
        for (int c = 0; c < 4; ++c) { unsigned pk = 0u;
#pragma unroll
            for (int r = 0; r < 4; ++r) { const int q = (int)rintf(v[g][r][c] * inv[c]); pk |= ((unsigned)q & 0xffu) << (8 * r); }
            *(LAS unsigned*)(lds + (4 * n4 + c) * 2064 + 4 * (64 * g + 8 * w + kr)) = pk; }
    __syncthreads();
#pragma unroll
    for (int i = 0; i < 8; ++i) { const int p = tid + 512 * i, row = p >> 7, pc = p & 127; const u32x4 o = *(const LAS u32x4*)(lds + row * 2064 + pc * 16); *(u32x4*)(Q + (size_t)row * 2048 + pc * 16) = o; }
}

constexpr int SC_QH = 0, SC_KH = 8448, SC_KT = 16896, SC_VT = 26112, SC_FAC = 35328, SC_RZ = 35840, SC_RV = 44032, SC_RQ = 52224, SC_GRP = 60416;
constexpr int RSQ = 264, RST = 72;
DI int crow(int i, int h) { return (i & 3) + 8 * (i >> 2) + 4 * h; }
DI bf16x8 pack8(float a0, float a1, float a2, float a3, float a4, float a5, float a6, float a7) {
    u32x4 p; p.x = pk2(a0, a1); p.y = pk2(a2, a3); p.z = pk2(a4, a5); p.w = pk2(a6, a7); return __builtin_bit_cast(bf16x8, p);
}
DI bf16x8 lds_frag2(const LAS unsigned char* p0, const LAS unsigned char* p1) {
    const u32x2 lo = *(const LAS u32x2*)p0, hi = *(const LAS u32x2*)p1; u32x4 v; v.x = lo.x; v.y = lo.y; v.z = hi.x; v.w = hi.y; return __builtin_bit_cast(bf16x8, v);
}
#define MFMA32(a, b, c) __builtin_amdgcn_mfma_f32_32x32x16_bf16((a), (b), (c), 0, 0, 0)

template <bool OUT>
DI void scan_segment(LAS unsigned char* ldsb, const bf16* proj, int hh, int segF, int segB, float* Lbuf, float* Dlog, bf16* oscr) {
    const int tid = threadIdx.x, lane = tid & 63, wave = __builtin_amdgcn_readfirstlane(tid >> 6);
    const int dir = wave >> 2, w4 = wave & 3, half = w4 >> 1, d = tid & 127, r = lane & 31, h5 = lane >> 5, e0 = 32 * w4;
    const int seg = dir ? segB : segF, scan = dir * 8 + hh;
    const int ntok = (seg == 0) ? NCTX : 512, sgn = dir ? -1 : 1;
    const int r0 = (seg == 0) ? (dir ? MROWS - 1 : NTOK) : (dir ? NTOK - 1 - (seg - 1) * 512 : (seg - 1) * 512);
    LAS unsigned char* G = ldsb + dir * SC_GRP;
    LAS unsigned char* QH = G + SC_QH; LAS unsigned char* KH = G + SC_KH; LAS unsigned char* KT = G + SC_KT; LAS unsigned char* VT = G + SC_VT; LAS float* FAC = (LAS float*)(G + SC_FAC);
    float* Lslot = Lbuf + (size_t)(scan * NSEG + seg) * 16384;
    f32x16 acc[4];
    if (OUT) {
        const float* Sin = Lbuf + (size_t)(scan * NSEG + seg - 1) * 16384;
#pragma unroll
        for (int dt = 0; dt < 4; ++dt)
#pragma unroll
            for (int i = 0; i < 16; ++i) acc[dt][i] = Sin[(32 * dt + crow(i, h5)) * 128 + e0 + r];
    } else {
#pragma unroll
        for (int dt = 0; dt < 4; ++dt)
#pragma unroll
            for (int i = 0; i < 16; ++i) acc[dt][i] = 0.f;
    }
    float tail_prev = 0.f, dlog_tot = 0.f;
    const bf16* zsrc = proj + (dir ? PO_ZB : PO_ZF) + (size_t)hh * MROWS * 128; const bf16* vsrc = proj + PO_BV + (size_t)hh * MROWS * 128; const bf16* qsrc = proj + PO_BQ + (size_t)hh * MROWS * 128;
    const int nch = ntok / 32;
    LAS unsigned char* RZ = G + SC_RZ; LAS unsigned char* RV = G + SC_RV; LAS unsigned char* RQ = G + SC_RQ;
#define SC_DMA(cc) do { const int rb_ = r0 + sgn * 32 * (cc); \
        _Pragma("unroll") for (int i_ = 0; i_ < 2; ++i_) { const int s_ = 8 * w4 + 4 * i_ + (lane >> 4); const size_t so_ = (size_t)(rb_ + sgn * s_) * 128 + 8 * (lane & 15); \
            __builtin_amdgcn_global_load_lds((const unsigned*)(zsrc + so_), (LAS unsigned*)(RZ + (8 * w4 + 4 * i_) * 256), 16, 0, 0); \
            __builtin_amdgcn_global_load_lds((const unsigned*)(vsrc + so_), (LAS unsigned*)(RV + (8 * w4 + 4 * i_) * 256), 16, 0, 0); \
            if (OUT) __builtin_amdgcn_global_load_lds((const unsigned*)(qsrc + so_), (LAS unsigned*)(RQ + (8 * w4 + 4 * i_) * 256), 16, 0, 0); } } while (0)
    SC_DMA(0);
    for (int c = 0; c < nch; ++c) {
        const int rb = r0 + sgn * 32 * c;
        if (OUT && c > 0) asm volatile("s_waitcnt vmcnt(4)" ::: "memory"); else asm volatile("s_waitcnt vmcnt(0)" ::: "memory");
        asm volatile("s_waitcnt lgkmcnt(0)" ::: "memory"); __builtin_amdgcn_s_barrier(); asm volatile("" ::: "memory");
        float rsum = 0.f, lf[16], vv[16], qq[16];
        if (half) {
#pragma unroll
            for (int s = 0; s < 16; ++s) rsum += bf2f(*(const LAS unsigned short*)(RZ + s * 256 + d * 2));
        }
#pragma unroll
        for (int i = 0; i < 16; ++i) { const int so = (16 * half + i) * 256 + d * 2;
            lf[i] = bf2f(*(const LAS unsigned short*)(RZ + so)); vv[i] = bf2f(*(const LAS unsigned short*)(RV + so)); if (OUT) qq[i] = bf2f(*(const LAS unsigned short*)(RQ + so)); }
        if (!half) {
#pragma unroll
            for (int i = 0; i < 16; ++i) rsum += lf[i];
        }
        float b = half ? rsum : 0.f, kh[16], qh[16];
#pragma unroll
        for (int i = 0; i < 16; ++i) { b += lf[i]; const float x = b - rsum;
            kh[i] = (1.0f - __expf(lf[i])) * __expf(fminf(-x, 60.f));
            if (OUT) qh[i] = qq[i] * __expf(fminf(x, 60.f)); }
        const float tail = b - rsum;
#pragma unroll
        for (int j = 0; j < 4; ++j) {
            u32x2 w; w.x = pk2(kh[4 * j], kh[4 * j + 1]); w.y = pk2(kh[4 * j + 2], kh[4 * j + 3]); *(LAS u32x2*)(KT + d * RST + 32 * half + 8 * j) = w;
            u32x2 v; v.x = pk2(vv[4 * j], vv[4 * j + 1]); v.y = pk2(vv[4 * j + 2], vv[4 * j + 3]); *(LAS u32x2*)(VT + d * RST + 32 * half + 8 * j) = v;
        }
        if (OUT) {
#pragma unroll
            for (int i = 0; i < 16; ++i) { const int s = 16 * half + i;
                *(LAS unsigned short*)(KH + s * RSQ + d * 2) = f2bf(kh[i]); *(LAS unsigned short*)(QH + s * RSQ + d * 2) = f2bf(qh[i]); }
        }
        if (half) { FAC[d] = __expf(tail_prev + rsum); tail_prev = tail; dlog_tot += rsum + tail; }
        asm volatile("s_waitcnt lgkmcnt(0)" ::: "memory"); __builtin_amdgcn_s_barrier(); asm volatile("" ::: "memory");
        if (c + 1 < nch) SC_DMA(c + 1);
        asm volatile("" ::: "memory");
#pragma unroll
        for (int dt = 0; dt < 4; ++dt)
#pragma unroll
            for (int g4 = 0; g4 < 4; ++g4) { const f32x4 f = *(const LAS f32x4*)(FAC + 32 * dt + 8 * g4 + 4 * h5);
#pragma unroll
                for (int j = 0; j < 4; ++j) acc[dt][4 * g4 + j] *= f[j]; }
        if (OUT) {
            bf16x8 qf[8];
            f32x16 pT, oT;
#pragma unroll
            for (int i = 0; i < 16; ++i) { pT[i] = 0.f; oT[i] = 0.f; }
#pragma unroll
            for (int kk = 0; kk < 8; ++kk) {
                qf[kk] = lds_frag2(QH + r * RSQ + (16 * kk + 4 * h5) * 2, QH + r * RSQ + (16 * kk + 8 + 4 * h5) * 2);
                const bf16x8 kf = lds_frag2(KH + r * RSQ + (16 * kk + 4 * h5) * 2, KH + r * RSQ + (16 * kk + 8 + 4 * h5) * 2);
                pT = MFMA32(kf, qf[kk], pT);
            }
#pragma unroll
            for (int i = 0; i < 16; ++i) if (crow(i, h5) > r) pT[i] = 0.f;
#pragma unroll
            for (int dt = 0; dt < 4; ++dt)
#pragma unroll
                for (int ks = 0; ks < 2; ++ks) {
                    const bf16x8 sa = pack8(acc[dt][8 * ks], acc[dt][8 * ks + 1], acc[dt][8 * ks + 2], acc[dt][8 * ks + 3], acc[dt][8 * ks + 4], acc[dt][8 * ks + 5], acc[dt][8 * ks + 6], acc[dt][8 * ks + 7]);
                    oT = MFMA32(sa, qf[2 * dt + ks], oT);
                }
#pragma unroll
            for (int ks = 0; ks < 2; ++ks) {
                const bf16x8 pf = pack8(pT[8 * ks], pT[8 * ks + 1], pT[8 * ks + 2], pT[8 * ks + 3], pT[8 * ks + 4], pT[8 * ks + 5], pT[8 * ks + 6], pT[8 * ks + 7]);
                const bf16x8 va = lds_frag2(VT + (e0 + r) * RST + (16 * ks + 4 * h5) * 2, VT + (e0 + r) * RST + (16 * ks + 8 + 4 * h5) * 2);
                oT = MFMA32(va, pf, oT);
            }
            bf16* orow = oscr + ((size_t)(dir * 8 + hh) * NTOK + (rb + sgn * r)) * 128 + e0 + 4 * h5;
#pragma unroll
            for (int g4 = 0; g4 < 4; ++g4) { u32x2 o; o.x = pk2(oT[4 * g4], oT[4 * g4 + 1]); o.y = pk2(oT[4 * g4 + 2], oT[4 * g4 + 3]); *(u32x2*)(orow + 8 * g4) = o; }
        }
#pragma unroll
        for (int ks = 0; ks < 2; ++ks) {
            const bf16x8 vb = lds_frag2(VT + (e0 + r) * RST + (16 * ks + 8 * h5) * 2, VT + (e0 + r) * RST + (16 * ks + 8 * h5) * 2 + 8);
#pragma unroll
            for (int dt = 0; dt < 4; ++dt) {
                const bf16x8 ka = lds_frag2(KT + (32 * dt + r) * RST + (16 * ks + 8 * h5) * 2, KT + (32 * dt + r) * RST + (16 * ks + 8 * h5) * 2 + 8);
                acc[dt] = MFMA32(ka, vb, acc[dt]);
            }
        }
    }
#undef SC_DMA
    if (!OUT) {
        __syncthreads();
        if (half) { FAC[d] = __expf(tail_prev); Dlog[(size_t)(scan * NSEG + seg) * 128 + d] = dlog_tot; }
        __syncthreads();
#pragma unroll
        for (int dt = 0; dt < 4; ++dt)
#pragma unroll
            for (int g4 = 0; g4 < 4; ++g4) { const f32x4 f = *(const LAS f32x4*)(FAC + 32 * dt + 8 * g4 + 4 * h5);
#pragma unroll
                for (int j = 0; j < 4; ++j) Lslot[(32 * dt + 8 * g4 + 4 * h5 + j) * 128 + e0 + r] = acc[dt][4 * g4 + j] * f[j]; }
    }
    __syncthreads();
}

constexpr int AT_KC = 0, AT_VC = 36864, AT_KL = 70144, AT_VL = 116224, AT_END = 157696;
constexpr int KRS = 144, VCRS = 520, VLRS = 648, NSLOT = 10;
static_assert(AT_END <= MISC_OFF, "attention LDS");
DI void attn_unit(LAS unsigned char* ldsb, const bf16* proj, const bf16* KR, const bf16* VTg, const float* rope, const float* sinks, bf16* yab, int kvh, int ab) {
    const int tid = threadIdx.x, lane = tid & 63, wave = __builtin_amdgcn_readfirstlane(tid >> 6), r = lane & 31, h5 = lane >> 5;
    const int head = kvh * 8 + wave;
    LAS unsigned char* KC = ldsb + AT_KC; LAS unsigned char* VC = ldsb + AT_VC; LAS unsigned char* KL = ldsb + AT_KL; LAS unsigned char* VL = ldsb + AT_VL;
    const float* rowcos = rope, *rowsin = rope + 4096, *colcos = rope + 8192, *colsin = rope + 8192 + 1024;
    __syncthreads();
    for (int p = tid; p < 2048; p += 512) {
        { const int key = p >> 3, c8 = p & 7; const u32x4 v = *(const u32x4*)(KR + ((size_t)(kvh * MROWS + NTOK + key)) * 64 + c8 * 8); *(LAS u32x4*)(KC + key * KRS + c8 * 16) = v; }
        { const int dd = p >> 5, c = p & 31; const u32x4 v = *(const u32x4*)(VTg + ((size_t)(kvh * 64 + dd)) * MROWS + NTOK + c * 8);
          u32x2 a; a.x = v.x; a.y = v.y; u32x2 b; b.x = v.z; b.y = v.w; *(LAS u32x2*)(VC + dd * VCRS + c * 16) = a; *(LAS u32x2*)(VC + dd * VCRS + c * 16 + 8) = b; }
    }
    const int T0 = ab * 4 - 4;
    for (int p = tid; p < 2304; p += 512) {
        { const int key = p >> 3, c8 = p & 7, T = T0 + (key >> 5), slot = (T + 2 * NSLOT) % NSLOT;
          if (T >= 0 && T < NTOK / 32) { const u32x4 v = *(const u32x4*)(KR + ((size_t)(kvh * MROWS + T * 32 + (key & 31))) * 64 + c8 * 8); *(LAS u32x4*)(KL + (slot * 32 + (key & 31)) * KRS + c8 * 16) = v; } }
        { const int dd = p / 36, c = p % 36, T = T0 + (c >> 2), slot = (T + 2 * NSLOT) % NSLOT;
          if (T >= 0 && T < NTOK / 32) { const u32x4 v = *(const u32x4*)(VTg + ((size_t)(kvh * 64 + dd)) * MROWS + T * 32 + (c & 3) * 8);
            u32x2 a; a.x = v.x; a.y = v.y; u32x2 b; b.x = v.z; b.y = v.w; LAS unsigned char* dst = VL + dd * VLRS + slot * 64 + (c & 3) * 16; *(LAS u32x2*)dst = a; *(LAS u32x2*)(dst + 8) = b; } }
    }
    const float sc = 0.125f * 1.4426950408889634f;
    u32x4 raw[4]; float cs[2][8], sn[2][8];
#define AT_LOADQ(P0) do { const int qp_ = (P0) + r; const bf16* qrow_ = proj + PO_AQ + ((size_t)head * MROWS + qp_) * 64 + 8 * h5; \
        _Pragma("unroll") for (int ks = 0; ks < 4; ++ks) raw[ks] = *(const u32x4*)(qrow_ + 16 * ks); \
        const float* c0_ = rowcos + (qp_ >> 6) * 16 + 8 * h5; const float* s0_ = rowsin + (qp_ >> 6) * 16 + 8 * h5; \
        const float* c1_ = colcos + (qp_ & 63) * 16 + 8 * h5; const float* s1_ = colsin + (qp_ & 63) * 16 + 8 * h5; \
        _Pragma("unroll") for (int j = 0; j < 8; ++j) { cs[0][j] = c0_[j]; sn[0][j] = s0_[j]; cs[1][j] = c1_[j]; sn[1][j] = s1_[j]; } } while (0)
    AT_LOADQ(ab * 128);
    __syncthreads();
    for (int qt = 0; qt < 4; ++qt) {
        const int p0 = ab * 128 + 32 * qt, kb0 = p0 - 128, qp = p0 + r, Tq = ab * 4 + qt - 4;
        bf16x8 qf[4];
#pragma unroll
        for (int ks = 0; ks < 2; ++ks) { float o1[8], o2[8];
#pragma unroll
            for (int q = 0; q < 4; ++q) {
                const float a0 = bflo(raw[ks][q]), a1 = bfhi(raw[ks][q]), b0 = bflo(raw[ks + 2][q]), b1 = bfhi(raw[ks + 2][q]);
                o1[2 * q] = a0 * cs[ks][2 * q] - b0 * sn[ks][2 * q]; o2[2 * q] = b0 * cs[ks][2 * q] + a0 * sn[ks][2 * q];
                o1[2 * q + 1] = a1 * cs[ks][2 * q + 1] - b1 * sn[ks][2 * q + 1]; o2[2 * q + 1] = b1 * cs[ks][2 * q + 1] + a1 * sn[ks][2 * q + 1]; }
            qf[ks] = pack8(o1[0], o1[1], o1[2], o1[3], o1[4], o1[5], o1[6], o1[7]);
            qf[ks + 2] = pack8(o2[0], o2[1], o2[2], o2[3], o2[4], o2[5], o2[6], o2[7]); }
        const int Tn = Tq + 9; const bool pre = (qt < 3) && Tn >= 0 && Tn < NTOK / 32; u32x4 nk = {0u, 0u, 0u, 0u};
        if (pre) { if (tid < 256) nk = *(const u32x4*)(KR + ((size_t)(kvh * MROWS + Tn * 32 + (tid >> 3))) * 64 + (tid & 7) * 8);
                   else { const int t2 = tid - 256; nk = *(const u32x4*)(VTg + ((size_t)(kvh * 64 + (t2 >> 2))) * MROWS + Tn * 32 + (t2 & 3) * 8); } }
        if (qt < 3) AT_LOADQ(p0 + 32);
        float m_run = sinks[head] * 1.4426950408889634f, l_run = h5 ? 0.f : 1.f;
        f32x16 o0, o1;
#pragma unroll
        for (int i = 0; i < 16; ++i) { o0[i] = 0.f; o1[i] = 0.f; }
        for (int kt = 0; kt < 17; ++kt) {
            const bool lat = kt >= 8; const int j = kt - 8, T = Tq + j, kb = kb0 + 32 * j, slot = (T + 2 * NSLOT) % NSLOT;
            if (lat && (T < 0 || T >= NTOK / 32)) continue;
            const LAS unsigned char* Kb = lat ? KL + (32 * slot + r) * KRS : KC + (32 * kt + r) * KRS;
            const LAS unsigned char* Vb = lat ? VL + r * VLRS + 64 * slot : VC + r * VCRS + 64 * kt;
            const int vrs32 = 32 * (lat ? VLRS : VCRS); const bool edge = lat && (j == 0 || j == 8);
            f32x16 s;
#pragma unroll
            for (int i = 0; i < 16; ++i) s[i] = 0.f;
#pragma unroll
            for (int ks = 0; ks < 4; ++ks) { const bf16x8 kf = *(const LAS bf16x8*)(Kb + (16 * ks + 8 * h5) * 2); s = MFMA32(kf, qf[ks], s); }
            float mt = -INFINITY;
#pragma unroll
            for (int i = 0; i < 16; ++i) { float v = s[i] * sc;
                if (edge) { const int dk = kb + crow(i, h5) - qp; if (dk > 128 || dk < -128) v = -INFINITY; }
                s[i] = v; mt = fmaxf(mt, v); }
            mt = fmaxf(mt, __shfl_xor(mt, 32));
            const float mn = fmaxf(m_run, mt);
            if (__any(mn > m_run)) { const float alpha = __builtin_amdgcn_exp2f(m_run - mn); l_run *= alpha;
#pragma unroll
                for (int i = 0; i < 16; ++i) { o0[i] *= alpha; o1[i] *= alpha; } }
            m_run = mn;
            float ps = 0.f;
#pragma unroll
            for (int i = 0; i < 16; ++i) { const float p = __builtin_amdgcn_exp2f(s[i] - mn); s[i] = p; ps += p; }
            l_run += ps;
#pragma unroll
            for (int ks = 0; ks < 2; ++ks) {
                const bf16x8 pf = pack8(s[8 * ks], s[8 * ks + 1], s[8 * ks + 2], s[8 * ks + 3], s[8 * ks + 4], s[8 * ks + 5], s[8 * ks + 6], s[8 * ks + 7]);
                const bf16x8 v0 = lds_frag2(Vb + (16 * ks + 4 * h5) * 2, Vb + (16 * ks + 8 + 4 * h5) * 2);
                const bf16x8 v1 = lds_frag2(Vb + vrs32 + (16 * ks + 4 * h5) * 2, Vb + vrs32 + (16 * ks + 8 + 4 * h5) * 2);
                o0 = MFMA32(v0, pf, o0);
                o1 = MFMA32(v1, pf, o1);
            }
        }
        const float l = l_run + __shfl_xor(l_run, 32), inv = 1.0f / l;
        bf16* orow = yab + (size_t)qp * D + head * 64 + 4 * h5;
#pragma unroll
        for (int g4 = 0; g4 < 4; ++g4) {
            u32x2 a; a.x = pk2(o0[4 * g4] * inv, o0[4 * g4 + 1] * inv); a.y = pk2(o0[4 * g4 + 2] * inv, o0[4 * g4 + 3] * inv); *(u32x2*)(orow + 8 * g4) = a;
            u32x2 b; b.x = pk2(o1[4 * g4] * inv, o1[4 * g4 + 1] * inv); b.y = pk2(o1[4 * g4 + 2] * inv, o1[4 * g4 + 3] * inv); *(u32x2*)(orow + 32 + 8 * g4) = b;
        }
        if (pre) { const int slot = (Tn + 2 * NSLOT) % NSLOT;
            if (tid < 256) *(LAS u32x4*)(KL + (slot * 32 + (tid >> 3)) * KRS + (tid & 7) * 16) = nk;
            else { const int t2 = tid - 256; u32x2 a; a.x = nk.x; a.y = nk.y; u32x2 b; b.x = nk.z; b.y = nk.w; LAS unsigned char* dst = VL + (t2 >> 2) * VLRS + slot * 64 + (t2 & 3) * 16; *(LAS u32x2*)dst = a; *(LAS u32x2*)(dst + 8) = b; } }
        __syncthreads();
    }
#undef AT_LOADQ
}

typedef const Args __attribute__((address_space(4))) ArgsC;
DI ArgsC* args_ptr() { ArgsC* p = (ArgsC*)__builtin_amdgcn_kernarg_segment_ptr(); asm volatile("" : "+s"(p)); return p; }
#define PH_BEGIN ArgsC* A = args_ptr(); unsigned char* const ws = A->ws; (void)ws
#define modl ((float*)(ws + WS_SMALL + SM_MODL))
#define modc ((float*)(ws + WS_SMALL + SM_MODC))
#define rope ((float*)(ws + WS_SMALL + SM_ROPE))
#define lbf ((float*)(ws + WS_SMALL + SM_LB))
#define lbb (lbf + 1024)
#define wrp ((float*)(ws + WS_SMALL + SM_WRP))
#define cvec ((float*)(ws + WS_SMALL + SM_CVEC))
#define tile_expert ((int*)(ws + WS_SMALL + SM_TILE))
#define ntiles_p (tile_expert + 512)
#define rt_e ((int*)(ws + WS_ROUTE + RT_E))
#define rt_g ((float*)(ws + WS_ROUTE + RT_G))
#define rt_r ((int*)(ws + WS_ROUTE + RT_R))
#define rt_s ((int*)(ws + WS_ROUTE + RT_S))
#define slot_rowoff ((unsigned*)(ws + WS_ROUTE + RT_OFF))
#define slot_gate ((float*)(ws + WS_ROUTE + RT_SG))
#define Dlog ((float*)(ws + WS_DLOG))
#define KR ((bf16*)(ws + WS_KR))
#define VTg ((bf16*)(ws + WS_VT))
#define Lbuf ((float*)(ws + WS_L))
#define WIN ((bf16*)(ws + WS_WIN))
#define WM ((bf16*)(ws + WS_WM))
#define WO ((bf16*)(ws + WS_WO))
#define WGU ((bf16*)(ws + WS_WGU))
#define WDN ((bf16*)(ws + WS_WDN))
#define H ((bf16*)(ws + WS_H))
#define PROJ ((bf16*)(ws + WS_PROJ))
#define ACT ((bf16*)(ws + WS_ACT))
#define YAB ((bf16*)(ws + WS_YAB))
#define OSCR ((bf16*)(ws + WS_OSCR))
#define MERGED ((bf16*)(ws + WS_MERGED))
#define X1 ((float*)(ws + WS_X1))
#define YS ((bf16*)(ws + WS_YS))

__global__ void __launch_bounds__(NWAVES * 64, 2) fwd_kernel(Args a_unused) {
    extern __shared__ __attribute__((aligned(16))) unsigned char lds_raw[];
    LAS unsigned char* lds = (LAS unsigned char*)lds_raw;
    volatile LAS unsigned* MISC = (volatile LAS unsigned*)(lds + MISC_OFF);
    const int tid = threadIdx.x, lane = tid & 63, wave = __builtin_amdgcn_readfirstlane(tid >> 6);
    const int G = gridDim.x, bx = blockIdx.x, vcu = (G % 8 == 0) ? (bx % 8) * (G / 8) + bx / 8 : bx;
    const int gw = vcu * NWAVES + wave, NGW = G * NWAVES;
    const int gtid = vcu * 512 + tid, NGT = G * 512;
    unsigned* ctl; { const ArgsC* A0 = args_ptr(); ctl = (unsigned*)(A0->ws + WS_CTL); }
    if (tid < 64) MISC[tid] = 0u;
    __syncthreads();
    XcdBarrier bar = xcd_barrier_post(ctl + CW_BAR, MISC);
    int lo, hi; { const ArgsC* A0 = args_ptr(); lo = A0->ph_lo; hi = A0->ph_hi; }
#ifndef PH_MASK
#define PH_MASK 0x1fff
#endif
#define IN(k) ((((PH_MASK) >> (k)) & 1) && lo <= (k) && (k) < hi)
#define SEAM(k) do { if (IN(k) && IN((k) + 1)) xcd_barrier(bar); } while (0)

    for (int rep_ = 0; rep_ < DUP0; ++rep_) { if (rep_) xcd_barrier(bar);
    if (IN(0)) {
        PH_BEGIN;
        constexpr int Q_TAB = 48, Q_WIN = 49, Q_GU = Q_WIN + INC / 32, Q_TR = Q_GU + 4096, I_BR = 1024, I_OUT = 1024, I_E = 32 * 1024, Q_END = Q_TR + (I_BR + I_OUT + I_E) / 8;
        int cur = vcu;
        while (cur < Q_END) {
            unsigned nxt = 0u; if (tid == 0) nxt = (unsigned)G + atomicAdd(ctl + CW_Q, 1u);
            if (cur < Q_TAB) {
                LAS float* sc = (LAS float*)lds; LAS float* scc = sc + 2048; LAS f32x4* red = (LAS f32x4*)(lds + 16384);
                for (int k = tid; k < 2048; k += 512) { const float v = A->c[k], u = A->c_ctx[k]; sc[k] = v * sigmoidf_(v); scc[k] = u * sigmoidf_(u); }
                __syncthreads();
                const int cb = cur, col = 256 * cb + 4 * lane; const bool hasc = cb < 16;
                f32x4 al = {0.f, 0.f, 0.f, 0.f}, ac = {0.f, 0.f, 0.f, 0.f};
#pragma unroll 8
                for (int k = wave; k < 2048; k += 8) { const f32x4 wv = *(const f32x4*)(A->w_mod + (size_t)k * 12288 + col); al += sc[k] * wv; ac += scc[k] * wv; }
                red[wave * 64 + lane] = al; red[512 + wave * 64 + lane] = ac;
                __syncthreads();
                if (wave == 0) { f32x4 s = *(const f32x4*)(A->b_mod + col), t = s;
#pragma unroll
                    for (int w = 0; w < 8; ++w) { s += red[w * 64 + lane]; t += red[512 + w * 64 + lane]; }
                    *(f32x4*)(modl + col) = s; if (hasc) *(f32x4*)(modc + col) = t; }
            } else if (cur == Q_TAB) {
                for (int i = tid; i < 4096 + 1024; i += 512) { const bool isrow = i < 4096; const int ii = isrow ? i : i - 4096, p = ii >> 4, j = ii & 15;
                    const float inv = powf(10000.0f, -(float)j / 16.0f), ang = (float)p * inv; float s, c; sincosf(ang, &s, &c);
                    if (isrow) { rope[ii] = c; rope[4096 + ii] = s; } else { rope[8192 + ii] = c; rope[9216 + ii] = s; } }
                for (int i = tid; i < 2048; i += 512) { const float* lg = (i < 1024) ? A->lbf_logits : A->lbb_logits; const int ch = i & 1023;
                    const float v = 1.0f / (1.0f + expf(lg[1024 + ch] - lg[ch])); if (i < 1024) lbf[ch] = v; else lbb[ch] = v; }
            } else if (cur < Q_GU) { const int it = cur - Q_WIN;
                p0_quant_item(A->w_in + 32 * it, INC, (signed char*)(ws + WS_WIN) + (size_t)(32 * it) * 2048, (float*)(ws + WS_CS + CS_WIN) + 32 * it, lds, tid);
            } else if (cur < Q_TR) { const int it = cur - Q_GU;
                const int e = it >> 7, which = (it >> 6) & 1, jb = it & 63, n0 = 32 * jb, np = e * 4096 + (n0 >> 7) * 256 + which * 128 + (n0 & 127);
                p0_quant_item((which ? A->w_e_up : A->w_e_gate) + (size_t)e * D * FF + n0, FF, (signed char*)(ws + WS_WGU) + (size_t)np * 2048, (float*)(ws + WS_CS) + np, lds, tid);
            } else {
                LAS unsigned char* scr = lds + wave * 9216; int r = (cur - Q_TR) * 8 + wave;
                if (r < I_BR) { const int br = r >> 9, r2 = r & 511, kb = r2 >> 5, nb = r2 & 31;
                    p0_transpose64(A->w_branch + (size_t)br * 1024 * D + (size_t)(64 * kb) * D + 64 * nb, D, WM + (size_t)(64 * nb) * D + br * 1024 + 64 * kb, D, scr, lane); }
                else if (r < I_BR + I_OUT) { r -= I_BR; const int kb = r >> 5, nb = r & 31; p0_transpose64(A->w_out + (size_t)(64 * kb) * D + 64 * nb, D, WO + (size_t)(64 * nb) * D + 64 * kb, D, scr, lane); }
                else { r -= I_BR + I_OUT; const int e = r >> 10, r2 = r & 1023, kb = r2 >> 5, nb = r2 & 31;
                    p0_transpose64(A->w_e_down + (size_t)e * D * FF + (size_t)(64 * kb) * FF + 64 * nb, FF, WDN + ((size_t)e * D + 64 * nb) * FF + 64 * kb, FF, scr, lane); }
            }
            __syncthreads();
            if (tid == 0) MISC[2] = nxt;
            __syncthreads();
            cur = (int)MISC[2];
        }
    }
    }
    SEAM(0);

    if (IN(1)) {
        PH_BEGIN;
        {
            f32x4 ca[8], cb[8];
#pragma unroll
            for (int j = 0; j < 8; ++j) { const int k = 4 * lane + 256 * j; const f32x4 g = *(const f32x4*)(A->norm_mix_g + k), s1 = *(const f32x4*)(modl + 2048 + k); ca[j] = g * (1.0f + s1); cb[j] = *(const f32x4*)(modl + k); }
            f32x4 v[8], vn[8];
            { const float* xr = A->x + (size_t)gw * D + 4 * lane;
#pragma unroll
              for (int j = 0; j < 8; ++j) v[j] = *(const f32x4*)(xr + 256 * j); }
            for (int m = gw; m < NTOK; m += NGW) {
                if (m + NGW < NTOK) { const float* xn = A->x + (size_t)(m + NGW) * D + 4 * lane;
#pragma unroll
                    for (int j = 0; j < 8; ++j) vn[j] = *(const f32x4*)(xn + 256 * j); }
                float ss = 0.f;
#pragma unroll
                for (int j = 0; j < 8; ++j) ss += v[j][0] * v[j][0] + v[j][1] * v[j][1] + v[j][2] * v[j][2] + v[j][3] * v[j][3];
                const float rstd = rsqrtf(wave_sum(ss) * (1.0f / D) + EPS);
                float am = 0.f;
#pragma unroll
                for (int j = 0; j < 8; ++j) { v[j] = v[j] * rstd * ca[j] + cb[j]; am = fmaxf(am, fmaxf(fmaxf(fabsf(v[j][0]), fabsf(v[j][1])), fmaxf(fabsf(v[j][2]), fabsf(v[j][3])))); }
#pragma unroll
                for (int o = 1; o < 64; o <<= 1) am = fmaxf(am, __shfl_xor(am, o));
                if (am == 0.f) am = 1.f;
                const float qi = 127.0f / am;
                if (lane == 0) ((float*)(ws + WS_CS + CS_HROW))[m] = am * (1.0f / 127.0f);
                unsigned* hq = (unsigned*)((signed char*)(ws + WS_H) + (size_t)m * D + 4 * lane);
#pragma unroll
                for (int j = 0; j < 8; ++j) { const int q0 = (int)rintf(v[j][0] * qi), q1 = (int)rintf(v[j][1] * qi), q2 = (int)rintf(v[j][2] * qi), q3 = (int)rintf(v[j][3] * qi);
                    hq[64 * j] = ((unsigned)q0 & 0xffu) | (((unsigned)q1 & 0xffu) << 8) | (((unsigned)q2 & 0xffu) << 16) | (((unsigned)q3 & 0xffu) << 24); }
#pragma unroll
                for (int j = 0; j < 8; ++j) v[j] = vn[j];
            }
        }
        if (gw < NCTX) {
            const int m = gw; const float* xr = A->ctx + (size_t)m * D + 4 * lane; f32x4 v[8]; float ss = 0.f;
#pragma unroll
            for (int j = 0; j < 8; ++j) { v[j] = *(const f32x4*)(xr + 256 * j); ss += v[j][0] * v[j][0] + v[j][1] * v[j][1] + v[j][2] * v[j][2] + v[j][3] * v[j][3]; }
            const float rstd = rsqrtf(wave_sum(ss) * (1.0f / D) + EPS);
            float am = 0.f;
#pragma unroll
            for (int j = 0; j < 8; ++j) { const int k = 4 * lane + 256 * j; const f32x4 g = *(const f32x4*)(A->norm_mix_g + k), s1 = *(const f32x4*)(modc + 2048 + k), s0 = *(const f32x4*)(modc + k);
                v[j] = v[j] * rstd * (g * (1.0f + s1)) + s0; am = fmaxf(am, fmaxf(fmaxf(fabsf(v[j][0]), fabsf(v[j][1])), fmaxf(fabsf(v[j][2]), fabsf(v[j][3])))); }
#pragma unroll
            for (int o = 1; o < 64; o <<= 1) am = fmaxf(am, __shfl_xor(am, o));
            if (am == 0.f) am = 1.f;
            const float qi = 127.0f / am;
            if (lane == 0) ((float*)(ws + WS_CS + CS_HROW))[NTOK + m] = am * (1.0f / 127.0f);
            unsigned* hq = (unsigned*)((signed char*)(ws + WS_H) + (size_t)(NTOK + m) * D + 4 * lane);
#pragma unroll
            for (int j = 0; j < 8; ++j) { const int q0 = (int)rintf(v[j][0] * qi), q1 = (int)rintf(v[j][1] * qi), q2 = (int)rintf(v[j][2] * qi), q3 = (int)rintf(v[j][3] * qi);
                hq[64 * j] = ((unsigned)q0 & 0xffu) | (((unsigned)q1 & 0xffu) << 8) | (((unsigned)q2 & 0xffu) << 16) | (((unsigned)q3 & 0xffu) << 24); }
        }
        for (int i = gtid; i < 2048 * 32; i += NGT) { const int k = i >> 5; wrp[i] = A->norm_ffn_g[k] * (1.0f + modl[4 * 2048 + k]) * A->w_router[i]; }
        if (vcu == G - 1) {
            for (int e = wave * 4; e < wave * 4 + 4; ++e) { float s = 0.f; for (int k = lane; k < 2048; k += 64) s += modl[3 * 2048 + k] * A->w_router[k * 32 + e];
                s = wave_sum(s); if (lane == 0) cvec[e] = s + A->b_router[e]; }
        }
    }
    SEAM(1);

    if (IN(2)) {
        PH_BEGIN;
        pg8::Gemm g{H, WIN, D / 2}; pg8::PlainOrder S; S.init(MROWS / 256, INC / 256, G, bx); S.K2 = D;
        EpiProj E{PROJ, lbf, lbb, (const float*)(ws + WS_CS + CS_HROW), (const float*)(ws + WS_CS + CS_WIN)};
        pg8::gemm_phase<EpiProj, pg8::PlainOrder, true>(lds, g, S, E);
    }
    SEAM(2);

    for (int rep_ = 0; rep_ < DUP3; ++rep_) { if (rep_) xcd_barrier(bar);
    if (IN(3)) {
        PH_BEGIN;
        for (int i = gtid; i < MROWS * 8; i += NGT) { const int jg = i & 3, kvh = (i >> 2) & 1, pos = i >> 3, j0 = 8 * jg;
            const bf16* kr = PROJ + PO_AKV + (size_t)pos * 256 + kvh * 64 + j0; const u32x4 a1 = *(const u32x4*)kr, a2 = *(const u32x4*)(kr + 32); u32x4 w1 = a1, w2 = a2;
            if (pos < NTOK) { const float* ct = (jg < 2) ? rope + (pos >> 6) * 16 + j0 : rope + 8192 + (pos & 63) * 16 + j0 - 16; const float* st = ct + ((jg < 2) ? 4096 : 1024);
                const f32x4 c0 = *(const f32x4*)ct, c1 = *(const f32x4*)(ct + 4), s0 = *(const f32x4*)st, s1 = *(const f32x4*)(st + 4);
#pragma unroll
                for (int q = 0; q < 4; ++q) { const float cl = q < 2 ? c0[2 * q] : c1[2 * q - 4], ch = q < 2 ? c0[2 * q + 1] : c1[2 * q - 3], sl = q < 2 ? s0[2 * q] : s1[2 * q - 4], sh = q < 2 ? s0[2 * q + 1] : s1[2 * q - 3];
                    const float k1l = bflo(a1[q]), k1h = bfhi(a1[q]), k2l = bflo(a2[q]), k2h = bfhi(a2[q]);
                    w1[q] = pk2(k1l * cl - k2l * sl, k1h * ch - k2h * sh); w2[q] = pk2(k2l * cl + k1l * sl, k2h * ch + k1h * sh); } }
            bf16* ko = KR + ((size_t)kvh * MROWS + pos) * 64 + j0; *(u32x4*)ko = w1; *(u32x4*)(ko + 32) = w2; }
        for (int i = gtid; i < 2 * (MROWS / 8) * 64; i += NGT) { const int dd = i & 63, pb = (i >> 6) % (MROWS / 8), kvh = (i >> 6) / (MROWS / 8);
            const bf16* vr = PROJ + PO_AKV + (size_t)(pb * 8) * 256 + 128 + kvh * 64 + dd; unsigned short t[8];
#pragma unroll
            for (int q = 0; q < 8; ++q) t[q] = vr[(size_t)q * 256];
            u32x4 w; w.x = t[0] | ((unsigned)t[1] << 16); w.y = t[2] | ((unsigned)t[3] << 16); w.z = t[4] | ((unsigned)t[5] << 16); w.w = t[6] | ((unsigned)t[7] << 16);
            *(u32x4*)(VTg + ((size_t)kvh * 64 + dd) * MROWS + pb * 8) = w; }
        for (int it = vcu; it < 8 * (NSEG - 1); it += G) { const int hh = it >> 5, seg = it & 31; scan_segment<false>(lds, PROJ, hh, seg, seg, Lbuf, Dlog, (bf16*)nullptr); }
    }
    }
    SEAM(3);

    if (IN(4)) {
        PH_BEGIN;
        for (int i = gtid; i < 16 * 16384; i += NGT) { const int scan = i >> 14, el = i & 16383, dd = el >> 7; float s = 0.f, lv[NSEG - 1], dv[NSEG - 1];
#pragma unroll
            for (int j = 0; j < NSEG - 1; ++j) { lv[j] = Lbuf[(size_t)(scan * NSEG + j) * 16384 + el]; dv[j] = Dlog[(scan * NSEG + j) * 128 + dd]; }
#pragma unroll
            for (int j = 0; j < NSEG - 1; ++j) { s = __expf(dv[j]) * s + lv[j]; Lbuf[(size_t)(scan * NSEG + j) * 16384 + el] = s; } }
        for (int rep_ = 0; rep_ < DUP4; ++rep_) for (int u = vcu; u < 256; u += G) attn_unit(lds, PROJ, KR, VTg, rope, A->sinks, YAB, u >> 7, u & 127);
    }
    SEAM(4);

    for (int rep_ = 0; rep_ < DUP5; ++rep_) { if (rep_) xcd_barrier(bar);
    if (IN(5)) {
        PH_BEGIN;
        for (int it = vcu; it < 8 * 32; it += G) { const int hh = it >> 5, segF = 1 + (it & 31);
            scan_segment<true>(lds, PROJ, hh, segF, NSEG - segF, Lbuf, Dlog, OSCR);
            VM_WAIT(); __syncthreads();
            { const int l16 = lane & 15, tq = lane >> 4; const f32x4 hg0 = *(const f32x4*)(A->hgrn_g + hh * 128 + 8 * l16), hg1 = *(const f32x4*)(A->hgrn_g + hh * 128 + 8 * l16 + 4);
              for (int i0 = wave * 64; i0 < wave * 64 + 64; i0 += 16) {
                u32x4 fw[4], bw[4], gq[4];
#pragma unroll
                for (int b = 0; b < 4; ++b) { const int row = (segF - 1) * 512 + i0 + 4 * b + tq;
                    fw[b] = *(const u32x4*)(OSCR + ((size_t)hh * NTOK + row) * 128 + 8 * l16); bw[b] = *(const u32x4*)(OSCR + ((size_t)(8 + hh) * NTOK + row) * 128 + 8 * l16);
                    gq[b] = *(const u32x4*)(PROJ + PO_BG + ((size_t)hh * MROWS + row) * 128 + 8 * l16); }
#pragma unroll
                for (int b = 0; b < 4; ++b) { const int row = (segF - 1) * 512 + i0 + 4 * b + tq;
                    f32x4 o0, o1; o0[0] = bflo(fw[b].x) + bflo(bw[b].x); o0[1] = bfhi(fw[b].x) + bfhi(bw[b].x); o0[2] = bflo(fw[b].y) + bflo(bw[b].y); o0[3] = bfhi(fw[b].y) + bfhi(bw[b].y);
                    o1[0] = bflo(fw[b].z) + bflo(bw[b].z); o1[1] = bfhi(fw[b].z) + bfhi(bw[b].z); o1[2] = bflo(fw[b].w) + bflo(bw[b].w); o1[3] = bfhi(fw[b].w) + bfhi(bw[b].w);
                    float ss = o0[0] * o0[0] + o0[1] * o0[1] + o0[2] * o0[2] + o0[3] * o0[3] + o1[0] * o1[0] + o1[1] * o1[1] + o1[2] * o1[2] + o1[3] * o1[3];
                    ss += __shfl_xor(ss, 1); ss += __shfl_xor(ss, 2); ss += __shfl_xor(ss, 4); ss += __shfl_xor(ss, 8);
                    const float rstd = rsqrtf(ss * (1.0f / 128.0f) + EPS);
                    u32x4 w; w.x = pk2(o0[0] * rstd * hg0[0] * bflo(gq[b].x), o0[1] * rstd * hg0[1] * bfhi(gq[b].x)); w.y = pk2(o0[2] * rstd * hg0[2] * bflo(gq[b].y), o0[3] * rstd * hg0[3] * bfhi(gq[b].y));
                    w.z = pk2(o1[0] * rstd * hg1[0] * bflo(gq[b].z), o1[1] * rstd * hg1[1] * bfhi(gq[b].z)); w.w = pk2(o1[2] * rstd * hg1[2] * bflo(gq[b].w), o1[3] * rstd * hg1[3] * bfhi(gq[b].w));
                    *(u32x4*)(YAB + (size_t)row * D + 1024 + hh * 128 + 8 * l16) = w; } } }
            __syncthreads();
        }
    }
    }
    SEAM(5);

    if (IN(6)) {
        PH_BEGIN;
        pg8::Gemm g{YAB, WM, D}; pg8::PlainOrder S; S.init(NTOK / 256, D / 256, G, bx); S.K2 = D * 2;
        EpiMerge E{MERGED, PROJ};
        pg8::gemm_phase<EpiMerge, pg8::PlainOrder>(lds, g, S, E);
    }
    SEAM(6);

    if (IN(7)) {
        PH_BEGIN;
        pg8::Gemm g{MERGED, WO, D}; pg8::PlainOrder S; S.init(NTOK / 256, D / 256, G, bx); S.K2 = D * 2;
        EpiOut E{X1, A->x, modl + 2 * 2048};
        pg8::gemm_phase<EpiOut, pg8::PlainOrder>(lds, g, S, E);
    }
    SEAM(7);

    if (IN(8)) {
        PH_BEGIN;
        LAS float* part = (LAS float*)lds;
        LAS float* rsd = (LAS float*)(lds + 16384);
        const int r16 = lane & 15, kk = lane >> 4;
        float bw[16][4][2];
#pragma unroll
        for (int kg = 0; kg < 16; ++kg)
#pragma unroll
            for (int m = 0; m < 4; ++m)
#pragma unroll
                for (int eh = 0; eh < 2; ++eh) bw[kg][m][eh] = wrp[(256 * wave + 16 * kg + 4 * kk + m) * 32 + 16 * eh + r16];
        for (int tl = vcu; tl < NTOK / 16; tl += G) {
            const int row0 = tl * 16;
#pragma unroll
            for (int q = 0; q < 2; ++q) { const int m = row0 + 2 * wave + q; const float* xr = X1 + (size_t)m * D + 4 * lane; f32x4 v[8]; float ss = 0.f;
#pragma unroll
                for (int j = 0; j < 8; ++j) { v[j] = *(const f32x4*)(xr + 256 * j); ss += v[j][0] * v[j][0] + v[j][1] * v[j][1] + v[j][2] * v[j][2] + v[j][3] * v[j][3]; }
                const float rstd = rsqrtf(wave_sum(ss) * (1.0f / D) + EPS);
                if (lane == 0) rsd[2 * wave + q] = rstd;
                float am = 0.f;
#pragma unroll
                for (int j = 0; j < 8; ++j) { const int k = 4 * lane + 256 * j; const f32x4 g = *(const f32x4*)(A->norm_ffn_g + k), s1 = *(const f32x4*)(modl + 4 * 2048 + k), s0 = *(const f32x4*)(modl + 3 * 2048 + k);
                    v[j] = v[j] * rstd * (g * (1.0f + s1)) + s0; am = fmaxf(am, fmaxf(fmaxf(fabsf(v[j][0]), fabsf(v[j][1])), fmaxf(fabsf(v[j][2]), fabsf(v[j][3])))); }
#pragma unroll
                for (int o = 1; o < 64; o <<= 1) am = fmaxf(am, __shfl_xor(am, o));
                if (am == 0.f) am = 1.f;
                const float qi = 127.0f / am;
                if (lane == 0) ((float*)(ws + WS_CS + CS_ROW))[m] = am * (1.0f / 127.0f);
                unsigned* hq = (unsigned*)((signed char*)(ws + WS_H) + (size_t)m * D + 4 * lane);
#pragma unroll
                for (int j = 0; j < 8; ++j) { const int q0 = (int)rintf(v[j][0] * qi), q1 = (int)rintf(v[j][1] * qi), q2 = (int)rintf(v[j][2] * qi), q3 = (int)rintf(v[j][3] * qi);
                    hq[64 * j] = ((unsigned)q0 & 0xffu) | (((unsigned)q1 & 0xffu) << 8) | (((unsigned)q2 & 0xffu) << 16) | (((unsigned)q3 & 0xffu) << 24); } }
            f32x4 acc0 = {0.f, 0.f, 0.f, 0.f}, acc1 = {0.f, 0.f, 0.f, 0.f};
            const float* xa = X1 + (size_t)(row0 + r16) * D + 256 * wave + 4 * kk;
#pragma unroll
            for (int kg = 0; kg < 16; ++kg) { const f32x4 av = *(const f32x4*)(xa + 16 * kg);
#pragma unroll
                for (int m = 0; m < 4; ++m) { acc0 = __builtin_amdgcn_mfma_f32_16x16x4f32(av[m], bw[kg][m][0], acc0, 0, 0, 0); acc1 = __builtin_amdgcn_mfma_f32_16x16x4f32(av[m], bw[kg][m][1], acc1, 0, 0, 0); } }
#pragma unroll
            for (int q = 0; q < 4; ++q) { part[(wave * 16 + 4 * kk + q) * 32 + r16] = acc0[q]; part[(wave * 16 + 4 * kk + q) * 32 + 16 + r16] = acc1[q]; }
            __syncthreads();
            { const int row = tid >> 5, e = tid & 31; float s = 0.f;
#pragma unroll
              for (int w = 0; w < 8; ++w) s += part[(w * 16 + row) * 32 + e];
              float val = rsd[row] * s + cvec[e];
              float tv[4]; int ti[4];
#pragma unroll
              for (int j = 0; j < 4; ++j) { float bv = val; int bi = e;
#pragma unroll
                  for (int off = 16; off >= 1; off >>= 1) { const float ov = __shfl_xor(bv, off); const int oi = __shfl_xor(bi, off); if (ov > bv || (ov == bv && oi < bi)) { bv = ov; bi = oi; } }
                  tv[j] = bv; ti[j] = bi; if (e == bi) val = -INFINITY; }
              const float e1 = __expf(tv[1] - tv[0]), e2 = __expf(tv[2] - tv[0]), e3 = __expf(tv[3] - tv[0]), inv = 1.0f / (1.0f + e1 + e2 + e3);
              const float gt[4] = {inv, e1 * inv, e2 * inv, e3 * inv};
#pragma unroll
              for (int j = 0; j < 4; ++j) if (e == ti[j]) { const int ai = (row0 + row) * 4 + j; const unsigned rk = atomicAdd(ctl + CW_CNT + 16 * e, 1u);
                  rt_e[ai] = e; rt_g[ai] = gt[j]; rt_r[ai] = (int)rk; } }
            __syncthreads();
        }
    }
    SEAM(8);

    if (IN(9)) {
        PH_BEGIN;
        LAS int* tb = (LAS int*)lds;
        if (tid == 0) { int acc = 0; for (int e = 0; e < NEXP; ++e) { tb[e] = acc; acc += (int)((ctl[CW_CNT + 16 * e] + 255u) >> 8); } tb[NEXP] = acc; }
        __syncthreads();
        for (int i = gtid; i < NTOK * 4; i += NGT) { const int e = rt_e[i], slot = tb[e] * 256 + rt_r[i]; rt_s[i] = slot; slot_rowoff[slot] = (unsigned)(i >> 2) * (unsigned)D; slot_gate[slot] = rt_g[i]; ((float*)(ws + WS_CS + CS_SLOT))[slot] = ((const float*)(ws + WS_CS + CS_ROW))[i >> 2]; }
        if (vcu == 0) {
            for (int e = 0; e < NEXP; ++e) { const int cnt = (int)ctl[CW_CNT + 16 * e], s0 = tb[e] * 256 + cnt, s1 = tb[e + 1] * 256;
                for (int s = s0 + tid; s < s1; s += 512) { slot_rowoff[s] = 0u; slot_gate[s] = 0.f; ((float*)(ws + WS_CS + CS_SLOT))[s] = 0.f; }
                for (int t = tb[e] + tid; t < tb[e + 1]; t += 512) tile_expert[t] = e; }
            if (tid == 0) *ntiles_p = tb[NEXP];
        }
        __syncthreads();
    }
    SEAM(9);

    if (IN(10)) {
        PH_BEGIN;
        const int ntiles = *ntiles_p;
        pg8::Gemm g{H, WGU, D / 2}; pg8::MoeOrder<true> S; S.init(ntiles, 4096 / 256, G, bx); S.K2 = D; S.nper = 4096; S.texp = tile_expert; S.sroff = slot_rowoff;
        EpiAct E{ACT, A->b_e_gate, A->b_e_up, (const float*)(ws + WS_CS), (const float*)(ws + WS_CS + CS_SLOT)};
        pg8::gemm_phase<EpiAct, pg8::MoeOrder<true>, true>(lds, g, S, E);
    }
    SEAM(10);

    if (IN(11)) {
        PH_BEGIN;
        const int ntiles = *ntiles_p;
        pg8::Gemm g{ACT, WDN, FF}; pg8::MoeOrder<false> S; S.init(ntiles, D / 256, G, bx); S.K2 = FF * 2; S.nper = D; S.texp = tile_expert; S.sroff = slot_rowoff;
        EpiDown E{YS, A->b_e_down, slot_gate};
        pg8::gemm_phase<EpiDown, pg8::MoeOrder<false>>(lds, g, S, E);
    }
    SEAM(11);

    if (IN(12)) {
        PH_BEGIN;
        f32x4 v[8], vn[8]; u32x2 yr[4][8], yn[4][8]; int sl[4];
#define P12_LOAD(VV, YY, M) do { const float* xr_ = X1 + (size_t)(M) * D + 4 * lane; \
            _Pragma("unroll") for (int j = 0; j < 8; ++j) VV[j] = *(const f32x4*)(xr_ + 256 * j); \
            _Pragma("unroll") for (int q = 0; q < 4; ++q) { const bf16* yp_ = YS + (size_t)sl[q] * D + 4 * lane; _Pragma("unroll") for (int j = 0; j < 8; ++j) YY[q][j] = *(const u32x2*)(yp_ + 256 * j); } } while (0)
#pragma unroll
        for (int q = 0; q < 4; ++q) sl[q] = rt_s[gw * 4 + q];
        P12_LOAD(v, yr, gw);
        if (gw + NGW < NTOK) {
#pragma unroll
            for (int q = 0; q < 4; ++q) sl[q] = rt_s[(gw + NGW) * 4 + q];
        }
        for (int m = gw; m < NTOK; m += NGW) {
            if (m + NGW < NTOK) { P12_LOAD(vn, yn, m + NGW);
                if (m + 2 * NGW < NTOK) {
#pragma unroll
                    for (int q = 0; q < 4; ++q) sl[q] = rt_s[(m + 2 * NGW) * 4 + q]; } }
            f32x4 y[8];
#pragma unroll
            for (int j = 0; j < 8; ++j) { y[j] = (f32x4){0.f, 0.f, 0.f, 0.f};
#pragma unroll
                for (int q = 0; q < 4; ++q) { const u32x2 w = yr[q][j]; y[j][0] += bflo(w.x); y[j][1] += bfhi(w.x); y[j][2] += bflo(w.y); y[j][3] += bfhi(w.y); } }
            float ss = 0.f;
#pragma unroll
            for (int j = 0; j < 8; ++j) { const f32x4 m5 = *(const f32x4*)(modl + 5 * 2048 + 4 * lane + 256 * j); v[j] = v[j] + m5 * y[j]; ss += v[j][0] * v[j][0] + v[j][1] * v[j][1] + v[j][2] * v[j][2] + v[j][3] * v[j][3]; }
            const float rstd = rsqrtf(wave_sum(ss) * (1.0f / D) + EPS);
            float* orow = A->out + (size_t)m * D + 4 * lane;
#pragma unroll
            for (int j = 0; j < 8; ++j) { const f32x4 fg = *(const f32x4*)(A->final_g + 4 * lane + 256 * j); *(f32x4*)(orow + 256 * j) = v[j] * rstd * fg; }
#pragma unroll
            for (int j = 0; j < 8; ++j) { v[j] = vn[j];
#pragma unroll
                for (int q = 0; q < 4; ++q) yr[q][j] = yn[q][j]; }
        }
#undef P12_LOAD
    }
#undef IN
#undef SEAM
}

#undef modl
#undef modc
#undef rope
#undef lbf
#undef lbb
#undef wrp
#undef cvec
#undef tile_expert
#undef ntiles_p
#undef rt_e
#undef rt_g
#undef rt_r
#undef rt_s
#undef slot_rowoff
#undef slot_gate
#undef Dlog
#undef KR
#undef VTg
#undef Lbuf
#undef WIN
#undef WM
#undef WO
#undef WGU
#undef WDN
#undef H
#undef PROJ
#undef ACT
#undef YAB
#undef OSCR
#undef MERGED
#undef X1
#undef YS
extern "C" void kernel_launch(void* const* d_in, const int* in_sizes, int n_in, void* d_out, int out_size, void* d_ws, size_t ws_size, hipStream_t stream) {
    static int grid = 0;
    if (grid == 0) {
        if (n_in != 24 || out_size != NTOK * D || ws_size < WS_END) { fprintf(stderr, "kernel_launch: unexpected shapes (n_in %d out %d ws %zu)\n", n_in, out_size, ws_size); grid = -1; return; }
        int dev = 0, cus = 0, per_cu = 0;
        if (hipGetDevice(&dev) != hipSuccess || hipDeviceGetAttribute(&cus, hipDeviceAttributeMultiprocessorCount, dev) != hipSuccess) { grid = -1; return; }
        if (hipFuncSetAttribute((const void*)fwd_kernel, hipFuncAttributeMaxDynamicSharedMemorySize, LDS_BYTES) != hipSuccess) { fprintf(stderr, "kernel_launch: hipFuncSetAttribute failed\n"); grid = -1; return; }
        if (hipOccupancyMaxActiveBlocksPerMultiprocessor(&per_cu, (const void*)fwd_kernel, NWAVES * 64, LDS_BYTES) != hipSuccess || per_cu < 1) { fprintf(stderr, "kernel_launch: occupancy query says %d\n", per_cu); (void)hipGetLastError(); grid = -1; return; }
        grid = cus;
    }
    if (grid < 0) return;
    if (hipMemsetAsync((char*)d_ws + WS_CTL, 0, CTL_ZERO_BYTES, stream) != hipSuccess) return;
    Args a{};
    const float** p = (const float**)&a;
    for (int i = 0; i < 24; ++i) p[i] = (const float*)d_in[i];
    a.out = (float*)d_out; a.ws = (unsigned char*)d_ws; a.ph_lo = 0; a.ph_hi = 13;
    hipLaunchKernelGGL(fwd_kernel, dim3(grid), dim3(NWAVES * 64), LDS_BYTES, stream, a);
    const hipError_t le = hipPeekAtLastError();
    if (le != hipSuccess) fprintf(stderr, "kernel_launch: launch failed: %s\n", hipGetErrorName(le));
}
```

```cpp
#include <hip/hip_runtime.h>
#include <cstdio>
#include <cstdint>

#define DI __device__ __forceinline__
#define LAS __attribute__((address_space(3)))
typedef unsigned short bf16;
typedef short bf16x8 __attribute__((ext_vector_type(8)));
typedef float f32x2 __attribute__((ext_vector_type(2)));
typedef float f32x4 __attribute__((ext_vector_type(4)));
typedef float f32x16 __attribute__((ext_vector_type(16)));
typedef unsigned u32x2 __attribute__((ext_vector_type(2)));
typedef unsigned u32x4 __attribute__((ext_vector_type(4)));
typedef __bf16 bf16x2_t __attribute__((ext_vector_type(2)));
typedef int i32x4 __attribute__((ext_vector_type(4)));

DI unsigned pk2(float lo, float hi) { f32x2 v = {lo, hi}; bf16x2_t b = __builtin_convertvector(v, bf16x2_t); return __builtin_bit_cast(unsigned, b); }
DI float bf2f(unsigned short b) { return __uint_as_float(((unsigned)b) << 16); }
DI float bflo(unsigned w) { return __uint_as_float(w << 16); }
DI float bfhi(unsigned w) { return __uint_as_float(w & 0xffff0000u); }
DI unsigned short f2bf(float f) { return (unsigned short)(pk2(f, 0.f) & 0xffffu); }
DI float wave_sum(float v) {
#pragma unroll
    for (int o = 1; o < 64; o <<= 1) v += __shfl_xor(v, o);
    return v;
}
DI float sigmoidf_(float x) { return 1.0f / (1.0f + __expf(-x)); }
#define LDS_WAIT() asm volatile("s_waitcnt lgkmcnt(0)" ::: "memory")
#define VM_WAIT() asm volatile("s_waitcnt vmcnt(0)" ::: "memory")

constexpr int D = 2048, NTOK = 16384, NCTX = 256, MROWS = NTOK + NCTX;
constexpr int INC = 10496;
constexpr int C_AQ = 0, C_AK = 1024, C_AV = 1152, C_BQ = 1280, C_ZF = 2304, C_ZB = 3328, C_BV = 4352, C_BG = 5376, C_GA = 6400, C_GB = 8448;
constexpr int NEXP = 32, FF = 2048;
constexpr int MAXTILES = 288, MAXSLOTS = MAXTILES * 256;
constexpr float EPS = 1e-6f;
constexpr int NSEG = 33;
constexpr int NWAVES = 8;
#ifndef DUP0
#define DUP0 1
#endif
#ifndef DUP3
#define DUP3 1
#endif
#ifndef DUP4
#define DUP4 1
#endif
#ifndef DUP5
#define DUP5 1
#endif
#ifndef DUP1
#define DUP1 1
#endif
#ifndef DUP12
#define DUP12 1
#endif

constexpr size_t MiB = 1u << 20;
constexpr size_t WS_CTL = 0, CTL_ZERO_BYTES = 1 * MiB;
constexpr size_t WS_SMALL = 1 * MiB;
constexpr size_t SM_MODL = 0, SM_MODC = 49152, SM_ROPE = 65536, SM_LB = 131072, SM_WRP = 262144, SM_CVEC = 524288, SM_TILE = 528384;
constexpr size_t WS_ROUTE = 2 * MiB;
constexpr size_t RT_E = 0, RT_G = 262144, RT_R = 524288, RT_S = 786432, RT_OFF = 1048576, RT_SG = 1048576 + 294912, RT_ARS = 1048576 + 2 * 294912;
static_assert(RT_ARS + (size_t)MAXSLOTS * 4 <= 2 * MiB, "route region");
constexpr size_t DL_CSD = 524288;
constexpr size_t WS_ACT8 = 1276 * MiB;
constexpr size_t WS_DLOG = 4 * MiB;
constexpr size_t WS_KR = 5 * MiB, WS_VT = 10 * MiB;
constexpr size_t WS_CS = 15 * MiB;
constexpr size_t CS_ROW = 524288, CS_SLOT = 524288 + 65536, CS_WIN = 917504, CS_HROW = 966656;
static_assert(CS_SLOT + (size_t)MAXSLOTS * 4 <= CS_WIN && CS_WIN + (size_t)INC * 4 <= CS_HROW && CS_HROW + (size_t)MROWS * 4 <= MiB, "scale arrays");
constexpr size_t WS_L = 16 * MiB;
constexpr size_t WS_WIN = 50 * MiB, WS_WM = 92 * MiB, WS_WO = 100 * MiB, WS_WGU = 108 * MiB, WS_WDN = 620 * MiB;
constexpr size_t WS_H = 876 * MiB, WS_PROJ = 942 * MiB, WS_ACT = WS_PROJ, WS_YAB = 1276 * MiB, WS_OSCR = 1340 * MiB, WS_MERGED = 1468 * MiB, WS_X1 = 1532 * MiB, WS_YS = 1660 * MiB, WS_END = 1948 * MiB;
constexpr size_t PO_AQ = 0, PO_AKV = PO_AQ + (size_t)16 * MROWS * 64, PO_BQ = PO_AKV + (size_t)MROWS * 256, PO_ZF = PO_BQ + (size_t)8 * MROWS * 128, PO_ZB = PO_ZF + (size_t)8 * MROWS * 128,
                 PO_BV = PO_ZB + (size_t)8 * MROWS * 128, PO_BG = PO_BV + (size_t)8 * MROWS * 128, PO_GA = PO_BG + (size_t)8 * MROWS * 128, PO_GB = PO_GA + (size_t)MROWS * 2048, PO_END = PO_GB + (size_t)MROWS * 2048;
static_assert(PO_END == (size_t)MROWS * INC, "projection layout");
static_assert(WS_L + (size_t)16 * NSEG * 65536 <= WS_WIN, "L");
static_assert(WS_PROJ + (size_t)MROWS * INC * 2 <= WS_YAB && WS_ACT + (size_t)MAXSLOTS * FF * 2 <= WS_YAB, "proj/act");
static_assert(WS_H + (size_t)MROWS * D * 2 <= WS_PROJ, "h");
constexpr int CW_BAR = 4096, CW_CNT = 8192, CW_Q = 9216;

constexpr int LDS_BYTES = 163840;
constexpr int MISC_OFF = 163840 - 256;

namespace pg8 {
constexpr int BM = 256, BK = 64, HALF = 128, HTB = HALF * BK * 2, STAGE_BYTES = 8 * HTB, NXCD = 8, WGM = 8;
__host__ __device__ __forceinline__ int lds_byte(int r, int c) { const int st = (r >> 4) * 2 + (c >> 5), rr = r & 15, cc = c & 31, ob = rr * 64 + cc * 2; return st * 1024 + (ob ^ (((ob >> 9) & 1) << 5)); }
__host__ __device__ __forceinline__ void stage_rc(int b, int& R, int& C) { const int st = b / 1024, sb = b % 1024, swz = sb ^ (((sb >> 9) & 1) << 5); R = (st >> 1) * 16 + swz / 64; C = (st & 1) * 32 + (swz % 64) / 2; }
__host__ __device__ __forceinline__ int perm32(int rho) { const int n = rho >> 4, i = rho & 15; return 8 * (i >> 2) + 4 * n + (i & 3); }

struct Unit { int pm, pn, e, brow; };
struct Gemm { const bf16* A; const bf16* Bt; int K; };

struct OrderBase {
    int nM, nN, nwg, G, c;
    DI void init(int nM_, int nN_, int G_, int c_) { nM = nM_; nN = nN_; nwg = nM * nN; G = G_; c = c_; }
    DI bool tile(int i, int& pm, int& pn) const {
        const long L = (long)i * G + c; if (L >= nwg) return false;
        int wgid = (int)L; { const int q = nwg / NXCD, r = nwg % NXCD, xcd = wgid % NXCD, off = wgid / NXCD; wgid = (xcd < r ? xcd * (q + 1) : r * (q + 1) + (xcd - r) * q) + off; }
        const int nig = WGM * nN, gid = wgid / nig, fm = gid * WGM, gsz = (nM - fm) < WGM ? (nM - fm) : WGM;
        pm = fm + ((wgid % nig) % gsz); pn = (wgid % nig) / gsz; return true;
    }
};
struct PlainOrder : OrderBase {
    int K2;
    DI bool next(int i, Unit& u) const { if (!tile(i, u.pm, u.pn)) return false; u.e = 0; u.brow = u.pn * BM; return true; }
    DI unsigned rowoff(const Unit& u, int r) const { return (unsigned)(u.pm * BM + r) * (unsigned)K2; }
};
template <bool GATHER> struct MoeOrder : OrderBase {
    int K2, nper;
    const int* texp; const unsigned* sroff;
    DI bool next(int i, Unit& u) const { if (!tile(i, u.pm, u.pn)) return false; u.e = texp[u.pm]; u.brow = u.e * nper + u.pn * BM; return true; }
    DI unsigned rowoff(const Unit& u, int r) const { if (GATHER) return sroff[u.pm * BM + r]; else return (unsigned)(u.pm * BM + r) * (unsigned)K2; }
};

template <class Epi, class Sched, bool I8 = false, bool ALIGN_EPI = true, bool SP2 = true>
__device__ __forceinline__ void gemm_phase(LAS unsigned char* lds, const Gemm g, const Sched& S, const Epi& E) {
    const int tid = threadIdx.x, wid = __builtin_amdgcn_readfirstlane(tid >> 6), lane = tid & 63, wr = wid >> 2, wc = wid & 3, fr = lane & 15, fq = lane >> 4;
    const int K = g.K, nt = K / BK;
    int stR[2]; unsigned stC2[2], voffB[2];
#pragma unroll
    for (int i = 0; i < 2; ++i) { int R, C; stage_rc(tid * 16 + i * 8192, R, C); const int Rb = Epi::PERM ? ((R & ~31) + perm32(R & 31)) : R;
        stR[i] = R; stC2[i] = (unsigned)C * 2u; voffB[i] = (unsigned)(Rb * K + C) * 2u; }
    const size_t kstep = (size_t)(BK * 2);
    const size_t hstep = (size_t)HALF * K * 2;
    const unsigned ldsw = (unsigned)wid * 1024u;
    const int aoffL = lds_byte(wr * 64 + fr, fq * 8), boffL = lds_byte(wc * 32 + fr, fq * 8);
#define PG8_SA(b, h) (((b) * 2 + (h)) * HTB)
#define PG8_SB(b, h) ((4 + (b) * 2 + (h)) * HTB)
#define PG8_STAGE(bufoff, gbase, voff) do { _Pragma("unroll") for (int _i = 0; _i < 2; ++_i) \
        __builtin_amdgcn_global_load_lds((const unsigned*)((const char*)(gbase) + (voff)[_i]), (LAS unsigned*)(lds + (bufoff) + ldsw + _i * 8192), 16, 0, 0); } while (0)
#define PG8_LDA(dst, b, h) do { _Pragma("unroll") for (int m = 0; m < 4; ++m) _Pragma("unroll") for (int k = 0; k < 2; ++k) dst[m][k] = *(const LAS bf16x8*)(lds + PG8_SA(b, h) + aoffL + m * 2048 + k * 1024); } while (0)
#define PG8_LDB(dst, b, h) do { _Pragma("unroll") for (int n = 0; n < 2; ++n) _Pragma("unroll") for (int k = 0; k < 2; ++k) dst[n][k] = *(const LAS bf16x8*)(lds + PG8_SB(b, h) + boffL + n * 2048 + k * 1024); } while (0)
#define PG8_MMA(ai, bj, At, Bt) do { __builtin_amdgcn_s_setprio(1); _Pragma("unroll") for (int m = 0; m < 4; ++m) _Pragma("unroll") for (int n = 0; n < 2; ++n) _Pragma("unroll") for (int k = 0; k < 2; ++k) \
        { if constexpr (I8) acc[ai][bj][m][n] = __builtin_bit_cast(f32x4, __builtin_amdgcn_mfma_i32_16x16x64_i8(__builtin_bit_cast(i32x4, Bt[n][k]), __builtin_bit_cast(i32x4, At[m][k]), __builtin_bit_cast(i32x4, acc[ai][bj][m][n]), 0, 0, 0)); \
          else acc[ai][bj][m][n] = __builtin_amdgcn_mfma_f32_16x16x32_bf16(Bt[n][k], At[m][k], acc[ai][bj][m][n], 0, 0, 0); } __builtin_amdgcn_s_setprio(0); } while (0)
#define PG8_WAIT_V(n) asm volatile("s_waitcnt vmcnt(" #n ")" ::: "memory")
#define PG8_WAIT_L(n) asm volatile("s_waitcnt lgkmcnt(" #n ")" ::: "memory")
#define PG8_BAR __builtin_amdgcn_s_barrier()
#define PG8_SCHED __builtin_amdgcn_sched_barrier(0)
    Unit cur, nxt; int ui = 0;
    if (!S.next(0, cur)) return;
    f32x4 acc[2][2][4][2];
#pragma unroll
    for (int a = 0; a < 2; ++a)
#pragma unroll
        for (int b = 0; b < 2; ++b)
#pragma unroll
            for (int m = 0; m < 4; ++m)
#pragma unroll
                for (int n = 0; n < 2; ++n) acc[a][b][m][n] = (f32x4){0.f, 0.f, 0.f, 0.f};
    bf16x8 At[4][2], B0[2][2], B1[2][2];
    unsigned ao0[2], ao1[2], no0[2], no1[2];
#pragma unroll
    for (int i = 0; i < 2; ++i) { ao0[i] = S.rowoff(cur, stR[i]) + stC2[i]; ao1[i] = S.rowoff(cur, HALF + stR[i]) + stC2[i]; no0[i] = ao0[i]; no1[i] = ao1[i]; }
    const char* Ab = (const char*)g.A;
    const char* cB = (const char*)g.Bt + (size_t)cur.brow * K * 2;
    if constexpr (SP2) {
        PG8_STAGE(PG8_SB(0, 0), cB, voffB); PG8_STAGE(PG8_SB(0, 1), cB + hstep, voffB); PG8_STAGE(PG8_SA(0, 0), Ab, ao0); PG8_STAGE(PG8_SA(0, 1), Ab, ao1);
        if (wr == 1) PG8_BAR;
        PG8_WAIT_V(2); PG8_BAR;
        PG8_STAGE(PG8_SB(1, 0), cB + kstep, voffB); PG8_STAGE(PG8_SA(1, 0), Ab + kstep, ao0); PG8_STAGE(PG8_SB(1, 1), cB + hstep + kstep, voffB);
        PG8_WAIT_V(6); PG8_BAR;
    } else {
        PG8_STAGE(PG8_SB(0, 0), cB, voffB); PG8_STAGE(PG8_SA(0, 0), Ab, ao0); PG8_STAGE(PG8_SB(0, 1), cB + hstep, voffB); PG8_STAGE(PG8_SA(0, 1), Ab, ao1);
        if (wr == 1) PG8_BAR;
        PG8_WAIT_V(4); PG8_BAR;
        PG8_STAGE(PG8_SB(1, 0), cB + kstep, voffB); PG8_STAGE(PG8_SA(1, 0), Ab + kstep, ao0); PG8_STAGE(PG8_SB(1, 1), cB + hstep + kstep, voffB);
        PG8_WAIT_V(6); PG8_BAR;
    }
    for (;;) {
        const bool has_next = S.next(ui + 1, nxt);
        if (has_next) {
#pragma unroll
            for (int i = 0; i < 2; ++i) { no0[i] = S.rowoff(nxt, stR[i]) + stC2[i]; no1[i] = S.rowoff(nxt, HALF + stR[i]) + stC2[i]; }
        }
        const char* nB = has_next ? (const char*)g.Bt + (size_t)nxt.brow * K * 2 : cB;
        for (int t = 0; t < nt; t += 2) {
            const bool last = (t == nt - 2);
            if constexpr (Epi::HOOK) { if (t == nt / 2) E.hook(acc, cur, wr, wc, fr, fq); }
            const char* a1 = Ab + (size_t)(t + 1) * kstep;
            const char* a2 = last ? Ab : Ab + (size_t)(t + 2) * kstep; const char* b2 = last ? nB : cB + (size_t)(t + 2) * kstep;
            const char* a3 = a2 + kstep; const char* b3 = b2 + kstep;
            unsigned x0[2], x1[2];
#pragma unroll
            for (int i = 0; i < 2; ++i) { x0[i] = last ? no0[i] : ao0[i]; x1[i] = last ? no1[i] : ao1[i]; }
            if constexpr (SP2) {
            PG8_LDB(B0, 0, 0); PG8_LDB(B1, 0, 1); PG8_SCHED; PG8_LDA(At, 0, 0); PG8_STAGE(PG8_SA(1, 1), a1, ao1);
            PG8_WAIT_V(8); PG8_WAIT_L(0); PG8_BAR; PG8_MMA(0, 0, At, B0); PG8_MMA(0, 1, At, B1); PG8_BAR; PG8_SCHED;
            PG8_LDA(At, 0, 1); PG8_STAGE(PG8_SB(0, 0), b2, voffB); PG8_STAGE(PG8_SB(0, 1), b2 + hstep, voffB); PG8_STAGE(PG8_SA(0, 0), a2, x0);
            PG8_WAIT_V(8); PG8_WAIT_L(0); PG8_BAR; PG8_MMA(1, 0, At, B0); PG8_MMA(1, 1, At, B1); PG8_BAR; PG8_SCHED;
            PG8_LDB(B0, 1, 0); PG8_LDB(B1, 1, 1); PG8_SCHED; PG8_LDA(At, 1, 0); PG8_STAGE(PG8_SA(0, 1), a2, x1);
            PG8_WAIT_V(8); PG8_WAIT_L(0); PG8_BAR; PG8_MMA(0, 0, At, B0); PG8_MMA(0, 1, At, B1); PG8_BAR; PG8_SCHED;
            PG8_LDA(At, 1, 1); PG8_STAGE(PG8_SB(1, 0), b3, voffB); PG8_STAGE(PG8_SB(1, 1), b3 + hstep, voffB); PG8_STAGE(PG8_SA(1, 0), a3, x0);
            PG8_WAIT_V(8); PG8_WAIT_L(0); PG8_BAR; PG8_MMA(1, 0, At, B0); PG8_MMA(1, 1, At, B1); PG8_BAR; PG8_SCHED;
            } else {
            PG8_LDB(B0, 0, 0); PG8_SCHED; PG8_LDA(At, 0, 0); PG8_STAGE(PG8_SA(1, 1), a1, ao1);
            PG8_WAIT_L(8); PG8_BAR; PG8_WAIT_L(0); PG8_MMA(0, 0, At, B0); PG8_BAR; PG8_SCHED;
            PG8_LDB(B1, 0, 1); PG8_STAGE(PG8_SB(0, 0), b2, voffB);
            PG8_BAR; PG8_WAIT_L(0); PG8_MMA(0, 1, At, B1); PG8_BAR;
            PG8_LDA(At, 0, 1); PG8_STAGE(PG8_SA(0, 0), a2, x0);
            PG8_BAR; PG8_WAIT_L(0); PG8_MMA(1, 0, At, B0); PG8_BAR; PG8_SCHED;
            PG8_STAGE(PG8_SB(0, 1), b2 + hstep, voffB);
            PG8_WAIT_V(6); PG8_BAR; PG8_MMA(1, 1, At, B1); PG8_BAR;
            PG8_LDB(B0, 1, 0); PG8_SCHED; PG8_LDA(At, 1, 0); PG8_STAGE(PG8_SA(0, 1), a2, x1);
            PG8_WAIT_L(8); PG8_BAR; PG8_WAIT_L(0); PG8_MMA(0, 0, At, B0); PG8_BAR; PG8_SCHED;
            PG8_LDB(B1, 1, 1); PG8_STAGE(PG8_SB(1, 0), b3, voffB);
            PG8_BAR; PG8_WAIT_L(0); PG8_MMA(0, 1, At, B1); PG8_BAR;
            PG8_LDA(At, 1, 1); PG8_STAGE(PG8_SA(1, 0), a3, x0);
            PG8_BAR; PG8_WAIT_L(0); PG8_MMA(1, 0, At, B0); PG8_BAR; PG8_SCHED;
            PG8_STAGE(PG8_SB(1, 1), b3 + hstep, voffB);
            PG8_WAIT_V(6); PG8_BAR; PG8_MMA(1, 1, At, B1); PG8_BAR;
            }
        }
        if constexpr (ALIGN_EPI) { if (wr == 0) PG8_BAR; }
        E(acc, cur, wr, wc, fr, fq);
        if (!has_next) break;
#pragma unroll
        for (int a = 0; a < 2; ++a)
#pragma unroll
            for (int b = 0; b < 2; ++b)
#pragma unroll
                for (int m = 0; m < 4; ++m)
#pragma unroll
                    for (int n = 0; n < 2; ++n) acc[a][b][m][n] = (f32x4){0.f, 0.f, 0.f, 0.f};
        cur = nxt; cB = nB; ++ui;
#pragma unroll
        for (int i = 0; i < 2; ++i) { ao0[i] = no0[i]; ao1[i] = no1[i]; }
        if constexpr (ALIGN_EPI) { if (wr == 1) PG8_BAR; }
    }
    PG8_WAIT_V(0);
    if constexpr (!ALIGN_EPI) { if (wr == 0) PG8_BAR; }
    PG8_BAR;
#undef PG8_SA
#undef PG8_SB
#undef PG8_STAGE
#undef PG8_LDA
#undef PG8_LDB
#undef PG8_MMA
#undef PG8_WAIT_V
#undef PG8_WAIT_L
#undef PG8_BAR
#undef PG8_SCHED
}
}

using pg8::Unit; using pg8::HALF; using pg8::BM;
struct EpiProj {
    static constexpr bool PERM = true, HOOK = false;
    bf16* P; const float* lbf; const float* lbb; const float* hrs; const float* wcs;
    DI void hook(f32x4 (&)[2][2][4][2], const Unit&, int, int, int, int) const {}
    DI void operator()(const f32x4 (&acc)[2][2][4][2], const Unit& u, int wr, int wc, int fr, int fq) const {
        const int pn = u.pn; int cls, cbase, hs, pitch; size_t po; const float* lb = lbf;
        if (pn < 4)       { cls = 0; cbase = C_AQ; po = PO_AQ;  hs = 6;  pitch = 64; }
        else if (pn < 5)  { cls = 0; cbase = C_AK; po = PO_AKV; hs = 30; pitch = 256; }
        else if (pn < 9)  { cls = 1; cbase = C_BQ; po = PO_BQ;  hs = 7;  pitch = 128; }
        else if (pn < 13) { cls = 2; cbase = C_ZF; po = PO_ZF;  hs = 7;  pitch = 128; }
        else if (pn < 17) { cls = 2; cbase = C_ZB; po = PO_ZB;  hs = 7;  pitch = 128; lb = lbb; }
        else if (pn < 21) { cls = 0; cbase = C_BV; po = PO_BV;  hs = 7;  pitch = 128; }
        else if (pn < 25) { cls = 1; cbase = C_BG; po = PO_BG;  hs = 7;  pitch = 128; }
        else if (pn < 33) { cls = 3; cbase = C_GA; po = PO_GA;  hs = 30; pitch = 2048; }
        else              { cls = 3; cbase = C_GB; po = PO_GB;  hs = 30; pitch = 2048; }
        int zz = 0; asm volatile("" : "+v"(zz));
        const int row0 = u.pm * BM + wr * 64 + fr + zz, cin0 = u.pn * BM + wc * 32 + 8 * fq - cbase;
        bf16* base = P + po;
#pragma unroll
        for (int bj = 0; bj < 2; ++bj) {
            float lbv[8];
            const int cin = cin0 + bj * HALF;
            { const int ci = (cls == 2) ? cin : 0; const f32x4 a = *(const f32x4*)(lb + ci), b = *(const f32x4*)(lb + ci + 4);
#pragma unroll
              for (int j = 0; j < 4; ++j) { lbv[j] = (cls == 2) ? a[j] : 0.f; lbv[4 + j] = (cls == 2) ? b[j] : 0.f; } }
            bf16* colp = base + (size_t)(cin >> hs) * MROWS * pitch + (cin & ((1 << hs) - 1));
            float csv[8];
            { const f32x4 a = *(const f32x4*)(wcs + cin + cbase), b = *(const f32x4*)(wcs + cin + cbase + 4);
#pragma unroll
              for (int j = 0; j < 4; ++j) { csv[j] = a[j]; csv[4 + j] = b[j]; } }
#pragma unroll
            for (int ai = 0; ai < 2; ++ai)
#pragma unroll
                for (int m = 0; m < 4; ++m) { const int rr = row0 + ai * HALF + m * 16; const size_t ro = (size_t)rr * pitch; float v[8]; const float rs = hrs[rr];
#pragma unroll
                    for (int j = 0; j < 8; ++j) v[j] = (float)__builtin_bit_cast(i32x4, acc[ai][bj][m][j >> 2])[j & 3] * (rs * csv[j]);
                    if (cls != 0) {
#pragma unroll
                        for (int j = 0; j < 8; ++j) { const float sg = sigmoidf_(v[j]); v[j] = (cls == 1) ? v[j] * sg : sg; }
                        if (cls == 2) {
#pragma unroll
                            for (int j = 0; j < 8; ++j) { const float l = lbv[j]; v[j] = __logf(l + (1.0f - l) * v[j]); } }
                    }
                    u32x4 w; w.x = pk2(v[0], v[1]); w.y = pk2(v[2], v[3]); w.z = pk2(v[4], v[5]); w.w = pk2(v[6], v[7]);
                    *(u32x4*)(colp + ro) = w; }
        }
    }
};
struct EpiMerge {
    static constexpr bool PERM = true, HOOK = true;
    bf16* O; const bf16* proj;
    DI void hook(f32x4 (&acc)[2][2][4][2], const Unit& u, int wr, int wc, int fr, int fq) const {
        int zz = 0; asm volatile("" : "+v"(zz));
        const int row0 = u.pm * BM + wr * 64 + fr + zz, col0 = u.pn * BM + wc * 32 + 8 * fq;
#pragma unroll
        for (int ai = 0; ai < 2; ++ai)
#pragma unroll
            for (int m = 0; m < 4; ++m) { const size_t rowp = (size_t)(row0 + ai * HALF + m * 16) * D + col0;
#pragma unroll
                for (int bj = 0; bj < 2; ++bj) { const u32x4 ga = *(const u32x4*)(proj + PO_GA + rowp + bj * HALF), gb = *(const u32x4*)(proj + PO_GB + rowp + bj * HALF);
#pragma unroll
                    for (int q = 0; q < 4; ++q) { const float r0 = bflo(ga[q]) * __builtin_amdgcn_rcpf(bflo(gb[q])), r1 = bfhi(ga[q]) * __builtin_amdgcn_rcpf(bfhi(gb[q]));
                        acc[ai][bj][m][q >> 1][(q & 1) * 2] *= r0; acc[ai][bj][m][q >> 1][(q & 1) * 2 + 1] *= r1; } }
                asm volatile("" ::: "memory"); }
    }
    DI void operator()(const f32x4 (&acc)[2][2][4][2], const Unit& u, int wr, int wc, int fr, int fq) const {
        const int row0 = u.pm * BM + wr * 64 + fr, col0 = u.pn * BM + wc * 32 + 8 * fq;
#pragma unroll
        for (int ai = 0; ai < 2; ++ai)
#pragma unroll
            for (int m = 0; m < 4; ++m) { const size_t r = (size_t)(row0 + ai * HALF + m * 16);
#pragma unroll
                for (int bj = 0; bj < 2; ++bj) { const u32x4 gb = *(const u32x4*)(proj + PO_GB + r * D + col0 + bj * HALF); u32x4 w;
#pragma unroll
                    for (int q = 0; q < 4; ++q) w[q] = pk2(acc[ai][bj][m][q >> 1][(q & 1) * 2] * bflo(gb[q]), acc[ai][bj][m][q >> 1][(q & 1) * 2 + 1] * bfhi(gb[q]));
                    *(u32x4*)(O + r * D + col0 + bj * HALF) = w; } }
    }
};
struct EpiOut {
    static constexpr bool PERM = false, HOOK = false;
    float* X1; const float* x; const float* mod2;
    DI void hook(f32x4 (&)[2][2][4][2], const Unit&, int, int, int, int) const {}
    DI void operator()(const f32x4 (&acc)[2][2][4][2], const Unit& u, int wr, int wc, int fr, int fq) const {
        const int row0 = u.pm * BM + wr * 64 + fr, col0 = u.pn * BM + wc * 32 + 4 * fq;
        f32x4 mv[2][2];
#pragma unroll
        for (int bj = 0; bj < 2; ++bj)
#pragma unroll
            for (int n = 0; n < 2; ++n) mv[bj][n] = *(const f32x4*)(mod2 + col0 + bj * HALF + n * 16);
#pragma unroll
        for (int ai = 0; ai < 2; ++ai)
#pragma unroll
            for (int m = 0; m < 4; ++m) { const size_t off = (size_t)(row0 + ai * HALF + m * 16) * D + col0;
#pragma unroll
                for (int bj = 0; bj < 2; ++bj)
#pragma unroll
                    for (int n = 0; n < 2; ++n) { const f32x4 xv = *(const f32x4*)(x + off + bj * HALF + n * 16);
                        *(f32x4*)(X1 + off + bj * HALF + n * 16) = xv + mv[bj][n] * acc[ai][bj][m][n]; } }
    }
};
struct EpiAct {
    static constexpr bool PERM = true, HOOK = false;
    bf16* ACTp; const float* bg; const float* bu; const float* cs; const float* srs;
    DI void hook(f32x4 (&)[2][2][4][2], const Unit&, int, int, int, int) const {}
    DI void operator()(const f32x4 (&acc)[2][2][4][2], const Unit& u, int wr, int wc, int fr, int fq) const {
        int zz = 0; asm volatile("" : "+v"(zz));
        const int row0 = u.pm * BM + wr * 64 + fr + zz, col0 = u.pn * HALF + wc * 32 + 8 * fq, nb = u.e * 4096 + u.pn * BM + wc * 32 + 8 * fq;
        float gbv[8], ubv[8], gsc[8], usc[8];
        { const f32x4 a = *(const f32x4*)(bg + u.e * FF + col0), b = *(const f32x4*)(bg + u.e * FF + col0 + 4), c = *(const f32x4*)(bu + u.e * FF + col0), d = *(const f32x4*)(bu + u.e * FF + col0 + 4);
          const f32x4 sa = *(const f32x4*)(cs + nb), sb = *(const f32x4*)(cs + nb + 4), sc = *(const f32x4*)(cs + nb + HALF), sd = *(const f32x4*)(cs + nb + HALF + 4);
#pragma unroll
          for (int j = 0; j < 4; ++j) { gbv[j] = a[j]; gbv[4 + j] = b[j]; ubv[j] = c[j]; ubv[4 + j] = d[j]; gsc[j] = sa[j]; gsc[4 + j] = sb[j]; usc[j] = sc[j]; usc[4 + j] = sd[j]; } }
#pragma unroll
        for (int ai = 0; ai < 2; ++ai)
#pragma unroll
            for (int m = 0; m < 4; ++m) { float v[8]; const int r = row0 + ai * HALF + m * 16; const float rs = srs[r];
#pragma unroll
                for (int j = 0; j < 8; ++j) { const i32x4 ga = __builtin_bit_cast(i32x4, acc[ai][0][m][j >> 2]), ua = __builtin_bit_cast(i32x4, acc[ai][1][m][j >> 2]);
                    float gg = (float)ga[j & 3] * (rs * gsc[j]) + gbv[j], uu = (float)ua[j & 3] * (rs * usc[j]) + ubv[j];
                    gg = fminf(gg, 7.0f); uu = fminf(fmaxf(uu, -7.0f), 7.0f);
                    v[j] = gg * sigmoidf_(1.702f * gg) * (uu + 1.0f); }
                u32x4 w; w.x = pk2(v[0], v[1]); w.y = pk2(v[2], v[3]); w.z = pk2(v[4], v[5]); w.w = pk2(v[6], v[7]);
                *(u32x4*)(ACTp + (size_t)r * FF + col0) = w; }
    }
};
struct EpiDown {
    static constexpr bool PERM = true, HOOK = false;
    bf16* YSp; const float* bd; const float* sgate; const float* ars; const float* csd;
    DI void hook(f32x4 (&)[2][2][4][2], const Unit&, int, int, int, int) const {}
    DI void operator()(const f32x4 (&acc)[2][2][4][2], const Unit& u, int wr, int wc, int fr, int fq) const {
        int zz = 0; asm volatile("" : "+v"(zz));
        const int row0 = u.pm * BM + wr * 64 + fr + zz, col0 = u.pn * BM + wc * 32 + 8 * fq;
#pragma unroll
        for (int bj = 0; bj < 2; ++bj) { float bv[8], cv[8];
            { const f32x4 a = *(const f32x4*)(bd + u.e * D + col0 + bj * HALF), b = *(const f32x4*)(bd + u.e * D + col0 + bj * HALF + 4), c = *(const f32x4*)(csd + u.e * D + col0 + bj * HALF), d = *(const f32x4*)(csd + u.e * D + col0 + bj * HALF + 4);
#pragma unroll
              for (int j = 0; j < 4; ++j) { bv[j] = a[j]; bv[4 + j] = b[j]; cv[j] = c[j]; cv[4 + j] = d[j]; } }
#pragma unroll
            for (int ai = 0; ai < 2; ++ai)
#pragma unroll
                for (int m = 0; m < 4; ++m) { const int r = row0 + ai * HALF + m * 16; const float gt = sgate[r], rs = ars[r]; u32x4 w;
#pragma unroll
                    for (int q = 0; q < 4; ++q) { const i32x4 ia = __builtin_bit_cast(i32x4, acc[ai][bj][m][q >> 1]);
                        w[q] = pk2(((float)ia[(q & 1) * 2] * (rs * cv[2 * q]) + bv[2 * q]) * gt, ((float)ia[(q & 1) * 2 + 1] * (rs * cv[2 * q + 1]) + bv[2 * q + 1]) * gt); }
                    *(u32x4*)(YSp + (size_t)r * D + col0 + bj * HALF) = w; } }
    }
};

#define XB_TMO      128
#define XB_XCNT(j)  (256  + 64 * (j))
#define XB_XSUB(j)  (1280 + 64 * (j))
#define XB_XGEN(j)  (2304 + 64 * (j))
#define XB_TOP      3328
#define XB_TOPGEN   3392
#define XCD_BAR_WORDS 3456
#define XB_SPIN_CAP (1u << 22)
DI unsigned xb_ld(unsigned* p)              { return __hip_atomic_load(p, __ATOMIC_RELAXED, __HIP_MEMORY_SCOPE_AGENT); }
DI unsigned xb_add(unsigned* p, unsigned v) { return __hip_atomic_fetch_add(p, v, __ATOMIC_RELAXED, __HIP_MEMORY_SCOPE_AGENT); }
DI unsigned xb_xcc_id() { return (unsigned)__builtin_amdgcn_s_getreg((3 << 11) | 20) & 0xFu; }
#define XB_SPIN(cond, bar) do { unsigned _sp = 0; while (cond) { __builtin_amdgcn_s_sleep(1); \
    if ((++_sp & 255u) == 0u) { if (xb_ld(&(bar)[XB_TMO])) break; if (_sp > XB_SPIN_CAP) { atomicAdd(&(bar)[XB_TMO], 1u); break; } } } } while (0)
struct XcdBarrier { unsigned* bar; unsigned x; volatile LAS unsigned* st; };
DI XcdBarrier xcd_barrier_post(unsigned* bar, volatile LAS unsigned* st) {
    XcdBarrier b; b.bar = bar; b.x = xb_xcc_id(); b.st = st;
    if (threadIdx.x == 0) (void)xb_add(&bar[XB_XCNT(b.x)], 1u);
    return b;
}
DI void xcd_barrier_complete(unsigned* bar, unsigned x, unsigned& nloc, unsigned& nx) {
    const unsigned G = gridDim.x * gridDim.y * gridDim.z;
    unsigned sum, cnt, mine, sp = 0u;
    for (;;) {
        sum = 0u; cnt = 0u; mine = 0u;
#pragma unroll
        for (unsigned j = 0; j < 16; ++j) { const unsigned c = xb_ld(&bar[XB_XCNT(j)]); sum += c; cnt += (c > 0u) ? 1u : 0u; mine = (j == x) ? c : mine; }
        if (sum == G) break;
        __builtin_amdgcn_s_sleep(1);
        if ((++sp & 255u) == 0u) { if (xb_ld(&bar[XB_TMO])) break; if (sp > XB_SPIN_CAP) { atomicAdd(&bar[XB_TMO], 1u); break; } }
    }
    nloc = mine > 0u ? mine : 1u; nx = cnt > 0u ? cnt : 1u;
}
DI void xcd_barrier(const XcdBarrier& b) {
    asm volatile("s_waitcnt vmcnt(0)" ::: "memory");
    __syncthreads();
    if (threadIdx.x == 0) {
        unsigned* bar = b.bar;
        __builtin_amdgcn_s_waitcnt(0);
        unsigned nloc = b.st[0], nx = b.st[1];
        if (nloc == 0u) { xcd_barrier_complete(bar, b.x, nloc, nx); b.st[0] = nloc; b.st[1] = nx; }
        const unsigned old = xb_add(&bar[XB_XSUB(b.x)], 1u);
        const unsigned gen = old / nloc;
        if (old + 1u == (gen + 1u) * nloc) {
            __builtin_amdgcn_fence(__ATOMIC_RELEASE, "agent");
            asm volatile("s_waitcnt vmcnt(0)" ::: "memory");
            const unsigned og = xb_add(&bar[XB_TOP], 1u);
            const unsigned tg = og / nx;
            if (og + 1u == (tg + 1u) * nx) xb_add(&bar[XB_TOPGEN], 1u);
            else XB_SPIN(xb_ld(&bar[XB_TOPGEN]) == tg, bar);
            __builtin_amdgcn_fence(__ATOMIC_ACQUIRE, "agent");
            xb_add(&bar[XB_XGEN(b.x)], 1u);
            asm volatile("s_waitcnt vmcnt(0)" ::: "memory");
        } else {
            XB_SPIN(xb_ld(&bar[XB_XGEN(b.x)]) == gen, bar);
            __builtin_amdgcn_fence(__ATOMIC_ACQUIRE, "agent");
            asm volatile("s_waitcnt vmcnt(0)" ::: "memory");
        }
    }
    __syncthreads();
}

struct Args {
    const float *x, *c, *ctx, *c_ctx, *norm_mix_g, *norm_ffn_g, *w_mod, *b_mod, *w_in, *sinks, *lbf_logits, *lbb_logits, *hgrn_g, *w_branch, *w_out,
                *w_router, *b_router, *w_e_gate, *b_e_gate, *w_e_up, *b_e_up, *w_e_down, *b_e_down, *final_g;
    float* out; unsigned char* ws; int ph_lo, ph_hi;
};

DI void p0_transpose64(const float* W, int ldw, bf16* WT, int ldt, LAS unsigned char* scr, int lane) {
    const int kq = lane >> 4, n4 = lane & 15;
    f32x4 v[16];
#pragma unroll
    for (int i = 0; i < 16; ++i) v[i] = *(const f32x4*)(W + (size_t)(16 * kq + i) * ldw + 4 * n4);
#pragma unroll
    for (int c = 0; c < 4; ++c)
#pragma unroll
        for (int h = 0; h < 2; ++h) { u32x4 w; w.x = pk2(v[8 * h][c], v[8 * h + 1][c]); w.y = pk2(v[8 * h + 2][c], v[8 * h + 3][c]); w.z = pk2(v[8 * h + 4][c], v[8 * h + 5][c]); w.w = pk2(v[8 * h + 6][c], v[8 * h + 7][c]);
            *(LAS u32x4*)(scr + (4 * n4 + c) * 144 + (16 * kq + 8 * h) * 2) = w; }
    LDS_WAIT(); asm volatile("" ::: "memory");
#pragma unroll
    for (int j = 0; j < 8; ++j) { const int row = (lane >> 3) + 8 * j, pc = lane & 7; const u32x4 o = *(const LAS u32x4*)(scr + row * 144 + pc * 16); *(u32x4*)(WT + (size_t)row * ldt + pc * 8) = o; }
    LDS_WAIT(); asm volatile("" ::: "memory");
}
DI void p0_quant_item(const float* W  , int ldw, signed char* Q  , float* csp  , LAS unsigned char* lds, int tid) {
    const int lane = tid & 63, w = tid >> 6, n4 = lane & 7, kr = lane >> 3;
    LAS float* smax = (LAS float*)(lds + 32 * 2064);
    f32x4 v[8][4]; f32x4 mx = {0.f, 0.f, 0.f, 0.f};
#pragma unroll
    for (int g = 0; g < 8; ++g)
#pragma unroll
        for (int r = 0; r < 4; ++r) { v[g][r] = *(const f32x4*)(W + (size_t)(256 * g + 32 * w + 4 * kr + r) * ldw + 4 * n4);
            mx[0] = fmaxf(mx[0], fabsf(v[g][r][0])); mx[1] = fmaxf(mx[1], fabsf(v[g][r][1])); mx[2] = fmaxf(mx[2], fabsf(v[g][r][2])); mx[3] = fmaxf(mx[3], fabsf(v[g][r][3])); }
#pragma unroll
    for (int c = 0; c < 4; ++c) { float m = mx[c]; m = fmaxf(m, __shfl_xor(m, 8)); m = fmaxf(m, __shfl_xor(m, 16)); m = fmaxf(m, __shfl_xor(m, 32)); mx[c] = m; }
    __syncthreads();
    if (kr == 0) *(LAS f32x4*)(smax + w * 32 + 4 * n4) = mx;
    __syncthreads();
    f32x4 cm = *(const LAS f32x4*)(smax + 4 * n4);
#pragma unroll
    for (int ww = 1; ww < 8; ++ww) { const f32x4 o = *(const LAS f32x4*)(smax + ww * 32 + 4 * n4); cm[0] = fmaxf(cm[0], o[0]); cm[1] = fmaxf(cm[1], o[1]); cm[2] = fmaxf(cm[2], o[2]); cm[3] = fmaxf(cm[3], o[3]); }
    f32x4 inv;
#pragma unroll
    for (int c = 0; c < 4; ++c) { if (cm[c] == 0.f) cm[c] = 1.f; inv[c] = 127.0f / cm[c]; }
    if (w == 0 && kr == 0) { f32x4 sc; sc[0] = cm[0] * (1.0f / 127.0f); sc[1] = cm[1] * (1.0f / 127.0f); sc[2] = cm[2] * (1.0f / 127.0f); sc[3] = cm[3] * (1.0f / 127.0f); *(f32x4*)(csp + 4 * n4) = sc; }
#pragma unroll
    for (int g = 0; g < 8; ++g)
#pragma unroll
        for (int c = 0; c < 4; ++c) { unsigned pk = 0u;
#pragma unroll
            for (int r = 0; r < 4; ++r) { const int q = (int)rintf(v[g][r][c] * inv[c]); pk |= ((unsigned)q & 0xffu) << (8 * r); }
            *(LAS unsigned*)(lds + (4 * n4 + c) * 2064 + 4 * (64 * g + 8 * w + kr)) = pk; }
    __syncthreads();
#pragma unroll
    for (int i = 0; i < 8; ++i) { const int p = tid + 512 * i, row = p >> 7, pc = p & 127; const u32x4 o = *(const LAS u32x4*)(lds + row * 2064 + pc * 16); *(u32x4*)(Q + (size_t)row * 2048 + pc * 16) = o; }
}

constexpr int SC_QH = 0, SC_KH = 8448, SC_KT = 16896, SC_VT = 26112, SC_FAC = 35328, SC_RZ = 35840, SC_RV = 44032, SC_RQ = 52224, SC_GRP = 60416;
constexpr int RSQ = 264, RST = 72;
DI int crow(int i, int h) { return (i & 3) + 8 * (i >> 2) + 4 * h; }
DI bf16x8 pack8(float a0, float a1, float a2, float a3, float a4, float a5, float a6, float a7) {
    u32x4 p; p.x = pk2(a0, a1); p.y = pk2(a2, a3); p.z = pk2(a4, a5); p.w = pk2(a6, a7); return __builtin_bit_cast(bf16x8, p);
}
DI bf16x8 lds_frag2(const LAS unsigned char* p0, const LAS unsigned char* p1) {
    const u32x2 lo = *(const LAS u32x2*)p0, hi = *(const LAS u32x2*)p1; u32x4 v; v.x = lo.x; v.y = lo.y; v.z = hi.x; v.w = hi.y; return __builtin_bit_cast(bf16x8, v);
}
#define MFMA32(a, b, c) __builtin_amdgcn_mfma_f32_32x32x16_bf16((a), (b), (c), 0, 0, 0)

template <bool OUT>
DI void scan_segment(LAS unsigned char* ldsb, const bf16* proj, int hh, int segF, int segB, float* Lbuf, float* Dlog, bf16* oscr) {
    const int tid = threadIdx.x, lane = tid & 63, wave = __builtin_amdgcn_readfirstlane(tid >> 6);
    const int dir = wave >> 2, w4 = wave & 3, half = w4 >> 1, d = tid & 127, r = lane & 31, h5 = lane >> 5, e0 = 32 * w4;
    const int seg = dir ? segB : segF, scan = dir * 8 + hh;
    const int ntok = (seg == 0) ? NCTX : 512, sgn = dir ? -1 : 1;
    const int r0 = (seg == 0) ? (dir ? MROWS - 1 : NTOK) : (dir ? NTOK - 1 - (seg - 1) * 512 : (seg - 1) * 512);
    LAS unsigned char* G = ldsb + dir * SC_GRP;
    LAS unsigned char* QH = G + SC_QH; LAS unsigned char* KH = G + SC_KH; LAS unsigned char* KT = G + SC_KT; LAS unsigned char* VT = G + SC_VT; LAS float* FAC = (LAS float*)(G + SC_FAC);
    float* Lslot = Lbuf + (size_t)(scan * NSEG + seg) * 16384;
    f32x16 acc[4];
    if (OUT) {
        const float* Sin = Lbuf + (size_t)(scan * NSEG + seg - 1) * 16384;
#pragma unroll
        for (int dt = 0; dt < 4; ++dt)
#pragma unroll
            for (int i = 0; i < 16; ++i) acc[dt][i] = Sin[(32 * dt + crow(i, h5)) * 128 + e0 + r];
    } else {
#pragma unroll
        for (int dt = 0; dt < 4; ++dt)
#pragma unroll
            for (int i = 0; i < 16; ++i) acc[dt][i] = 0.f;
    }
    float tail_prev = 0.f, dlog_tot = 0.f;
    const bf16* zsrc = proj + (dir ? PO_ZB : PO_ZF) + (size_t)hh * MROWS * 128; const bf16* vsrc = proj + PO_BV + (size_t)hh * MROWS * 128; const bf16* qsrc = proj + PO_BQ + (size_t)hh * MROWS * 128;
    const int nch = ntok / 32;
    LAS unsigned char* RZ = G + SC_RZ; LAS unsigned char* RV = G + SC_RV; LAS unsigned char* RQ = G + SC_RQ;
#define SC_DMA(cc) do { const int rb_ = r0 + sgn * 32 * (cc); \
        _Pragma("unroll") for (int i_ = 0; i_ < 2; ++i_) { const int s_ = 8 * w4 + 4 * i_ + (lane >> 4); const size_t so_ = (size_t)(rb_ + sgn * s_) * 128 + 8 * (lane & 15); \
            __builtin_amdgcn_global_load_lds((const unsigned*)(zsrc + so_), (LAS unsigned*)(RZ + (8 * w4 + 4 * i_) * 256), 16, 0, 0); \
            __builtin_amdgcn_global_load_lds((const unsigned*)(vsrc + so_), (LAS unsigned*)(RV + (8 * w4 + 4 * i_) * 256), 16, 0, 0); \
            if (OUT) __builtin_amdgcn_global_load_lds((const unsigned*)(qsrc + so_), (LAS unsigned*)(RQ + (8 * w4 + 4 * i_) * 256), 16, 0, 0); } } while (0)
    SC_DMA(0);
    for (int c = 0; c < nch; ++c) {
        const int rb = r0 + sgn * 32 * c;
        if (OUT && c > 0) asm volatile("s_waitcnt vmcnt(4)" ::: "memory"); else asm volatile("s_waitcnt vmcnt(0)" ::: "memory");
        asm volatile("s_waitcnt lgkmcnt(0)" ::: "memory"); __builtin_amdgcn_s_barrier(); asm volatile("" ::: "memory");
        float rsum = 0.f, lf[16], vv[16], qq[16];
        if (half) {
#pragma unroll
            for (int s = 0; s < 16; ++s) rsum += bf2f(*(const LAS unsigned short*)(RZ + s * 256 + d * 2));
        }
#pragma unroll
        for (int i = 0; i < 16; ++i) { const int so = (16 * half + i) * 256 + d * 2;
            lf[i] = bf2f(*(const LAS unsigned short*)(RZ + so)); vv[i] = bf2f(*(const LAS unsigned short*)(RV + so)); if (OUT) qq[i] = bf2f(*(const LAS unsigned short*)(RQ + so)); }
        if (!half) {
#pragma unroll
            for (int i = 0; i < 16; ++i) rsum += lf[i];
        }
        float b = half ? rsum : 0.f, kh[16], qh[16];
#pragma unroll
        for (int i = 0; i < 16; ++i) { b += lf[i]; const float x = b - rsum;
            kh[i] = (1.0f - __expf(lf[i])) * __expf(fminf(-x, 60.f));
            if (OUT) qh[i] = qq[i] * __expf(fminf(x, 60.f)); }
        const float tail = b - rsum;
#pragma unroll
        for (int j = 0; j < 4; ++j) {
            u32x2 w; w.x = pk2(kh[4 * j], kh[4 * j + 1]); w.y = pk2(kh[4 * j + 2], kh[4 * j + 3]); *(LAS u32x2*)(KT + d * RST + 32 * half + 8 * j) = w;
            u32x2 v; v.x = pk2(vv[4 * j], vv[4 * j + 1]); v.y = pk2(vv[4 * j + 2], vv[4 * j + 3]); *(LAS u32x2*)(VT + d * RST + 32 * half + 8 * j) = v;
        }
        if (OUT) {
#pragma unroll
            for (int i = 0; i < 16; ++i) { const int s = 16 * half + i;
                *(LAS unsigned short*)(KH + s * RSQ + d * 2) = f2bf(kh[i]); *(LAS unsigned short*)(QH + s * RSQ + d * 2) = f2bf(qh[i]); }
        }
        if (half) { FAC[d] = __expf(tail_prev + rsum); tail_prev = tail; dlog_tot += rsum + tail; }
        asm volatile("s_waitcnt lgkmcnt(0)" ::: "memory"); __builtin_amdgcn_s_barrier(); asm volatile("" ::: "memory");
        if (c + 1 < nch) SC_DMA(c + 1);
        asm volatile("" ::: "memory");
#pragma unroll
        for (int dt = 0; dt < 4; ++dt)
#pragma unroll
            for (int g4 = 0; g4 < 4; ++g4) { const f32x4 f = *(const LAS f32x4*)(FAC + 32 * dt + 8 * g4 + 4 * h5);
#pragma unroll
                for (int j = 0; j < 4; ++j) acc[dt][4 * g4 + j] *= f[j]; }
        if (OUT) {
            bf16x8 qf[8];
            f32x16 pT, oT;
#pragma unroll
            for (int i = 0; i < 16; ++i) { pT[i] = 0.f; oT[i] = 0.f; }
#pragma unroll
            for (int kk = 0; kk < 8; ++kk) {
                qf[kk] = lds_frag2(QH + r * RSQ + (16 * kk + 4 * h5) * 2, QH + r * RSQ + (16 * kk + 8 + 4 * h5) * 2);
                const bf16x8 kf = lds_frag2(KH + r * RSQ + (16 * kk + 4 * h5) * 2, KH + r * RSQ + (16 * kk + 8 + 4 * h5) * 2);
                pT = MFMA32(kf, qf[kk], pT);
            }
#pragma unroll
            for (int i = 0; i < 16; ++i) if (crow(i, h5) > r) pT[i] = 0.f;
#pragma unroll
            for (int dt = 0; dt < 4; ++dt)
#pragma unroll
                for (int ks = 0; ks < 2; ++ks) {
                    const bf16x8 sa = pack8(acc[dt][8 * ks], acc[dt][8 * ks + 1], acc[dt][8 * ks + 2], acc[dt][8 * ks + 3], acc[dt][8 * ks + 4], acc[dt][8 * ks + 5], acc[dt][8 * ks + 6], acc[dt][8 * ks + 7]);
                    oT = MFMA32(sa, qf[2 * dt + ks], oT);
                }
#pragma unroll
            for (int ks = 0; ks < 2; ++ks) {
                const bf16x8 pf = pack8(pT[8 * ks], pT[8 * ks + 1], pT[8 * ks + 2], pT[8 * ks + 3], pT[8 * ks + 4], pT[8 * ks + 5], pT[8 * ks + 6], pT[8 * ks + 7]);
                const bf16x8 va = lds_frag2(VT + (e0 + r) * RST + (16 * ks + 4 * h5) * 2, VT + (e0 + r) * RST + (16 * ks + 8 + 4 * h5) * 2);
                oT = MFMA32(va, pf, oT);
            }
            bf16* orow = oscr + ((size_t)(dir * 8 + hh) * NTOK + (rb + sgn * r)) * 128 + e0 + 4 * h5;
#pragma unroll
            for (int g4 = 0; g4 < 4; ++g4) { u32x2 o; o.x = pk2(oT[4 * g4], oT[4 * g4 + 1]); o.y = pk2(oT[4 * g4 + 2], oT[4 * g4 + 3]); *(u32x2*)(orow + 8 * g4) = o; }
        }
#pragma unroll
        for (int ks = 0; ks < 2; ++ks) {
            const bf16x8 vb = lds_frag2(VT + (e0 + r) * RST + (16 * ks + 8 * h5) * 2, VT + (e0 + r) * RST + (16 * ks + 8 * h5) * 2 + 8);
#pragma unroll
            for (int dt = 0; dt < 4; ++dt) {
                const bf16x8 ka = lds_frag2(KT + (32 * dt + r) * RST + (16 * ks + 8 * h5) * 2, KT + (32 * dt + r) * RST + (16 * ks + 8 * h5) * 2 + 8);
                acc[dt] = MFMA32(ka, vb, acc[dt]);
            }
        }
    }
#undef SC_DMA
    if (!OUT) {
        __syncthreads();
        if (half) { FAC[d] = __expf(tail_prev); Dlog[(size_t)(scan * NSEG + seg) * 128 + d] = dlog_tot; }
        __syncthreads();
#pragma unroll
        for (int dt = 0; dt < 4; ++dt)
#pragma unroll
            for (int g4 = 0; g4 < 4; ++g4) { const f32x4 f = *(const LAS f32x4*)(FAC + 32 * dt + 8 * g4 + 4 * h5);
#pragma unroll
                for (int j = 0; j < 4; ++j) Lslot[(32 * dt + 8 * g4 + 4 * h5 + j) * 128 + e0 + r] = acc[dt][4 * g4 + j] * f[j]; }
    }
    __syncthreads();
}

constexpr int AT_KC = 0, AT_VC = 36864, AT_KL = 70144, AT_VL = 116224, AT_END = 157696;
constexpr int KRS = 144, VCRS = 520, VLRS = 648, NSLOT = 10;
static_assert(AT_END <= MISC_OFF, "attention LDS");
DI void attn_unit(LAS unsigned char* ldsb, const bf16* proj, const bf16* KR, const bf16* VTg, const float* rope, const float* sinks, bf16* yab, int kvh, int ab) {
    const int tid = threadIdx.x, lane = tid & 63, wave = __builtin_amdgcn_readfirstlane(tid >> 6), r = lane & 31, h5 = lane >> 5;
    const int head = kvh * 8 + wave;
    LAS unsigned char* KC = ldsb + AT_KC; LAS unsigned char* VC = ldsb + AT_VC; LAS unsigned char* KL = ldsb + AT_KL; LAS unsigned char* VL = ldsb + AT_VL;
    const float* rowcos = rope, *rowsin = rope + 4096, *colcos = rope + 8192, *colsin = rope + 8192 + 1024;
    __syncthreads();
    for (int p = tid; p < 2048; p += 512) {
        { const int key = p >> 3, c8 = p & 7; const u32x4 v = *(const u32x4*)(KR + ((size_t)(kvh * MROWS + NTOK + key)) * 64 + c8 * 8); *(LAS u32x4*)(KC + key * KRS + c8 * 16) = v; }
        { const int dd = p >> 5, c = p & 31; const u32x4 v = *(const u32x4*)(VTg + ((size_t)(kvh * 64 + dd)) * MROWS + NTOK + c * 8);
          u32x2 a; a.x = v.x; a.y = v.y; u32x2 b; b.x = v.z; b.y = v.w; *(LAS u32x2*)(VC + dd * VCRS + c * 16) = a; *(LAS u32x2*)(VC + dd * VCRS + c * 16 + 8) = b; }
    }
    const int T0 = ab * 4 - 4;
    for (int p = tid; p < 2304; p += 512) {
        { const int key = p >> 3, c8 = p & 7, T = T0 + (key >> 5), slot = (T + 2 * NSLOT) % NSLOT;
          if (T >= 0 && T < NTOK / 32) { const u32x4 v = *(const u32x4*)(KR + ((size_t)(kvh * MROWS + T * 32 + (key & 31))) * 64 + c8 * 8); *(LAS u32x4*)(KL + (slot * 32 + (key & 31)) * KRS + c8 * 16) = v; } }
        { const int dd = p / 36, c = p % 36, T = T0 + (c >> 2), slot = (T + 2 * NSLOT) % NSLOT;
          if (T >= 0 && T < NTOK / 32) { const u32x4 v = *(const u32x4*)(VTg + ((size_t)(kvh * 64 + dd)) * MROWS + T * 32 + (c & 3) * 8);
            u32x2 a; a.x = v.x; a.y = v.y; u32x2 b; b.x = v.z; b.y = v.w; LAS unsigned char* dst = VL + dd * VLRS + slot * 64 + (c & 3) * 16; *(LAS u32x2*)dst = a; *(LAS u32x2*)(dst + 8) = b; } }
    }
    const float sc = 0.125f * 1.4426950408889634f;
    u32x4 raw[4]; float cs[2][8], sn[2][8];
#define AT_LOADQ(P0) do { const int qp_ = (P0) + r; const bf16* qrow_ = proj + PO_AQ + ((size_t)head * MROWS + qp_) * 64 + 8 * h5; \
        _Pragma("unroll") for (int ks = 0; ks < 4; ++ks) raw[ks] = *(const u32x4*)(qrow_ + 16 * ks); \
        const float* c0_ = rowcos + (qp_ >> 6) * 16 + 8 * h5; const float* s0_ = rowsin + (qp_ >> 6) * 16 + 8 * h5; \
        const float* c1_ = colcos + (qp_ & 63) * 16 + 8 * h5; const float* s1_ = colsin + (qp_ & 63) * 16 + 8 * h5; \
        _Pragma("unroll") for (int j = 0; j < 8; ++j) { cs[0][j] = c0_[j]; sn[0][j] = s0_[j]; cs[1][j] = c1_[j]; sn[1][j] = s1_[j]; } } while (0)
    AT_LOADQ(ab * 128);
    __syncthreads();
    for (int qt = 0; qt < 4; ++qt) {
        const int p0 = ab * 128 + 32 * qt, kb0 = p0 - 128, qp = p0 + r, Tq = ab * 4 + qt - 4;
        bf16x8 qf[4];
#pragma unroll
        for (int ks = 0; ks < 2; ++ks) { float o1[8], o2[8];
#pragma unroll
            for (int q = 0; q < 4; ++q) {
                const float a0 = bflo(raw[ks][q]), a1 = bfhi(raw[ks][q]), b0 = bflo(raw[ks + 2][q]), b1 = bfhi(raw[ks + 2][q]);
                o1[2 * q] = a0 * cs[ks][2 * q] - b0 * sn[ks][2 * q]; o2[2 * q] = b0 * cs[ks][2 * q] + a0 * sn[ks][2 * q];
                o1[2 * q + 1] = a1 * cs[ks][2 * q + 1] - b1 * sn[ks][2 * q + 1]; o2[2 * q + 1] = b1 * cs[ks][2 * q + 1] + a1 * sn[ks][2 * q + 1]; }
            qf[ks] = pack8(o1[0], o1[1], o1[2], o1[3], o1[4], o1[5], o1[6], o1[7]);
            qf[ks + 2] = pack8(o2[0], o2[1], o2[2], o2[3], o2[4], o2[5], o2[6], o2[7]); }
        const int Tn = Tq + 9; const bool pre = (qt < 3) && Tn >= 0 && Tn < NTOK / 32; u32x4 nk = {0u, 0u, 0u, 0u};
        if (pre) { if (tid < 256) nk = *(const u32x4*)(KR + ((size_t)(kvh * MROWS + Tn * 32 + (tid >> 3))) * 64 + (tid & 7) * 8);
                   else { const int t2 = tid - 256; nk = *(const u32x4*)(VTg + ((size_t)(kvh * 64 + (t2 >> 2))) * MROWS + Tn * 32 + (t2 & 3) * 8); } }
        if (qt < 3) AT_LOADQ(p0 + 32);
        float m_run = sinks[head] * 1.4426950408889634f, l_run = h5 ? 0.f : 1.f;
        f32x16 o0, o1;
#pragma unroll
        for (int i = 0; i < 16; ++i) { o0[i] = 0.f; o1[i] = 0.f; }
        for (int kt = 0; kt < 17; ++kt) {
            const bool lat = kt >= 8; const int j = kt - 8, T = Tq + j, kb = kb0 + 32 * j, slot = (T + 2 * NSLOT) % NSLOT;
            if (lat && (T < 0 || T >= NTOK / 32)) continue;
            const LAS unsigned char* Kb = lat ? KL + (32 * slot + r) * KRS : KC + (32 * kt + r) * KRS;
            const LAS unsigned char* Vb = lat ? VL + r * VLRS + 64 * slot : VC + r * VCRS + 64 * kt;
            const int vrs32 = 32 * (lat ? VLRS : VCRS); const bool edge = lat && (j == 0 || j == 8);
            f32x16 s;
#pragma unroll
            for (int i = 0; i < 16; ++i) s[i] = 0.f;
#pragma unroll
            for (int ks = 0; ks < 4; ++ks) { const bf16x8 kf = *(const LAS bf16x8*)(Kb + (16 * ks + 8 * h5) * 2); s = MFMA32(kf, qf[ks], s); }
            float mt = -INFINITY;
#pragma unroll
            for (int i = 0; i < 16; ++i) { float v = s[i] * sc;
                if (edge) { const int dk = kb + crow(i, h5) - qp; if (dk > 128 || dk < -128) v = -INFINITY; }
                s[i] = v; mt = fmaxf(mt, v); }
            mt = fmaxf(mt, __shfl_xor(mt, 32));
            const float mn = fmaxf(m_run, mt);
            if (__any(mn > m_run)) { const float alpha = __builtin_amdgcn_exp2f(m_run - mn); l_run *= alpha;
#pragma unroll
                for (int i = 0; i < 16; ++i) { o0[i] *= alpha; o1[i] *= alpha; } }
            m_run = mn;
            float ps = 0.f;
#pragma unroll
            for (int i = 0; i < 16; ++i) { const float p = __builtin_amdgcn_exp2f(s[i] - mn); s[i] = p; ps += p; }
            l_run += ps;
#pragma unroll
            for (int ks = 0; ks < 2; ++ks) {
                const bf16x8 pf = pack8(s[8 * ks], s[8 * ks + 1], s[8 * ks + 2], s[8 * ks + 3], s[8 * ks + 4], s[8 * ks + 5], s[8 * ks + 6], s[8 * ks + 7]);
                const bf16x8 v0 = lds_frag2(Vb + (16 * ks + 4 * h5) * 2, Vb + (16 * ks + 8 + 4 * h5) * 2);
                const bf16x8 v1 = lds_frag2(Vb + vrs32 + (16 * ks + 4 * h5) * 2, Vb + vrs32 + (16 * ks + 8 + 4 * h5) * 2);
                o0 = MFMA32(v0, pf, o0);
                o1 = MFMA32(v1, pf, o1);
            }
        }
        const float l = l_run + __shfl_xor(l_run, 32), inv = 1.0f / l;
        bf16* orow = yab + (size_t)qp * D + head * 64 + 4 * h5;
#pragma unroll
        for (int g4 = 0; g4 < 4; ++g4) {
            u32x2 a; a.x = pk2(o0[4 * g4] * inv, o0[4 * g4 + 1] * inv); a.y = pk2(o0[4 * g4 + 2] * inv, o0[4 * g4 + 3] * inv); *(u32x2*)(orow + 8 * g4) = a;
            u32x2 b; b.x = pk2(o1[4 * g4] * inv, o1[4 * g4 + 1] * inv); b.y = pk2(o1[4 * g4 + 2] * inv, o1[4 * g4 + 3] * inv); *(u32x2*)(orow + 32 + 8 * g4) = b;
        }
        if (pre) { const int slot = (Tn + 2 * NSLOT) % NSLOT;
            if (tid < 256) *(LAS u32x4*)(KL + (slot * 32 + (tid >> 3)) * KRS + (tid & 7) * 16) = nk;
            else { const int t2 = tid - 256; u32x2 a; a.x = nk.x; a.y = nk.y; u32x2 b; b.x = nk.z; b.y = nk.w; LAS unsigned char* dst = VL + (t2 >> 2) * VLRS + slot * 64 + (t2 & 3) * 16; *(LAS u32x2*)dst = a; *(LAS u32x2*)(dst + 8) = b; } }
        __syncthreads();
    }
#undef AT_LOADQ
}

typedef const Args __attribute__((address_space(4))) ArgsC;
DI ArgsC* args_ptr() { ArgsC* p = (ArgsC*)__builtin_amdgcn_kernarg_segment_ptr(); asm volatile("" : "+s"(p)); return p; }
#define PH_BEGIN ArgsC* A = args_ptr(); unsigned char* const ws = A->ws; (void)ws
#define modl ((float*)(ws + WS_SMALL + SM_MODL))
#define modc ((float*)(ws + WS_SMALL + SM_MODC))
#define rope ((float*)(ws + WS_SMALL + SM_ROPE))
#define lbf ((float*)(ws + WS_SMALL + SM_LB))
#define lbb (lbf + 1024)
#define wrp ((float*)(ws + WS_SMALL + SM_WRP))
#define cvec ((float*)(ws + WS_SMALL + SM_CVEC))
#define tile_expert ((int*)(ws + WS_SMALL + SM_TILE))
#define ntiles_p (tile_expert + 512)
#define rt_e ((int*)(ws + WS_ROUTE + RT_E))
#define rt_g ((float*)(ws + WS_ROUTE + RT_G))
#define rt_r ((int*)(ws + WS_ROUTE + RT_R))
#define rt_s ((int*)(ws + WS_ROUTE + RT_S))
#define slot_rowoff ((unsigned*)(ws + WS_ROUTE + RT_OFF))
#define slot_gate ((float*)(ws + WS_ROUTE + RT_SG))
#define Dlog ((float*)(ws + WS_DLOG))
#define KR ((bf16*)(ws + WS_KR))
#define VTg ((bf16*)(ws + WS_VT))
#define Lbuf ((float*)(ws + WS_L))
#define WIN ((bf16*)(ws + WS_WIN))
#define WM ((bf16*)(ws + WS_WM))
#define WO ((bf16*)(ws + WS_WO))
#define WGU ((bf16*)(ws + WS_WGU))
#define WDN ((bf16*)(ws + WS_WDN))
#define H ((bf16*)(ws + WS_H))
#define PROJ ((bf16*)(ws + WS_PROJ))
#define ACT ((bf16*)(ws + WS_ACT))
#define YAB ((bf16*)(ws + WS_YAB))
#define OSCR ((bf16*)(ws + WS_OSCR))
#define MERGED ((bf16*)(ws + WS_MERGED))
#define X1 ((float*)(ws + WS_X1))
#define YS ((bf16*)(ws + WS_YS))

__global__ void __launch_bounds__(NWAVES * 64, 2) fwd_kernel(Args a_unused) {
    extern __shared__ __attribute__((aligned(16))) unsigned char lds_raw[];
    LAS unsigned char* lds = (LAS unsigned char*)lds_raw;
    volatile LAS unsigned* MISC = (volatile LAS unsigned*)(lds + MISC_OFF);
    const int tid = threadIdx.x, lane = tid & 63, wave = __builtin_amdgcn_readfirstlane(tid >> 6);
    const int G = gridDim.x, bx = blockIdx.x, vcu = (G % 8 == 0) ? (bx % 8) * (G / 8) + bx / 8 : bx;
    const int gw = vcu * NWAVES + wave, NGW = G * NWAVES;
    const int gtid = vcu * 512 + tid, NGT = G * 512;
    unsigned* ctl; { const ArgsC* A0 = args_ptr(); ctl = (unsigned*)(A0->ws + WS_CTL); }
    if (tid < 64) MISC[tid] = 0u;
    __syncthreads();
    XcdBarrier bar = xcd_barrier_post(ctl + CW_BAR, MISC);
    int lo, hi; { const ArgsC* A0 = args_ptr(); lo = A0->ph_lo; hi = A0->ph_hi; }
#ifndef PH_MASK
#define PH_MASK 0x1fff
#endif
#define IN(k) ((((PH_MASK) >> (k)) & 1) && lo <= (k) && (k) < hi)
#define SEAM(k) do { if (IN(k) && IN((k) + 1)) xcd_barrier(bar); } while (0)

    for (int rep_ = 0; rep_ < DUP0; ++rep_) { if (rep_) xcd_barrier(bar);
    if (IN(0)) {
        PH_BEGIN;
        constexpr int Q_TAB = 48, Q_WIN = 49, Q_GU = Q_WIN + INC / 32, Q_DN = Q_GU + 4096, Q_TR = Q_DN + 2048, I_BR = 1024, I_OUT = 1024, Q_END = Q_TR + (I_BR + I_OUT) / 8;
        int cur = vcu;
        while (cur < Q_END) {
            unsigned nxt = 0u; if (tid == 0) nxt = (unsigned)G + atomicAdd(ctl + CW_Q, 1u);
            if (cur < Q_TAB) {
                LAS float* sc = (LAS float*)lds; LAS float* scc = sc + 2048; LAS f32x4* red = (LAS f32x4*)(lds + 16384);
                for (int k = tid; k < 2048; k += 512) { const float v = A->c[k], u = A->c_ctx[k]; sc[k] = v * sigmoidf_(v); scc[k] = u * sigmoidf_(u); }
                __syncthreads();
                const int cb = cur, col = 256 * cb + 4 * lane; const bool hasc = cb < 16;
                f32x4 al = {0.f, 0.f, 0.f, 0.f}, ac = {0.f, 0.f, 0.f, 0.f};
#pragma unroll 8
                for (int k = wave; k < 2048; k += 8) { const f32x4 wv = *(const f32x4*)(A->w_mod + (size_t)k * 12288 + col); al += sc[k] * wv; ac += scc[k] * wv; }
                red[wave * 64 + lane] = al; red[512 + wave * 64 + lane] = ac;
                __syncthreads();
                if (wave == 0) { f32x4 s = *(const f32x4*)(A->b_mod + col), t = s;
#pragma unroll
                    for (int w = 0; w < 8; ++w) { s += red[w * 64 + lane]; t += red[512 + w * 64 + lane]; }
                    *(f32x4*)(modl + col) = s; if (hasc) *(f32x4*)(modc + col) = t; }
            } else if (cur == Q_TAB) {
                for (int i = tid; i < 4096 + 1024; i += 512) { const bool isrow = i < 4096; const int ii = isrow ? i : i - 4096, p = ii >> 4, j = ii & 15;
                    const float inv = powf(10000.0f, -(float)j / 16.0f), ang = (float)p * inv; float s, c; sincosf(ang, &s, &c);
                    if (isrow) { rope[ii] = c; rope[4096 + ii] = s; } else { rope[8192 + ii] = c; rope[9216 + ii] = s; } }
                for (int i = tid; i < 2048; i += 512) { const float* lg = (i < 1024) ? A->lbf_logits : A->lbb_logits; const int ch = i & 1023;
                    const float v = 1.0f / (1.0f + expf(lg[1024 + ch] - lg[ch])); if (i < 1024) lbf[ch] = v; else lbb[ch] = v; }
            } else if (cur < Q_GU) { const int it = cur - Q_WIN;
                p0_quant_item(A->w_in + 32 * it, INC, (signed char*)(ws + WS_WIN) + (size_t)(32 * it) * 2048, (float*)(ws + WS_CS + CS_WIN) + 32 * it, lds, tid);
            } else if (cur < Q_DN) { const int it = cur - Q_GU;
                const int e = it >> 7, which = (it >> 6) & 1, jb = it & 63, n0 = 32 * jb, np = e * 4096 + (n0 >> 7) * 256 + which * 128 + (n0 & 127);
                p0_quant_item((which ? A->w_e_up : A->w_e_gate) + (size_t)e * D * FF + n0, FF, (signed char*)(ws + WS_WGU) + (size_t)np * 2048, (float*)(ws + WS_CS) + np, lds, tid);
            } else if (cur < Q_TR) { const int it = cur - Q_DN, e = it >> 6, n0 = 32 * (it & 63);
                p0_quant_item(A->w_e_down + (size_t)e * FF * D + n0, D, (signed char*)(ws + WS_WDN) + ((size_t)e * D + n0) * 2048, (float*)(ws + WS_DLOG + DL_CSD) + e * D + n0, lds, tid);
            } else {
                LAS unsigned char* scr = lds + wave * 9216; int r = (cur - Q_TR) * 8 + wave;
                if (r < I_BR) { const int br = r >> 9, r2 = r & 511, kb = r2 >> 5, nb = r2 & 31;
                    p0_transpose64(A->w_branch + (size_t)br * 1024 * D + (size_t)(64 * kb) * D + 64 * nb, D, WM + (size_t)(64 * nb) * D + br * 1024 + 64 * kb, D, scr, lane); }
                else { r -= I_BR; const int kb = r >> 5, nb = r & 31; p0_transpose64(A->w_out + (size_t)(64 * kb) * D + 64 * nb, D, WO + (size_t)(64 * nb) * D + 64 * kb, D, scr, lane); }
            }
            __syncthreads();
            if (tid == 0) MISC[2] = nxt;
            __syncthreads();
            cur = (int)MISC[2];
        }
    }
    }
    SEAM(0);

    for (int rep_ = 0; rep_ < DUP1; ++rep_) { if (rep_) xcd_barrier(bar);
    if (IN(1)) {
        PH_BEGIN;
        {
            f32x4 ca[8], cb[8];
#pragma unroll
            for (int j = 0; j < 8; ++j) { const int k = 4 * lane + 256 * j; const f32x4 g = *(const f32x4*)(A->norm_mix_g + k), s1 = *(const f32x4*)(modl + 2048 + k); ca[j] = g * (1.0f + s1); cb[j] = *(const f32x4*)(modl + k); }
            f32x4 v[8], vn[8];
            { const float* xr = A->x + (size_t)gw * D + 4 * lane;
#pragma unroll
              for (int j = 0; j < 8; ++j) v[j] = *(const f32x4*)(xr + 256 * j); }
            for (int m = gw; m < NTOK; m += NGW) {
                if (m + NGW < NTOK) { const float* xn = A->x + (size_t)(m + NGW) * D + 4 * lane;
#pragma unroll
                    for (int j = 0; j < 8; ++j) vn[j] = *(const f32x4*)(xn + 256 * j); }
                float ss = 0.f;
#pragma unroll
                for (int j = 0; j < 8; ++j) ss += v[j][0] * v[j][0] + v[j][1] * v[j][1] + v[j][2] * v[j][2] + v[j][3] * v[j][3];
                const float rstd = rsqrtf(wave_sum(ss) * (1.0f / D) + EPS);
                float am = 0.f;
#pragma unroll
                for (int j = 0; j < 8; ++j) { v[j] = v[j] * rstd * ca[j] + cb[j]; am = fmaxf(am, fmaxf(fmaxf(fabsf(v[j][0]), fabsf(v[j][1])), fmaxf(fabsf(v[j][2]), fabsf(v[j][3])))); }
#pragma unroll
                for (int o = 1; o < 64; o <<= 1) am = fmaxf(am, __shfl_xor(am, o));
                if (am == 0.f) am = 1.f;
                const float qi = 127.0f / am;
                if (lane == 0) ((float*)(ws + WS_CS + CS_HROW))[m] = am * (1.0f / 127.0f);
                unsigned* hq = (unsigned*)((signed char*)(ws + WS_H) + (size_t)m * D + 4 * lane);
#pragma unroll
                for (int j = 0; j < 8; ++j) { const int q0 = (int)rintf(v[j][0] * qi), q1 = (int)rintf(v[j][1] * qi), q2 = (int)rintf(v[j][2] * qi), q3 = (int)rintf(v[j][3] * qi);
                    hq[64 * j] = ((unsigned)q0 & 0xffu) | (((unsigned)q1 & 0xffu) << 8) | (((unsigned)q2 & 0xffu) << 16) | (((unsigned)q3 & 0xffu) << 24); }
#pragma unroll
                for (int j = 0; j < 8; ++j) v[j] = vn[j];
            }
        }
        if (gw < NCTX) {
            const int m = gw; const float* xr = A->ctx + (size_t)m * D + 4 * lane; f32x4 v[8]; float ss = 0.f;
#pragma unroll
            for (int j = 0; j < 8; ++j) { v[j] = *(const f32x4*)(xr + 256 * j); ss += v[j][0] * v[j][0] + v[j][1] * v[j][1] + v[j][2] * v[j][2] + v[j][3] * v[j][3]; }
            const float rstd = rsqrtf(wave_sum(ss) * (1.0f / D) + EPS);
            float am = 0.f;
#pragma unroll
            for (int j = 0; j < 8; ++j) { const int k = 4 * lane + 256 * j; const f32x4 g = *(const f32x4*)(A->norm_mix_g + k), s1 = *(const f32x4*)(modc + 2048 + k), s0 = *(const f32x4*)(modc + k);
                v[j] = v[j] * rstd * (g * (1.0f + s1)) + s0; am = fmaxf(am, fmaxf(fmaxf(fabsf(v[j][0]), fabsf(v[j][1])), fmaxf(fabsf(v[j][2]), fabsf(v[j][3])))); }
#pragma unroll
            for (int o = 1; o < 64; o <<= 1) am = fmaxf(am, __shfl_xor(am, o));
            if (am == 0.f) am = 1.f;
            const float qi = 127.0f / am;
            if (lane == 0) ((float*)(ws + WS_CS + CS_HROW))[NTOK + m] = am * (1.0f / 127.0f);
            unsigned* hq = (unsigned*)((signed char*)(ws + WS_H) + (size_t)(NTOK + m) * D + 4 * lane);
#pragma unroll
            for (int j = 0; j < 8; ++j) { const int q0 = (int)rintf(v[j][0] * qi), q1 = (int)rintf(v[j][1] * qi), q2 = (int)rintf(v[j][2] * qi), q3 = (int)rintf(v[j][3] * qi);
                hq[64 * j] = ((unsigned)q0 & 0xffu) | (((unsigned)q1 & 0xffu) << 8) | (((unsigned)q2 & 0xffu) << 16) | (((unsigned)q3 & 0xffu) << 24); }
        }
        for (int i = gtid; i < 2048 * 32; i += NGT) { const int k = i >> 5; wrp[i] = A->norm_ffn_g[k] * (1.0f + modl[4 * 2048 + k]) * A->w_router[i]; }
        if (vcu == G - 1) {
            for (int e = wave * 4; e < wave * 4 + 4; ++e) { float s = 0.f; for (int k = lane; k < 2048; k += 64) s += modl[3 * 2048 + k] * A->w_router[k * 32 + e];
                s = wave_sum(s); if (lane == 0) cvec[e] = s + A->b_router[e]; }
        }
    }
    }
    SEAM(1);

    if (IN(2)) {
        PH_BEGIN;
        pg8::Gemm g{H, WIN, D / 2}; pg8::PlainOrder S; S.init(MROWS / 256, INC / 256, G, bx); S.K2 = D;
        EpiProj E{PROJ, lbf, lbb, (const float*)(ws + WS_CS + CS_HROW), (const float*)(ws + WS_CS + CS_WIN)};
        pg8::gemm_phase<EpiProj, pg8::PlainOrder, true>(lds, g, S, E);
    }
    SEAM(2);

    for (int rep_ = 0; rep_ < DUP3; ++rep_) { if (rep_) xcd_barrier(bar);
    if (IN(3)) {
        PH_BEGIN;
        for (int i = gtid; i < MROWS * 8; i += NGT) { const int jg = i & 3, kvh = (i >> 2) & 1, pos = i >> 3, j0 = 8 * jg;
            const bf16* kr = PROJ + PO_AKV + (size_t)pos * 256 + kvh * 64 + j0; const u32x4 a1 = *(const u32x4*)kr, a2 = *(const u32x4*)(kr + 32); u32x4 w1 = a1, w2 = a2;
            if (pos < NTOK) { const float* ct = (jg < 2) ? rope + (pos >> 6) * 16 + j0 : rope + 8192 + (pos & 63) * 16 + j0 - 16; const float* st = ct + ((jg < 2) ? 4096 : 1024);
                const f32x4 c0 = *(const f32x4*)ct, c1 = *(const f32x4*)(ct + 4), s0 = *(const f32x4*)st, s1 = *(const f32x4*)(st + 4);
#pragma unroll
                for (int q = 0; q < 4; ++q) { const float cl = q < 2 ? c0[2 * q] : c1[2 * q - 4], ch = q < 2 ? c0[2 * q + 1] : c1[2 * q - 3], sl = q < 2 ? s0[2 * q] : s1[2 * q - 4], sh = q < 2 ? s0[2 * q + 1] : s1[2 * q - 3];
                    const float k1l = bflo(a1[q]), k1h = bfhi(a1[q]), k2l = bflo(a2[q]), k2h = bfhi(a2[q]);
                    w1[q] = pk2(k1l * cl - k2l * sl, k1h * ch - k2h * sh); w2[q] = pk2(k2l * cl + k1l * sl, k2h * ch + k1h * sh); } }
            bf16* ko = KR + ((size_t)kvh * MROWS + pos) * 64 + j0; *(u32x4*)ko = w1; *(u32x4*)(ko + 32) = w2; }
        for (int i = gtid; i < 2 * (MROWS / 8) * 64; i += NGT) { const int dd = i & 63, pb = (i >> 6) % (MROWS / 8), kvh = (i >> 6) / (MROWS / 8);
            const bf16* vr = PROJ + PO_AKV + (size_t)(pb * 8) * 256 + 128 + kvh * 64 + dd; unsigned short t[8];
#pragma unroll
            for (int q = 0; q < 8; ++q) t[q] = vr[(size_t)q * 256];
            u32x4 w; w.x = t[0] | ((unsigned)t[1] << 16); w.y = t[2] | ((unsigned)t[3] << 16); w.z = t[4] | ((unsigned)t[5] << 16); w.w = t[6] | ((unsigned)t[7] << 16);
            *(u32x4*)(VTg + ((size_t)kvh * 64 + dd) * MROWS + pb * 8) = w; }
        for (int it = vcu; it < 8 * (NSEG - 1); it += G) { const int hh = it >> 5, seg = it & 31; scan_segment<false>(lds, PROJ, hh, seg, seg, Lbuf, Dlog, (bf16*)nullptr); }
    }
    }
    SEAM(3);

    if (IN(4)) {
        PH_BEGIN;
        for (int i = gtid; i < 16 * 16384; i += NGT) { const int scan = i >> 14, el = i & 16383, dd = el >> 7; float s = 0.f, lv[NSEG - 1], dv[NSEG - 1];
#pragma unroll
            for (int j = 0; j < NSEG - 1; ++j) { lv[j] = Lbuf[(size_t)(scan * NSEG + j) * 16384 + el]; dv[j] = Dlog[(scan * NSEG + j) * 128 + dd]; }
#pragma unroll
            for (int j = 0; j < NSEG - 1; ++j) { s = __expf(dv[j]) * s + lv[j]; Lbuf[(size_t)(scan * NSEG + j) * 16384 + el] = s; } }
        for (int rep_ = 0; rep_ < DUP4; ++rep_) for (int u = vcu; u < 256; u += G) attn_unit(lds, PROJ, KR, VTg, rope, A->sinks, YAB, u >> 7, u & 127);
    }
    SEAM(4);

    for (int rep_ = 0; rep_ < DUP5; ++rep_) { if (rep_) xcd_barrier(bar);
    if (IN(5)) {
        PH_BEGIN;
        for (int it = vcu; it < 8 * 32; it += G) { const int hh = it >> 5, segF = 1 + (it & 31);
            scan_segment<true>(lds, PROJ, hh, segF, NSEG - segF, Lbuf, Dlog, OSCR);
            VM_WAIT(); __syncthreads();
            { const int l16 = lane & 15, tq = lane >> 4; const f32x4 hg0 = *(const f32x4*)(A->hgrn_g + hh * 128 + 8 * l16), hg1 = *(const f32x4*)(A->hgrn_g + hh * 128 + 8 * l16 + 4);
              for (int i0 = wave * 64; i0 < wave * 64 + 64; i0 += 16) {
                u32x4 fw[4], bw[4], gq[4];
#pragma unroll
                for (int b = 0; b < 4; ++b) { const int row = (segF - 1) * 512 + i0 + 4 * b + tq;
                    fw[b] = *(const u32x4*)(OSCR + ((size_t)hh * NTOK + row) * 128 + 8 * l16); bw[b] = *(const u32x4*)(OSCR + ((size_t)(8 + hh) * NTOK + row) * 128 + 8 * l16);
                    gq[b] = *(const u32x4*)(PROJ + PO_BG + ((size_t)hh * MROWS + row) * 128 + 8 * l16); }
#pragma unroll
                for (int b = 0; b < 4; ++b) { const int row = (segF - 1) * 512 + i0 + 4 * b + tq;
                    f32x4 o0, o1; o0[0] = bflo(fw[b].x) + bflo(bw[b].x); o0[1] = bfhi(fw[b].x) + bfhi(bw[b].x); o0[2] = bflo(fw[b].y) + bflo(bw[b].y); o0[3] = bfhi(fw[b].y) + bfhi(bw[b].y);
                    o1[0] = bflo(fw[b].z) + bflo(bw[b].z); o1[1] = bfhi(fw[b].z) + bfhi(bw[b].z); o1[2] = bflo(fw[b].w) + bflo(bw[b].w); o1[3] = bfhi(fw[b].w) + bfhi(bw[b].w);
                    float ss = o0[0] * o0[0] + o0[1] * o0[1] + o0[2] * o0[2] + o0[3] * o0[3] + o1[0] * o1[0] + o1[1] * o1[1] + o1[2] * o1[2] + o1[3] * o1[3];
                    ss += __shfl_xor(ss, 1); ss += __shfl_xor(ss, 2); ss += __shfl_xor(ss, 4); ss += __shfl_xor(ss, 8);
                    const float rstd = rsqrtf(ss * (1.0f / 128.0f) + EPS);
                    u32x4 w; w.x = pk2(o0[0] * rstd * hg0[0] * bflo(gq[b].x), o0[1] * rstd * hg0[1] * bfhi(gq[b].x)); w.y = pk2(o0[2] * rstd * hg0[2] * bflo(gq[b].y), o0[3] * rstd * hg0[3] * bfhi(gq[b].y));
                    w.z = pk2(o1[0] * rstd * hg1[0] * bflo(gq[b].z), o1[1] * rstd * hg1[1] * bfhi(gq[b].z)); w.w = pk2(o1[2] * rstd * hg1[2] * bflo(gq[b].w), o1[3] * rstd * hg1[3] * bfhi(gq[b].w));
                    *(u32x4*)(YAB + (size_t)row * D + 1024 + hh * 128 + 8 * l16) = w; } } }
            __syncthreads();
        }
    }
    }
    SEAM(5);

    if (IN(6)) {
        PH_BEGIN;
        pg8::Gemm g{YAB, WM, D}; pg8::PlainOrder S; S.init(NTOK / 256, D / 256, G, bx); S.K2 = D * 2;
        EpiMerge E{MERGED, PROJ};
        pg8::gemm_phase<EpiMerge, pg8::PlainOrder>(lds, g, S, E);
    }
    SEAM(6);

    if (IN(7)) {
        PH_BEGIN;
        pg8::Gemm g{MERGED, WO, D}; pg8::PlainOrder S; S.init(NTOK / 256, D / 256, G, bx); S.K2 = D * 2;
        EpiOut E{X1, A->x, modl + 2 * 2048};
        pg8::gemm_phase<EpiOut, pg8::PlainOrder>(lds, g, S, E);
    }
    SEAM(7);

    if (IN(8)) {
        PH_BEGIN;
        LAS float* part = (LAS float*)lds;
        LAS float* rsd = (LAS float*)(lds + 16384);
        const int r16 = lane & 15, kk = lane >> 4;
        float bw[16][4][2];
#pragma unroll
        for (int kg = 0; kg < 16; ++kg)
#pragma unroll
            for (int m = 0; m < 4; ++m)
#pragma unroll
                for (int eh = 0; eh < 2; ++eh) bw[kg][m][eh] = wrp[(256 * wave + 16 * kg + 4 * kk + m) * 32 + 16 * eh + r16];
        for (int tl = vcu; tl < NTOK / 16; tl += G) {
            const int row0 = tl * 16;
#pragma unroll
            for (int q = 0; q < 2; ++q) { const int m = row0 + 2 * wave + q; const float* xr = X1 + (size_t)m * D + 4 * lane; f32x4 v[8]; float ss = 0.f;
#pragma unroll
                for (int j = 0; j < 8; ++j) { v[j] = *(const f32x4*)(xr + 256 * j); ss += v[j][0] * v[j][0] + v[j][1] * v[j][1] + v[j][2] * v[j][2] + v[j][3] * v[j][3]; }
                const float rstd = rsqrtf(wave_sum(ss) * (1.0f / D) + EPS);
                if (lane == 0) rsd[2 * wave + q] = rstd;
                float am = 0.f;
#pragma unroll
                for (int j = 0; j < 8; ++j) { const int k = 4 * lane + 256 * j; const f32x4 g = *(const f32x4*)(A->norm_ffn_g + k), s1 = *(const f32x4*)(modl + 4 * 2048 + k), s0 = *(const f32x4*)(modl + 3 * 2048 + k);
                    v[j] = v[j] * rstd * (g * (1.0f + s1)) + s0; am = fmaxf(am, fmaxf(fmaxf(fabsf(v[j][0]), fabsf(v[j][1])), fmaxf(fabsf(v[j][2]), fabsf(v[j][3])))); }
#pragma unroll
                for (int o = 1; o < 64; o <<= 1) am = fmaxf(am, __shfl_xor(am, o));
                if (am == 0.f) am = 1.f;
                const float qi = 127.0f / am;
                if (lane == 0) ((float*)(ws + WS_CS + CS_ROW))[m] = am * (1.0f / 127.0f);
                unsigned* hq = (unsigned*)((signed char*)(ws + WS_H) + (size_t)m * D + 4 * lane);
#pragma unroll
                for (int j = 0; j < 8; ++j) { const int q0 = (int)rintf(v[j][0] * qi), q1 = (int)rintf(v[j][1] * qi), q2 = (int)rintf(v[j][2] * qi), q3 = (int)rintf(v[j][3] * qi);
                    hq[64 * j] = ((unsigned)q0 & 0xffu) | (((unsigned)q1 & 0xffu) << 8) | (((unsigned)q2 & 0xffu) << 16) | (((unsigned)q3 & 0xffu) << 24); } }
            f32x4 acc0 = {0.f, 0.f, 0.f, 0.f}, acc1 = {0.f, 0.f, 0.f, 0.f};
            const float* xa = X1 + (size_t)(row0 + r16) * D + 256 * wave + 4 * kk;
#pragma unroll
            for (int kg = 0; kg < 16; ++kg) { const f32x4 av = *(const f32x4*)(xa + 16 * kg);
#pragma unroll
                for (int m = 0; m < 4; ++m) { acc0 = __builtin_amdgcn_mfma_f32_16x16x4f32(av[m], bw[kg][m][0], acc0, 0, 0, 0); acc1 = __builtin_amdgcn_mfma_f32_16x16x4f32(av[m], bw[kg][m][1], acc1, 0, 0, 0); } }
#pragma unroll
            for (int q = 0; q < 4; ++q) { part[(wave * 16 + 4 * kk + q) * 32 + r16] = acc0[q]; part[(wave * 16 + 4 * kk + q) * 32 + 16 + r16] = acc1[q]; }
            __syncthreads();
            { const int row = tid >> 5, e = tid & 31; float s = 0.f;
#pragma unroll
              for (int w = 0; w < 8; ++w) s += part[(w * 16 + row) * 32 + e];
              float val = rsd[row] * s + cvec[e];
              float tv[4]; int ti[4];
#pragma unroll
              for (int j = 0; j < 4; ++j) { float bv = val; int bi = e;
#pragma unroll
                  for (int off = 16; off >= 1; off >>= 1) { const float ov = __shfl_xor(bv, off); const int oi = __shfl_xor(bi, off); if (ov > bv || (ov == bv && oi < bi)) { bv = ov; bi = oi; } }
                  tv[j] = bv; ti[j] = bi; if (e == bi) val = -INFINITY; }
              const float e1 = __expf(tv[1] - tv[0]), e2 = __expf(tv[2] - tv[0]), e3 = __expf(tv[3] - tv[0]), inv = 1.0f / (1.0f + e1 + e2 + e3);
              const float gt[4] = {inv, e1 * inv, e2 * inv, e3 * inv};
#pragma unroll
              for (int j = 0; j < 4; ++j) if (e == ti[j]) { const int ai = (row0 + row) * 4 + j; const unsigned rk = atomicAdd(ctl + CW_CNT + 16 * e, 1u);
                  rt_e[ai] = e; rt_g[ai] = gt[j]; rt_r[ai] = (int)rk; } }
            __syncthreads();
        }
    }
    SEAM(8);

    if (IN(9)) {
        PH_BEGIN;
        LAS int* tb = (LAS int*)lds;
        if (tid == 0) { int acc = 0; for (int e = 0; e < NEXP; ++e) { tb[e] = acc; acc += (int)((ctl[CW_CNT + 16 * e] + 255u) >> 8); } tb[NEXP] = acc; }
        __syncthreads();
        for (int i = gtid; i < NTOK * 4; i += NGT) { const int e = rt_e[i], slot = tb[e] * 256 + rt_r[i]; rt_s[i] = slot; slot_rowoff[slot] = (unsigned)(i >> 2) * (unsigned)D; slot_gate[slot] = rt_g[i]; ((float*)(ws + WS_CS + CS_SLOT))[slot] = ((const float*)(ws + WS_CS + CS_ROW))[i >> 2]; }
        if (vcu == 0) {
            for (int e = 0; e < NEXP; ++e) { const int cnt = (int)ctl[CW_CNT + 16 * e], s0 = tb[e] * 256 + cnt, s1 = tb[e + 1] * 256;
                for (int s = s0 + tid; s < s1; s += 512) { slot_rowoff[s] = 0u; slot_gate[s] = 0.f; ((float*)(ws + WS_CS + CS_SLOT))[s] = 0.f; }
                for (int t = tb[e] + tid; t < tb[e + 1]; t += 512) tile_expert[t] = e; }
            if (tid == 0) *ntiles_p = tb[NEXP];
        }
        __syncthreads();
    }
    SEAM(9);

    if (IN(10)) {
        PH_BEGIN;
        const int ntiles = *ntiles_p;
        pg8::Gemm g{H, WGU, D / 2}; pg8::MoeOrder<true> S; S.init(ntiles, 4096 / 256, G, bx); S.K2 = D; S.nper = 4096; S.texp = tile_expert; S.sroff = slot_rowoff;
        EpiAct E{ACT, A->b_e_gate, A->b_e_up, (const float*)(ws + WS_CS), (const float*)(ws + WS_CS + CS_SLOT)};
        pg8::gemm_phase<EpiAct, pg8::MoeOrder<true>, true>(lds, g, S, E);
    }
    SEAM(10);

    if (IN(11)) {
        PH_BEGIN;
        const int ntiles = *ntiles_p;
        { const int nrows = ntiles * 256; u32x2 v[8], vn[8];
          if (gw < nrows) { const bf16* ar = ACT + (size_t)gw * FF + 4 * lane;
#pragma unroll
              for (int j = 0; j < 8; ++j) v[j] = *(const u32x2*)(ar + 256 * j); }
          for (int m = gw; m < nrows; m += NGW) {
              if (m + NGW < nrows) { const bf16* an = ACT + (size_t)(m + NGW) * FF + 4 * lane;
#pragma unroll
                  for (int j = 0; j < 8; ++j) vn[j] = *(const u32x2*)(an + 256 * j); }
              float am = 0.f;
#pragma unroll
              for (int j = 0; j < 8; ++j) am = fmaxf(am, fmaxf(fmaxf(fabsf(bflo(v[j].x)), fabsf(bfhi(v[j].x))), fmaxf(fabsf(bflo(v[j].y)), fabsf(bfhi(v[j].y)))));
#pragma unroll
              for (int o = 1; o < 64; o <<= 1) am = fmaxf(am, __shfl_xor(am, o));
              if (!(am > 0.f)) am = 1.f;
              const float qi = 127.0f / am;
              if (lane == 0) ((float*)(ws + WS_ROUTE + RT_ARS))[m] = am * (1.0f / 127.0f);
              unsigned* aq = (unsigned*)((signed char*)(ws + WS_ACT8) + (size_t)m * FF + 4 * lane);
#pragma unroll
              for (int j = 0; j < 8; ++j) { const int q0 = (int)rintf(bflo(v[j].x) * qi), q1 = (int)rintf(bfhi(v[j].x) * qi), q2 = (int)rintf(bflo(v[j].y) * qi), q3 = (int)rintf(bfhi(v[j].y) * qi);
                  aq[64 * j] = ((unsigned)q0 & 0xffu) | (((unsigned)q1 & 0xffu) << 8) | (((unsigned)q2 & 0xffu) << 16) | (((unsigned)q3 & 0xffu) << 24); }
#pragma unroll
              for (int j = 0; j < 8; ++j) v[j] = vn[j];
          } }
        xcd_barrier(bar);
        pg8::Gemm g{(const bf16*)(ws + WS_ACT8), WDN, FF / 2}; pg8::MoeOrder<false> S; S.init(ntiles, D / 256, G, bx); S.K2 = FF; S.nper = D; S.texp = tile_expert; S.sroff = slot_rowoff;
        EpiDown E{YS, A->b_e_down, slot_gate, (const float*)(ws + WS_ROUTE + RT_ARS), (const float*)(ws + WS_DLOG + DL_CSD)};
        pg8::gemm_phase<EpiDown, pg8::MoeOrder<false>, true>(lds, g, S, E);
    }
    SEAM(11);

    for (int rep_ = 0; rep_ < DUP12; ++rep_) { if (rep_) xcd_barrier(bar);
    if (IN(12)) {
        PH_BEGIN;
        f32x4 v[8], vn[8]; u32x2 yr[4][8], yn[4][8]; int sl[4];
#define P12_LOAD(VV, YY, M) do { const float* xr_ = X1 + (size_t)(M) * D + 4 * lane; \
            _Pragma("unroll") for (int j = 0; j < 8; ++j) VV[j] = *(const f32x4*)(xr_ + 256 * j); \
            _Pragma("unroll") for (int q = 0; q < 4; ++q) { const bf16* yp_ = YS + (size_t)sl[q] * D + 4 * lane; _Pragma("unroll") for (int j = 0; j < 8; ++j) YY[q][j] = *(const u32x2*)(yp_ + 256 * j); } } while (0)
#pragma unroll
        for (int q = 0; q < 4; ++q) sl[q] = rt_s[gw * 4 + q];
        P12_LOAD(v, yr, gw);
        if (gw + NGW < NTOK) {
#pragma unroll
            for (int q = 0; q < 4; ++q) sl[q] = rt_s[(gw + NGW) * 4 + q];
        }
        for (int m = gw; m < NTOK; m += NGW) {
            if (m + NGW < NTOK) { P12_LOAD(vn, yn, m + NGW);
                if (m + 2 * NGW < NTOK) {
#pragma unroll
                    for (int q = 0; q < 4; ++q) sl[q] = rt_s[(m + 2 * NGW) * 4 + q]; } }
            f32x4 y[8];
#pragma unroll
            for (int j = 0; j < 8; ++j) { y[j] = (f32x4){0.f, 0.f, 0.f, 0.f};
#pragma unroll
                for (int q = 0; q < 4; ++q) { const u32x2 w = yr[q][j]; y[j][0] += bflo(w.x); y[j][1] += bfhi(w.x); y[j][2] += bflo(w.y); y[j][3] += bfhi(w.y); } }
            float ss = 0.f;
#pragma unroll
            for (int j = 0; j < 8; ++j) { const f32x4 m5 = *(const f32x4*)(modl + 5 * 2048 + 4 * lane + 256 * j); v[j] = v[j] + m5 * y[j]; ss += v[j][0] * v[j][0] + v[j][1] * v[j][1] + v[j][2] * v[j][2] + v[j][3] * v[j][3]; }
            const float rstd = rsqrtf(wave_sum(ss) * (1.0f / D) + EPS);
            float* orow = A->out + (size_t)m * D + 4 * lane;
#pragma unroll
            for (int j = 0; j < 8; ++j) { const f32x4 fg = *(const f32x4*)(A->final_g + 4 * lane + 256 * j); *(f32x4*)(orow + 256 * j) = v[j] * rstd * fg; }
#pragma unroll
            for (int j = 0; j < 8; ++j) { v[j] = vn[j];
#pragma unroll
                for (int q = 0; q < 4; ++q) yr[q][j] = yn[q][j]; }
        }
#undef P12_LOAD
    }
    }
#undef IN
#undef SEAM
}

#undef modl
#undef modc
#undef rope
#undef lbf
#undef lbb
#undef wrp
#undef cvec
#undef tile_expert
#undef ntiles_p
#undef rt_e
#undef rt_g
#undef rt_r
#undef rt_s
#undef slot_rowoff
#undef slot_gate
#undef Dlog
#undef KR
#undef VTg
#undef Lbuf
#undef WIN
#undef WM
#undef WO
#undef WGU
#undef WDN
#undef H
#undef PROJ
#undef ACT
#undef YAB
#undef OSCR
#undef MERGED
#undef X1
#undef YS
extern "C" void kernel_launch(void* const* d_in, const int* in_sizes, int n_in, void* d_out, int out_size, void* d_ws, size_t ws_size, hipStream_t stream) {
    static int grid = 0;
    if (grid == 0) {
        if (n_in != 24 || out_size != NTOK * D || ws_size < WS_END) { fprintf(stderr, "kernel_launch: unexpected shapes (n_in %d out %d ws %zu)\n", n_in, out_size, ws_size); grid = -1; return; }
        int dev = 0, cus = 0, per_cu = 0;
        if (hipGetDevice(&dev) != hipSuccess || hipDeviceGetAttribute(&cus, hipDeviceAttributeMultiprocessorCount, dev) != hipSuccess) { grid = -1; return; }
        if (hipFuncSetAttribute((const void*)fwd_kernel, hipFuncAttributeMaxDynamicSharedMemorySize, LDS_BYTES) != hipSuccess) { fprintf(stderr, "kernel_launch: hipFuncSetAttribute failed\n"); grid = -1; return; }
        if (hipOccupancyMaxActiveBlocksPerMultiprocessor(&per_cu, (const void*)fwd_kernel, NWAVES * 64, LDS_BYTES) != hipSuccess || per_cu < 1) { fprintf(stderr, "kernel_launch: occupancy query says %d\n", per_cu); (void)hipGetLastError(); grid = -1; return; }
        grid = cus;
    }
    if (grid < 0) return;
    if (hipMemsetAsync((char*)d_ws + WS_CTL, 0, CTL_ZERO_BYTES, stream) != hipSuccess) return;
    Args a{};
    const float** p = (const float**)&a;
    for (int i = 0; i < 24; ++i) p[i] = (const float*)d_in[i];
    a.out = (float*)d_out; a.ws = (unsigned char*)d_ws; a.ph_lo = 0; a.ph_hi = 13;
    hipLaunchKernelGGL(fwd_kernel, dim3(grid), dim3(NWAVES * 64), LDS_BYTES, stream, a);
    const hipError_t le = hipPeekAtLastError();
    if (le != hipSuccess) fprintf(stderr, "kernel_launch: launch failed: %s\n", hipGetErrorName(le));
}
```

```cpp
#include <hip/hip_runtime.h>
#include <cstdio>
#include <cstdint>

#define DI __device__ __forceinline__
#define LAS __attribute__((address_space(3)))
typedef unsigned short bf16;
typedef short bf16x8 __attribute__((ext_vector_type(8)));
typedef float f32x2 __attribute__((ext_vector_type(2)));
typedef float f32x4 __attribute__((ext_vector_type(4)));
typedef float f32x16 __attribute__((ext_vector_type(16)));
typedef unsigned u32x2 __attribute__((ext_vector_type(2)));
typedef unsigned u32x4 __attribute__((ext_vector_type(4)));
typedef __bf16 bf16x2_t __attribute__((ext_vector_type(2)));
typedef int i32x4 __attribute__((ext_vector_type(4)));

DI unsigned pk2(float lo, float hi) { f32x2 v = {lo, hi}; bf16x2_t b = __builtin_convertvector(v, bf16x2_t); return __builtin_bit_cast(unsigned, b); }
DI float bf2f(unsigned short b) { return __uint_as_float(((unsigned)b) << 16); }
DI float bflo(unsigned w) { return __uint_as_float(w << 16); }
DI float bfhi(unsigned w) { return __uint_as_float(w & 0xffff0000u); }
DI unsigned short f2bf(float f) { return (unsigned short)(pk2(f, 0.f) & 0xffffu); }
DI float wave_sum(float v) {
#pragma unroll
    for (int o = 1; o < 64; o <<= 1) v += __shfl_xor(v, o);
    return v;
}
DI float sigmoidf_(float x) { return __builtin_amdgcn_rcpf(1.0f + __expf(-x)); }
#define LDS_WAIT() asm volatile("s_waitcnt lgkmcnt(0)" ::: "memory")
#define VM_WAIT() asm volatile("s_waitcnt vmcnt(0)" ::: "memory")

constexpr int D = 2048, NTOK = 16384, NCTX = 256, MROWS = NTOK + NCTX;
constexpr int INC = 10496;
constexpr int C_AQ = 0, C_AK = 1024, C_AV = 1152, C_BQ = 1280, C_ZF = 2304, C_ZB = 3328, C_BV = 4352, C_BG = 5376, C_GA = 6400, C_GB = 8448;
constexpr int NEXP = 32, FF = 2048;
constexpr int MAXTILES = 288, MAXSLOTS = MAXTILES * 256;
constexpr float EPS = 1e-6f;
constexpr int NSEG = 33;
constexpr int NWAVES = 8;
#ifndef DUP0
#define DUP0 1
#endif
#ifndef DUP3
#define DUP3 1
#endif
#ifndef DUP4
#define DUP4 1
#endif
#ifndef DUP5
#define DUP5 1
#endif
#ifndef DUP2
#define DUP2 1
#endif
#ifndef DUP10
#define DUP10 1
#endif
#ifndef DUP11
#define DUP11 1
#endif
#ifndef DUP1
#define DUP1 1
#endif
#ifndef DUP12
#define DUP12 1
#endif

constexpr size_t MiB = 1u << 20;
constexpr size_t WS_CTL = 0, CTL_ZERO_BYTES = 1 * MiB;
constexpr size_t WS_SMALL = 1 * MiB;
constexpr size_t SM_MODL = 0, SM_MODC = 49152, SM_ROPE = 65536, SM_LB = 131072, SM_WRP = 262144, SM_CVEC = 524288, SM_TILE = 528384;
constexpr size_t WS_ROUTE = 2 * MiB;
constexpr size_t RT_E = 0, RT_G = 262144, RT_R = 524288, RT_S = 786432, RT_OFF = 1048576, RT_SG = 1048576 + 294912, RT_ARS = 1048576 + 2 * 294912;
static_assert(RT_ARS + (size_t)MAXSLOTS * 4 <= 2 * MiB, "route region");
constexpr size_t DL_CSD = 524288;
constexpr size_t WS_ACT8 = 1276 * MiB;
constexpr size_t WS_DLOG = 4 * MiB;
constexpr size_t WS_KR = 5 * MiB, WS_VT = 10 * MiB;
constexpr size_t WS_CS = 15 * MiB;
constexpr size_t CS_ROW = 524288, CS_SLOT = 524288 + 65536, CS_WIN = 917504, CS_HROW = 966656;
static_assert(CS_SLOT + (size_t)MAXSLOTS * 4 <= CS_WIN && CS_WIN + (size_t)INC * 4 <= CS_HROW && CS_HROW + (size_t)MROWS * 4 <= MiB, "scale arrays");
constexpr size_t WS_L = 16 * MiB;
constexpr size_t WS_WIN = 50 * MiB, WS_WM = 92 * MiB, WS_WO = 100 * MiB, WS_WGU = 108 * MiB, WS_WDN = 620 * MiB;
constexpr size_t WS_H = 876 * MiB, WS_PROJ = 942 * MiB, WS_ACT = WS_PROJ, WS_YAB = 1276 * MiB, WS_OSCR = 1340 * MiB, WS_MERGED = 1468 * MiB, WS_X1 = 1532 * MiB, WS_YS = 1660 * MiB, WS_END = 1948 * MiB;
constexpr size_t PO_AQ = 0, PO_AKV = PO_AQ + (size_t)16 * MROWS * 64, PO_BQ = PO_AKV + (size_t)MROWS * 256, PO_ZF = PO_BQ + (size_t)8 * MROWS * 128, PO_ZB = PO_ZF + (size_t)8 * MROWS * 128,
                 PO_BV = PO_ZB + (size_t)8 * MROWS * 128, PO_BG = PO_BV + (size_t)8 * MROWS * 128, PO_GA = PO_BG + (size_t)8 * MROWS * 128, PO_GB = PO_GA + (size_t)MROWS * 2048, PO_END = PO_GB + (size_t)MROWS * 2048;
static_assert(PO_END == (size_t)MROWS * INC, "projection layout");
static_assert(WS_L + (size_t)16 * NSEG * 65536 <= WS_WIN, "L");
static_assert(WS_PROJ + (size_t)MROWS * INC * 2 <= WS_YAB && WS_ACT + (size_t)MAXSLOTS * FF * 2 <= WS_YAB, "proj/act");
static_assert(WS_H + (size_t)MROWS * D * 2 <= WS_PROJ, "h");
constexpr int CW_BAR = 4096, CW_CNT = 8192, CW_Q = 9216;

constexpr int LDS_BYTES = 163840;
constexpr int MISC_OFF = 163840 - 256;

namespace pg8 {
constexpr int BM = 256, BK = 64, HALF = 128, HTB = HALF * BK * 2, STAGE_BYTES = 8 * HTB, NXCD = 8, WGM = 8;
__host__ __device__ __forceinline__ int lds_byte(int r, int c) { const int st = (r >> 4) * 2 + (c >> 5), rr = r & 15, cc = c & 31, ob = rr * 64 + cc * 2; return st * 1024 + (ob ^ (((ob >> 9) & 1) << 5)); }
__host__ __device__ __forceinline__ void stage_rc(int b, int& R, int& C) { const int st = b / 1024, sb = b % 1024, swz = sb ^ (((sb >> 9) & 1) << 5); R = (st >> 1) * 16 + swz / 64; C = (st & 1) * 32 + (swz % 64) / 2; }
__host__ __device__ __forceinline__ int perm32(int rho) { const int n = rho >> 4, i = rho & 15; return 8 * (i >> 2) + 4 * n + (i & 3); }

struct Unit { int pm, pn, e, brow; };
struct Gemm { const bf16* A; const bf16* Bt; int K; };

struct OrderBase {
    int nM, nN, nwg, G, c;
    DI void init(int nM_, int nN_, int G_, int c_) { nM = nM_; nN = nN_; nwg = nM * nN; G = G_; c = c_; }
    DI bool tile(int i, int& pm, int& pn) const {
        const long L = (long)i * G + c; if (L >= nwg) return false;
        int wgid = (int)L; { const int q = nwg / NXCD, r = nwg % NXCD, xcd = wgid % NXCD, off = wgid / NXCD; wgid = (xcd < r ? xcd * (q + 1) : r * (q + 1) + (xcd - r) * q) + off; }
        const int nig = WGM * nN, gid = wgid / nig, fm = gid * WGM, gsz = (nM - fm) < WGM ? (nM - fm) : WGM;
        pm = fm + ((wgid % nig) % gsz); pn = (wgid % nig) / gsz; return true;
    }
};
struct PlainOrder : OrderBase {
    int K2;
    DI bool next(int i, Unit& u) const { if (!tile(i, u.pm, u.pn)) return false; u.e = 0; u.brow = u.pn * BM; return true; }
    DI unsigned rowoff(const Unit& u, int r) const { return (unsigned)(u.pm * BM + r) * (unsigned)K2; }
};
template <bool GATHER> struct MoeOrder : OrderBase {
    int K2, nper;
    const int* texp; const unsigned* sroff;
    DI bool next(int i, Unit& u) const { if (!tile(i, u.pm, u.pn)) return false; u.e = texp[u.pm]; u.brow = u.e * nper + u.pn * BM; return true; }
    DI unsigned rowoff(const Unit& u, int r) const { if (GATHER) return sroff[u.pm * BM + r]; else return (unsigned)(u.pm * BM + r) * (unsigned)K2; }
};

template <class Epi, class Sched, bool I8 = false, bool ALIGN_EPI = true, bool SP2 = true>
__device__ __forceinline__ void gemm_phase(LAS unsigned char* lds, const Gemm g, const Sched& S, const Epi& E) {
    const int tid = threadIdx.x, wid = __builtin_amdgcn_readfirstlane(tid >> 6), lane = tid & 63, wr = wid >> 2, wc = wid & 3, fr = lane & 15, fq = lane >> 4;
    const int K = g.K, nt = K / BK;
    int stR[2]; unsigned stC2[2], voffB[2];
#pragma unroll
    for (int i = 0; i < 2; ++i) { int R, C; stage_rc(tid * 16 + i * 8192, R, C); const int Rb = Epi::PERM ? ((R & ~31) + perm32(R & 31)) : R;
        stR[i] = R; stC2[i] = (unsigned)C * 2u; voffB[i] = (unsigned)(Rb * K + C) * 2u; }
    const size_t kstep = (size_t)(BK * 2);
    const size_t hstep = (size_t)HALF * K * 2;
    const unsigned ldsw = (unsigned)wid * 1024u;
    const int aoffL = lds_byte(wr * 64 + fr, fq * 8), boffL = lds_byte(wc * 32 + fr, fq * 8);
#define PG8_SA(b, h) (((b) * 2 + (h)) * HTB)
#define PG8_SB(b, h) ((4 + (b) * 2 + (h)) * HTB)
#define PG8_STAGE(bufoff, gbase, voff) do { _Pragma("unroll") for (int _i = 0; _i < 2; ++_i) \
        __builtin_amdgcn_global_load_lds((const unsigned*)((const char*)(gbase) + (voff)[_i]), (LAS unsigned*)(lds + (bufoff) + ldsw + _i * 8192), 16, 0, 0); } while (0)
#define PG8_LDA(dst, b, h) do { _Pragma("unroll") for (int m = 0; m < 4; ++m) _Pragma("unroll") for (int k = 0; k < 2; ++k) dst[m][k] = *(const LAS bf16x8*)(lds + PG8_SA(b, h) + aoffL + m * 2048 + k * 1024); } while (0)
#define PG8_LDB(dst, b, h) do { _Pragma("unroll") for (int n = 0; n < 2; ++n) _Pragma("unroll") for (int k = 0; k < 2; ++k) dst[n][k] = *(const LAS bf16x8*)(lds + PG8_SB(b, h) + boffL + n * 2048 + k * 1024); } while (0)
#define PG8_MMA(ai, bj, At, Bt) do { __builtin_amdgcn_s_setprio(1); _Pragma("unroll") for (int m = 0; m < 4; ++m) _Pragma("unroll") for (int n = 0; n < 2; ++n) _Pragma("unroll") for (int k = 0; k < 2; ++k) \
        { if constexpr (I8) acc[ai][bj][m][n] = __builtin_bit_cast(f32x4, __builtin_amdgcn_mfma_i32_16x16x64_i8(__builtin_bit_cast(i32x4, Bt[n][k]), __builtin_bit_cast(i32x4, At[m][k]), __builtin_bit_cast(i32x4, acc[ai][bj][m][n]), 0, 0, 0)); \
          else acc[ai][bj][m][n] = __builtin_amdgcn_mfma_f32_16x16x32_bf16(Bt[n][k], At[m][k], acc[ai][bj][m][n], 0, 0, 0); } __builtin_amdgcn_s_setprio(0); } while (0)
#define PG8_WAIT_V(n) asm volatile("s_waitcnt vmcnt(" #n ")" ::: "memory")
#define PG8_WAIT_L(n) asm volatile("s_waitcnt lgkmcnt(" #n ")" ::: "memory")
#define PG8_BAR __builtin_amdgcn_s_barrier()
#define PG8_SCHED __builtin_amdgcn_sched_barrier(0)
    Unit cur, nxt; int ui = 0;
    if (!S.next(0, cur)) return;
    f32x4 acc[2][2][4][2];
#pragma unroll
    for (int a = 0; a < 2; ++a)
#pragma unroll
        for (int b = 0; b < 2; ++b)
#pragma unroll
            for (int m = 0; m < 4; ++m)
#pragma unroll
                for (int n = 0; n < 2; ++n) acc[a][b][m][n] = (f32x4){0.f, 0.f, 0.f, 0.f};
    bf16x8 At[4][2], B0[2][2], B1[2][2];
    unsigned ao0[2], ao1[2], no0[2], no1[2];
#pragma unroll
    for (int i = 0; i < 2; ++i) { ao0[i] = S.rowoff(cur, stR[i]) + stC2[i]; ao1[i] = S.rowoff(cur, HALF + stR[i]) + stC2[i]; no0[i] = ao0[i]; no1[i] = ao1[i]; }
    const char* Ab = (const char*)g.A;
    const char* cB = (const char*)g.Bt + (size_t)cur.brow * K * 2;
    if constexpr (SP2) {
        PG8_STAGE(PG8_SB(0, 0), cB, voffB); PG8_STAGE(PG8_SB(0, 1), cB + hstep, voffB); PG8_STAGE(PG8_SA(0, 0), Ab, ao0); PG8_STAGE(PG8_SA(0, 1), Ab, ao1);
        if (wr == 1) PG8_BAR;
        PG8_WAIT_V(2); PG8_BAR;
        PG8_STAGE(PG8_SB(1, 0), cB + kstep, voffB); PG8_STAGE(PG8_SA(1, 0), Ab + kstep, ao0); PG8_STAGE(PG8_SB(1, 1), cB + hstep + kstep, voffB);
        PG8_WAIT_V(6); PG8_BAR;
    } else {
        PG8_STAGE(PG8_SB(0, 0), cB, voffB); PG8_STAGE(PG8_SA(0, 0), Ab, ao0); PG8_STAGE(PG8_SB(0, 1), cB + hstep, voffB); PG8_STAGE(PG8_SA(0, 1), Ab, ao1);
        if (wr == 1) PG8_BAR;
        PG8_WAIT_V(4); PG8_BAR;
        PG8_STAGE(PG8_SB(1, 0), cB + kstep, voffB); PG8_STAGE(PG8_SA(1, 0), Ab + kstep, ao0); PG8_STAGE(PG8_SB(1, 1), cB + hstep + kstep, voffB);
        PG8_WAIT_V(6); PG8_BAR;
    }
    for (;;) {
        const bool has_next = S.next(ui + 1, nxt);
        if (has_next) {
#pragma unroll
            for (int i = 0; i < 2; ++i) { no0[i] = S.rowoff(nxt, stR[i]) + stC2[i]; no1[i] = S.rowoff(nxt, HALF + stR[i]) + stC2[i]; }
        }
        const char* nB = has_next ? (const char*)g.Bt + (size_t)nxt.brow * K * 2 : cB;
        for (int t = 0; t < nt; t += 2) {
            const bool last = (t == nt - 2);
            if constexpr (Epi::HOOK) { if (t == nt / 2) E.hook(acc, cur, wr, wc, fr, fq); }
            const char* a1 = Ab + (size_t)(t + 1) * kstep;
            const char* a2 = last ? Ab : Ab + (size_t)(t + 2) * kstep; const char* b2 = last ? nB : cB + (size_t)(t + 2) * kstep;
            const char* a3 = a2 + kstep; const char* b3 = b2 + kstep;
            unsigned x0[2], x1[2];
#pragma unroll
            for (int i = 0; i < 2; ++i) { x0[i] = last ? no0[i] : ao0[i]; x1[i] = last ? no1[i] : ao1[i]; }
            if constexpr (SP2) {
            PG8_LDB(B0, 0, 0); PG8_LDB(B1, 0, 1); PG8_SCHED; PG8_LDA(At, 0, 0); PG8_STAGE(PG8_SA(1, 1), a1, ao1);
            PG8_WAIT_V(8); PG8_WAIT_L(0); PG8_BAR; PG8_MMA(0, 0, At, B0); PG8_MMA(0, 1, At, B1); PG8_BAR; PG8_SCHED;
            PG8_LDA(At, 0, 1); PG8_STAGE(PG8_SB(0, 0), b2, voffB); PG8_STAGE(PG8_SB(0, 1), b2 + hstep, voffB); PG8_STAGE(PG8_SA(0, 0), a2, x0);
            PG8_WAIT_V(8); PG8_WAIT_L(0); PG8_BAR; PG8_MMA(1, 0, At, B0); PG8_MMA(1, 1, At, B1); PG8_BAR; PG8_SCHED;
            PG8_LDB(B0, 1, 0); PG8_LDB(B1, 1, 1); PG8_SCHED; PG8_LDA(At, 1, 0); PG8_STAGE(PG8_SA(0, 1), a2, x1);
            PG8_WAIT_V(8); PG8_WAIT_L(0); PG8_BAR; PG8_MMA(0, 0, At, B0); PG8_MMA(0, 1, At, B1); PG8_BAR; PG8_SCHED;
            PG8_LDA(At, 1, 1); PG8_STAGE(PG8_SB(1, 0), b3, voffB); PG8_STAGE(PG8_SB(1, 1), b3 + hstep, voffB); PG8_STAGE(PG8_SA(1, 0), a3, x0);
            PG8_WAIT_V(8); PG8_WAIT_L(0); PG8_BAR; PG8_MMA(1, 0, At, B0); PG8_MMA(1, 1, At, B1); PG8_BAR; PG8_SCHED;
            } else {
            PG8_LDB(B0, 0, 0); PG8_SCHED; PG8_LDA(At, 0, 0); PG8_STAGE(PG8_SA(1, 1), a1, ao1);
            PG8_WAIT_L(8); PG8_BAR; PG8_WAIT_L(0); PG8_MMA(0, 0, At, B0); PG8_BAR; PG8_SCHED;
            PG8_LDB(B1, 0, 1); PG8_STAGE(PG8_SB(0, 0), b2, voffB);
            PG8_BAR; PG8_WAIT_L(0); PG8_MMA(0, 1, At, B1); PG8_BAR;
            PG8_LDA(At, 0, 1); PG8_STAGE(PG8_SA(0, 0), a2, x0);
            PG8_BAR; PG8_WAIT_L(0); PG8_MMA(1, 0, At, B0); PG8_BAR; PG8_SCHED;
            PG8_STAGE(PG8_SB(0, 1), b2 + hstep, voffB);
            PG8_WAIT_V(6); PG8_BAR; PG8_MMA(1, 1, At, B1); PG8_BAR;
            PG8_LDB(B0, 1, 0); PG8_SCHED; PG8_LDA(At, 1, 0); PG8_STAGE(PG8_SA(0, 1), a2, x1);
            PG8_WAIT_L(8); PG8_BAR; PG8_WAIT_L(0); PG8_MMA(0, 0, At, B0); PG8_BAR; PG8_SCHED;
            PG8_LDB(B1, 1, 1); PG8_STAGE(PG8_SB(1, 0), b3, voffB);
            PG8_BAR; PG8_WAIT_L(0); PG8_MMA(0, 1, At, B1); PG8_BAR;
            PG8_LDA(At, 1, 1); PG8_STAGE(PG8_SA(1, 0), a3, x0);
            PG8_BAR; PG8_WAIT_L(0); PG8_MMA(1, 0, At, B0); PG8_BAR; PG8_SCHED;
            PG8_STAGE(PG8_SB(1, 1), b3 + hstep, voffB);
            PG8_WAIT_V(6); PG8_BAR; PG8_MMA(1, 1, At, B1); PG8_BAR;
            }
        }
        if constexpr (ALIGN_EPI) { if (wr == 0) PG8_BAR; }
        E(acc, cur, wr, wc, fr, fq);
        if (!has_next) break;
#pragma unroll
        for (int a = 0; a < 2; ++a)
#pragma unroll
            for (int b = 0; b < 2; ++b)
#pragma unroll
                for (int m = 0; m < 4; ++m)
#pragma unroll
                    for (int n = 0; n < 2; ++n) acc[a][b][m][n] = (f32x4){0.f, 0.f, 0.f, 0.f};
        cur = nxt; cB = nB; ++ui;
#pragma unroll
        for (int i = 0; i < 2; ++i) { ao0[i] = no0[i]; ao1[i] = no1[i]; }
        if constexpr (ALIGN_EPI) { if (wr == 1) PG8_BAR; }
    }
    PG8_WAIT_V(0);
    if constexpr (!ALIGN_EPI) { if (wr == 0) PG8_BAR; }
    PG8_BAR;
#undef PG8_SA
#undef PG8_SB
#undef PG8_STAGE
#undef PG8_LDA
#undef PG8_LDB
#undef PG8_MMA
#undef PG8_WAIT_V
#undef PG8_WAIT_L
#undef PG8_BAR
#undef PG8_SCHED
}
}

using pg8::Unit; using pg8::HALF; using pg8::BM;
struct EpiProj {
    static constexpr bool PERM = true, HOOK = false;
    bf16* P; const float* lbf; const float* lbb; const float* hrs; const float* wcs;
    DI void hook(f32x4 (&)[2][2][4][2], const Unit&, int, int, int, int) const {}
    DI void operator()(const f32x4 (&acc)[2][2][4][2], const Unit& u, int wr, int wc, int fr, int fq) const {
        const int pn = u.pn; int cls, cbase, hs, pitch; size_t po; const float* lb = lbf;
        if (pn < 4)       { cls = 0; cbase = C_AQ; po = PO_AQ;  hs = 6;  pitch = 64; }
        else if (pn < 5)  { cls = 0; cbase = C_AK; po = PO_AKV; hs = 30; pitch = 256; }
        else if (pn < 9)  { cls = 1; cbase = C_BQ; po = PO_BQ;  hs = 7;  pitch = 128; }
        else if (pn < 13) { cls = 2; cbase = C_ZF; po = PO_ZF;  hs = 7;  pitch = 128; }
        else if (pn < 17) { cls = 2; cbase = C_ZB; po = PO_ZB;  hs = 7;  pitch = 128; lb = lbb; }
        else if (pn < 21) { cls = 0; cbase = C_BV; po = PO_BV;  hs = 7;  pitch = 128; }
        else if (pn < 25) { cls = 1; cbase = C_BG; po = PO_BG;  hs = 7;  pitch = 128; }
        else if (pn < 33) { cls = 3; cbase = C_GA; po = PO_GA;  hs = 30; pitch = 2048; }
        else              { cls = 3; cbase = C_GB; po = PO_GB;  hs = 30; pitch = 2048; }
        int zz = 0; asm volatile("" : "+v"(zz));
        const int row0 = u.pm * BM + wr * 64 + fr + zz, cin0 = u.pn * BM + wc * 32 + 8 * fq - cbase;
        bf16* base = P + po;
#pragma unroll
        for (int bj = 0; bj < 2; ++bj) {
            float lbv[8];
            const int cin = cin0 + bj * HALF;
            { const int ci = (cls == 2) ? cin : 0; const f32x4 a = *(const f32x4*)(lb + ci), b = *(const f32x4*)(lb + ci + 4);
#pragma unroll
              for (int j = 0; j < 4; ++j) { lbv[j] = (cls == 2) ? a[j] : 0.f; lbv[4 + j] = (cls == 2) ? b[j] : 0.f; } }
            bf16* colp = base + (size_t)(cin >> hs) * MROWS * pitch + (cin & ((1 << hs) - 1));
            float csv[8];
            { const f32x4 a = *(const f32x4*)(wcs + cin + cbase), b = *(const f32x4*)(wcs + cin + cbase + 4);
#pragma unroll
              for (int j = 0; j < 4; ++j) { csv[j] = a[j]; csv[4 + j] = b[j]; } }
#pragma unroll
            for (int ai = 0; ai < 2; ++ai)
#pragma unroll
                for (int m = 0; m < 4; ++m) { const int rr = row0 + ai * HALF + m * 16; const size_t ro = (size_t)rr * pitch; float v[8]; const float rs = hrs[rr];
#pragma unroll
                    for (int j = 0; j < 8; ++j) v[j] = (float)__builtin_bit_cast(i32x4, acc[ai][bj][m][j >> 2])[j & 3] * (rs * csv[j]);
                    if (cls != 0) {
#pragma unroll
                        for (int j = 0; j < 8; ++j) { const float sg = sigmoidf_(v[j]); v[j] = (cls == 1) ? v[j] * sg : sg; }
                        if (cls == 2) {
#pragma unroll
                            for (int j = 0; j < 8; ++j) { const float l = lbv[j]; v[j] = __logf(l + (1.0f - l) * v[j]); } }
                    }
                    u32x4 w; w.x = pk2(v[0], v[1]); w.y = pk2(v[2], v[3]); w.z = pk2(v[4], v[5]); w.w = pk2(v[6], v[7]);
                    *(u32x4*)(colp + ro) = w; }
        }
    }
};
struct EpiMerge {
    static constexpr bool PERM = true, HOOK = true;
    bf16* O; const bf16* proj;
    DI void hook(f32x4 (&acc)[2][2][4][2], const Unit& u, int wr, int wc, int fr, int fq) const {
        int zz = 0; asm volatile("" : "+v"(zz));
        const int row0 = u.pm * BM + wr * 64 + fr + zz, col0 = u.pn * BM + wc * 32 + 8 * fq;
#pragma unroll
        for (int ai = 0; ai < 2; ++ai)
#pragma unroll
            for (int m = 0; m < 4; ++m) { const size_t rowp = (size_t)(row0 + ai * HALF + m * 16) * D + col0;
#pragma unroll
                for (int bj = 0; bj < 2; ++bj) { const u32x4 ga = *(const u32x4*)(proj + PO_GA + rowp + bj * HALF), gb = *(const u32x4*)(proj + PO_GB + rowp + bj * HALF);
#pragma unroll
                    for (int q = 0; q < 4; ++q) { const float r0 = bflo(ga[q]) * __builtin_amdgcn_rcpf(bflo(gb[q])), r1 = bfhi(ga[q]) * __builtin_amdgcn_rcpf(bfhi(gb[q]));
                        acc[ai][bj][m][q >> 1][(q & 1) * 2] *= r0; acc[ai][bj][m][q >> 1][(q & 1) * 2 + 1] *= r1; } }
                asm volatile("" ::: "memory"); }
    }
    DI void operator()(const f32x4 (&acc)[2][2][4][2], const Unit& u, int wr, int wc, int fr, int fq) const {
        const int row0 = u.pm * BM + wr * 64 + fr, col0 = u.pn * BM + wc * 32 + 8 * fq;
#pragma unroll
        for (int ai = 0; ai < 2; ++ai)
#pragma unroll
            for (int m = 0; m < 4; ++m) { const size_t r = (size_t)(row0 + ai * HALF + m * 16);
#pragma unroll
                for (int bj = 0; bj < 2; ++bj) { const u32x4 gb = *(const u32x4*)(proj + PO_GB + r * D + col0 + bj * HALF); u32x4 w;
#pragma unroll
                    for (int q = 0; q < 4; ++q) w[q] = pk2(acc[ai][bj][m][q >> 1][(q & 1) * 2] * bflo(gb[q]), acc[ai][bj][m][q >> 1][(q & 1) * 2 + 1] * bfhi(gb[q]));
                    *(u32x4*)(O + r * D + col0 + bj * HALF) = w; } }
    }
};
struct EpiOut {
    static constexpr bool PERM = false, HOOK = false;
    float* X1; const float* x; const float* mod2;
    DI void hook(f32x4 (&)[2][2][4][2], const Unit&, int, int, int, int) const {}
    DI void operator()(const f32x4 (&acc)[2][2][4][2], const Unit& u, int wr, int wc, int fr, int fq) const {
        const int row0 = u.pm * BM + wr * 64 + fr, col0 = u.pn * BM + wc * 32 + 4 * fq;
        f32x4 mv[2][2];
#pragma unroll
        for (int bj = 0; bj < 2; ++bj)
#pragma unroll
            for (int n = 0; n < 2; ++n) mv[bj][n] = *(const f32x4*)(mod2 + col0 + bj * HALF + n * 16);
#pragma unroll
        for (int ai = 0; ai < 2; ++ai)
#pragma unroll
            for (int m = 0; m < 4; ++m) { const size_t off = (size_t)(row0 + ai * HALF + m * 16) * D + col0;
#pragma unroll
                for (int bj = 0; bj < 2; ++bj)
#pragma unroll
                    for (int n = 0; n < 2; ++n) { const f32x4 xv = *(const f32x4*)(x + off + bj * HALF + n * 16);
                        *(f32x4*)(X1 + off + bj * HALF + n * 16) = xv + mv[bj][n] * acc[ai][bj][m][n]; } }
    }
};
struct EpiAct {
    static constexpr bool PERM = true, HOOK = false;
    bf16* ACTp; const float* bg; const float* bu; const float* cs; const float* srs;
    DI void hook(f32x4 (&)[2][2][4][2], const Unit&, int, int, int, int) const {}
    DI void operator()(const f32x4 (&acc)[2][2][4][2], const Unit& u, int wr, int wc, int fr, int fq) const {
        int zz = 0; asm volatile("" : "+v"(zz));
        const int row0 = u.pm * BM + wr * 64 + fr + zz, col0 = u.pn * HALF + wc * 32 + 8 * fq, nb = u.e * 4096 + u.pn * BM + wc * 32 + 8 * fq;
        float gbv[8], ubv[8], gsc[8], usc[8];
        { const f32x4 a = *(const f32x4*)(bg + u.e * FF + col0), b = *(const f32x4*)(bg + u.e * FF + col0 + 4), c = *(const f32x4*)(bu + u.e * FF + col0), d = *(const f32x4*)(bu + u.e * FF + col0 + 4);
          const f32x4 sa = *(const f32x4*)(cs + nb), sb = *(const f32x4*)(cs + nb + 4), sc = *(const f32x4*)(cs + nb + HALF), sd = *(const f32x4*)(cs + nb + HALF + 4);
#pragma unroll
          for (int j = 0; j < 4; ++j) { gbv[j] = a[j]; gbv[4 + j] = b[j]; ubv[j] = c[j]; ubv[4 + j] = d[j]; gsc[j] = sa[j]; gsc[4 + j] = sb[j]; usc[j] = sc[j]; usc[4 + j] = sd[j]; } }
#pragma unroll
        for (int ai = 0; ai < 2; ++ai)
#pragma unroll
            for (int m = 0; m < 4; ++m) { float v[8]; const int r = row0 + ai * HALF + m * 16; const float rs = srs[r];
#pragma unroll
                for (int j = 0; j < 8; ++j) { const i32x4 ga = __builtin_bit_cast(i32x4, acc[ai][0][m][j >> 2]), ua = __builtin_bit_cast(i32x4, acc[ai][1][m][j >> 2]);
                    float gg = (float)ga[j & 3] * (rs * gsc[j]) + gbv[j], uu = (float)ua[j & 3] * (rs * usc[j]) + ubv[j];
                    gg = fminf(gg, 7.0f); uu = fminf(fmaxf(uu, -7.0f), 7.0f);
                    v[j] = gg * sigmoidf_(1.702f * gg) * (uu + 1.0f); }
                u32x4 w; w.x = pk2(v[0], v[1]); w.y = pk2(v[2], v[3]); w.z = pk2(v[4], v[5]); w.w = pk2(v[6], v[7]);
                *(u32x4*)(ACTp + (size_t)r * FF + col0) = w; }
    }
};
struct EpiDown {
    static constexpr bool PERM = true, HOOK = false;
    bf16* YSp; const float* bd; const float* sgate; const float* ars; const float* csd;
    DI void hook(f32x4 (&)[2][2][4][2], const Unit&, int, int, int, int) const {}
    DI void operator()(const f32x4 (&acc)[2][2][4][2], const Unit& u, int wr, int wc, int fr, int fq) const {
        int zz = 0; asm volatile("" : "+v"(zz));
        const int row0 = u.pm * BM + wr * 64 + fr + zz, col0 = u.pn * BM + wc * 32 + 8 * fq;
#pragma unroll
        for (int bj = 0; bj < 2; ++bj) { float bv[8], cv[8];
            { const f32x4 a = *(const f32x4*)(bd + u.e * D + col0 + bj * HALF), b = *(const f32x4*)(bd + u.e * D + col0 + bj * HALF + 4), c = *(const f32x4*)(csd + u.e * D + col0 + bj * HALF), d = *(const f32x4*)(csd + u.e * D + col0 + bj * HALF + 4);
#pragma unroll
              for (int j = 0; j < 4; ++j) { bv[j] = a[j]; bv[4 + j] = b[j]; cv[j] = c[j]; cv[4 + j] = d[j]; } }
#pragma unroll
            for (int ai = 0; ai < 2; ++ai)
#pragma unroll
                for (int m = 0; m < 4; ++m) { const int r = row0 + ai * HALF + m * 16; const float gt = sgate[r], rs = ars[r]; u32x4 w;
#pragma unroll
                    for (int q = 0; q < 4; ++q) { const i32x4 ia = __builtin_bit_cast(i32x4, acc[ai][bj][m][q >> 1]);
                        w[q] = pk2(((float)ia[(q & 1) * 2] * (rs * cv[2 * q]) + bv[2 * q]) * gt, ((float)ia[(q & 1) * 2 + 1] * (rs * cv[2 * q + 1]) + bv[2 * q + 1]) * gt); }
                    *(u32x4*)(YSp + (size_t)r * D + col0 + bj * HALF) = w; } }
    }
};

#define XB_TMO      128
#define XB_XCNT(j)  (256  + 64 * (j))
#define XB_XSUB(j)  (1280 + 64 * (j))
#define XB_XGEN(j)  (2304 + 64 * (j))
#define XB_TOP      3328
#define XB_TOPGEN   3392
#define XCD_BAR_WORDS 3456
#define XB_SPIN_CAP (1u << 22)
DI unsigned xb_ld(unsigned* p)              { return __hip_atomic_load(p, __ATOMIC_RELAXED, __HIP_MEMORY_SCOPE_AGENT); }
DI unsigned xb_add(unsigned* p, unsigned v) { return __hip_atomic_fetch_add(p, v, __ATOMIC_RELAXED, __HIP_MEMORY_SCOPE_AGENT); }
DI unsigned xb_xcc_id() { return (unsigned)__builtin_amdgcn_s_getreg((3 << 11) | 20) & 0xFu; }
#define XB_SPIN(cond, bar) do { unsigned _sp = 0; while (cond) { __builtin_amdgcn_s_sleep(1); \
    if ((++_sp & 255u) == 0u) { if (xb_ld(&(bar)[XB_TMO])) break; if (_sp > XB_SPIN_CAP) { atomicAdd(&(bar)[XB_TMO], 1u); break; } } } } while (0)
struct XcdBarrier { unsigned* bar; unsigned x; volatile LAS unsigned* st; };
DI XcdBarrier xcd_barrier_post(unsigned* bar, volatile LAS unsigned* st) {
    XcdBarrier b; b.bar = bar; b.x = xb_xcc_id(); b.st = st;
    if (threadIdx.x == 0) (void)xb_add(&bar[XB_XCNT(b.x)], 1u);
    return b;
}
DI void xcd_barrier_complete(unsigned* bar, unsigned x, unsigned& nloc, unsigned& nx) {
    const unsigned G = gridDim.x * gridDim.y * gridDim.z;
    unsigned sum, cnt, mine, sp = 0u;
    for (;;) {
        sum = 0u; cnt = 0u; mine = 0u;
#pragma unroll
        for (unsigned j = 0; j < 16; ++j) { const unsigned c = xb_ld(&bar[XB_XCNT(j)]); sum += c; cnt += (c > 0u) ? 1u : 0u; mine = (j == x) ? c : mine; }
        if (sum == G) break;
        __builtin_amdgcn_s_sleep(1);
        if ((++sp & 255u) == 0u) { if (xb_ld(&bar[XB_TMO])) break; if (sp > XB_SPIN_CAP) { atomicAdd(&bar[XB_TMO], 1u); break; } }
    }
    nloc = mine > 0u ? mine : 1u; nx = cnt > 0u ? cnt : 1u;
}
DI void xcd_barrier(const XcdBarrier& b) {
    asm volatile("s_waitcnt vmcnt(0)" ::: "memory");
    __syncthreads();
    if (threadIdx.x == 0) {
        unsigned* bar = b.bar;
        __builtin_amdgcn_s_waitcnt(0);
        unsigned nloc = b.st[0], nx = b.st[1];
        if (nloc == 0u) { xcd_barrier_complete(bar, b.x, nloc, nx); b.st[0] = nloc; b.st[1] = nx; }
        const unsigned old = xb_add(&bar[XB_XSUB(b.x)], 1u);
        const unsigned gen = old / nloc;
        if (old + 1u == (gen + 1u) * nloc) {
            __builtin_amdgcn_fence(__ATOMIC_RELEASE, "agent");
            asm volatile("s_waitcnt vmcnt(0)" ::: "memory");
            const unsigned og = xb_add(&bar[XB_TOP], 1u);
            const unsigned tg = og / nx;
            if (og + 1u == (tg + 1u) * nx) xb_add(&bar[XB_TOPGEN], 1u);
            else XB_SPIN(xb_ld(&bar[XB_TOPGEN]) == tg, bar);
            __builtin_amdgcn_fence(__ATOMIC_ACQUIRE, "agent");
            xb_add(&bar[XB_XGEN(b.x)], 1u);
            asm volatile("s_waitcnt vmcnt(0)" ::: "memory");
        } else {
            XB_SPIN(xb_ld(&bar[XB_XGEN(b.x)]) == gen, bar);
            __builtin_amdgcn_fence(__ATOMIC_ACQUIRE, "agent");
            asm volatile("s_waitcnt vmcnt(0)" ::: "memory");
        }
    }
    __syncthreads();
}

struct Args {
    const float *x, *c, *ctx, *c_ctx, *norm_mix_g, *norm_ffn_g, *w_mod, *b_mod, *w_in, *sinks, *lbf_logits, *lbb_logits, *hgrn_g, *w_branch, *w_out,
                *w_router, *b_router, *w_e_gate, *b_e_gate, *w_e_up, *b_e_up, *w_e_down, *b_e_down, *final_g;
    float* out; unsigned char* ws; int ph_lo, ph_hi;
};

DI void p0_transpose64(const float* W, int ldw, bf16* WT, int ldt, LAS unsigned char* scr, int lane) {
    const int kq = lane >> 4, n4 = lane & 15;
    f32x4 v[16];
#pragma unroll
    for (int i = 0; i < 16; ++i) v[i] = *(const f32x4*)(W + (size_t)(16 * kq + i) * ldw + 4 * n4);
#pragma unroll
    for (int c = 0; c < 4; ++c)
#pragma unroll
        for (int h = 0; h < 2; ++h) { u32x4 w; w.x = pk2(v[8 * h][c], v[8 * h + 1][c]); w.y = pk2(v[8 * h + 2][c], v[8 * h + 3][c]); w.z = pk2(v[8 * h + 4][c], v[8 * h + 5][c]); w.w = pk2(v[8 * h + 6][c], v[8 * h + 7][c]);
            *(LAS u32x4*)(scr + (4 * n4 + c) * 144 + (16 * kq + 8 * h) * 2) = w; }
    LDS_WAIT(); asm volatile("" ::: "memory");
#pragma unroll
    for (int j = 0; j < 8; ++j) { const int row = (lane >> 3) + 8 * j, pc = lane & 7; const u32x4 o = *(const LAS u32x4*)(scr + row * 144 + pc * 16); *(u32x4*)(WT + (size_t)row * ldt + pc * 8) = o; }
    LDS_WAIT(); asm volatile("" ::: "memory");
}
DI void p0_quant_item(const float* W  , int ldw, signed char* Q  , float* csp  , LAS unsigned char* lds, int tid) {
    const int lane = tid & 63, w = tid >> 6, n4 = lane & 7, kr = lane >> 3;
    LAS float* smax = (LAS float*)(lds + 32 * 2064);
    f32x4 v[8][4]; f32x4 mx = {0.f, 0.f, 0.f, 0.f};
#pragma unroll
    for (int g = 0; g < 8; ++g)
#pragma unroll
        for (int r = 0; r < 4; ++r) { v[g][r] = *(const f32x4*)(W + (size_t)(256 * g + 32 * w + 4 * kr + r) * ldw + 4 * n4);
            mx[0] = fmaxf(mx[0], fabsf(v[g][r][0])); mx[1] = fmaxf(mx[1], fabsf(v[g][r][1])); mx[2] = fmaxf(mx[2], fabsf(v[g][r][2])); mx[3] = fmaxf(mx[3], fabsf(v[g][r][3])); }
#pragma unroll
    for (int c = 0; c < 4; ++c) { float m = mx[c]; m = fmaxf(m, __shfl_xor(m, 8)); m = fmaxf(m, __shfl_xor(m, 16)); m = fmaxf(m, __shfl_xor(m, 32)); mx[c] = m; }
    __syncthreads();
    if (kr == 0) *(LAS f32x4*)(smax + w * 32 + 4 * n4) = mx;
    __syncthreads();
    f32x4 cm = *(const LAS f32x4*)(smax + 4 * n4);
#pragma unroll
    for (int ww = 1; ww < 8; ++ww) { const f32x4 o = *(const LAS f32x4*)(smax + ww * 32 + 4 * n4); cm[0] = fmaxf(cm[0], o[0]); cm[1] = fmaxf(cm[1], o[1]); cm[2] = fmaxf(cm[2], o[2]); cm[3] = fmaxf(cm[3], o[3]); }
    f32x4 inv;
#pragma unroll
    for (int c = 0; c < 4; ++c) { if (cm[c] == 0.f) cm[c] = 1.f; inv[c] = 127.0f / cm[c]; }
    if (w == 0 && kr == 0) { f32x4 sc; sc[0] = cm[0] * (1.0f / 127.0f); sc[1] = cm[1] * (1.0f / 127.0f); sc[2] = cm[2] * (1.0f / 127.0f); sc[3] = cm[3] * (1.0f / 127.0f); *(f32x4*)(csp + 4 * n4) = sc; }
#pragma unroll
    for (int g = 0; g < 8; ++g)
#pragma unroll
        for (int c = 0; c < 4; ++c) { unsigned pk = 0u;
#pragma unroll
            for (int r = 0; r < 4; ++r) { const int q = (int)rintf(v[g][r][c] * inv[c]); pk |= ((unsigned)q & 0xffu) << (8 * r); }
            *(LAS unsigned*)(lds + (4 * n4 + c) * 2064 + 4 * (64 * g + 8 * w + kr)) = pk; }
    __syncthreads();
#pragma unroll
    for (int i = 0; i < 8; ++i) { const int p = tid + 512 * i, row = p >> 7, pc = p & 127; const u32x4 o = *(const LAS u32x4*)(lds + row * 2064 + pc * 16); *(u32x4*)(Q + (size_t)row * 2048 + pc * 16) = o; }
}

constexpr int SC_QH = 0, SC_KH = 8448, SC_KT = 16896, SC_VT = 26112, SC_FAC = 35328, SC_RZ = 35840, SC_RV = 44032, SC_RQ = 52224, SC_GRP = 60416;
constexpr int RSQ = 264, RST = 72;
DI int crow(int i, int h) { return (i & 3) + 8 * (i >> 2) + 4 * h; }
DI bf16x8 pack8(float a0, float a1, float a2, float a3, float a4, float a5, float a6, float a7) {
    u32x4 p; p.x = pk2(a0, a1); p.y = pk2(a2, a3); p.z = pk2(a4, a5); p.w = pk2(a6, a7); return __builtin_bit_cast(bf16x8, p);
}
DI bf16x8 lds_frag2(const LAS unsigned char* p0, const LAS unsigned char* p1) {
    const u32x2 lo = *(const LAS u32x2*)p0, hi = *(const LAS u32x2*)p1; u32x4 v; v.x = lo.x; v.y = lo.y; v.z = hi.x; v.w = hi.y; return __builtin_bit_cast(bf16x8, v);
}
#define MFMA32(a, b, c) __builtin_amdgcn_mfma_f32_32x32x16_bf16((a), (b), (c), 0, 0, 0)

template <bool OUT>
DI void scan_segment(LAS unsigned char* ldsb, const bf16* proj, int hh, int segF, int segB, float* Lbuf, float* Dlog, bf16* oscr) {
    const int tid = threadIdx.x, lane = tid & 63, wave = __builtin_amdgcn_readfirstlane(tid >> 6);
    const int dir = wave >> 2, w4 = wave & 3, half = w4 >> 1, d = tid & 127, r = lane & 31, h5 = lane >> 5, e0 = 32 * w4;
    const int seg = dir ? segB : segF, scan = dir * 8 + hh;
    const int ntok = (seg == 0) ? NCTX : 512, sgn = dir ? -1 : 1;
    const int r0 = (seg == 0) ? (dir ? MROWS - 1 : NTOK) : (dir ? NTOK - 1 - (seg - 1) * 512 : (seg - 1) * 512);
    LAS unsigned char* G = ldsb + dir * SC_GRP;
    LAS unsigned char* QH = G + SC_QH; LAS unsigned char* KH = G + SC_KH; LAS unsigned char* KT = G + SC_KT; LAS unsigned char* VT = G + SC_VT; LAS float* FAC = (LAS float*)(G + SC_FAC);
    float* Lslot = Lbuf + (size_t)(scan * NSEG + seg) * 16384;
    f32x16 acc[4];
    if (OUT) {
        const float* Sin = Lbuf + (size_t)(scan * NSEG + seg - 1) * 16384;
#pragma unroll
        for (int dt = 0; dt < 4; ++dt)
#pragma unroll
            for (int i = 0; i < 16; ++i) acc[dt][i] = Sin[(32 * dt + crow(i, h5)) * 128 + e0 + r];
    } else {
#pragma unroll
        for (int dt = 0; dt < 4; ++dt)
#pragma unroll
            for (int i = 0; i < 16; ++i) acc[dt][i] = 0.f;
    }
    float tail_prev = 0.f, dlog_tot = 0.f;
    const bf16* zsrc = proj + (dir ? PO_ZB : PO_ZF) + (size_t)hh * MROWS * 128; const bf16* vsrc = proj + PO_BV + (size_t)hh * MROWS * 128; const bf16* qsrc = proj + PO_BQ + (size_t)hh * MROWS * 128;
    const int nch = ntok / 32;
    LAS unsigned char* RZ = G + SC_RZ; LAS unsigned char* RV = G + SC_RV; LAS unsigned char* RQ = G + SC_RQ;
#define SC_DMA(cc) do { const int rb_ = r0 + sgn * 32 * (cc); \
        _Pragma("unroll") for (int i_ = 0; i_ < 2; ++i_) { const int s_ = 8 * w4 + 4 * i_ + (lane >> 4); const size_t so_ = (size_t)(rb_ + sgn * s_) * 128 + 8 * (lane & 15); \
            __builtin_amdgcn_global_load_lds((const unsigned*)(zsrc + so_), (LAS unsigned*)(RZ + (8 * w4 + 4 * i_) * 256), 16, 0, 0); \
            __builtin_amdgcn_global_load_lds((const unsigned*)(vsrc + so_), (LAS unsigned*)(RV + (8 * w4 + 4 * i_) * 256), 16, 0, 0); \
            if (OUT) __builtin_amdgcn_global_load_lds((const unsigned*)(qsrc + so_), (LAS unsigned*)(RQ + (8 * w4 + 4 * i_) * 256), 16, 0, 0); } } while (0)
    SC_DMA(0);
    for (int c = 0; c < nch; ++c) {
        const int rb = r0 + sgn * 32 * c;
        if (OUT && c > 0) asm volatile("s_waitcnt vmcnt(4)" ::: "memory"); else asm volatile("s_waitcnt vmcnt(0)" ::: "memory");
        asm volatile("s_waitcnt lgkmcnt(0)" ::: "memory"); __builtin_amdgcn_s_barrier(); asm volatile("" ::: "memory");
        float rsum = 0.f, lf[16], vv[16], qq[16];
        if (half) {
#pragma unroll
            for (int s = 0; s < 16; ++s) rsum += bf2f(*(const LAS unsigned short*)(RZ + s * 256 + d * 2));
        }
#pragma unroll
        for (int i = 0; i < 16; ++i) { const int so = (16 * half + i) * 256 + d * 2;
            lf[i] = bf2f(*(const LAS unsigned short*)(RZ + so)); vv[i] = bf2f(*(const LAS unsigned short*)(RV + so)); if (OUT) qq[i] = bf2f(*(const LAS unsigned short*)(RQ + so)); }
        if (!half) {
#pragma unroll
            for (int i = 0; i < 16; ++i) rsum += lf[i];
        }
        float b = half ? rsum : 0.f, kh[16], qh[16];
#pragma unroll
        for (int i = 0; i < 16; ++i) { b += lf[i]; const float x = b - rsum;
            kh[i] = (1.0f - __expf(lf[i])) * __expf(fminf(-x, 60.f));
            if (OUT) qh[i] = qq[i] * __expf(fminf(x, 60.f)); }
        const float tail = b - rsum;
#pragma unroll
        for (int j = 0; j < 4; ++j) {
            u32x2 w; w.x = pk2(kh[4 * j], kh[4 * j + 1]); w.y = pk2(kh[4 * j + 2], kh[4 * j + 3]); *(LAS u32x2*)(KT + d * RST + 32 * half + 8 * j) = w;
            u32x2 v; v.x = pk2(vv[4 * j], vv[4 * j + 1]); v.y = pk2(vv[4 * j + 2], vv[4 * j + 3]); *(LAS u32x2*)(VT + d * RST + 32 * half + 8 * j) = v;
        }
        if (OUT) {
#pragma unroll
            for (int i = 0; i < 16; ++i) { const int s = 16 * half + i;
                *(LAS unsigned short*)(KH + s * RSQ + d * 2) = f2bf(kh[i]); *(LAS unsigned short*)(QH + s * RSQ + d * 2) = f2bf(qh[i]); }
        }
        if (half) { FAC[d] = __expf(tail_prev + rsum); tail_prev = tail; dlog_tot += rsum + tail; }
        asm volatile("s_waitcnt lgkmcnt(0)" ::: "memory"); __builtin_amdgcn_s_barrier(); asm volatile("" ::: "memory");
        if (c + 1 < nch) SC_DMA(c + 1);
        asm volatile("" ::: "memory");
#pragma unroll
        for (int dt = 0; dt < 4; ++dt)
#pragma unroll
            for (int g4 = 0; g4 < 4; ++g4) { const f32x4 f = *(const LAS f32x4*)(FAC + 32 * dt + 8 * g4 + 4 * h5);
#pragma unroll
                for (int j = 0; j < 4; ++j) acc[dt][4 * g4 + j] *= f[j]; }
        if (OUT) {
            bf16x8 qf[8];
            f32x16 pT, oT;
#pragma unroll
            for (int i = 0; i < 16; ++i) { pT[i] = 0.f; oT[i] = 0.f; }
#pragma unroll
            for (int kk = 0; kk < 8; ++kk) {
                qf[kk] = lds_frag2(QH + r * RSQ + (16 * kk + 4 * h5) * 2, QH + r * RSQ + (16 * kk + 8 + 4 * h5) * 2);
                const bf16x8 kf = lds_frag2(KH + r * RSQ + (16 * kk + 4 * h5) * 2, KH + r * RSQ + (16 * kk + 8 + 4 * h5) * 2);
                pT = MFMA32(kf, qf[kk], pT);
            }
#pragma unroll
            for (int i = 0; i < 16; ++i) if (crow(i, h5) > r) pT[i] = 0.f;
#pragma unroll
            for (int dt = 0; dt < 4; ++dt)
#pragma unroll
                for (int ks = 0; ks < 2; ++ks) {
                    const bf16x8 sa = pack8(acc[dt][8 * ks], acc[dt][8 * ks + 1], acc[dt][8 * ks + 2], acc[dt][8 * ks + 3], acc[dt][8 * ks + 4], acc[dt][8 * ks + 5], acc[dt][8 * ks + 6], acc[dt][8 * ks + 7]);
                    oT = MFMA32(sa, qf[2 * dt + ks], oT);
                }
#pragma unroll
            for (int ks = 0; ks < 2; ++ks) {
                const bf16x8 pf = pack8(pT[8 * ks], pT[8 * ks + 1], pT[8 * ks + 2], pT[8 * ks + 3], pT[8 * ks + 4], pT[8 * ks + 5], pT[8 * ks + 6], pT[8 * ks + 7]);
                const bf16x8 va = lds_frag2(VT + (e0 + r) * RST + (16 * ks + 4 * h5) * 2, VT + (e0 + r) * RST + (16 * ks + 8 + 4 * h5) * 2);
                oT = MFMA32(va, pf, oT);
            }
            bf16* orow = oscr + ((size_t)(dir * 8 + hh) * NTOK + (rb + sgn * r)) * 128 + e0 + 4 * h5;
#pragma unroll
            for (int g4 = 0; g4 < 4; ++g4) { u32x2 o; o.x = pk2(oT[4 * g4], oT[4 * g4 + 1]); o.y = pk2(oT[4 * g4 + 2], oT[4 * g4 + 3]); *(u32x2*)(orow + 8 * g4) = o; }
        }
#pragma unroll
        for (int ks = 0; ks < 2; ++ks) {
            const bf16x8 vb = lds_frag2(VT + (e0 + r) * RST + (16 * ks + 8 * h5) * 2, VT + (e0 + r) * RST + (16 * ks + 8 * h5) * 2 + 8);
#pragma unroll
            for (int dt = 0; dt < 4; ++dt) {
                const bf16x8 ka = lds_frag2(KT + (32 * dt + r) * RST + (16 * ks + 8 * h5) * 2, KT + (32 * dt + r) * RST + (16 * ks + 8 * h5) * 2 + 8);
                acc[dt] = MFMA32(ka, vb, acc[dt]);
            }
        }
    }
#undef SC_DMA
    if (!OUT) {
        __syncthreads();
        if (half) { FAC[d] = __expf(tail_prev); Dlog[(size_t)(scan * NSEG + seg) * 128 + d] = dlog_tot; }
        __syncthreads();
#pragma unroll
        for (int dt = 0; dt < 4; ++dt)
#pragma unroll
            for (int g4 = 0; g4 < 4; ++g4) { const f32x4 f = *(const LAS f32x4*)(FAC + 32 * dt + 8 * g4 + 4 * h5);
#pragma unroll
                for (int j = 0; j < 4; ++j) Lslot[(32 * dt + 8 * g4 + 4 * h5 + j) * 128 + e0 + r] = acc[dt][4 * g4 + j] * f[j]; }
    }
    __syncthreads();
}

constexpr int AT_KC = 0, AT_VC = 36864, AT_KL = 70144, AT_VL = 116224, AT_END = 157696;
constexpr int KRS = 144, VCRS = 520, VLRS = 648, NSLOT = 10;
static_assert(AT_END <= MISC_OFF, "attention LDS");
DI void attn_unit(LAS unsigned char* ldsb, const bf16* proj, const bf16* KR, const bf16* VTg, const float* rope, const float* sinks, bf16* yab, int kvh, int ab) {
    const int tid = threadIdx.x, lane = tid & 63, wave = __builtin_amdgcn_readfirstlane(tid >> 6), r = lane & 31, h5 = lane >> 5;
    const int head = kvh * 8 + wave;
    LAS unsigned char* KC = ldsb + AT_KC; LAS unsigned char* VC = ldsb + AT_VC; LAS unsigned char* KL = ldsb + AT_KL; LAS unsigned char* VL = ldsb + AT_VL;
    const float* rowcos = rope, *rowsin = rope + 4096, *colcos = rope + 8192, *colsin = rope + 8192 + 1024;
    __syncthreads();
    for (int p = tid; p < 2048; p += 512) {
        { const int key = p >> 3, c8 = p & 7; const u32x4 v = *(const u32x4*)(KR + ((size_t)(kvh * MROWS + NTOK + key)) * 64 + c8 * 8); *(LAS u32x4*)(KC + key * KRS + c8 * 16) = v; }
        { const int dd = p >> 5, c = p & 31; const u32x4 v = *(const u32x4*)(VTg + ((size_t)(kvh * 64 + dd)) * MROWS + NTOK + c * 8);
          u32x2 a; a.x = v.x; a.y = v.y; u32x2 b; b.x = v.z; b.y = v.w; *(LAS u32x2*)(VC + dd * VCRS + c * 16) = a; *(LAS u32x2*)(VC + dd * VCRS + c * 16 + 8) = b; }
    }
    const int T0 = ab * 4 - 4;
    for (int p = tid; p < 2304; p += 512) {
        { const int key = p >> 3, c8 = p & 7, T = T0 + (key >> 5), slot = (T + 2 * NSLOT) % NSLOT;
          if (T >= 0 && T < NTOK / 32) { const u32x4 v = *(const u32x4*)(KR + ((size_t)(kvh * MROWS + T * 32 + (key & 31))) * 64 + c8 * 8); *(LAS u32x4*)(KL + (slot * 32 + (key & 31)) * KRS + c8 * 16) = v; } }
        { const int dd = p / 36, c = p % 36, T = T0 + (c >> 2), slot = (T + 2 * NSLOT) % NSLOT;
          if (T >= 0 && T < NTOK / 32) { const u32x4 v = *(const u32x4*)(VTg + ((size_t)(kvh * 64 + dd)) * MROWS + T * 32 + (c & 3) * 8);
            u32x2 a; a.x = v.x; a.y = v.y; u32x2 b; b.x = v.z; b.y = v.w; LAS unsigned char* dst = VL + dd * VLRS + slot * 64 + (c & 3) * 16; *(LAS u32x2*)dst = a; *(LAS u32x2*)(dst + 8) = b; } }
    }
    const float sc = 0.125f * 1.4426950408889634f;
    u32x4 raw[4]; float cs[2][8], sn[2][8];
#define AT_LOADQ(P0) do { const int qp_ = (P0) + r; const bf16* qrow_ = proj + PO_AQ + ((size_t)head * MROWS + qp_) * 64 + 8 * h5; \
        _Pragma("unroll") for (int ks = 0; ks < 4; ++ks) raw[ks] = *(const u32x4*)(qrow_ + 16 * ks); \
        const float* c0_ = rowcos + (qp_ >> 6) * 16 + 8 * h5; const float* s0_ = rowsin + (qp_ >> 6) * 16 + 8 * h5; \
        const float* c1_ = colcos + (qp_ & 63) * 16 + 8 * h5; const float* s1_ = colsin + (qp_ & 63) * 16 + 8 * h5; \
        _Pragma("unroll") for (int j = 0; j < 8; ++j) { cs[0][j] = c0_[j]; sn[0][j] = s0_[j]; cs[1][j] = c1_[j]; sn[1][j] = s1_[j]; } } while (0)
    AT_LOADQ(ab * 128);
    __syncthreads();
    for (int qt = 0; qt < 4; ++qt) {
        const int p0 = ab * 128 + 32 * qt, kb0 = p0 - 128, qp = p0 + r, Tq = ab * 4 + qt - 4;
        bf16x8 qf[4];
#pragma unroll
        for (int ks = 0; ks < 2; ++ks) { float o1[8], o2[8];
#pragma unroll
            for (int q = 0; q < 4; ++q) {
                const float a0 = bflo(raw[ks][q]), a1 = bfhi(raw[ks][q]), b0 = bflo(raw[ks + 2][q]), b1 = bfhi(raw[ks + 2][q]);
                o1[2 * q] = a0 * cs[ks][2 * q] - b0 * sn[ks][2 * q]; o2[2 * q] = b0 * cs[ks][2 * q] + a0 * sn[ks][2 * q];
                o1[2 * q + 1] = a1 * cs[ks][2 * q + 1] - b1 * sn[ks][2 * q + 1]; o2[2 * q + 1] = b1 * cs[ks][2 * q + 1] + a1 * sn[ks][2 * q + 1]; }
            qf[ks] = pack8(o1[0], o1[1], o1[2], o1[3], o1[4], o1[5], o1[6], o1[7]);
            qf[ks + 2] = pack8(o2[0], o2[1], o2[2], o2[3], o2[4], o2[5], o2[6], o2[7]); }
        const int Tn = Tq + 9; const bool pre = (qt < 3) && Tn >= 0 && Tn < NTOK / 32; u32x4 nk = {0u, 0u, 0u, 0u};
        if (pre) { if (tid < 256) nk = *(const u32x4*)(KR + ((size_t)(kvh * MROWS + Tn * 32 + (tid >> 3))) * 64 + (tid & 7) * 8);
                   else { const int t2 = tid - 256; nk = *(const u32x4*)(VTg + ((size_t)(kvh * 64 + (t2 >> 2))) * MROWS + Tn * 32 + (t2 & 3) * 8); } }
        if (qt < 3) AT_LOADQ(p0 + 32);
        float m_run = sinks[head] * 1.4426950408889634f, l_run = h5 ? 0.f : 1.f;
        f32x16 o0, o1;
#pragma unroll
        for (int i = 0; i < 16; ++i) { o0[i] = 0.f; o1[i] = 0.f; }
        for (int kt = 0; kt < 17; ++kt) {
            const bool lat = kt >= 8; const int j = kt - 8, T = Tq + j, kb = kb0 + 32 * j, slot = (T + 2 * NSLOT) % NSLOT;
            if (lat && (T < 0 || T >= NTOK / 32)) continue;
            const LAS unsigned char* Kb = lat ? KL + (32 * slot + r) * KRS : KC + (32 * kt + r) * KRS;
            const LAS unsigned char* Vb = lat ? VL + r * VLRS + 64 * slot : VC + r * VCRS + 64 * kt;
            const int vrs32 = 32 * (lat ? VLRS : VCRS); const bool edge = lat && (j == 0 || j == 8);
            f32x16 s;
#pragma unroll
            for (int i = 0; i < 16; ++i) s[i] = 0.f;
#pragma unroll
            for (int ks = 0; ks < 4; ++ks) { const bf16x8 kf = *(const LAS bf16x8*)(Kb + (16 * ks + 8 * h5) * 2); s = MFMA32(kf, qf[ks], s); }
            float mt = -INFINITY;
#pragma unroll
            for (int i = 0; i < 16; ++i) { float v = s[i] * sc;
                if (edge) { const int dk = kb + crow(i, h5) - qp; if (dk > 128 || dk < -128) v = -INFINITY; }
                s[i] = v; mt = fmaxf(mt, v); }
            mt = fmaxf(mt, __shfl_xor(mt, 32));
            const float mn = fmaxf(m_run, mt);
            if (__any(mn > m_run)) { const float alpha = __builtin_amdgcn_exp2f(m_run - mn); l_run *= alpha;
#pragma unroll
                for (int i = 0; i < 16; ++i) { o0[i] *= alpha; o1[i] *= alpha; } }
            m_run = mn;
            float ps = 0.f;
#pragma unroll
            for (int i = 0; i < 16; ++i) { const float p = __builtin_amdgcn_exp2f(s[i] - mn); s[i] = p; ps += p; }
            l_run += ps;
#pragma unroll
            for (int ks = 0; ks < 2; ++ks) {
                const bf16x8 pf = pack8(s[8 * ks], s[8 * ks + 1], s[8 * ks + 2], s[8 * ks + 3], s[8 * ks + 4], s[8 * ks + 5], s[8 * ks + 6], s[8 * ks + 7]);
                const bf16x8 v0 = lds_frag2(Vb + (16 * ks + 4 * h5) * 2, Vb + (16 * ks + 8 + 4 * h5) * 2);
                const bf16x8 v1 = lds_frag2(Vb + vrs32 + (16 * ks + 4 * h5) * 2, Vb + vrs32 + (16 * ks + 8 + 4 * h5) * 2);
                o0 = MFMA32(v0, pf, o0);
                o1 = MFMA32(v1, pf, o1);
            }
        }
        const float l = l_run + __shfl_xor(l_run, 32), inv = 1.0f / l;
        bf16* orow = yab + (size_t)qp * D + head * 64 + 4 * h5;
#pragma unroll
        for (int g4 = 0; g4 < 4; ++g4) {
            u32x2 a; a.x = pk2(o0[4 * g4] * inv, o0[4 * g4 + 1] * inv); a.y = pk2(o0[4 * g4 + 2] * inv, o0[4 * g4 + 3] * inv); *(u32x2*)(orow + 8 * g4) = a;
            u32x2 b; b.x = pk2(o1[4 * g4] * inv, o1[4 * g4 + 1] * inv); b.y = pk2(o1[4 * g4 + 2] * inv, o1[4 * g4 + 3] * inv); *(u32x2*)(orow + 32 + 8 * g4) = b;
        }
        if (pre) { const int slot = (Tn + 2 * NSLOT) % NSLOT;
            if (tid < 256) *(LAS u32x4*)(KL + (slot * 32 + (tid >> 3)) * KRS + (tid & 7) * 16) = nk;
            else { const int t2 = tid - 256; u32x2 a; a.x = nk.x; a.y = nk.y; u32x2 b; b.x = nk.z; b.y = nk.w; LAS unsigned char* dst = VL + (t2 >> 2) * VLRS + slot * 64 + (t2 & 3) * 16; *(LAS u32x2*)dst = a; *(LAS u32x2*)(dst + 8) = b; } }
        __syncthreads();
    }
#undef AT_LOADQ
}

typedef const Args __attribute__((address_space(4))) ArgsC;
DI ArgsC* args_ptr() { ArgsC* p = (ArgsC*)__builtin_amdgcn_kernarg_segment_ptr(); asm volatile("" : "+s"(p)); return p; }
#define PH_BEGIN ArgsC* A = args_ptr(); unsigned char* const ws = A->ws; (void)ws
#define modl ((float*)(ws + WS_SMALL + SM_MODL))
#define modc ((float*)(ws + WS_SMALL + SM_MODC))
#define rope ((float*)(ws + WS_SMALL + SM_ROPE))
#define lbf ((float*)(ws + WS_SMALL + SM_LB))
#define lbb (lbf + 1024)
#define wrp ((float*)(ws + WS_SMALL + SM_WRP))
#define cvec ((float*)(ws + WS_SMALL + SM_CVEC))
#define tile_expert ((int*)(ws + WS_SMALL + SM_TILE))
#define ntiles_p (tile_expert + 512)
#define rt_e ((int*)(ws + WS_ROUTE + RT_E))
#define rt_g ((float*)(ws + WS_ROUTE + RT_G))
#define rt_r ((int*)(ws + WS_ROUTE + RT_R))
#define rt_s ((int*)(ws + WS_ROUTE + RT_S))
#define slot_rowoff ((unsigned*)(ws + WS_ROUTE + RT_OFF))
#define slot_gate ((float*)(ws + WS_ROUTE + RT_SG))
#define Dlog ((float*)(ws + WS_DLOG))
#define KR ((bf16*)(ws + WS_KR))
#define VTg ((bf16*)(ws + WS_VT))
#define Lbuf ((float*)(ws + WS_L))
#define WIN ((bf16*)(ws + WS_WIN))
#define WM ((bf16*)(ws + WS_WM))
#define WO ((bf16*)(ws + WS_WO))
#define WGU ((bf16*)(ws + WS_WGU))
#define WDN ((bf16*)(ws + WS_WDN))
#define H ((bf16*)(ws + WS_H))
#define PROJ ((bf16*)(ws + WS_PROJ))
#define ACT ((bf16*)(ws + WS_ACT))
#define YAB ((bf16*)(ws + WS_YAB))
#define OSCR ((bf16*)(ws + WS_OSCR))
#define MERGED ((bf16*)(ws + WS_MERGED))
#define X1 ((float*)(ws + WS_X1))
#define YS ((bf16*)(ws + WS_YS))

__global__ void __launch_bounds__(NWAVES * 64, 2) fwd_kernel(Args a_unused) {
    extern __shared__ __attribute__((aligned(16))) unsigned char lds_raw[];
    LAS unsigned char* lds = (LAS unsigned char*)lds_raw;
    volatile LAS unsigned* MISC = (volatile LAS unsigned*)(lds + MISC_OFF);
    const int tid = threadIdx.x, lane = tid & 63, wave = __builtin_amdgcn_readfirstlane(tid >> 6);
    const int G = gridDim.x, bx = blockIdx.x, vcu = (G % 8 == 0) ? (bx % 8) * (G / 8) + bx / 8 : bx;
    const int gw = vcu * NWAVES + wave, NGW = G * NWAVES;
    const int gtid = vcu * 512 + tid, NGT = G * 512;
    unsigned* ctl; { const ArgsC* A0 = args_ptr(); ctl = (unsigned*)(A0->ws + WS_CTL); }
    if (tid < 64) MISC[tid] = 0u;
    __syncthreads();
    XcdBarrier bar = xcd_barrier_post(ctl + CW_BAR, MISC);
    int lo, hi; { const ArgsC* A0 = args_ptr(); lo = A0->ph_lo; hi = A0->ph_hi; }
#ifndef PH_MASK
#define PH_MASK 0x1fff
#endif
#define IN(k) ((((PH_MASK) >> (k)) & 1) && lo <= (k) && (k) < hi)
#define SEAM(k) do { if (IN(k) && IN((k) + 1)) xcd_barrier(bar); } while (0)

    for (int rep_ = 0; rep_ < DUP0; ++rep_) { if (rep_) xcd_barrier(bar);
    if (IN(0)) {
        PH_BEGIN;
        constexpr int Q_TAB = 48, Q_WIN = 49, Q_GU = Q_WIN + INC / 32, Q_DN = Q_GU + 4096, Q_TR = Q_DN + 2048, I_BR = 1024, I_OUT = 1024, Q_END = Q_TR + (I_BR + I_OUT) / 8;
        int cur = vcu;
        while (cur < Q_END) {
            unsigned nxt = 0u; if (tid == 0) nxt = (unsigned)G + atomicAdd(ctl + CW_Q, 1u);
            if (cur < Q_TAB) {
                LAS float* sc = (LAS float*)lds; LAS float* scc = sc + 2048; LAS f32x4* red = (LAS f32x4*)(lds + 16384);
                for (int k = tid; k < 2048; k += 512) { const float v = A->c[k], u = A->c_ctx[k]; sc[k] = v * sigmoidf_(v); scc[k] = u * sigmoidf_(u); }
                __syncthreads();
                const int cb = cur, col = 256 * cb + 4 * lane; const bool hasc = cb < 16;
                f32x4 al = {0.f, 0.f, 0.f, 0.f}, ac = {0.f, 0.f, 0.f, 0.f};
#pragma unroll 8
                for (int k = wave; k < 2048; k += 8) { const f32x4 wv = *(const f32x4*)(A->w_mod + (size_t)k * 12288 + col); al += sc[k] * wv; ac += scc[k] * wv; }
                red[wave * 64 + lane] = al; red[512 + wave * 64 + lane] = ac;
                __syncthreads();
                if (wave == 0) { f32x4 s = *(const f32x4*)(A->b_mod + col), t = s;
#pragma unroll
                    for (int w = 0; w < 8; ++w) { s += red[w * 64 + lane]; t += red[512 + w * 64 + lane]; }
                    *(f32x4*)(modl + col) = s; if (hasc) *(f32x4*)(modc + col) = t; }
            } else if (cur == Q_TAB) {
                for (int i = tid; i < 4096 + 1024; i += 512) { const bool isrow = i < 4096; const int ii = isrow ? i : i - 4096, p = ii >> 4, j = ii & 15;
                    const float inv = powf(10000.0f, -(float)j / 16.0f), ang = (float)p * inv; float s, c; sincosf(ang, &s, &c);
                    if (isrow) { rope[ii] = c; rope[4096 + ii] = s; } else { rope[8192 + ii] = c; rope[9216 + ii] = s; } }
                for (int i = tid; i < 2048; i += 512) { const float* lg = (i < 1024) ? A->lbf_logits : A->lbb_logits; const int ch = i & 1023;
                    const float v = 1.0f / (1.0f + expf(lg[1024 + ch] - lg[ch])); if (i < 1024) lbf[ch] = v; else lbb[ch] = v; }
            } else if (cur < Q_GU) { const int it = cur - Q_WIN;
                p0_quant_item(A->w_in + 32 * it, INC, (signed char*)(ws + WS_WIN) + (size_t)(32 * it) * 2048, (float*)(ws + WS_CS + CS_WIN) + 32 * it, lds, tid);
            } else if (cur < Q_DN) { const int it = cur - Q_GU;
                const int e = it >> 7, which = (it >> 6) & 1, jb = it & 63, n0 = 32 * jb, np = e * 4096 + (n0 >> 7) * 256 + which * 128 + (n0 & 127);
                p0_quant_item((which ? A->w_e_up : A->w_e_gate) + (size_t)e * D * FF + n0, FF, (signed char*)(ws + WS_WGU) + (size_t)np * 2048, (float*)(ws + WS_CS) + np, lds, tid);
            } else if (cur < Q_TR) { const int it = cur - Q_DN, e = it >> 6, n0 = 32 * (it & 63);
                p0_quant_item(A->w_e_down + (size_t)e * FF * D + n0, D, (signed char*)(ws + WS_WDN) + ((size_t)e * D + n0) * 2048, (float*)(ws + WS_DLOG + DL_CSD) + e * D + n0, lds, tid);
            } else {
                LAS unsigned char* scr = lds + wave * 9216; int r = (cur - Q_TR) * 8 + wave;
                if (r < I_BR) { const int br = r >> 9, r2 = r & 511, kb = r2 >> 5, nb = r2 & 31;
                    p0_transpose64(A->w_branch + (size_t)br * 1024 * D + (size_t)(64 * kb) * D + 64 * nb, D, WM + (size_t)(64 * nb) * D + br * 1024 + 64 * kb, D, scr, lane); }
                else { r -= I_BR; const int kb = r >> 5, nb = r & 31; p0_transpose64(A->w_out + (size_t)(64 * kb) * D + 64 * nb, D, WO + (size_t)(64 * nb) * D + 64 * kb, D, scr, lane); }
            }
            __syncthreads();
            if (tid == 0) MISC[2] = nxt;
            __syncthreads();
            cur = (int)MISC[2];
        }
    }
    }
    SEAM(0);

    for (int rep_ = 0; rep_ < DUP1; ++rep_) { if (rep_) xcd_barrier(bar);
    if (IN(1)) {
        PH_BEGIN;
        {
            f32x4 ca[8], cb[8];
#pragma unroll
            for (int j = 0; j < 8; ++j) { const int k = 4 * lane + 256 * j; const f32x4 g = *(const f32x4*)(A->norm_mix_g + k), s1 = *(const f32x4*)(modl + 2048 + k); ca[j] = g * (1.0f + s1); cb[j] = *(const f32x4*)(modl + k); }
            f32x4 v[8], vn[8];
            { const float* xr = A->x + (size_t)gw * D + 4 * lane;
#pragma unroll
              for (int j = 0; j < 8; ++j) v[j] = *(const f32x4*)(xr + 256 * j); }
            for (int m = gw; m < NTOK; m += NGW) {
                if (m + NGW < NTOK) { const float* xn = A->x + (size_t)(m + NGW) * D + 4 * lane;
#pragma unroll
                    for (int j = 0; j < 8; ++j) vn[j] = *(const f32x4*)(xn + 256 * j); }
                float ss = 0.f;
#pragma unroll
                for (int j = 0; j < 8; ++j) ss += v[j][0] * v[j][0] + v[j][1] * v[j][1] + v[j][2] * v[j][2] + v[j][3] * v[j][3];
                const float rstd = rsqrtf(wave_sum(ss) * (1.0f / D) + EPS);
                float am = 0.f;
#pragma unroll
                for (int j = 0; j < 8; ++j) { v[j] = v[j] * rstd * ca[j] + cb[j]; am = fmaxf(am, fmaxf(fmaxf(fabsf(v[j][0]), fabsf(v[j][1])), fmaxf(fabsf(v[j][2]), fabsf(v[j][3])))); }
#pragma unroll
                for (int o = 1; o < 64; o <<= 1) am = fmaxf(am, __shfl_xor(am, o));
                if (am == 0.f) am = 1.f;
                const float qi = 127.0f / am;
                if (lane == 0) ((float*)(ws + WS_CS + CS_HROW))[m] = am * (1.0f / 127.0f);
                unsigned* hq = (unsigned*)((signed char*)(ws + WS_H) + (size_t)m * D + 4 * lane);
#pragma unroll
                for (int j = 0; j < 8; ++j) { const int q0 = (int)rintf(v[j][0] * qi), q1 = (int)rintf(v[j][1] * qi), q2 = (int)rintf(v[j][2] * qi), q3 = (int)rintf(v[j][3] * qi);
                    hq[64 * j] = ((unsigned)q0 & 0xffu) | (((unsigned)q1 & 0xffu) << 8) | (((unsigned)q2 & 0xffu) << 16) | (((unsigned)q3 & 0xffu) << 24); }
#pragma unroll
                for (int j = 0; j < 8; ++j) v[j] = vn[j];
            }
        }
        if (gw < NCTX) {
            const int m = gw; const float* xr = A->ctx + (size_t)m * D + 4 * lane; f32x4 v[8]; float ss = 0.f;
#pragma unroll
            for (int j = 0; j < 8; ++j) { v[j] = *(const f32x4*)(xr + 256 * j); ss += v[j][0] * v[j][0] + v[j][1] * v[j][1] + v[j][2] * v[j][2] + v[j][3] * v[j][3]; }
            const float rstd = rsqrtf(wave_sum(ss) * (1.0f / D) + EPS);
            float am = 0.f;
#pragma unroll
            for (int j = 0; j < 8; ++j) { const int k = 4 * lane + 256 * j; const f32x4 g = *(const f32x4*)(A->norm_mix_g + k), s1 = *(const f32x4*)(modc + 2048 + k), s0 = *(const f32x4*)(modc + k);
                v[j] = v[j] * rstd * (g * (1.0f + s1)) + s0; am = fmaxf(am, fmaxf(fmaxf(fabsf(v[j][0]), fabsf(v[j][1])), fmaxf(fabsf(v[j][2]), fabsf(v[j][3])))); }
#pragma unroll
            for (int o = 1; o < 64; o <<= 1) am = fmaxf(am, __shfl_xor(am, o));
            if (am == 0.f) am = 1.f;
            const float qi = 127.0f / am;
            if (lane == 0) ((float*)(ws + WS_CS + CS_HROW))[NTOK + m] = am * (1.0f / 127.0f);
            unsigned* hq = (unsigned*)((signed char*)(ws + WS_H) + (size_t)(NTOK + m) * D + 4 * lane);
#pragma unroll
            for (int j = 0; j < 8; ++j) { const int q0 = (int)rintf(v[j][0] * qi), q1 = (int)rintf(v[j][1] * qi), q2 = (int)rintf(v[j][2] * qi), q3 = (int)rintf(v[j][3] * qi);
                hq[64 * j] = ((unsigned)q0 & 0xffu) | (((unsigned)q1 & 0xffu) << 8) | (((unsigned)q2 & 0xffu) << 16) | (((unsigned)q3 & 0xffu) << 24); }
        }
        for (int i = gtid; i < 2048 * 32; i += NGT) { const int k = i >> 5; wrp[i] = A->norm_ffn_g[k] * (1.0f + modl[4 * 2048 + k]) * A->w_router[i]; }
        if (vcu == G - 1) {
            for (int e = wave * 4; e < wave * 4 + 4; ++e) { float s = 0.f; for (int k = lane; k < 2048; k += 64) s += modl[3 * 2048 + k] * A->w_router[k * 32 + e];
                s = wave_sum(s); if (lane == 0) cvec[e] = s + A->b_router[e]; }
        }
    }
    }
    SEAM(1);

    for (int rep_ = 0; rep_ < DUP2; ++rep_) { if (rep_) xcd_barrier(bar);
    if (IN(2)) {
        PH_BEGIN;
        pg8::Gemm g{H, WIN, D / 2}; pg8::PlainOrder S; S.init(MROWS / 256, INC / 256, G, bx); S.K2 = D;
        EpiProj E{PROJ, lbf, lbb, (const float*)(ws + WS_CS + CS_HROW), (const float*)(ws + WS_CS + CS_WIN)};
        pg8::gemm_phase<EpiProj, pg8::PlainOrder, true>(lds, g, S, E);
    }
    }
    SEAM(2);

    for (int rep_ = 0; rep_ < DUP3; ++rep_) { if (rep_) xcd_barrier(bar);
    if (IN(3)) {
        PH_BEGIN;
        for (int i = gtid; i < MROWS * 8; i += NGT) { const int jg = i & 3, kvh = (i >> 2) & 1, pos = i >> 3, j0 = 8 * jg;
            const bf16* kr = PROJ + PO_AKV + (size_t)pos * 256 + kvh * 64 + j0; const u32x4 a1 = *(const u32x4*)kr, a2 = *(const u32x4*)(kr + 32); u32x4 w1 = a1, w2 = a2;
            if (pos < NTOK) { const float* ct = (jg < 2) ? rope + (pos >> 6) * 16 + j0 : rope + 8192 + (pos & 63) * 16 + j0 - 16; const float* st = ct + ((jg < 2) ? 4096 : 1024);
                const f32x4 c0 = *(const f32x4*)ct, c1 = *(const f32x4*)(ct + 4), s0 = *(const f32x4*)st, s1 = *(const f32x4*)(st + 4);
#pragma unroll
                for (int q = 0; q < 4; ++q) { const float cl = q < 2 ? c0[2 * q] : c1[2 * q - 4], ch = q < 2 ? c0[2 * q + 1] : c1[2 * q - 3], sl = q < 2 ? s0[2 * q] : s1[2 * q - 4], sh = q < 2 ? s0[2 * q + 1] : s1[2 * q - 3];
                    const float k1l = bflo(a1[q]), k1h = bfhi(a1[q]), k2l = bflo(a2[q]), k2h = bfhi(a2[q]);
                    w1[q] = pk2(k1l * cl - k2l * sl, k1h * ch - k2h * sh); w2[q] = pk2(k2l * cl + k1l * sl, k2h * ch + k1h * sh); } }
            bf16* ko = KR + ((size_t)kvh * MROWS + pos) * 64 + j0; *(u32x4*)ko = w1; *(u32x4*)(ko + 32) = w2; }
        for (int i = gtid; i < 2 * (MROWS / 8) * 64; i += NGT) { const int dd = i & 63, pb = (i >> 6) % (MROWS / 8), kvh = (i >> 6) / (MROWS / 8);
            const bf16* vr = PROJ + PO_AKV + (size_t)(pb * 8) * 256 + 128 + kvh * 64 + dd; unsigned short t[8];
#pragma unroll
            for (int q = 0; q < 8; ++q) t[q] = vr[(size_t)q * 256];
            u32x4 w; w.x = t[0] | ((unsigned)t[1] << 16); w.y = t[2] | ((unsigned)t[3] << 16); w.z = t[4] | ((unsigned)t[5] << 16); w.w = t[6] | ((unsigned)t[7] << 16);
            *(u32x4*)(VTg + ((size_t)kvh * 64 + dd) * MROWS + pb * 8) = w; }
        for (int it = vcu; it < 8 * (NSEG - 1); it += G) { const int hh = it >> 5, seg = it & 31; scan_segment<false>(lds, PROJ, hh, seg, seg, Lbuf, Dlog, (bf16*)nullptr); }
    }
    }
    SEAM(3);

    if (IN(4)) {
        PH_BEGIN;
        for (int i = gtid; i < 16 * 16384; i += NGT) { const int scan = i >> 14, el = i & 16383, dd = el >> 7; float s = 0.f, lv[NSEG - 1], dv[NSEG - 1];
#pragma unroll
            for (int j = 0; j < NSEG - 1; ++j) { lv[j] = Lbuf[(size_t)(scan * NSEG + j) * 16384 + el]; dv[j] = Dlog[(scan * NSEG + j) * 128 + dd]; }
#pragma unroll
            for (int j = 0; j < NSEG - 1; ++j) { s = __expf(dv[j]) * s + lv[j]; Lbuf[(size_t)(scan * NSEG + j) * 16384 + el] = s; } }
        for (int rep_ = 0; rep_ < DUP4; ++rep_) for (int u = vcu; u < 256; u += G) attn_unit(lds, PROJ, KR, VTg, rope, A->sinks, YAB, u >> 7, u & 127);
    }
    SEAM(4);

    for (int rep_ = 0; rep_ < DUP5; ++rep_) { if (rep_) xcd_barrier(bar);
    if (IN(5)) {
        PH_BEGIN;
        for (int it = vcu; it < 8 * 32; it += G) { const int hh = it >> 5, segF = 1 + (it & 31);
            scan_segment<true>(lds, PROJ, hh, segF, NSEG - segF, Lbuf, Dlog, OSCR);
            VM_WAIT(); __syncthreads();
            { const int l16 = lane & 15, tq = lane >> 4; const f32x4 hg0 = *(const f32x4*)(A->hgrn_g + hh * 128 + 8 * l16), hg1 = *(const f32x4*)(A->hgrn_g + hh * 128 + 8 * l16 + 4);
              for (int i0 = wave * 64; i0 < wave * 64 + 64; i0 += 16) {
                u32x4 fw[4], bw[4], gq[4];
#pragma unroll
                for (int b = 0; b < 4; ++b) { const int row = (segF - 1) * 512 + i0 + 4 * b + tq;
                    fw[b] = *(const u32x4*)(OSCR + ((size_t)hh * NTOK + row) * 128 + 8 * l16); bw[b] = *(const u32x4*)(OSCR + ((size_t)(8 + hh) * NTOK + row) * 128 + 8 * l16);
                    gq[b] = *(const u32x4*)(PROJ + PO_BG + ((size_t)hh * MROWS + row) * 128 + 8 * l16); }
#pragma unroll
                for (int b = 0; b < 4; ++b) { const int row = (segF - 1) * 512 + i0 + 4 * b + tq;
                    f32x4 o0, o1; o0[0] = bflo(fw[b].x) + bflo(bw[b].x); o0[1] = bfhi(fw[b].x) + bfhi(bw[b].x); o0[2] = bflo(fw[b].y) + bflo(bw[b].y); o0[3] = bfhi(fw[b].y) + bfhi(bw[b].y);
                    o1[0] = bflo(fw[b].z) + bflo(bw[b].z); o1[1] = bfhi(fw[b].z) + bfhi(bw[b].z); o1[2] = bflo(fw[b].w) + bflo(bw[b].w); o1[3] = bfhi(fw[b].w) + bfhi(bw[b].w);
                    float ss = o0[0] * o0[0] + o0[1] * o0[1] + o0[2] * o0[2] + o0[3] * o0[3] + o1[0] * o1[0] + o1[1] * o1[1] + o1[2] * o1[2] + o1[3] * o1[3];
                    ss += __shfl_xor(ss, 1); ss += __shfl_xor(ss, 2); ss += __shfl_xor(ss, 4); ss += __shfl_xor(ss, 8);
                    const float rstd = rsqrtf(ss * (1.0f / 128.0f) + EPS);
                    u32x4 w; w.x = pk2(o0[0] * rstd * hg0[0] * bflo(gq[b].x), o0[1] * rstd * hg0[1] * bfhi(gq[b].x)); w.y = pk2(o0[2] * rstd * hg0[2] * bflo(gq[b].y), o0[3] * rstd * hg0[3] * bfhi(gq[b].y));
                    w.z = pk2(o1[0] * rstd * hg1[0] * bflo(gq[b].z), o1[1] * rstd * hg1[1] * bfhi(gq[b].z)); w.w = pk2(o1[2] * rstd * hg1[2] * bflo(gq[b].w), o1[3] * rstd * hg1[3] * bfhi(gq[b].w));
                    *(u32x4*)(YAB + (size_t)row * D + 1024 + hh * 128 + 8 * l16) = w; } } }
            __syncthreads();
        }
    }
    }
    SEAM(5);

    if (IN(6)) {
        PH_BEGIN;
        pg8::Gemm g{YAB, WM, D}; pg8::PlainOrder S; S.init(NTOK / 256, D / 256, G, bx); S.K2 = D * 2;
        EpiMerge E{MERGED, PROJ};
        pg8::gemm_phase<EpiMerge, pg8::PlainOrder>(lds, g, S, E);
    }
    SEAM(6);

    if (IN(7)) {
        PH_BEGIN;
        pg8::Gemm g{MERGED, WO, D}; pg8::PlainOrder S; S.init(NTOK / 256, D / 256, G, bx); S.K2 = D * 2;
        EpiOut E{X1, A->x, modl + 2 * 2048};
        pg8::gemm_phase<EpiOut, pg8::PlainOrder>(lds, g, S, E);
    }
    SEAM(7);

    if (IN(8)) {
        PH_BEGIN;
        LAS float* part = (LAS float*)lds;
        LAS float* rsd = (LAS float*)(lds + 16384);
        const int r16 = lane & 15, kk = lane >> 4;
        for (int tl = vcu; tl < NTOK / 16; tl += G) {
            const int row0 = tl * 16;
#pragma unroll
            for (int q = 0; q < 2; ++q) { const int m = row0 + 2 * wave + q; const float* xr = X1 + (size_t)m * D + 4 * lane; f32x4 v[8]; float ss = 0.f;
#pragma unroll
                for (int j = 0; j < 8; ++j) { v[j] = *(const f32x4*)(xr + 256 * j); ss += v[j][0] * v[j][0] + v[j][1] * v[j][1] + v[j][2] * v[j][2] + v[j][3] * v[j][3]; }
                const float rstd = rsqrtf(wave_sum(ss) * (1.0f / D) + EPS);
                if (lane == 0) rsd[2 * wave + q] = rstd;
                float am = 0.f;
#pragma unroll
                for (int j = 0; j < 8; ++j) { const int k = 4 * lane + 256 * j; const f32x4 g = *(const f32x4*)(A->norm_ffn_g + k), s1 = *(const f32x4*)(modl + 4 * 2048 + k), s0 = *(const f32x4*)(modl + 3 * 2048 + k);
                    v[j] = v[j] * rstd * (g * (1.0f + s1)) + s0; am = fmaxf(am, fmaxf(fmaxf(fabsf(v[j][0]), fabsf(v[j][1])), fmaxf(fabsf(v[j][2]), fabsf(v[j][3])))); }
#pragma unroll
                for (int o = 1; o < 64; o <<= 1) am = fmaxf(am, __shfl_xor(am, o));
                if (am == 0.f) am = 1.f;
                const float qi = 127.0f / am;
                if (lane == 0) ((float*)(ws + WS_CS + CS_ROW))[m] = am * (1.0f / 127.0f);
                unsigned* hq = (unsigned*)((signed char*)(ws + WS_H) + (size_t)m * D + 4 * lane);
#pragma unroll
                for (int j = 0; j < 8; ++j) { const int q0 = (int)rintf(v[j][0] * qi), q1 = (int)rintf(v[j][1] * qi), q2 = (int)rintf(v[j][2] * qi), q3 = (int)rintf(v[j][3] * qi);
                    hq[64 * j] = ((unsigned)q0 & 0xffu) | (((unsigned)q1 & 0xffu) << 8) | (((unsigned)q2 & 0xffu) << 16) | (((unsigned)q3 & 0xffu) << 24); } }
            float bw[16][4][2];
            { int zz = 0; asm volatile("" : "+v"(zz));
#pragma unroll
              for (int kg = 0; kg < 16; ++kg)
#pragma unroll
                for (int m = 0; m < 4; ++m)
#pragma unroll
                    for (int eh = 0; eh < 2; ++eh) bw[kg][m][eh] = wrp[(256 * wave + 16 * kg + 4 * kk + m) * 32 + 16 * eh + r16 + zz]; }
            f32x4 acc0 = {0.f, 0.f, 0.f, 0.f}, acc1 = {0.f, 0.f, 0.f, 0.f};
            const float* xa = X1 + (size_t)(row0 + r16) * D + 256 * wave + 4 * kk;
#pragma unroll
            for (int kg = 0; kg < 16; ++kg) { const f32x4 av = *(const f32x4*)(xa + 16 * kg);
#pragma unroll
                for (int m = 0; m < 4; ++m) { acc0 = __builtin_amdgcn_mfma_f32_16x16x4f32(av[m], bw[kg][m][0], acc0, 0, 0, 0); acc1 = __builtin_amdgcn_mfma_f32_16x16x4f32(av[m], bw[kg][m][1], acc1, 0, 0, 0); } }
#pragma unroll
            for (int q = 0; q < 4; ++q) { part[(wave * 16 + 4 * kk + q) * 32 + r16] = acc0[q]; part[(wave * 16 + 4 * kk + q) * 32 + 16 + r16] = acc1[q]; }
            __syncthreads();
            { const int row = tid >> 5, e = tid & 31; float s = 0.f;
#pragma unroll
              for (int w = 0; w < 8; ++w) s += part[(w * 16 + row) * 32 + e];
              float val = rsd[row] * s + cvec[e];
              float tv[4]; int ti[4];
#pragma unroll
              for (int j = 0; j < 4; ++j) { float bv = val; int bi = e;
#pragma unroll
                  for (int off = 16; off >= 1; off >>= 1) { const float ov = __shfl_xor(bv, off); const int oi = __shfl_xor(bi, off); if (ov > bv || (ov == bv && oi < bi)) { bv = ov; bi = oi; } }
                  tv[j] = bv; ti[j] = bi; if (e == bi) val = -INFINITY; }
              const float e1 = __expf(tv[1] - tv[0]), e2 = __expf(tv[2] - tv[0]), e3 = __expf(tv[3] - tv[0]), inv = 1.0f / (1.0f + e1 + e2 + e3);
              const float gt[4] = {inv, e1 * inv, e2 * inv, e3 * inv};
#pragma unroll
              for (int j = 0; j < 4; ++j) if (e == ti[j]) { const int ai = (row0 + row) * 4 + j; const unsigned rk = atomicAdd(ctl + CW_CNT + 16 * e, 1u);
                  rt_e[ai] = e; rt_g[ai] = gt[j]; rt_r[ai] = (int)rk; } }
            __syncthreads();
        }
    }
    SEAM(8);

    if (IN(9)) {
        PH_BEGIN;
        LAS int* tb = (LAS int*)lds;
        if (tid == 0) { int acc = 0; for (int e = 0; e < NEXP; ++e) { tb[e] = acc; acc += (int)((ctl[CW_CNT + 16 * e] + 255u) >> 8); } tb[NEXP] = acc; }
        __syncthreads();
        for (int i = gtid; i < NTOK * 4; i += NGT) { const int e = rt_e[i], slot = tb[e] * 256 + rt_r[i]; rt_s[i] = slot; slot_rowoff[slot] = (unsigned)(i >> 2) * (unsigned)D; slot_gate[slot] = rt_g[i]; ((float*)(ws + WS_CS + CS_SLOT))[slot] = ((const float*)(ws + WS_CS + CS_ROW))[i >> 2]; }
        if (vcu == 0) {
            for (int e = 0; e < NEXP; ++e) { const int cnt = (int)ctl[CW_CNT + 16 * e], s0 = tb[e] * 256 + cnt, s1 = tb[e + 1] * 256;
                for (int s = s0 + tid; s < s1; s += 512) { slot_rowoff[s] = 0u; slot_gate[s] = 0.f; ((float*)(ws + WS_CS + CS_SLOT))[s] = 0.f; }
                for (int t = tb[e] + tid; t < tb[e + 1]; t += 512) tile_expert[t] = e; }
            if (tid == 0) *ntiles_p = tb[NEXP];
        }
        __syncthreads();
    }
    SEAM(9);

    for (int rep_ = 0; rep_ < DUP10; ++rep_) { if (rep_) xcd_barrier(bar);
    if (IN(10)) {
        PH_BEGIN;
        const int ntiles = *ntiles_p;
        pg8::Gemm g{H, WGU, D / 2}; pg8::MoeOrder<true> S; S.init(ntiles, 4096 / 256, G, bx); S.K2 = D; S.nper = 4096; S.texp = tile_expert; S.sroff = slot_rowoff;
        EpiAct E{ACT, A->b_e_gate, A->b_e_up, (const float*)(ws + WS_CS), (const float*)(ws + WS_CS + CS_SLOT)};
        pg8::gemm_phase<EpiAct, pg8::MoeOrder<true>, true>(lds, g, S, E);
    }
    }
    SEAM(10);

    for (int rep_ = 0; rep_ < DUP11; ++rep_) { if (rep_) xcd_barrier(bar);
    if (IN(11)) {
        PH_BEGIN;
        const int ntiles = *ntiles_p;
        { const int nrows = ntiles * 256; u32x2 v[8], vn[8];
          if (gw < nrows) { const bf16* ar = ACT + (size_t)gw * FF + 4 * lane;
#pragma unroll
              for (int j = 0; j < 8; ++j) v[j] = *(const u32x2*)(ar + 256 * j); }
          for (int m = gw; m < nrows; m += NGW) {
              if (m + NGW < nrows) { const bf16* an = ACT + (size_t)(m + NGW) * FF + 4 * lane;
#pragma unroll
                  for (int j = 0; j < 8; ++j) vn[j] = *(const u32x2*)(an + 256 * j); }
              float am = 0.f;
#pragma unroll
              for (int j = 0; j < 8; ++j) am = fmaxf(am, fmaxf(fmaxf(fabsf(bflo(v[j].x)), fabsf(bfhi(v[j].x))), fmaxf(fabsf(bflo(v[j].y)), fabsf(bfhi(v[j].y)))));
#pragma unroll
              for (int o = 1; o < 64; o <<= 1) am = fmaxf(am, __shfl_xor(am, o));
              if (!(am > 0.f)) am = 1.f;
              const float qi = 127.0f / am;
              if (lane == 0) ((float*)(ws + WS_ROUTE + RT_ARS))[m] = am * (1.0f / 127.0f);
              unsigned* aq = (unsigned*)((signed char*)(ws + WS_ACT8) + (size_t)m * FF + 4 * lane);
#pragma unroll
              for (int j = 0; j < 8; ++j) { const int q0 = (int)rintf(bflo(v[j].x) * qi), q1 = (int)rintf(bfhi(v[j].x) * qi), q2 = (int)rintf(bflo(v[j].y) * qi), q3 = (int)rintf(bfhi(v[j].y) * qi);
                  aq[64 * j] = ((unsigned)q0 & 0xffu) | (((unsigned)q1 & 0xffu) << 8) | (((unsigned)q2 & 0xffu) << 16) | (((unsigned)q3 & 0xffu) << 24); }
#pragma unroll
              for (int j = 0; j < 8; ++j) v[j] = vn[j];
          } }
        xcd_barrier(bar);
        pg8::Gemm g{(const bf16*)(ws + WS_ACT8), WDN, FF / 2}; pg8::MoeOrder<false> S; S.init(ntiles, D / 256, G, bx); S.K2 = FF; S.nper = D; S.texp = tile_expert; S.sroff = slot_rowoff;
        EpiDown E{YS, A->b_e_down, slot_gate, (const float*)(ws + WS_ROUTE + RT_ARS), (const float*)(ws + WS_DLOG + DL_CSD)};
        pg8::gemm_phase<EpiDown, pg8::MoeOrder<false>, true>(lds, g, S, E);
    }
    }
    SEAM(11);

    for (int rep_ = 0; rep_ < DUP12; ++rep_) { if (rep_) xcd_barrier(bar);
    if (IN(12)) {
        PH_BEGIN;
        f32x4 v[8], vn[8], y[8]; u32x2 yn[4][8]; int sl[4];
#define P12_LOAD(VV, M) do { const float* xr_ = X1 + (size_t)(M) * D + 4 * lane; \
            _Pragma("unroll") for (int j = 0; j < 8; ++j) VV[j] = *(const f32x4*)(xr_ + 256 * j); \
            _Pragma("unroll") for (int q = 0; q < 4; ++q) { const bf16* yp_ = YS + (size_t)sl[q] * D + 4 * lane; _Pragma("unroll") for (int j = 0; j < 8; ++j) yn[q][j] = *(const u32x2*)(yp_ + 256 * j); } } while (0)
#define P12_SUM() do { _Pragma("unroll") for (int j = 0; j < 8; ++j) { y[j] = (f32x4){0.f, 0.f, 0.f, 0.f}; \
            _Pragma("unroll") for (int q = 0; q < 4; ++q) { const u32x2 w_ = yn[q][j]; y[j][0] += bflo(w_.x); y[j][1] += bfhi(w_.x); y[j][2] += bflo(w_.y); y[j][3] += bfhi(w_.y); } } } while (0)
#pragma unroll
        for (int q = 0; q < 4; ++q) sl[q] = rt_s[gw * 4 + q];
        P12_LOAD(v, gw); P12_SUM();
        if (gw + NGW < NTOK) {
#pragma unroll
            for (int q = 0; q < 4; ++q) sl[q] = rt_s[(gw + NGW) * 4 + q];
        }
        for (int m = gw; m < NTOK; m += NGW) {
            const bool more = m + NGW < NTOK;
            if (more) { P12_LOAD(vn, m + NGW);
                if (m + 2 * NGW < NTOK) {
#pragma unroll
                    for (int q = 0; q < 4; ++q) sl[q] = rt_s[(m + 2 * NGW) * 4 + q]; } }
            float ss = 0.f;
#pragma unroll
            for (int j = 0; j < 8; ++j) { const f32x4 m5 = *(const f32x4*)(modl + 5 * 2048 + 4 * lane + 256 * j); v[j] = v[j] + m5 * y[j]; ss += v[j][0] * v[j][0] + v[j][1] * v[j][1] + v[j][2] * v[j][2] + v[j][3] * v[j][3]; }
            const float rstd = rsqrtf(wave_sum(ss) * (1.0f / D) + EPS);
            float* orow = A->out + (size_t)m * D + 4 * lane;
#pragma unroll
            for (int j = 0; j < 8; ++j) { const f32x4 fg = *(const f32x4*)(A->final_g + 4 * lane + 256 * j); *(f32x4*)(orow + 256 * j) = v[j] * rstd * fg; }
            if (more) { P12_SUM();
#pragma unroll
                for (int j = 0; j < 8; ++j) v[j] = vn[j]; }
        }
#undef P12_SUM
#undef P12_LOAD
    }
    }
#undef IN
#undef SEAM
}

#undef modl
#undef modc
#undef rope
#undef lbf
#undef lbb
#undef wrp
#undef cvec
#undef tile_expert
#undef ntiles_p
#undef rt_e
#undef rt_g
#undef rt_r
#undef rt_s
#undef slot_rowoff
#undef slot_gate
#undef Dlog
#undef KR
#undef VTg
#undef Lbuf
#undef WIN
#undef WM
#undef WO
#undef WGU
#undef WDN
#undef H
#undef PROJ
#undef ACT
#undef YAB
#undef OSCR
#undef MERGED
#undef X1
#undef YS
extern "C" void kernel_launch(void* const* d_in, const int* in_sizes, int n_in, void* d_out, int out_size, void* d_ws, size_t ws_size, hipStream_t stream) {
    static int grid = 0;
    if (grid == 0) {
        if (n_in != 24 || out_size != NTOK * D || ws_size < WS_END) { fprintf(stderr, "kernel_launch: unexpected shapes (n_in %d out %d ws %zu)\n", n_in, out_size, ws_size); grid = -1; return; }
        int dev = 0, cus = 0, per_cu = 0;
        if (hipGetDevice(&dev) != hipSuccess || hipDeviceGetAttribute(&cus, hipDeviceAttributeMultiprocessorCount, dev) != hipSuccess) { grid = -1; return; }
        if (hipFuncSetAttribute((const void*)fwd_kernel, hipFuncAttributeMaxDynamicSharedMemorySize, LDS_BYTES) != hipSuccess) { fprintf(stderr, "kernel_launch: hipFuncSetAttribute failed\n"); grid = -1; return; }
        if (hipOccupancyMaxActiveBlocksPerMultiprocessor(&per_cu, (const void*)fwd_kernel, NWAVES * 64, LDS_BYTES) != hipSuccess || per_cu < 1) { fprintf(stderr, "kernel_launch: occupancy query says %d\n", per_cu); (void)hipGetLastError(); grid = -1; return; }
        grid = cus;
    }
    if (grid < 0) return;
    if (hipMemsetAsync((char*)d_ws + WS_CTL, 0, CTL_ZERO_BYTES, stream) != hipSuccess) return;
    Args a{};
    const float** p = (const float**)&a;
    for (int i = 0; i < 24; ++i) p[i] = (const float*)d_in[i];
    a.out = (float*)d_out; a.ws = (unsigned char*)d_ws; a.ph_lo = 0; a.ph_hi = 13;
    hipLaunchKernelGGL(fwd_kernel, dim3(grid), dim3(NWAVES * 64), LDS_BYTES, stream, a);
    const hipError_t le = hipPeekAtLastError();
    if (le != hipSuccess) fprintf(stderr, "kernel_launch: launch failed: %s\n", hipGetErrorName(le));
}
```

```cpp
#include <hip/hip_runtime.h>
#include <cstdio>
#include <cstdint>

#define DI __device__ __forceinline__
#define LAS __attribute__((address_space(3)))
typedef unsigned short bf16;
typedef short bf16x8 __attribute__((ext_vector_type(8)));
typedef float f32x2 __attribute__((ext_vector_type(2)));
typedef float f32x4 __attribute__((ext_vector_type(4)));
typedef float f32x16 __attribute__((ext_vector_type(16)));
typedef unsigned u32x2 __attribute__((ext_vector_type(2)));
typedef unsigned u32x4 __attribute__((ext_vector_type(4)));
typedef __bf16 bf16x2_t __attribute__((ext_vector_type(2)));
typedef int i32x4 __attribute__((ext_vector_type(4)));

DI unsigned pk2(float lo, float hi) { f32x2 v = {lo, hi}; bf16x2_t b = __builtin_convertvector(v, bf16x2_t); return __builtin_bit_cast(unsigned, b); }
DI float bf2f(unsigned short b) { return __uint_as_float(((unsigned)b) << 16); }
DI float bflo(unsigned w) { return __uint_as_float(w << 16); }
DI float bfhi(unsigned w) { return __uint_as_float(w & 0xffff0000u); }
DI unsigned short f2bf(float f) { return (unsigned short)(pk2(f, 0.f) & 0xffffu); }
DI float wave_sum(float v) {
#pragma unroll
    for (int o = 1; o < 64; o <<= 1) v += __shfl_xor(v, o);
    return v;
}
DI float sigmoidf_(float x) { return __builtin_amdgcn_rcpf(1.0f + __expf(-x)); }
#define LDS_WAIT() asm volatile("s_waitcnt lgkmcnt(0)" ::: "memory")
#define VM_WAIT() asm volatile("s_waitcnt vmcnt(0)" ::: "memory")

constexpr int D = 2048, NTOK = 16384, NCTX = 256, MROWS = NTOK + NCTX;
constexpr int INC = 10496;
constexpr int C_AQ = 0, C_AK = 1024, C_AV = 1152, C_BQ = 1280, C_ZF = 2304, C_ZB = 3328, C_BV = 4352, C_BG = 5376, C_GA = 6400, C_GB = 8448;
constexpr int NEXP = 32, FF = 2048;
constexpr int MAXTILES = 288, MAXSLOTS = MAXTILES * 256;
constexpr float EPS = 1e-6f;
constexpr int NSEG = 33;
constexpr int NWAVES = 8;

constexpr size_t MiB = 1u << 20;
constexpr size_t WS_CTL = 0, CTL_ZERO_BYTES = 1 * MiB;
constexpr size_t WS_SMALL = 1 * MiB;
constexpr size_t SM_MODL = 0, SM_MODC = 49152, SM_ROPE = 65536, SM_LB = 131072, SM_WRP = 262144, SM_CVEC = 524288, SM_TILE = 528384;
constexpr size_t WS_ROUTE = 2 * MiB;
constexpr size_t RT_E = 0, RT_G = 262144, RT_R = 524288, RT_S = 786432, RT_OFF = 1048576, RT_SG = 1048576 + 294912, RT_ARS = 1048576 + 2 * 294912;
static_assert(RT_ARS + (size_t)MAXSLOTS * 4 <= 2 * MiB, "route region");
constexpr size_t DL_CSD = 524288;
constexpr size_t WS_ACT8 = 1276 * MiB;
constexpr size_t WS_DLOG = 4 * MiB;
constexpr size_t WS_KR = 5 * MiB, WS_VT = 10 * MiB;
constexpr size_t WS_CS = 15 * MiB;
constexpr size_t CS_ROW = 524288, CS_SLOT = 524288 + 65536, CS_WIN = 917504, CS_HROW = 966656;
static_assert(CS_SLOT + (size_t)MAXSLOTS * 4 <= CS_WIN && CS_WIN + (size_t)INC * 4 <= CS_HROW && CS_HROW + (size_t)MROWS * 4 <= MiB, "scale arrays");
constexpr size_t WS_L = 16 * MiB;
constexpr size_t WS_WIN = 50 * MiB, WS_WM = 92 * MiB, WS_WO = 100 * MiB, WS_WGU = 108 * MiB, WS_WDN = 620 * MiB;
constexpr size_t WS_H = 876 * MiB, WS_PROJ = 942 * MiB, WS_ACT = WS_PROJ, WS_YAB = 1276 * MiB, WS_OSCR = 1340 * MiB, WS_MERGED = 1468 * MiB, WS_X1 = 1532 * MiB, WS_YS = 1660 * MiB, WS_END = 1948 * MiB;
constexpr size_t PO_AQ = 0, PO_AKV = PO_AQ + (size_t)16 * MROWS * 64, PO_BQ = PO_AKV + (size_t)MROWS * 256, PO_ZF = PO_BQ + (size_t)8 * MROWS * 128, PO_ZB = PO_ZF + (size_t)8 * MROWS * 128,
                 PO_BV = PO_ZB + (size_t)8 * MROWS * 128, PO_BG = PO_BV + (size_t)8 * MROWS * 128, PO_GA = PO_BG + (size_t)8 * MROWS * 128, PO_GB = PO_GA + (size_t)MROWS * 2048, PO_END = PO_GB + (size_t)MROWS * 2048;
static_assert(PO_END == (size_t)MROWS * INC, "projection layout");
static_assert(WS_L + (size_t)16 * NSEG * 65536 <= WS_WIN, "L");
static_assert(WS_PROJ + (size_t)MROWS * INC * 2 <= WS_YAB && WS_ACT + (size_t)MAXSLOTS * FF * 2 <= WS_YAB, "proj/act");
static_assert(WS_H + (size_t)MROWS * D * 2 <= WS_PROJ, "h");
constexpr int CW_BAR = 4096, CW_CNT = 8192, CW_Q = 9216;

constexpr int LDS_BYTES = 163840;
constexpr int MISC_OFF = 163840 - 256;

namespace pg8 {
constexpr int BM = 256, BK = 64, HALF = 128, HTB = HALF * BK * 2, STAGE_BYTES = 8 * HTB, NXCD = 8, WGM = 8;
__host__ __device__ __forceinline__ int lds_byte(int r, int c) { const int st = (r >> 4) * 2 + (c >> 5), rr = r & 15, cc = c & 31, ob = rr * 64 + cc * 2; return st * 1024 + (ob ^ (((ob >> 9) & 1) << 5)); }
__host__ __device__ __forceinline__ void stage_rc(int b, int& R, int& C) { const int st = b / 1024, sb = b % 1024, swz = sb ^ (((sb >> 9) & 1) << 5); R = (st >> 1) * 16 + swz / 64; C = (st & 1) * 32 + (swz % 64) / 2; }
__host__ __device__ __forceinline__ int perm32(int rho) { const int n = rho >> 4, i = rho & 15; return 8 * (i >> 2) + 4 * n + (i & 3); }

struct Unit { int pm, pn, e, brow; };
struct Gemm { const bf16* A; const bf16* Bt; int K; };

struct OrderBase {
    int nM, nN, nwg, G, c;
    DI void init(int nM_, int nN_, int G_, int c_) { nM = nM_; nN = nN_; nwg = nM * nN; G = G_; c = c_; }
    DI bool tile(int i, int& pm, int& pn) const {
        const long L = (long)i * G + c; if (L >= nwg) return false;
        int wgid = (int)L; { const int q = nwg / NXCD, r = nwg % NXCD, xcd = wgid % NXCD, off = wgid / NXCD; wgid = (xcd < r ? xcd * (q + 1) : r * (q + 1) + (xcd - r) * q) + off; }
        const int nig = WGM * nN, gid = wgid / nig, fm = gid * WGM, gsz = (nM - fm) < WGM ? (nM - fm) : WGM;
        pm = fm + ((wgid % nig) % gsz); pn = (wgid % nig) / gsz; return true;
    }
};
struct PlainOrder : OrderBase {
    int K2;
    DI bool next(int i, Unit& u) const { if (!tile(i, u.pm, u.pn)) return false; u.e = 0; u.brow = u.pn * BM; return true; }
    DI unsigned rowoff(const Unit& u, int r) const { return (unsigned)(u.pm * BM + r) * (unsigned)K2; }
};
template <bool GATHER> struct MoeOrder : OrderBase {
    int K2, nper;
    const int* texp; const unsigned* sroff;
    DI bool next(int i, Unit& u) const { if (!tile(i, u.pm, u.pn)) return false; u.e = texp[u.pm]; u.brow = u.e * nper + u.pn * BM; return true; }
    DI unsigned rowoff(const Unit& u, int r) const { if (GATHER) return sroff[u.pm * BM + r]; else return (unsigned)(u.pm * BM + r) * (unsigned)K2; }
};

template <class Epi, class Sched, bool I8 = false, bool ALIGN_EPI = true, bool SP2 = true>
__device__ __forceinline__ void gemm_phase(LAS unsigned char* lds, const Gemm g, const Sched& S, const Epi& E) {
    const int tid = threadIdx.x, wid = __builtin_amdgcn_readfirstlane(tid >> 6), lane = tid & 63, wr = wid >> 2, wc = wid & 3, fr = lane & 15, fq = lane >> 4;
    const int K = g.K, nt = K / BK;
    int stR[2]; unsigned stC2[2], voffB[2];
#pragma unroll
    for (int i = 0; i < 2; ++i) { int R, C; stage_rc(tid * 16 + i * 8192, R, C); const int Rb = Epi::PERM ? ((R & ~31) + perm32(R & 31)) : R;
        stR[i] = R; stC2[i] = (unsigned)C * 2u; voffB[i] = (unsigned)(Rb * K + C) * 2u; }
    const size_t kstep = (size_t)(BK * 2);
    const size_t hstep = (size_t)HALF * K * 2;
    const unsigned ldsw = (unsigned)wid * 1024u;
    const int aoffL = lds_byte(wr * 64 + fr, fq * 8), boffL = lds_byte(wc * 32 + fr, fq * 8);
#define PG8_SA(b, h) (((b) * 2 + (h)) * HTB)
#define PG8_SB(b, h) ((4 + (b) * 2 + (h)) * HTB)
#define PG8_STAGE(bufoff, gbase, voff) do { _Pragma("unroll") for (int _i = 0; _i < 2; ++_i) \
        __builtin_amdgcn_global_load_lds((const unsigned*)((const char*)(gbase) + (voff)[_i]), (LAS unsigned*)(lds + (bufoff) + ldsw + _i * 8192), 16, 0, 0); } while (0)
#define PG8_LDA(dst, b, h) do { _Pragma("unroll") for (int m = 0; m < 4; ++m) _Pragma("unroll") for (int k = 0; k < 2; ++k) dst[m][k] = *(const LAS bf16x8*)(lds + PG8_SA(b, h) + aoffL + m * 2048 + k * 1024); } while (0)
#define PG8_LDB(dst, b, h) do { _Pragma("unroll") for (int n = 0; n < 2; ++n) _Pragma("unroll") for (int k = 0; k < 2; ++k) dst[n][k] = *(const LAS bf16x8*)(lds + PG8_SB(b, h) + boffL + n * 2048 + k * 1024); } while (0)
#define PG8_MMA(ai, bj, At, Bt) do { __builtin_amdgcn_s_setprio(1); _Pragma("unroll") for (int m = 0; m < 4; ++m) _Pragma("unroll") for (int n = 0; n < 2; ++n) _Pragma("unroll") for (int k = 0; k < 2; ++k) \
        { if constexpr (I8) acc[ai][bj][m][n] = __builtin_bit_cast(f32x4, __builtin_amdgcn_mfma_i32_16x16x64_i8(__builtin_bit_cast(i32x4, Bt[n][k]), __builtin_bit_cast(i32x4, At[m][k]), __builtin_bit_cast(i32x4, acc[ai][bj][m][n]), 0, 0, 0)); \
          else acc[ai][bj][m][n] = __builtin_amdgcn_mfma_f32_16x16x32_bf16(Bt[n][k], At[m][k], acc[ai][bj][m][n], 0, 0, 0); } __builtin_amdgcn_s_setprio(0); } while (0)
#define PG8_WAIT_V(n) asm volatile("s_waitcnt vmcnt(" #n ")" ::: "memory")
#define PG8_WAIT_L(n) asm volatile("s_waitcnt lgkmcnt(" #n ")" ::: "memory")
#define PG8_BAR __builtin_amdgcn_s_barrier()
#define PG8_SCHED __builtin_amdgcn_sched_barrier(0)
    Unit cur, nxt; int ui = 0;
    if (!S.next(0, cur)) return;
    f32x4 acc[2][2][4][2];
#pragma unroll
    for (int a = 0; a < 2; ++a)
#pragma unroll
        for (int b = 0; b < 2; ++b)
#pragma unroll
            for (int m = 0; m < 4; ++m)
#pragma unroll
                for (int n = 0; n < 2; ++n) acc[a][b][m][n] = (f32x4){0.f, 0.f, 0.f, 0.f};
    bf16x8 At[4][2], B0[2][2], B1[2][2];
    unsigned ao0[2], ao1[2], no0[2], no1[2];
#pragma unroll
    for (int i = 0; i < 2; ++i) { ao0[i] = S.rowoff(cur, stR[i]) + stC2[i]; ao1[i] = S.rowoff(cur, HALF + stR[i]) + stC2[i]; no0[i] = ao0[i]; no1[i] = ao1[i]; }
    const char* Ab = (const char*)g.A;
    const char* cB = (const char*)g.Bt + (size_t)cur.brow * K * 2;
    if constexpr (SP2) {
        PG8_STAGE(PG8_SB(0, 0), cB, voffB); PG8_STAGE(PG8_SB(0, 1), cB + hstep, voffB); PG8_STAGE(PG8_SA(0, 0), Ab, ao0); PG8_STAGE(PG8_SA(0, 1), Ab, ao1);
        if (wr == 1) PG8_BAR;
        PG8_WAIT_V(2); PG8_BAR;
        PG8_STAGE(PG8_SB(1, 0), cB + kstep, voffB); PG8_STAGE(PG8_SA(1, 0), Ab + kstep, ao0); PG8_STAGE(PG8_SB(1, 1), cB + hstep + kstep, voffB);
        PG8_WAIT_V(6); PG8_BAR;
    } else {
        PG8_STAGE(PG8_SB(0, 0), cB, voffB); PG8_STAGE(PG8_SA(0, 0), Ab, ao0); PG8_STAGE(PG8_SB(0, 1), cB + hstep, voffB); PG8_STAGE(PG8_SA(0, 1), Ab, ao1);
        if (wr == 1) PG8_BAR;
        PG8_WAIT_V(4); PG8_BAR;
        PG8_STAGE(PG8_SB(1, 0), cB + kstep, voffB); PG8_STAGE(PG8_SA(1, 0), Ab + kstep, ao0); PG8_STAGE(PG8_SB(1, 1), cB + hstep + kstep, voffB);
        PG8_WAIT_V(6); PG8_BAR;
    }
    for (;;) {
        const bool has_next = S.next(ui + 1, nxt);
        if (has_next) {
#pragma unroll
            for (int i = 0; i < 2; ++i) { no0[i] = S.rowoff(nxt, stR[i]) + stC2[i]; no1[i] = S.rowoff(nxt, HALF + stR[i]) + stC2[i]; }
        }
        const char* nB = has_next ? (const char*)g.Bt + (size_t)nxt.brow * K * 2 : cB;
        for (int t = 0; t < nt; t += 2) {
            const bool last = (t == nt - 2);
            if constexpr (Epi::HOOK) { if (t == nt / 2) E.hook(acc, cur, wr, wc, fr, fq); }
            const char* a1 = Ab + (size_t)(t + 1) * kstep;
            const char* a2 = last ? Ab : Ab + (size_t)(t + 2) * kstep; const char* b2 = last ? nB : cB + (size_t)(t + 2) * kstep;
            const char* a3 = a2 + kstep; const char* b3 = b2 + kstep;
            unsigned x0[2], x1[2];
#pragma unroll
            for (int i = 0; i < 2; ++i) { x0[i] = last ? no0[i] : ao0[i]; x1[i] = last ? no1[i] : ao1[i]; }
            if constexpr (SP2) {
            PG8_LDB(B0, 0, 0); PG8_LDB(B1, 0, 1); PG8_SCHED; PG8_LDA(At, 0, 0); PG8_STAGE(PG8_SA(1, 1), a1, ao1);
            PG8_WAIT_V(8); PG8_WAIT_L(0); PG8_BAR; PG8_MMA(0, 0, At, B0); PG8_MMA(0, 1, At, B1); PG8_BAR; PG8_SCHED;
            PG8_LDA(At, 0, 1); PG8_STAGE(PG8_SB(0, 0), b2, voffB); PG8_STAGE(PG8_SB(0, 1), b2 + hstep, voffB); PG8_STAGE(PG8_SA(0, 0), a2, x0);
            PG8_WAIT_V(8); PG8_WAIT_L(0); PG8_BAR; PG8_MMA(1, 0, At, B0); PG8_MMA(1, 1, At, B1); PG8_BAR; PG8_SCHED;
            PG8_LDB(B0, 1, 0); PG8_LDB(B1, 1, 1); PG8_SCHED; PG8_LDA(At, 1, 0); PG8_STAGE(PG8_SA(0, 1), a2, x1);
            PG8_WAIT_V(8); PG8_WAIT_L(0); PG8_BAR; PG8_MMA(0, 0, At, B0); PG8_MMA(0, 1, At, B1); PG8_BAR; PG8_SCHED;
            PG8_LDA(At, 1, 1); PG8_STAGE(PG8_SB(1, 0), b3, voffB); PG8_STAGE(PG8_SB(1, 1), b3 + hstep, voffB); PG8_STAGE(PG8_SA(1, 0), a3, x0);
            PG8_WAIT_V(8); PG8_WAIT_L(0); PG8_BAR; PG8_MMA(1, 0, At, B0); PG8_MMA(1, 1, At, B1); PG8_BAR; PG8_SCHED;
            } else {
            PG8_LDB(B0, 0, 0); PG8_SCHED; PG8_LDA(At, 0, 0); PG8_STAGE(PG8_SA(1, 1), a1, ao1);
            PG8_WAIT_L(8); PG8_BAR; PG8_WAIT_L(0); PG8_MMA(0, 0, At, B0); PG8_BAR; PG8_SCHED;
            PG8_LDB(B1, 0, 1); PG8_STAGE(PG8_SB(0, 0), b2, voffB);
            PG8_BAR; PG8_WAIT_L(0); PG8_MMA(0, 1, At, B1); PG8_BAR;
            PG8_LDA(At, 0, 1); PG8_STAGE(PG8_SA(0, 0), a2, x0);
            PG8_BAR; PG8_WAIT_L(0); PG8_MMA(1, 0, At, B0); PG8_BAR; PG8_SCHED;
            PG8_STAGE(PG8_SB(0, 1), b2 + hstep, voffB);
            PG8_WAIT_V(6); PG8_BAR; PG8_MMA(1, 1, At, B1); PG8_BAR;
            PG8_LDB(B0, 1, 0); PG8_SCHED; PG8_LDA(At, 1, 0); PG8_STAGE(PG8_SA(0, 1), a2, x1);
            PG8_WAIT_L(8); PG8_BAR; PG8_WAIT_L(0); PG8_MMA(0, 0, At, B0); PG8_BAR; PG8_SCHED;
            PG8_LDB(B1, 1, 1); PG8_STAGE(PG8_SB(1, 0), b3, voffB);
            PG8_BAR; PG8_WAIT_L(0); PG8_MMA(0, 1, At, B1); PG8_BAR;
            PG8_LDA(At, 1, 1); PG8_STAGE(PG8_SA(1, 0), a3, x0);
            PG8_BAR; PG8_WAIT_L(0); PG8_MMA(1, 0, At, B0); PG8_BAR; PG8_SCHED;
            PG8_STAGE(PG8_SB(1, 1), b3 + hstep, voffB);
            PG8_WAIT_V(6); PG8_BAR; PG8_MMA(1, 1, At, B1); PG8_BAR;
            }
        }
        if constexpr (ALIGN_EPI) { if (wr == 0) PG8_BAR; }
        E(acc, cur, wr, wc, fr, fq);
        if (!has_next) break;
#pragma unroll
        for (int a = 0; a < 2; ++a)
#pragma unroll
            for (int b = 0; b < 2; ++b)
#pragma unroll
                for (int m = 0; m < 4; ++m)
#pragma unroll
                    for (int n = 0; n < 2; ++n) acc[a][b][m][n] = (f32x4){0.f, 0.f, 0.f, 0.f};
        cur = nxt; cB = nB; ++ui;
#pragma unroll
        for (int i = 0; i < 2; ++i) { ao0[i] = no0[i]; ao1[i] = no1[i]; }
        if constexpr (ALIGN_EPI) { if (wr == 1) PG8_BAR; }
    }
    PG8_WAIT_V(0);
    if constexpr (!ALIGN_EPI) { if (wr == 0) PG8_BAR; }
    PG8_BAR;
#undef PG8_SA
#undef PG8_SB
#undef PG8_STAGE
#undef PG8_LDA
#undef PG8_LDB
#undef PG8_MMA
#undef PG8_WAIT_V
#undef PG8_WAIT_L
#undef PG8_BAR
#undef PG8_SCHED
}
}

using pg8::Unit; using pg8::HALF; using pg8::BM;
struct EpiProj {
    static constexpr bool PERM = true, HOOK = false;
    bf16* P; const float* lbf; const float* lbb; const float* hrs; const float* wcs;
    DI void hook(f32x4 (&)[2][2][4][2], const Unit&, int, int, int, int) const {}
    DI void operator()(const f32x4 (&acc)[2][2][4][2], const Unit& u, int wr, int wc, int fr, int fq) const {
        const int pn = u.pn; int cls, cbase, hs, pitch; size_t po; const float* lb = lbf;
        if (pn < 4)       { cls = 0; cbase = C_AQ; po = PO_AQ;  hs = 6;  pitch = 64; }
        else if (pn < 5)  { cls = 0; cbase = C_AK; po = PO_AKV; hs = 30; pitch = 256; }
        else if (pn < 9)  { cls = 1; cbase = C_BQ; po = PO_BQ;  hs = 7;  pitch = 128; }
        else if (pn < 13) { cls = 2; cbase = C_ZF; po = PO_ZF;  hs = 7;  pitch = 128; }
        else if (pn < 17) { cls = 2; cbase = C_ZB; po = PO_ZB;  hs = 7;  pitch = 128; lb = lbb; }
        else if (pn < 21) { cls = 0; cbase = C_BV; po = PO_BV;  hs = 7;  pitch = 128; }
        else if (pn < 25) { cls = 1; cbase = C_BG; po = PO_BG;  hs = 7;  pitch = 128; }
        else if (pn < 33) { cls = 3; cbase = C_GA; po = PO_GA;  hs = 30; pitch = 2048; }
        else              { cls = 3; cbase = C_GB; po = PO_GB;  hs = 30; pitch = 2048; }
        int zz = 0; asm volatile("" : "+v"(zz));
        const int row0 = u.pm * BM + wr * 64 + fr + zz, cin0 = u.pn * BM + wc * 32 + 8 * fq - cbase;
        bf16* base = P + po;
#pragma unroll
        for (int bj = 0; bj < 2; ++bj) {
            float lbv[8];
            const int cin = cin0 + bj * HALF;
            { const int ci = (cls == 2) ? cin : 0; const f32x4 a = *(const f32x4*)(lb + ci), b = *(const f32x4*)(lb + ci + 4);
#pragma unroll
              for (int j = 0; j < 4; ++j) { lbv[j] = (cls == 2) ? a[j] : 0.f; lbv[4 + j] = (cls == 2) ? b[j] : 0.f; } }
            bf16* colp = base + (size_t)(cin >> hs) * MROWS * pitch + (cin & ((1 << hs) - 1));
            float csv[8];
            { const f32x4 a = *(const f32x4*)(wcs + cin + cbase), b = *(const f32x4*)(wcs + cin + cbase + 4);
#pragma unroll
              for (int j = 0; j < 4; ++j) { csv[j] = a[j]; csv[4 + j] = b[j]; } }
#pragma unroll
            for (int ai = 0; ai < 2; ++ai)
#pragma unroll
                for (int m = 0; m < 4; ++m) { const int rr = row0 + ai * HALF + m * 16; const size_t ro = (size_t)rr * pitch; float v[8]; const float rs = hrs[rr];
#pragma unroll
                    for (int j = 0; j < 8; ++j) v[j] = (float)__builtin_bit_cast(i32x4, acc[ai][bj][m][j >> 2])[j & 3] * (rs * csv[j]);
                    if (cls != 0) {
#pragma unroll
                        for (int j = 0; j < 8; ++j) { const float sg = sigmoidf_(v[j]); v[j] = (cls == 1) ? v[j] * sg : sg; }
                        if (cls == 2) {
#pragma unroll
                            for (int j = 0; j < 8; ++j) { const float l = lbv[j]; v[j] = __logf(l + (1.0f - l) * v[j]); } }
                    }
                    u32x4 w; w.x = pk2(v[0], v[1]); w.y = pk2(v[2], v[3]); w.z = pk2(v[4], v[5]); w.w = pk2(v[6], v[7]);
                    *(u32x4*)(colp + ro) = w; }
        }
    }
};
struct EpiMerge {
    static constexpr bool PERM = true, HOOK = true;
    bf16* O; const bf16* proj;
    DI void hook(f32x4 (&acc)[2][2][4][2], const Unit& u, int wr, int wc, int fr, int fq) const {
        int zz = 0; asm volatile("" : "+v"(zz));
        const int row0 = u.pm * BM + wr * 64 + fr + zz, col0 = u.pn * BM + wc * 32 + 8 * fq;
#pragma unroll
        for (int ai = 0; ai < 2; ++ai)
#pragma unroll
            for (int m = 0; m < 4; ++m) { const size_t rowp = (size_t)(row0 + ai * HALF + m * 16) * D + col0;
#pragma unroll
                for (int bj = 0; bj < 2; ++bj) { const u32x4 ga = *(const u32x4*)(proj + PO_GA + rowp + bj * HALF), gb = *(const u32x4*)(proj + PO_GB + rowp + bj * HALF);
#pragma unroll
                    for (int q = 0; q < 4; ++q) { const float r0 = bflo(ga[q]) * __builtin_amdgcn_rcpf(bflo(gb[q])), r1 = bfhi(ga[q]) * __builtin_amdgcn_rcpf(bfhi(gb[q]));
                        acc[ai][bj][m][q >> 1][(q & 1) * 2] *= r0; acc[ai][bj][m][q >> 1][(q & 1) * 2 + 1] *= r1; } }
                asm volatile("" ::: "memory"); }
    }
    DI void operator()(const f32x4 (&acc)[2][2][4][2], const Unit& u, int wr, int wc, int fr, int fq) const {
        const int row0 = u.pm * BM + wr * 64 + fr, col0 = u.pn * BM + wc * 32 + 8 * fq;
#pragma unroll
        for (int ai = 0; ai < 2; ++ai)
#pragma unroll
            for (int m = 0; m < 4; ++m) { const size_t r = (size_t)(row0 + ai * HALF + m * 16);
#pragma unroll
                for (int bj = 0; bj < 2; ++bj) { const u32x4 gb = *(const u32x4*)(proj + PO_GB + r * D + col0 + bj * HALF); u32x4 w;
#pragma unroll
                    for (int q = 0; q < 4; ++q) w[q] = pk2(acc[ai][bj][m][q >> 1][(q & 1) * 2] * bflo(gb[q]), acc[ai][bj][m][q >> 1][(q & 1) * 2 + 1] * bfhi(gb[q]));
                    *(u32x4*)(O + r * D + col0 + bj * HALF) = w; } }
    }
};
struct EpiOut {
    static constexpr bool PERM = false, HOOK = false;
    float* X1; const float* x; const float* mod2;
    DI void hook(f32x4 (&)[2][2][4][2], const Unit&, int, int, int, int) const {}
    DI void operator()(const f32x4 (&acc)[2][2][4][2], const Unit& u, int wr, int wc, int fr, int fq) const {
        const int row0 = u.pm * BM + wr * 64 + fr, col0 = u.pn * BM + wc * 32 + 4 * fq;
        f32x4 mv[2][2];
#pragma unroll
        for (int bj = 0; bj < 2; ++bj)
#pragma unroll
            for (int n = 0; n < 2; ++n) mv[bj][n] = *(const f32x4*)(mod2 + col0 + bj * HALF + n * 16);
#pragma unroll
        for (int ai = 0; ai < 2; ++ai)
#pragma unroll
            for (int m = 0; m < 4; ++m) { const size_t off = (size_t)(row0 + ai * HALF + m * 16) * D + col0;
#pragma unroll
                for (int bj = 0; bj < 2; ++bj)
#pragma unroll
                    for (int n = 0; n < 2; ++n) { const f32x4 xv = *(const f32x4*)(x + off + bj * HALF + n * 16);
                        *(f32x4*)(X1 + off + bj * HALF + n * 16) = xv + mv[bj][n] * acc[ai][bj][m][n]; } }
    }
};
struct EpiAct {
    static constexpr bool PERM = true, HOOK = false;
    bf16* ACTp; const float* bg; const float* bu; const float* cs; const float* srs;
    DI void hook(f32x4 (&)[2][2][4][2], const Unit&, int, int, int, int) const {}
    DI void operator()(const f32x4 (&acc)[2][2][4][2], const Unit& u, int wr, int wc, int fr, int fq) const {
        int zz = 0; asm volatile("" : "+v"(zz));
        const int row0 = u.pm * BM + wr * 64 + fr + zz, col0 = u.pn * HALF + wc * 32 + 8 * fq, nb = u.e * 4096 + u.pn * BM + wc * 32 + 8 * fq;
        float gbv[8], ubv[8], gsc[8], usc[8];
        { const f32x4 a = *(const f32x4*)(bg + u.e * FF + col0), b = *(const f32x4*)(bg + u.e * FF + col0 + 4), c = *(const f32x4*)(bu + u.e * FF + col0), d = *(const f32x4*)(bu + u.e * FF + col0 + 4);
          const f32x4 sa = *(const f32x4*)(cs + nb), sb = *(const f32x4*)(cs + nb + 4), sc = *(const f32x4*)(cs + nb + HALF), sd = *(const f32x4*)(cs + nb + HALF + 4);
#pragma unroll
          for (int j = 0; j < 4; ++j) { gbv[j] = a[j]; gbv[4 + j] = b[j]; ubv[j] = c[j]; ubv[4 + j] = d[j]; gsc[j] = sa[j]; gsc[4 + j] = sb[j]; usc[j] = sc[j]; usc[4 + j] = sd[j]; } }
#pragma unroll
        for (int ai = 0; ai < 2; ++ai)
#pragma unroll
            for (int m = 0; m < 4; ++m) { float v[8]; const int r = row0 + ai * HALF + m * 16; const float rs = srs[r];
#pragma unroll
                for (int j = 0; j < 8; ++j) { const i32x4 ga = __builtin_bit_cast(i32x4, acc[ai][0][m][j >> 2]), ua = __builtin_bit_cast(i32x4, acc[ai][1][m][j >> 2]);
                    float gg = (float)ga[j & 3] * (rs * gsc[j]) + gbv[j], uu = (float)ua[j & 3] * (rs * usc[j]) + ubv[j];
                    gg = fminf(gg, 7.0f); uu = fminf(fmaxf(uu, -7.0f), 7.0f);
                    v[j] = gg * sigmoidf_(1.702f * gg) * (uu + 1.0f); }
                u32x4 w; w.x = pk2(v[0], v[1]); w.y = pk2(v[2], v[3]); w.z = pk2(v[4], v[5]); w.w = pk2(v[6], v[7]);
                *(u32x4*)(ACTp + (size_t)r * FF + col0) = w; }
    }
};
struct EpiDown {
    static constexpr bool PERM = true, HOOK = false;
    bf16* YSp; const float* bd; const float* sgate; const float* ars; const float* csd;
    DI void hook(f32x4 (&)[2][2][4][2], const Unit&, int, int, int, int) const {}
    DI void operator()(const f32x4 (&acc)[2][2][4][2], const Unit& u, int wr, int wc, int fr, int fq) const {
        int zz = 0; asm volatile("" : "+v"(zz));
        const int row0 = u.pm * BM + wr * 64 + fr + zz, col0 = u.pn * BM + wc * 32 + 8 * fq;
#pragma unroll
        for (int bj = 0; bj < 2; ++bj) { float bv[8], cv[8];
            { const f32x4 a = *(const f32x4*)(bd + u.e * D + col0 + bj * HALF), b = *(const f32x4*)(bd + u.e * D + col0 + bj * HALF + 4), c = *(const f32x4*)(csd + u.e * D + col0 + bj * HALF), d = *(const f32x4*)(csd + u.e * D + col0 + bj * HALF + 4);
#pragma unroll
              for (int j = 0; j < 4; ++j) { bv[j] = a[j]; bv[4 + j] = b[j]; cv[j] = c[j]; cv[4 + j] = d[j]; } }
#pragma unroll
            for (int ai = 0; ai < 2; ++ai)
#pragma unroll
                for (int m = 0; m < 4; ++m) { const int r = row0 + ai * HALF + m * 16; const float gt = sgate[r], rs = ars[r]; u32x4 w;
#pragma unroll
                    for (int q = 0; q < 4; ++q) { const i32x4 ia = __builtin_bit_cast(i32x4, acc[ai][bj][m][q >> 1]);
                        w[q] = pk2(((float)ia[(q & 1) * 2] * (rs * cv[2 * q]) + bv[2 * q]) * gt, ((float)ia[(q & 1) * 2 + 1] * (rs * cv[2 * q + 1]) + bv[2 * q + 1]) * gt); }
                    *(u32x4*)(YSp + (size_t)r * D + col0 + bj * HALF) = w; } }
    }
};

#define XB_TMO      128
#define XB_XCNT(j)  (256  + 64 * (j))
#define XB_XSUB(j)  (1280 + 64 * (j))
#define XB_XGEN(j)  (2304 + 64 * (j))
#define XB_TOP      3328
#define XB_TOPGEN   3392
#define XCD_BAR_WORDS 3456
#define XB_SPIN_CAP (1u << 22)
DI unsigned xb_ld(unsigned* p)              { return __hip_atomic_load(p, __ATOMIC_RELAXED, __HIP_MEMORY_SCOPE_AGENT); }
DI unsigned xb_add(unsigned* p, unsigned v) { return __hip_atomic_fetch_add(p, v, __ATOMIC_RELAXED, __HIP_MEMORY_SCOPE_AGENT); }
DI unsigned xb_xcc_id() { return (unsigned)__builtin_amdgcn_s_getreg((3 << 11) | 20) & 0xFu; }
#define XB_SPIN(cond, bar) do { unsigned _sp = 0; while (cond) { __builtin_amdgcn_s_sleep(1); \
    if ((++_sp & 255u) == 0u) { if (xb_ld(&(bar)[XB_TMO])) break; if (_sp > XB_SPIN_CAP) { atomicAdd(&(bar)[XB_TMO], 1u); break; } } } } while (0)
struct XcdBarrier { unsigned* bar; unsigned x; volatile LAS unsigned* st; };
DI XcdBarrier xcd_barrier_post(unsigned* bar, volatile LAS unsigned* st) {
    XcdBarrier b; b.bar = bar; b.x = xb_xcc_id(); b.st = st;
    if (threadIdx.x == 0) (void)xb_add(&bar[XB_XCNT(b.x)], 1u);
    return b;
}
DI void xcd_barrier_complete(unsigned* bar, unsigned x, unsigned& nloc, unsigned& nx) {
    const unsigned G = gridDim.x * gridDim.y * gridDim.z;
    unsigned sum, cnt, mine, sp = 0u;
    for (;;) {
        sum = 0u; cnt = 0u; mine = 0u;
#pragma unroll
        for (unsigned j = 0; j < 16; ++j) { const unsigned c = xb_ld(&bar[XB_XCNT(j)]); sum += c; cnt += (c > 0u) ? 1u : 0u; mine = (j == x) ? c : mine; }
        if (sum == G) break;
        __builtin_amdgcn_s_sleep(1);
        if ((++sp & 255u) == 0u) { if (xb_ld(&bar[XB_TMO])) break; if (sp > XB_SPIN_CAP) { atomicAdd(&bar[XB_TMO], 1u); break; } }
    }
    nloc = mine > 0u ? mine : 1u; nx = cnt > 0u ? cnt : 1u;
}
DI void xcd_barrier(const XcdBarrier& b) {
    asm volatile("s_waitcnt vmcnt(0)" ::: "memory");
    __syncthreads();
    if (threadIdx.x == 0) {
        unsigned* bar = b.bar;
        __builtin_amdgcn_s_waitcnt(0);
        unsigned nloc = b.st[0], nx = b.st[1];
        if (nloc == 0u) { xcd_barrier_complete(bar, b.x, nloc, nx); b.st[0] = nloc; b.st[1] = nx; }
        const unsigned old = xb_add(&bar[XB_XSUB(b.x)], 1u);
        const unsigned gen = old / nloc;
        if (old + 1u == (gen + 1u) * nloc) {
            __builtin_amdgcn_fence(__ATOMIC_RELEASE, "agent");
            asm volatile("s_waitcnt vmcnt(0)" ::: "memory");
            const unsigned og = xb_add(&bar[XB_TOP], 1u);
            const unsigned tg = og / nx;
            if (og + 1u == (tg + 1u) * nx) xb_add(&bar[XB_TOPGEN], 1u);
            else XB_SPIN(xb_ld(&bar[XB_TOPGEN]) == tg, bar);
            __builtin_amdgcn_fence(__ATOMIC_ACQUIRE, "agent");
            xb_add(&bar[XB_XGEN(b.x)], 1u);
            asm volatile("s_waitcnt vmcnt(0)" ::: "memory");
        } else {
            XB_SPIN(xb_ld(&bar[XB_XGEN(b.x)]) == gen, bar);
            __builtin_amdgcn_fence(__ATOMIC_ACQUIRE, "agent");
            asm volatile("s_waitcnt vmcnt(0)" ::: "memory");
        }
    }
    __syncthreads();
}

struct Args {
    const float *x, *c, *ctx, *c_ctx, *norm_mix_g, *norm_ffn_g, *w_mod, *b_mod, *w_in, *sinks, *lbf_logits, *lbb_logits, *hgrn_g, *w_branch, *w_out,
                *w_router, *b_router, *w_e_gate, *b_e_gate, *w_e_up, *b_e_up, *w_e_down, *b_e_down, *final_g;
    float* out; unsigned char* ws; int ph_lo, ph_hi;
};

DI void p0_transpose64(const float* W, int ldw, bf16* WT, int ldt, LAS unsigned char* scr, int lane) {
    const int kq = lane >> 4, n4 = lane & 15;
    f32x4 v[16];
#pragma unroll
    for (int i = 0; i < 16; ++i) v[i] = *(const f32x4*)(W + (size_t)(16 * kq + i) * ldw + 4 * n4);
#pragma unroll
    for (int c = 0; c < 4; ++c)
#pragma unroll
        for (int h = 0; h < 2; ++h) { u32x4 w; w.x = pk2(v[8 * h][c], v[8 * h + 1][c]); w.y = pk2(v[8 * h + 2][c], v[8 * h + 3][c]); w.z = pk2(v[8 * h + 4][c], v[8 * h + 5][c]); w.w = pk2(v[8 * h + 6][c], v[8 * h + 7][c]);
            *(LAS u32x4*)(scr + (4 * n4 + c) * 144 + (16 * kq + 8 * h) * 2) = w; }
    LDS_WAIT(); asm volatile("" ::: "memory");
#pragma unroll
    for (int j = 0; j < 8; ++j) { const int row = (lane >> 3) + 8 * j, pc = lane & 7; const u32x4 o = *(const LAS u32x4*)(scr + row * 144 + pc * 16); *(u32x4*)(WT + (size_t)row * ldt + pc * 8) = o; }
    LDS_WAIT(); asm volatile("" ::: "memory");
}
DI void p0_quant_item(const float* W  , int ldw, signed char* Q  , float* csp  , LAS unsigned char* lds, int tid) {
    const int lane = tid & 63, w = tid >> 6, n4 = lane & 7, kr = lane >> 3;
    LAS float* smax = (LAS float*)(lds + 32 * 2064);
    f32x4 v[8][4]; f32x4 mx = {0.f, 0.f, 0.f, 0.f};
#pragma unroll
    for (int g = 0; g < 8; ++g)
#pragma unroll
        for (int r = 0; r < 4; ++r) { v[g][r] = *(const f32x4*)(W + (size_t)(256 * g + 32 * w + 4 * kr + r) * ldw + 4 * n4);
            mx[0] = fmaxf(mx[0], fabsf(v[g][r][0])); mx[1] = fmaxf(mx[1], fabsf(v[g][r][1])); mx[2] = fmaxf(mx[2], fabsf(v[g][r][2])); mx[3] = fmaxf(mx[3], fabsf(v[g][r][3])); }
#pragma unroll
    for (int c = 0; c < 4; ++c) { float m = mx[c]; m = fmaxf(m, __shfl_xor(m, 8)); m = fmaxf(m, __shfl_xor(m, 16)); m = fmaxf(m, __shfl_xor(m, 32)); mx[c] = m; }
    __syncthreads();
    if (kr == 0) *(LAS f32x4*)(smax + w * 32 + 4 * n4) = mx;
    __syncthreads();
    f32x4 cm = *(const LAS f32x4*)(smax + 4 * n4);
#pragma unroll
    for (int ww = 1; ww < 8; ++ww) { const f32x4 o = *(const LAS f32x4*)(smax + ww * 32 + 4 * n4); cm[0] = fmaxf(cm[0], o[0]); cm[1] = fmaxf(cm[1], o[1]); cm[2] = fmaxf(cm[2], o[2]); cm[3] = fmaxf(cm[3], o[3]); }
    f32x4 inv;
#pragma unroll
    for (int c = 0; c < 4; ++c) { if (cm[c] == 0.f) cm[c] = 1.f; inv[c] = 127.0f / cm[c]; }
    if (w == 0 && kr == 0) { f32x4 sc; sc[0] = cm[0] * (1.0f / 127.0f); sc[1] = cm[1] * (1.0f / 127.0f); sc[2] = cm[2] * (1.0f / 127.0f); sc[3] = cm[3] * (1.0f / 127.0f); *(f32x4*)(csp + 4 * n4) = sc; }
#pragma unroll
    for (int g = 0; g < 8; ++g)
#pragma unroll
        for (int c = 0; c < 4; ++c) { unsigned pk = 0u;
#pragma unroll
            for (int r = 0; r < 4; ++r) { const int q = (int)rintf(v[g][r][c] * inv[c]); pk |= ((unsigned)q & 0xffu) << (8 * r); }
            *(LAS unsigned*)(lds + (4 * n4 + c) * 2064 + 4 * (64 * g + 8 * w + kr)) = pk; }
    __syncthreads();
#pragma unroll
    for (int i = 0; i < 8; ++i) { const int p = tid + 512 * i, row = p >> 7, pc = p & 127; const u32x4 o = *(const LAS u32x4*)(lds + row * 2064 + pc * 16); *(u32x4*)(Q + (size_t)row * 2048 + pc * 16) = o; }
}

constexpr int SC_QH = 0, SC_KH = 8448, SC_KT = 16896, SC_VT = 26112, SC_FAC = 35328, SC_RZ = 35840, SC_RV = 44032, SC_RQ = 52224, SC_GRP = 60416;
constexpr int RSQ = 264, RST = 72;
DI int crow(int i, int h) { return (i & 3) + 8 * (i >> 2) + 4 * h; }
DI bf16x8 pack8(float a0, float a1, float a2, float a3, float a4, float a5, float a6, float a7) {
    u32x4 p; p.x = pk2(a0, a1); p.y = pk2(a2, a3); p.z = pk2(a4, a5); p.w = pk2(a6, a7); return __builtin_bit_cast(bf16x8, p);
}
DI bf16x8 lds_frag2(const LAS unsigned char* p0, const LAS unsigned char* p1) {
    const u32x2 lo = *(const LAS u32x2*)p0, hi = *(const LAS u32x2*)p1; u32x4 v; v.x = lo.x; v.y = lo.y; v.z = hi.x; v.w = hi.y; return __builtin_bit_cast(bf16x8, v);
}
#define MFMA32(a, b, c) __builtin_amdgcn_mfma_f32_32x32x16_bf16((a), (b), (c), 0, 0, 0)

template <bool OUT>
DI void scan_segment(LAS unsigned char* ldsb, const bf16* proj, int hh, int segF, int segB, float* Lbuf, float* Dlog, bf16* oscr) {
    const int tid = threadIdx.x, lane = tid & 63, wave = __builtin_amdgcn_readfirstlane(tid >> 6);
    const int dir = wave >> 2, w4 = wave & 3, half = w4 >> 1, d = tid & 127, r = lane & 31, h5 = lane >> 5, e0 = 32 * w4;
    const int seg = dir ? segB : segF, scan = dir * 8 + hh;
    const int ntok = (seg == 0) ? NCTX : 512, sgn = dir ? -1 : 1;
    const int r0 = (seg == 0) ? (dir ? MROWS - 1 : NTOK) : (dir ? NTOK - 1 - (seg - 1) * 512 : (seg - 1) * 512);
    LAS unsigned char* G = ldsb + dir * SC_GRP;
    LAS unsigned char* QH = G + SC_QH; LAS unsigned char* KH = G + SC_KH; LAS unsigned char* KT = G + SC_KT; LAS unsigned char* VT = G + SC_VT; LAS float* FAC = (LAS float*)(G + SC_FAC);
    float* Lslot = Lbuf + (size_t)(scan * NSEG + seg) * 16384;
    f32x16 acc[4];
    if (OUT) {
        const float* Sin = Lbuf + (size_t)(scan * NSEG + seg - 1) * 16384;
#pragma unroll
        for (int dt = 0; dt < 4; ++dt)
#pragma unroll
            for (int i = 0; i < 16; ++i) acc[dt][i] = Sin[(32 * dt + crow(i, h5)) * 128 + e0 + r];
    } else {
#pragma unroll
        for (int dt = 0; dt < 4; ++dt)
#pragma unroll
            for (int i = 0; i < 16; ++i) acc[dt][i] = 0.f;
    }
    float tail_prev = 0.f, dlog_tot = 0.f;
    const bf16* zsrc = proj + (dir ? PO_ZB : PO_ZF) + (size_t)hh * MROWS * 128; const bf16* vsrc = proj + PO_BV + (size_t)hh * MROWS * 128; const bf16* qsrc = proj + PO_BQ + (size_t)hh * MROWS * 128;
    const int nch = ntok / 32;
    LAS unsigned char* RZ = G + SC_RZ; LAS unsigned char* RV = G + SC_RV; LAS unsigned char* RQ = G + SC_RQ;
#define SC_SETZ(k) (OUT ? RZ : ((k) == 0 ? RZ : (k) == 1 ? G + SC_QH : ldsb + 2 * SC_GRP + dir * 16384))
#define SC_SETV(k) (OUT ? RV : ((k) == 0 ? RV : (k) == 1 ? G + SC_KH : ldsb + 2 * SC_GRP + dir * 16384 + 8192))
#define SC_DMA(cc) do { const int rb_ = r0 + sgn * 32 * (cc); LAS unsigned char* dz_ = SC_SETZ((cc) % 3); LAS unsigned char* dv_ = SC_SETV((cc) % 3); \
        _Pragma("unroll") for (int i_ = 0; i_ < 2; ++i_) { const int s_ = 8 * w4 + 4 * i_ + (lane >> 4); const size_t so_ = (size_t)(rb_ + sgn * s_) * 128 + 8 * (lane & 15); \
            __builtin_amdgcn_global_load_lds((const unsigned*)(zsrc + so_), (LAS unsigned*)(dz_ + (8 * w4 + 4 * i_) * 256), 16, 0, 0); \
            __builtin_amdgcn_global_load_lds((const unsigned*)(vsrc + so_), (LAS unsigned*)(dv_ + (8 * w4 + 4 * i_) * 256), 16, 0, 0); \
            if (OUT) __builtin_amdgcn_global_load_lds((const unsigned*)(qsrc + so_), (LAS unsigned*)(RQ + (8 * w4 + 4 * i_) * 256), 16, 0, 0); } } while (0)
    SC_DMA(0);
    if (!OUT) SC_DMA(1);
    for (int c = 0; c < nch; ++c) {
        const int rb = r0 + sgn * 32 * c;
        const LAS unsigned char* RZc = SC_SETZ(c % 3); const LAS unsigned char* RVc = SC_SETV(c % 3);
        if ((OUT && c > 0) || (!OUT && c + 1 < nch)) asm volatile("s_waitcnt vmcnt(4)" ::: "memory"); else asm volatile("s_waitcnt vmcnt(0)" ::: "memory");
        asm volatile("s_waitcnt lgkmcnt(0)" ::: "memory"); __builtin_amdgcn_s_barrier(); asm volatile("" ::: "memory");
        float rsum = 0.f, lf[16], vv[16], qq[16];
        if (half) {
#pragma unroll
            for (int s = 0; s < 16; ++s) rsum += bf2f(*(const LAS unsigned short*)(RZc + s * 256 + d * 2));
        }
#pragma unroll
        for (int i = 0; i < 16; ++i) { const int so = (16 * half + i) * 256 + d * 2;
            lf[i] = bf2f(*(const LAS unsigned short*)(RZc + so)); vv[i] = bf2f(*(const LAS unsigned short*)(RVc + so)); if (OUT) qq[i] = bf2f(*(const LAS unsigned short*)(RQ + so)); }
        if (!half) {
#pragma unroll
            for (int i = 0; i < 16; ++i) rsum += lf[i];
        }
        float b = half ? rsum : 0.f, kh[16], qh[16];
#pragma unroll
        for (int i = 0; i < 16; ++i) { b += lf[i]; const float x = b - rsum;
            kh[i] = (1.0f - __expf(lf[i])) * __expf(fminf(-x, 60.f));
            if (OUT) qh[i] = qq[i] * __expf(fminf(x, 60.f)); }
        const float tail = b - rsum;
#pragma unroll
        for (int j = 0; j < 4; ++j) {
            u32x2 w; w.x = pk2(kh[4 * j], kh[4 * j + 1]); w.y = pk2(kh[4 * j + 2], kh[4 * j + 3]); *(LAS u32x2*)(KT + d * RST + 32 * half + 8 * j) = w;
            u32x2 v; v.x = pk2(vv[4 * j], vv[4 * j + 1]); v.y = pk2(vv[4 * j + 2], vv[4 * j + 3]); *(LAS u32x2*)(VT + d * RST + 32 * half + 8 * j) = v;
        }
        if (OUT) {
#pragma unroll
            for (int i = 0; i < 16; ++i) { const int s = 16 * half + i;
                *(LAS unsigned short*)(KH + s * RSQ + d * 2) = f2bf(kh[i]); *(LAS unsigned short*)(QH + s * RSQ + d * 2) = f2bf(qh[i]); }
        }
        if (half) { FAC[d] = __expf(tail_prev + rsum); tail_prev = tail; dlog_tot += rsum + tail; }
        asm volatile("s_waitcnt lgkmcnt(0)" ::: "memory"); __builtin_amdgcn_s_barrier(); asm volatile("" ::: "memory");
        if (OUT) { if (c + 1 < nch) SC_DMA(c + 1); } else { if (c + 2 < nch) SC_DMA(c + 2); }
        asm volatile("" ::: "memory");
#pragma unroll
        for (int dt = 0; dt < 4; ++dt)
#pragma unroll
            for (int g4 = 0; g4 < 4; ++g4) { const f32x4 f = *(const LAS f32x4*)(FAC + 32 * dt + 8 * g4 + 4 * h5);
#pragma unroll
                for (int j = 0; j < 4; ++j) acc[dt][4 * g4 + j] *= f[j]; }
        if (OUT) {
            bf16x8 qf[8];
            f32x16 pT, oT;
#pragma unroll
            for (int i = 0; i < 16; ++i) { pT[i] = 0.f; oT[i] = 0.f; }
#pragma unroll
            for (int kk = 0; kk < 8; ++kk) {
                qf[kk] = lds_frag2(QH + r * RSQ + (16 * kk + 4 * h5) * 2, QH + r * RSQ + (16 * kk + 8 + 4 * h5) * 2);
                const bf16x8 kf = lds_frag2(KH + r * RSQ + (16 * kk + 4 * h5) * 2, KH + r * RSQ + (16 * kk + 8 + 4 * h5) * 2);
                pT = MFMA32(kf, qf[kk], pT);
            }
#pragma unroll
            for (int i = 0; i < 16; ++i) if (crow(i, h5) > r) pT[i] = 0.f;
#pragma unroll
            for (int dt = 0; dt < 4; ++dt)
#pragma unroll
                for (int ks = 0; ks < 2; ++ks) {
                    const bf16x8 sa = pack8(acc[dt][8 * ks], acc[dt][8 * ks + 1], acc[dt][8 * ks + 2], acc[dt][8 * ks + 3], acc[dt][8 * ks + 4], acc[dt][8 * ks + 5], acc[dt][8 * ks + 6], acc[dt][8 * ks + 7]);
                    oT = MFMA32(sa, qf[2 * dt + ks], oT);
                }
#pragma unroll
            for (int ks = 0; ks < 2; ++ks) {
                const bf16x8 pf = pack8(pT[8 * ks], pT[8 * ks + 1], pT[8 * ks + 2], pT[8 * ks + 3], pT[8 * ks + 4], pT[8 * ks + 5], pT[8 * ks + 6], pT[8 * ks + 7]);
                const bf16x8 va = lds_frag2(VT + (e0 + r) * RST + (16 * ks + 4 * h5) * 2, VT + (e0 + r) * RST + (16 * ks + 8 + 4 * h5) * 2);
                oT = MFMA32(va, pf, oT);
            }
            bf16* orow = oscr + ((size_t)(dir * 8 + hh) * NTOK + (rb + sgn * r)) * 128 + e0 + 4 * h5;
#pragma unroll
            for (int g4 = 0; g4 < 4; ++g4) { u32x2 o; o.x = pk2(oT[4 * g4], oT[4 * g4 + 1]); o.y = pk2(oT[4 * g4 + 2], oT[4 * g4 + 3]); *(u32x2*)(orow + 8 * g4) = o; }
        }
#pragma unroll
        for (int ks = 0; ks < 2; ++ks) {
            const bf16x8 vb = lds_frag2(VT + (e0 + r) * RST + (16 * ks + 8 * h5) * 2, VT + (e0 + r) * RST + (16 * ks + 8 * h5) * 2 + 8);
#pragma unroll
            for (int dt = 0; dt < 4; ++dt) {
                const bf16x8 ka = lds_frag2(KT + (32 * dt + r) * RST + (16 * ks + 8 * h5) * 2, KT + (32 * dt + r) * RST + (16 * ks + 8 * h5) * 2 + 8);
                acc[dt] = MFMA32(ka, vb, acc[dt]);
            }
        }
    }
#undef SC_DMA
#undef SC_SETZ
#undef SC_SETV
    if (!OUT) {
        __syncthreads();
        if (half) { FAC[d] = __expf(tail_prev); Dlog[(size_t)(scan * NSEG + seg) * 128 + d] = dlog_tot; }
        __syncthreads();
#pragma unroll
        for (int dt = 0; dt < 4; ++dt)
#pragma unroll
            for (int g4 = 0; g4 < 4; ++g4) { const f32x4 f = *(const LAS f32x4*)(FAC + 32 * dt + 8 * g4 + 4 * h5);
#pragma unroll
                for (int j = 0; j < 4; ++j) Lslot[(32 * dt + 8 * g4 + 4 * h5 + j) * 128 + e0 + r] = acc[dt][4 * g4 + j] * f[j]; }
    }
    __syncthreads();
}

constexpr int AT_KC = 0, AT_VC = 36864, AT_KL = 70144, AT_VL = 116224, AT_END = 157696;
constexpr int KRS = 144, VCRS = 520, VLRS = 648, NSLOT = 10;
static_assert(AT_END <= MISC_OFF, "attention LDS");
static_assert(2 * SC_GRP + 2 * 16384 <= MISC_OFF, "scan LDS");
DI void attn_unit(LAS unsigned char* ldsb, const bf16* proj, const bf16* KR, const bf16* VTg, const float* rope, const float* sinks, bf16* yab, int kvh, int ab) {
    const int tid = threadIdx.x, lane = tid & 63, wave = __builtin_amdgcn_readfirstlane(tid >> 6), r = lane & 31, h5 = lane >> 5;
    const int head = kvh * 8 + wave;
    LAS unsigned char* KC = ldsb + AT_KC; LAS unsigned char* VC = ldsb + AT_VC; LAS unsigned char* KL = ldsb + AT_KL; LAS unsigned char* VL = ldsb + AT_VL;
    const float* rowcos = rope, *rowsin = rope + 4096, *colcos = rope + 8192, *colsin = rope + 8192 + 1024;
    __syncthreads();
    for (int p = tid; p < 2048; p += 512) {
        { const int key = p >> 3, c8 = p & 7; const u32x4 v = *(const u32x4*)(KR + ((size_t)(kvh * MROWS + NTOK + key)) * 64 + c8 * 8); *(LAS u32x4*)(KC + key * KRS + c8 * 16) = v; }
        { const int dd = p >> 5, c = p & 31; const u32x4 v = *(const u32x4*)(VTg + ((size_t)(kvh * 64 + dd)) * MROWS + NTOK + c * 8);
          u32x2 a; a.x = v.x; a.y = v.y; u32x2 b; b.x = v.z; b.y = v.w; *(LAS u32x2*)(VC + dd * VCRS + c * 16) = a; *(LAS u32x2*)(VC + dd * VCRS + c * 16 + 8) = b; }
    }
    const int T0 = ab * 4 - 4;
    for (int p = tid; p < 2304; p += 512) {
        { const int key = p >> 3, c8 = p & 7, T = T0 + (key >> 5), slot = (T + 2 * NSLOT) % NSLOT;
          if (T >= 0 && T < NTOK / 32) { const u32x4 v = *(const u32x4*)(KR + ((size_t)(kvh * MROWS + T * 32 + (key & 31))) * 64 + c8 * 8); *(LAS u32x4*)(KL + (slot * 32 + (key & 31)) * KRS + c8 * 16) = v; } }
        { const int dd = p / 36, c = p % 36, T = T0 + (c >> 2), slot = (T + 2 * NSLOT) % NSLOT;
          if (T >= 0 && T < NTOK / 32) { const u32x4 v = *(const u32x4*)(VTg + ((size_t)(kvh * 64 + dd)) * MROWS + T * 32 + (c & 3) * 8);
            u32x2 a; a.x = v.x; a.y = v.y; u32x2 b; b.x = v.z; b.y = v.w; LAS unsigned char* dst = VL + dd * VLRS + slot * 64 + (c & 3) * 16; *(LAS u32x2*)dst = a; *(LAS u32x2*)(dst + 8) = b; } }
    }
    const float sc = 0.125f * 1.4426950408889634f;
    u32x4 raw[4]; float cs[2][8], sn[2][8];
#define AT_LOADQ(P0) do { const int qp_ = (P0) + r; const bf16* qrow_ = proj + PO_AQ + ((size_t)head * MROWS + qp_) * 64 + 8 * h5; \
        _Pragma("unroll") for (int ks = 0; ks < 4; ++ks) raw[ks] = *(const u32x4*)(qrow_ + 16 * ks); \
        const float* c0_ = rowcos + (qp_ >> 6) * 16 + 8 * h5; const float* s0_ = rowsin + (qp_ >> 6) * 16 + 8 * h5; \
        const float* c1_ = colcos + (qp_ & 63) * 16 + 8 * h5; const float* s1_ = colsin + (qp_ & 63) * 16 + 8 * h5; \
        _Pragma("unroll") for (int j = 0; j < 8; ++j) { cs[0][j] = c0_[j]; sn[0][j] = s0_[j]; cs[1][j] = c1_[j]; sn[1][j] = s1_[j]; } } while (0)
    AT_LOADQ(ab * 128);
    __syncthreads();
    for (int qt = 0; qt < 4; ++qt) {
        const int p0 = ab * 128 + 32 * qt, kb0 = p0 - 128, qp = p0 + r, Tq = ab * 4 + qt - 4;
        bf16x8 qf[4];
#pragma unroll
        for (int ks = 0; ks < 2; ++ks) { float o1[8], o2[8];
#pragma unroll
            for (int q = 0; q < 4; ++q) {
                const float a0 = bflo(raw[ks][q]), a1 = bfhi(raw[ks][q]), b0 = bflo(raw[ks + 2][q]), b1 = bfhi(raw[ks + 2][q]);
                o1[2 * q] = a0 * cs[ks][2 * q] - b0 * sn[ks][2 * q]; o2[2 * q] = b0 * cs[ks][2 * q] + a0 * sn[ks][2 * q];
                o1[2 * q + 1] = a1 * cs[ks][2 * q + 1] - b1 * sn[ks][2 * q + 1]; o2[2 * q + 1] = b1 * cs[ks][2 * q + 1] + a1 * sn[ks][2 * q + 1]; }
            qf[ks] = pack8(o1[0], o1[1], o1[2], o1[3], o1[4], o1[5], o1[6], o1[7]);
            qf[ks + 2] = pack8(o2[0], o2[1], o2[2], o2[3], o2[4], o2[5], o2[6], o2[7]); }
        const int Tn = Tq + 9; const bool pre = (qt < 3) && Tn >= 0 && Tn < NTOK / 32; u32x4 nk = {0u, 0u, 0u, 0u};
        if (pre) { if (tid < 256) nk = *(const u32x4*)(KR + ((size_t)(kvh * MROWS + Tn * 32 + (tid >> 3))) * 64 + (tid & 7) * 8);
                   else { const int t2 = tid - 256; nk = *(const u32x4*)(VTg + ((size_t)(kvh * 64 + (t2 >> 2))) * MROWS + Tn * 32 + (t2 & 3) * 8); } }
        if (qt < 3) AT_LOADQ(p0 + 32);
        float m_run = sinks[head] * 1.4426950408889634f, l_run = h5 ? 0.f : 1.f;
        f32x16 o0, o1;
#pragma unroll
        for (int i = 0; i < 16; ++i) { o0[i] = 0.f; o1[i] = 0.f; }
        for (int kt = 0; kt < 17; ++kt) {
            const bool lat = kt >= 8; const int j = kt - 8, T = Tq + j, kb = kb0 + 32 * j, slot = (T + 2 * NSLOT) % NSLOT;
            if (lat && (T < 0 || T >= NTOK / 32)) continue;
            const LAS unsigned char* Kb = lat ? KL + (32 * slot + r) * KRS : KC + (32 * kt + r) * KRS;
            const LAS unsigned char* Vb = lat ? VL + r * VLRS + 64 * slot : VC + r * VCRS + 64 * kt;
            const int vrs32 = 32 * (lat ? VLRS : VCRS); const bool edge = lat && (j == 0 || j == 8);
            f32x16 s;
#pragma unroll
            for (int i = 0; i < 16; ++i) s[i] = 0.f;
#pragma unroll
            for (int ks = 0; ks < 4; ++ks) { const bf16x8 kf = *(const LAS bf16x8*)(Kb + (16 * ks + 8 * h5) * 2); s = MFMA32(kf, qf[ks], s); }
            float mt = -INFINITY;
#pragma unroll
            for (int i = 0; i < 16; ++i) { float v = s[i] * sc;
                if (edge) { const int dk = kb + crow(i, h5) - qp; if (dk > 128 || dk < -128) v = -INFINITY; }
                s[i] = v; mt = fmaxf(mt, v); }
            mt = fmaxf(mt, __shfl_xor(mt, 32));
            const float mn = fmaxf(m_run, mt);
            if (__any(mn > m_run)) { const float alpha = __builtin_amdgcn_exp2f(m_run - mn); l_run *= alpha;
#pragma unroll
                for (int i = 0; i < 16; ++i) { o0[i] *= alpha; o1[i] *= alpha; } }
            m_run = mn;
            float ps = 0.f;
#pragma unroll
            for (int i = 0; i < 16; ++i) { const float p = __builtin_amdgcn_exp2f(s[i] - mn); s[i] = p; ps += p; }
            l_run += ps;
#pragma unroll
            for (int ks = 0; ks < 2; ++ks) {
                const bf16x8 pf = pack8(s[8 * ks], s[8 * ks + 1], s[8 * ks + 2], s[8 * ks + 3], s[8 * ks + 4], s[8 * ks + 5], s[8 * ks + 6], s[8 * ks + 7]);
                const bf16x8 v0 = lds_frag2(Vb + (16 * ks + 4 * h5) * 2, Vb + (16 * ks + 8 + 4 * h5) * 2);
                const bf16x8 v1 = lds_frag2(Vb + vrs32 + (16 * ks + 4 * h5) * 2, Vb + vrs32 + (16 * ks + 8 + 4 * h5) * 2);
                o0 = MFMA32(v0, pf, o0);
                o1 = MFMA32(v1, pf, o1);
            }
        }
        const float l = l_run + __shfl_xor(l_run, 32), inv = 1.0f / l;
        bf16* orow = yab + (size_t)qp * D + head * 64 + 4 * h5;
#pragma unroll
        for (int g4 = 0; g4 < 4; ++g4) {
            u32x2 a; a.x = pk2(o0[4 * g4] * inv, o0[4 * g4 + 1] * inv); a.y = pk2(o0[4 * g4 + 2] * inv, o0[4 * g4 + 3] * inv); *(u32x2*)(orow + 8 * g4) = a;
            u32x2 b; b.x = pk2(o1[4 * g4] * inv, o1[4 * g4 + 1] * inv); b.y = pk2(o1[4 * g4 + 2] * inv, o1[4 * g4 + 3] * inv); *(u32x2*)(orow + 32 + 8 * g4) = b;
        }
        if (pre) { const int slot = (Tn + 2 * NSLOT) % NSLOT;
            if (tid < 256) *(LAS u32x4*)(KL + (slot * 32 + (tid >> 3)) * KRS + (tid & 7) * 16) = nk;
            else { const int t2 = tid - 256; u32x2 a; a.x = nk.x; a.y = nk.y; u32x2 b; b.x = nk.z; b.y = nk.w; LAS unsigned char* dst = VL + (t2 >> 2) * VLRS + slot * 64 + (t2 & 3) * 16; *(LAS u32x2*)dst = a; *(LAS u32x2*)(dst + 8) = b; } }
        __syncthreads();
    }
#undef AT_LOADQ
}

typedef const Args __attribute__((address_space(4))) ArgsC;
DI ArgsC* args_ptr() { ArgsC* p = (ArgsC*)__builtin_amdgcn_kernarg_segment_ptr(); asm volatile("" : "+s"(p)); return p; }
#define PH_BEGIN ArgsC* A = args_ptr(); unsigned char* const ws = A->ws; (void)ws
#define modl ((float*)(ws + WS_SMALL + SM_MODL))
#define modc ((float*)(ws + WS_SMALL + SM_MODC))
#define rope ((float*)(ws + WS_SMALL + SM_ROPE))
#define lbf ((float*)(ws + WS_SMALL + SM_LB))
#define lbb (lbf + 1024)
#define wrp ((float*)(ws + WS_SMALL + SM_WRP))
#define cvec ((float*)(ws + WS_SMALL + SM_CVEC))
#define tile_expert ((int*)(ws + WS_SMALL + SM_TILE))
#define ntiles_p (tile_expert + 512)
#define rt_e ((int*)(ws + WS_ROUTE + RT_E))
#define rt_g ((float*)(ws + WS_ROUTE + RT_G))
#define rt_r ((int*)(ws + WS_ROUTE + RT_R))
#define rt_s ((int*)(ws + WS_ROUTE + RT_S))
#define slot_rowoff ((unsigned*)(ws + WS_ROUTE + RT_OFF))
#define slot_gate ((float*)(ws + WS_ROUTE + RT_SG))
#define Dlog ((float*)(ws + WS_DLOG))
#define KR ((bf16*)(ws + WS_KR))
#define VTg ((bf16*)(ws + WS_VT))
#define Lbuf ((float*)(ws + WS_L))
#define WIN ((bf16*)(ws + WS_WIN))
#define WM ((bf16*)(ws + WS_WM))
#define WO ((bf16*)(ws + WS_WO))
#define WGU ((bf16*)(ws + WS_WGU))
#define WDN ((bf16*)(ws + WS_WDN))
#define H ((bf16*)(ws + WS_H))
#define PROJ ((bf16*)(ws + WS_PROJ))
#define ACT ((bf16*)(ws + WS_ACT))
#define YAB ((bf16*)(ws + WS_YAB))
#define OSCR ((bf16*)(ws + WS_OSCR))
#define MERGED ((bf16*)(ws + WS_MERGED))
#define X1 ((float*)(ws + WS_X1))
#define YS ((bf16*)(ws + WS_YS))

__global__ void __launch_bounds__(NWAVES * 64, 2) fwd_kernel(Args a_unused) {
    extern __shared__ __attribute__((aligned(16))) unsigned char lds_raw[];
    LAS unsigned char* lds = (LAS unsigned char*)lds_raw;
    volatile LAS unsigned* MISC = (volatile LAS unsigned*)(lds + MISC_OFF);
    const int tid = threadIdx.x, lane = tid & 63, wave = __builtin_amdgcn_readfirstlane(tid >> 6);
    const int G = gridDim.x, bx = blockIdx.x, vcu = (G % 8 == 0) ? (bx % 8) * (G / 8) + bx / 8 : bx;
    const int gw = vcu * NWAVES + wave, NGW = G * NWAVES;
    const int gtid = vcu * 512 + tid, NGT = G * 512;
    unsigned* ctl; { const ArgsC* A0 = args_ptr(); ctl = (unsigned*)(A0->ws + WS_CTL); }
    if (tid < 64) MISC[tid] = 0u;
    __syncthreads();
    XcdBarrier bar = xcd_barrier_post(ctl + CW_BAR, MISC);
    int lo, hi; { const ArgsC* A0 = args_ptr(); lo = A0->ph_lo; hi = A0->ph_hi; }
#ifndef PH_MASK
#define PH_MASK 0x1fff
#endif
#define IN(k) ((((PH_MASK) >> (k)) & 1) && lo <= (k) && (k) < hi)
#define SEAM(k) do { if (IN(k) && IN((k) + 1)) xcd_barrier(bar); } while (0)

    if (IN(0)) {
        PH_BEGIN;
        if (vcu < 48) {
            LAS float* sc = (LAS float*)lds; LAS float* scc = sc + 2048; LAS f32x4* red = (LAS f32x4*)(lds + 16384);
            for (int k = tid; k < 2048; k += 512) { const float v = A->c[k], u = A->c_ctx[k]; sc[k] = v * sigmoidf_(v); scc[k] = u * sigmoidf_(u); }
            __syncthreads();
            const int cb = vcu, col = 256 * cb + 4 * lane; const bool hasc = cb < 16;
            f32x4 al = {0.f, 0.f, 0.f, 0.f}, ac = {0.f, 0.f, 0.f, 0.f};
#pragma unroll 8
            for (int k = wave; k < 2048; k += 8) { const f32x4 wv = *(const f32x4*)(A->w_mod + (size_t)k * 12288 + col); al += sc[k] * wv; ac += scc[k] * wv; }
            red[wave * 64 + lane] = al; red[512 + wave * 64 + lane] = ac;
            __syncthreads();
            if (wave == 0) { f32x4 s = *(const f32x4*)(A->b_mod + col), t = s;
#pragma unroll
                for (int w = 0; w < 8; ++w) { s += red[w * 64 + lane]; t += red[512 + w * 64 + lane]; }
                *(f32x4*)(modl + col) = s; if (hasc) *(f32x4*)(modc + col) = t; }
            __syncthreads();
        } else if (vcu == 48) {
            for (int i = tid; i < 4096 + 1024; i += 512) { const bool isrow = i < 4096; const int ii = isrow ? i : i - 4096, p = ii >> 4, j = ii & 15;
                const float inv = powf(10000.0f, -(float)j / 16.0f), ang = (float)p * inv; float s, c; sincosf(ang, &s, &c);
                if (isrow) { rope[ii] = c; rope[4096 + ii] = s; } else { rope[8192 + ii] = c; rope[9216 + ii] = s; } }
            for (int i = tid; i < 2048; i += 512) { const float* lg = (i < 1024) ? A->lbf_logits : A->lbb_logits; const int ch = i & 1023;
                const float v = 1.0f / (1.0f + expf(lg[1024 + ch] - lg[ch])); if (i < 1024) lbf[ch] = v; else lbb[ch] = v; }
            __syncthreads();
        }
        { LAS unsigned char* scr = lds + wave * 9216;
          for (int r = gw; r < 2048; r += NGW) {
              if (r < 1024) { const int br = r >> 9, r2 = r & 511, kb = r2 >> 5, nb = r2 & 31;
                  p0_transpose64(A->w_branch + (size_t)br * 1024 * D + (size_t)(64 * kb) * D + 64 * nb, D, WM + (size_t)(64 * nb) * D + br * 1024 + 64 * kb, D, scr, lane); }
              else { const int r2 = r - 1024, kb = r2 >> 5, nb = r2 & 31; p0_transpose64(A->w_out + (size_t)(64 * kb) * D + 64 * nb, D, WO + (size_t)(64 * nb) * D + 64 * kb, D, scr, lane); } }
          __syncthreads(); }
        { constexpr int NQ = INC / 32 + 4096 + 2048;
          const int n4 = lane & 7, kr = lane >> 3;
          LAS float* smax = (LAS float*)(lds + 32 * 2064);
          f32x4 v[8][4];
          const float* Wp; int ldw; signed char* Qp; float* csp;
#define Q_ITEM(idx) do { int it_ = (idx); \
              if (it_ < INC / 32) { Wp = A->w_in + 32 * it_; ldw = INC; Qp = (signed char*)(ws + WS_WIN) + (size_t)(32 * it_) * 2048; csp = (float*)(ws + WS_CS + CS_WIN) + 32 * it_; } \
              else if (it_ < INC / 32 + 4096) { it_ -= INC / 32; const int e_ = it_ >> 7, wh_ = (it_ >> 6) & 1, n0_ = 32 * (it_ & 63), np_ = e_ * 4096 + (n0_ >> 7) * 256 + wh_ * 128 + (n0_ & 127); \
                  Wp = (wh_ ? A->w_e_up : A->w_e_gate) + (size_t)e_ * D * FF + n0_; ldw = FF; Qp = (signed char*)(ws + WS_WGU) + (size_t)np_ * 2048; csp = (float*)(ws + WS_CS) + np_; } \
              else { it_ -= INC / 32 + 4096; const int e_ = it_ >> 6, n0_ = 32 * (it_ & 63); \
                  Wp = A->w_e_down + (size_t)e_ * FF * D + n0_; ldw = D; Qp = (signed char*)(ws + WS_WDN) + ((size_t)e_ * D + n0_) * 2048; csp = (float*)(ws + WS_DLOG + DL_CSD) + e_ * D + n0_; } } while (0)
#define Q_LOAD() do { _Pragma("unroll") for (int g = 0; g < 8; ++g) _Pragma("unroll") for (int r = 0; r < 4; ++r) v[g][r] = *(const f32x4*)(Wp + (size_t)(256 * g + 32 * wave + 4 * kr + r) * ldw + 4 * n4); } while (0)
          int cur = vcu;
          if (cur < NQ) { Q_ITEM(cur); Q_LOAD(); }
          while (cur < NQ) {
              unsigned nxt = 0u; if (tid == 0) nxt = (unsigned)G + atomicAdd(ctl + CW_Q, 1u);
              signed char* Qc = Qp; float* csc = csp;
              f32x4 mx = {0.f, 0.f, 0.f, 0.f};
#pragma unroll
              for (int g = 0; g < 8; ++g)
#pragma unroll
                  for (int r = 0; r < 4; ++r) { mx[0] = fmaxf(mx[0], fabsf(v[g][r][0])); mx[1] = fmaxf(mx[1], fabsf(v[g][r][1])); mx[2] = fmaxf(mx[2], fabsf(v[g][r][2])); mx[3] = fmaxf(mx[3], fabsf(v[g][r][3])); }
#pragma unroll
              for (int c = 0; c < 4; ++c) { float m = mx[c]; m = fmaxf(m, __shfl_xor(m, 8)); m = fmaxf(m, __shfl_xor(m, 16)); m = fmaxf(m, __shfl_xor(m, 32)); mx[c] = m; }
              __syncthreads();
              if (kr == 0) *(LAS f32x4*)(smax + wave * 32 + 4 * n4) = mx;
              __syncthreads();
              f32x4 cm = *(const LAS f32x4*)(smax + 4 * n4);
#pragma unroll
              for (int ww = 1; ww < 8; ++ww) { const f32x4 o = *(const LAS f32x4*)(smax + ww * 32 + 4 * n4); cm[0] = fmaxf(cm[0], o[0]); cm[1] = fmaxf(cm[1], o[1]); cm[2] = fmaxf(cm[2], o[2]); cm[3] = fmaxf(cm[3], o[3]); }
              f32x4 inv;
#pragma unroll
              for (int c = 0; c < 4; ++c) { if (cm[c] == 0.f) cm[c] = 1.f; inv[c] = 127.0f / cm[c]; }
              if (wave == 0 && kr == 0) { f32x4 sc; sc[0] = cm[0] * (1.0f / 127.0f); sc[1] = cm[1] * (1.0f / 127.0f); sc[2] = cm[2] * (1.0f / 127.0f); sc[3] = cm[3] * (1.0f / 127.0f); *(f32x4*)(csc + 4 * n4) = sc; }
#pragma unroll
              for (int g = 0; g < 8; ++g)
#pragma unroll
                  for (int c = 0; c < 4; ++c) { unsigned pk = 0u;
#pragma unroll
                      for (int r = 0; r < 4; ++r) { const int q = (int)rintf(v[g][r][c] * inv[c]); pk |= ((unsigned)q & 0xffu) << (8 * r); }
                      *(LAS unsigned*)(lds + (4 * n4 + c) * 2064 + 4 * (64 * g + 8 * wave + kr)) = pk; }
              if (tid == 0) MISC[2] = nxt;
              __syncthreads();
              const int nx = (int)MISC[2];
              if (nx < NQ) { Q_ITEM(nx); Q_LOAD(); }
#pragma unroll
              for (int i = 0; i < 8; ++i) { const int p = tid + 512 * i, row = p >> 7, pc = p & 127; const u32x4 o = *(const LAS u32x4*)(lds + row * 2064 + pc * 16); *(u32x4*)(Qc + (size_t)row * 2048 + pc * 16) = o; }
              cur = nx;
          }
#undef Q_ITEM
#undef Q_LOAD
        }
    }
    SEAM(0);

    if (IN(1)) {
        PH_BEGIN;
        {
            f32x4 ca[8], cb[8];
#pragma unroll
            for (int j = 0; j < 8; ++j) { const int k = 4 * lane + 256 * j; const f32x4 g = *(const f32x4*)(A->norm_mix_g + k), s1 = *(const f32x4*)(modl + 2048 + k); ca[j] = g * (1.0f + s1); cb[j] = *(const f32x4*)(modl + k); }
            f32x4 v[8], vn[8];
            { const float* xr = A->x + (size_t)gw * D + 4 * lane;
#pragma unroll
              for (int j = 0; j < 8; ++j) v[j] = *(const f32x4*)(xr + 256 * j); }
            for (int m = gw; m < NTOK; m += NGW) {
                if (m + NGW < NTOK) { const float* xn = A->x + (size_t)(m + NGW) * D + 4 * lane;
#pragma unroll
                    for (int j = 0; j < 8; ++j) vn[j] = *(const f32x4*)(xn + 256 * j); }
                float ss = 0.f;
#pragma unroll
                for (int j = 0; j < 8; ++j) ss += v[j][0] * v[j][0] + v[j][1] * v[j][1] + v[j][2] * v[j][2] + v[j][3] * v[j][3];
                const float rstd = rsqrtf(wave_sum(ss) * (1.0f / D) + EPS);
                float am = 0.f;
#pragma unroll
                for (int j = 0; j < 8; ++j) { v[j] = v[j] * rstd * ca[j] + cb[j]; am = fmaxf(am, fmaxf(fmaxf(fabsf(v[j][0]), fabsf(v[j][1])), fmaxf(fabsf(v[j][2]), fabsf(v[j][3])))); }
#pragma unroll
                for (int o = 1; o < 64; o <<= 1) am = fmaxf(am, __shfl_xor(am, o));
                if (am == 0.f) am = 1.f;
                const float qi = 127.0f / am;
                if (lane == 0) ((float*)(ws + WS_CS + CS_HROW))[m] = am * (1.0f / 127.0f);
                unsigned* hq = (unsigned*)((signed char*)(ws + WS_H) + (size_t)m * D + 4 * lane);
#pragma unroll
                for (int j = 0; j < 8; ++j) { const int q0 = (int)rintf(v[j][0] * qi), q1 = (int)rintf(v[j][1] * qi), q2 = (int)rintf(v[j][2] * qi), q3 = (int)rintf(v[j][3] * qi);
                    hq[64 * j] = ((unsigned)q0 & 0xffu) | (((unsigned)q1 & 0xffu) << 8) | (((unsigned)q2 & 0xffu) << 16) | (((unsigned)q3 & 0xffu) << 24); }
#pragma unroll
                for (int j = 0; j < 8; ++j) v[j] = vn[j];
            }
        }
        if (gw < NCTX) {
            const int m = gw; const float* xr = A->ctx + (size_t)m * D + 4 * lane; f32x4 v[8]; float ss = 0.f;
#pragma unroll
            for (int j = 0; j < 8; ++j) { v[j] = *(const f32x4*)(xr + 256 * j); ss += v[j][0] * v[j][0] + v[j][1] * v[j][1] + v[j][2] * v[j][2] + v[j][3] * v[j][3]; }
            const float rstd = rsqrtf(wave_sum(ss) * (1.0f / D) + EPS);
            float am = 0.f;
#pragma unroll
            for (int j = 0; j < 8; ++j) { const int k = 4 * lane + 256 * j; const f32x4 g = *(const f32x4*)(A->norm_mix_g + k), s1 = *(const f32x4*)(modc + 2048 + k), s0 = *(const f32x4*)(modc + k);
                v[j] = v[j] * rstd * (g * (1.0f + s1)) + s0; am = fmaxf(am, fmaxf(fmaxf(fabsf(v[j][0]), fabsf(v[j][1])), fmaxf(fabsf(v[j][2]), fabsf(v[j][3])))); }
#pragma unroll
            for (int o = 1; o < 64; o <<= 1) am = fmaxf(am, __shfl_xor(am, o));
            if (am == 0.f) am = 1.f;
            const float qi = 127.0f / am;
            if (lane == 0) ((float*)(ws + WS_CS + CS_HROW))[NTOK + m] = am * (1.0f / 127.0f);
            unsigned* hq = (unsigned*)((signed char*)(ws + WS_H) + (size_t)(NTOK + m) * D + 4 * lane);
#pragma unroll
            for (int j = 0; j < 8; ++j) { const int q0 = (int)rintf(v[j][0] * qi), q1 = (int)rintf(v[j][1] * qi), q2 = (int)rintf(v[j][2] * qi), q3 = (int)rintf(v[j][3] * qi);
                hq[64 * j] = ((unsigned)q0 & 0xffu) | (((unsigned)q1 & 0xffu) << 8) | (((unsigned)q2 & 0xffu) << 16) | (((unsigned)q3 & 0xffu) << 24); }
        }
        for (int i = gtid; i < 2048 * 32; i += NGT) { const int k = i >> 5; wrp[i] = A->norm_ffn_g[k] * (1.0f + modl[4 * 2048 + k]) * A->w_router[i]; }
        if (vcu == G - 1) {
            for (int e = wave * 4; e < wave * 4 + 4; ++e) { float s = 0.f; for (int k = lane; k < 2048; k += 64) s += modl[3 * 2048 + k] * A->w_router[k * 32 + e];
                s = wave_sum(s); if (lane == 0) cvec[e] = s + A->b_router[e]; }
        }
    }
    SEAM(1);

    if (IN(2)) {
        PH_BEGIN;
        pg8::Gemm g{H, WIN, D / 2}; pg8::PlainOrder S; S.init(MROWS / 256, INC / 256, G, bx); S.K2 = D;
        EpiProj E{PROJ, lbf, lbb, (const float*)(ws + WS_CS + CS_HROW), (const float*)(ws + WS_CS + CS_WIN)};
        pg8::gemm_phase<EpiProj, pg8::PlainOrder, true>(lds, g, S, E);
    }
    SEAM(2);

    if (IN(3)) {
        PH_BEGIN;
        for (int i = gtid; i < MROWS * 8; i += NGT) { const int jg = i & 3, kvh = (i >> 2) & 1, pos = i >> 3, j0 = 8 * jg;
            const bf16* kr = PROJ + PO_AKV + (size_t)pos * 256 + kvh * 64 + j0; const u32x4 a1 = *(const u32x4*)kr, a2 = *(const u32x4*)(kr + 32); u32x4 w1 = a1, w2 = a2;
            if (pos < NTOK) { const float* ct = (jg < 2) ? rope + (pos >> 6) * 16 + j0 : rope + 8192 + (pos & 63) * 16 + j0 - 16; const float* st = ct + ((jg < 2) ? 4096 : 1024);
                const f32x4 c0 = *(const f32x4*)ct, c1 = *(const f32x4*)(ct + 4), s0 = *(const f32x4*)st, s1 = *(const f32x4*)(st + 4);
#pragma unroll
                for (int q = 0; q < 4; ++q) { const float cl = q < 2 ? c0[2 * q] : c1[2 * q - 4], ch = q < 2 ? c0[2 * q + 1] : c1[2 * q - 3], sl = q < 2 ? s0[2 * q] : s1[2 * q - 4], sh = q < 2 ? s0[2 * q + 1] : s1[2 * q - 3];
                    const float k1l = bflo(a1[q]), k1h = bfhi(a1[q]), k2l = bflo(a2[q]), k2h = bfhi(a2[q]);
                    w1[q] = pk2(k1l * cl - k2l * sl, k1h * ch - k2h * sh); w2[q] = pk2(k2l * cl + k1l * sl, k2h * ch + k1h * sh); } }
            bf16* ko = KR + ((size_t)kvh * MROWS + pos) * 64 + j0; *(u32x4*)ko = w1; *(u32x4*)(ko + 32) = w2; }
        for (int i = gtid; i < 2 * (MROWS / 8) * 64; i += NGT) { const int dd = i & 63, pb = (i >> 6) % (MROWS / 8), kvh = (i >> 6) / (MROWS / 8);
            const bf16* vr = PROJ + PO_AKV + (size_t)(pb * 8) * 256 + 128 + kvh * 64 + dd; unsigned short t[8];
#pragma unroll
            for (int q = 0; q < 8; ++q) t[q] = vr[(size_t)q * 256];
            u32x4 w; w.x = t[0] | ((unsigned)t[1] << 16); w.y = t[2] | ((unsigned)t[3] << 16); w.z = t[4] | ((unsigned)t[5] << 16); w.w = t[6] | ((unsigned)t[7] << 16);
            *(u32x4*)(VTg + ((size_t)kvh * 64 + dd) * MROWS + pb * 8) = w; }
        for (int it = vcu; it < 8 * (NSEG - 1); it += G) { const int hh = it >> 5, seg = it & 31; scan_segment<false>(lds, PROJ, hh, seg, seg, Lbuf, Dlog, (bf16*)nullptr); }
    }
    SEAM(3);

    if (IN(4)) {
        PH_BEGIN;
        for (int i = gtid; i < 16 * 16384; i += NGT) { const int scan = i >> 14, el = i & 16383, dd = el >> 7; float s = 0.f, lv[NSEG - 1], dv[NSEG - 1];
#pragma unroll
            for (int j = 0; j < NSEG - 1; ++j) { lv[j] = Lbuf[(size_t)(scan * NSEG + j) * 16384 + el]; dv[j] = Dlog[(scan * NSEG + j) * 128 + dd]; }
#pragma unroll
            for (int j = 0; j < NSEG - 1; ++j) { s = __expf(dv[j]) * s + lv[j]; Lbuf[(size_t)(scan * NSEG + j) * 16384 + el] = s; } }
        for (int u = vcu; u < 256; u += G) attn_unit(lds, PROJ, KR, VTg, rope, A->sinks, YAB, u >> 7, u & 127);
    }
    SEAM(4);

    if (IN(5)) {
        PH_BEGIN;
        for (int it = vcu; it < 8 * 32; it += G) { const int hh = it >> 5, segF = 1 + (it & 31);
            scan_segment<true>(lds, PROJ, hh, segF, NSEG - segF, Lbuf, Dlog, OSCR);
            VM_WAIT(); __syncthreads();
            { const int l16 = lane & 15, tq = lane >> 4; const f32x4 hg0 = *(const f32x4*)(A->hgrn_g + hh * 128 + 8 * l16), hg1 = *(const f32x4*)(A->hgrn_g + hh * 128 + 8 * l16 + 4);
              for (int i0 = wave * 64; i0 < wave * 64 + 64; i0 += 16) {
                u32x4 fw[4], bw[4], gq[4];
#pragma unroll
                for (int b = 0; b < 4; ++b) { const int row = (segF - 1) * 512 + i0 + 4 * b + tq;
                    fw[b] = *(const u32x4*)(OSCR + ((size_t)hh * NTOK + row) * 128 + 8 * l16); bw[b] = *(const u32x4*)(OSCR + ((size_t)(8 + hh) * NTOK + row) * 128 + 8 * l16);
                    gq[b] = *(const u32x4*)(PROJ + PO_BG + ((size_t)hh * MROWS + row) * 128 + 8 * l16); }
#pragma unroll
                for (int b = 0; b < 4; ++b) { const int row = (segF - 1) * 512 + i0 + 4 * b + tq;
                    f32x4 o0, o1; o0[0] = bflo(fw[b].x) + bflo(bw[b].x); o0[1] = bfhi(fw[b].x) + bfhi(bw[b].x); o0[2] = bflo(fw[b].y) + bflo(bw[b].y); o0[3] = bfhi(fw[b].y) + bfhi(bw[b].y);
                    o1[0] = bflo(fw[b].z) + bflo(bw[b].z); o1[1] = bfhi(fw[b].z) + bfhi(bw[b].z); o1[2] = bflo(fw[b].w) + bflo(bw[b].w); o1[3] = bfhi(fw[b].w) + bfhi(bw[b].w);
                    float ss = o0[0] * o0[0] + o0[1] * o0[1] + o0[2] * o0[2] + o0[3] * o0[3] + o1[0] * o1[0] + o1[1] * o1[1] + o1[2] * o1[2] + o1[3] * o1[3];
                    ss += __shfl_xor(ss, 1); ss += __shfl_xor(ss, 2); ss += __shfl_xor(ss, 4); ss += __shfl_xor(ss, 8);
                    const float rstd = rsqrtf(ss * (1.0f / 128.0f) + EPS);
                    u32x4 w; w.x = pk2(o0[0] * rstd * hg0[0] * bflo(gq[b].x), o0[1] * rstd * hg0[1] * bfhi(gq[b].x)); w.y = pk2(o0[2] * rstd * hg0[2] * bflo(gq[b].y), o0[3] * rstd * hg0[3] * bfhi(gq[b].y));
                    w.z = pk2(o1[0] * rstd * hg1[0] * bflo(gq[b].z), o1[1] * rstd * hg1[1] * bfhi(gq[b].z)); w.w = pk2(o1[2] * rstd * hg1[2] * bflo(gq[b].w), o1[3] * rstd * hg1[3] * bfhi(gq[b].w));
                    *(u32x4*)(YAB + (size_t)row * D + 1024 + hh * 128 + 8 * l16) = w; } } }
            __syncthreads();
        }
    }
    SEAM(5);

    if (IN(6)) {
        PH_BEGIN;
        pg8::Gemm g{YAB, WM, D}; pg8::PlainOrder S; S.init(NTOK / 256, D / 256, G, bx); S.K2 = D * 2;
        EpiMerge E{MERGED, PROJ};
        pg8::gemm_phase<EpiMerge, pg8::PlainOrder>(lds, g, S, E);
    }
    SEAM(6);

    if (IN(7)) {
        PH_BEGIN;
        pg8::Gemm g{MERGED, WO, D}; pg8::PlainOrder S; S.init(NTOK / 256, D / 256, G, bx); S.K2 = D * 2;
        EpiOut E{X1, A->x, modl + 2 * 2048};
        pg8::gemm_phase<EpiOut, pg8::PlainOrder>(lds, g, S, E);
    }
    SEAM(7);

    if (IN(8)) {
        PH_BEGIN;
        LAS float* part = (LAS float*)lds;
        LAS float* rsd = (LAS float*)(lds + 16384);
        const int r16 = lane & 15, kk = lane >> 4;
        for (int tl = vcu; tl < NTOK / 16; tl += G) {
            const int row0 = tl * 16;
#pragma unroll
            for (int q = 0; q < 2; ++q) { const int m = row0 + 2 * wave + q; const float* xr = X1 + (size_t)m * D + 4 * lane; f32x4 v[8]; float ss = 0.f;
#pragma unroll
                for (int j = 0; j < 8; ++j) { v[j] = *(const f32x4*)(xr + 256 * j); ss += v[j][0] * v[j][0] + v[j][1] * v[j][1] + v[j][2] * v[j][2] + v[j][3] * v[j][3]; }
                const float rstd = rsqrtf(wave_sum(ss) * (1.0f / D) + EPS);
                if (lane == 0) rsd[2 * wave + q] = rstd;
                float am = 0.f;
#pragma unroll
                for (int j = 0; j < 8; ++j) { const int k = 4 * lane + 256 * j; const f32x4 g = *(const f32x4*)(A->norm_ffn_g + k), s1 = *(const f32x4*)(modl + 4 * 2048 + k), s0 = *(const f32x4*)(modl + 3 * 2048 + k);
                    v[j] = v[j] * rstd * (g * (1.0f + s1)) + s0; am = fmaxf(am, fmaxf(fmaxf(fabsf(v[j][0]), fabsf(v[j][1])), fmaxf(fabsf(v[j][2]), fabsf(v[j][3])))); }
#pragma unroll
                for (int o = 1; o < 64; o <<= 1) am = fmaxf(am, __shfl_xor(am, o));
                if (am == 0.f) am = 1.f;
                const float qi = 127.0f / am;
                if (lane == 0) ((float*)(ws + WS_CS + CS_ROW))[m] = am * (1.0f / 127.0f);
                unsigned* hq = (unsigned*)((signed char*)(ws + WS_H) + (size_t)m * D + 4 * lane);
#pragma unroll
                for (int j = 0; j < 8; ++j) { const int q0 = (int)rintf(v[j][0] * qi), q1 = (int)rintf(v[j][1] * qi), q2 = (int)rintf(v[j][2] * qi), q3 = (int)rintf(v[j][3] * qi);
                    hq[64 * j] = ((unsigned)q0 & 0xffu) | (((unsigned)q1 & 0xffu) << 8) | (((unsigned)q2 & 0xffu) << 16) | (((unsigned)q3 & 0xffu) << 24); } }
            float bw[16][4][2];
            { int zz = 0; asm volatile("" : "+v"(zz));
#pragma unroll
              for (int kg = 0; kg < 16; ++kg)
#pragma unroll
                for (int m = 0; m < 4; ++m)
#pragma unroll
                    for (int eh = 0; eh < 2; ++eh) bw[kg][m][eh] = wrp[(256 * wave + 16 * kg + 4 * kk + m) * 32 + 16 * eh + r16 + zz]; }
            f32x4 acc0 = {0.f, 0.f, 0.f, 0.f}, acc1 = {0.f, 0.f, 0.f, 0.f};
            const float* xa = X1 + (size_t)(row0 + r16) * D + 256 * wave + 4 * kk;
#pragma unroll
            for (int kg = 0; kg < 16; ++kg) { const f32x4 av = *(const f32x4*)(xa + 16 * kg);
#pragma unroll
                for (int m = 0; m < 4; ++m) { acc0 = __builtin_amdgcn_mfma_f32_16x16x4f32(av[m], bw[kg][m][0], acc0, 0, 0, 0); acc1 = __builtin_amdgcn_mfma_f32_16x16x4f32(av[m], bw[kg][m][1], acc1, 0, 0, 0); } }
#pragma unroll
            for (int q = 0; q < 4; ++q) { part[(wave * 16 + 4 * kk + q) * 32 + r16] = acc0[q]; part[(wave * 16 + 4 * kk + q) * 32 + 16 + r16] = acc1[q]; }
            __syncthreads();
            { const int row = tid >> 5, e = tid & 31; float s = 0.f;
#pragma unroll
              for (int w = 0; w < 8; ++w) s += part[(w * 16 + row) * 32 + e];
              float val = rsd[row] * s + cvec[e];
              float tv[4]; int ti[4];
#pragma unroll
              for (int j = 0; j < 4; ++j) { float bv = val; int bi = e;
#pragma unroll
                  for (int off = 16; off >= 1; off >>= 1) { const float ov = __shfl_xor(bv, off); const int oi = __shfl_xor(bi, off); if (ov > bv || (ov == bv && oi < bi)) { bv = ov; bi = oi; } }
                  tv[j] = bv; ti[j] = bi; if (e == bi) val = -INFINITY; }
              const float e1 = __expf(tv[1] - tv[0]), e2 = __expf(tv[2] - tv[0]), e3 = __expf(tv[3] - tv[0]), inv = 1.0f / (1.0f + e1 + e2 + e3);
              const float gt[4] = {inv, e1 * inv, e2 * inv, e3 * inv};
#pragma unroll
              for (int j = 0; j < 4; ++j) if (e == ti[j]) { const int ai = (row0 + row) * 4 + j; const unsigned rk = atomicAdd(ctl + CW_CNT + 16 * e, 1u);
                  rt_e[ai] = e; rt_g[ai] = gt[j]; rt_r[ai] = (int)rk; } }
            __syncthreads();
        }
    }
    SEAM(8);

    if (IN(9)) {
        PH_BEGIN;
        LAS int* tb = (LAS int*)lds;
        if (tid == 0) { int acc = 0; for (int e = 0; e < NEXP; ++e) { tb[e] = acc; acc += (int)((ctl[CW_CNT + 16 * e] + 255u) >> 8); } tb[NEXP] = acc; }
        __syncthreads();
        for (int i = gtid; i < NTOK * 4; i += NGT) { const int e = rt_e[i], slot = tb[e] * 256 + rt_r[i]; rt_s[i] = slot; slot_rowoff[slot] = (unsigned)(i >> 2) * (unsigned)D; slot_gate[slot] = rt_g[i]; ((float*)(ws + WS_CS + CS_SLOT))[slot] = ((const float*)(ws + WS_CS + CS_ROW))[i >> 2]; }
        if (vcu == 0) {
            for (int e = 0; e < NEXP; ++e) { const int cnt = (int)ctl[CW_CNT + 16 * e], s0 = tb[e] * 256 + cnt, s1 = tb[e + 1] * 256;
                for (int s = s0 + tid; s < s1; s += 512) { slot_rowoff[s] = 0u; slot_gate[s] = 0.f; ((float*)(ws + WS_CS + CS_SLOT))[s] = 0.f; }
                for (int t = tb[e] + tid; t < tb[e + 1]; t += 512) tile_expert[t] = e; }
            if (tid == 0) *ntiles_p = tb[NEXP];
        }
        __syncthreads();
    }
    SEAM(9);

    if (IN(10)) {
        PH_BEGIN;
        const int ntiles = *ntiles_p;
        pg8::Gemm g{H, WGU, D / 2}; pg8::MoeOrder<true> S; S.init(ntiles, 4096 / 256, G, bx); S.K2 = D; S.nper = 4096; S.texp = tile_expert; S.sroff = slot_rowoff;
        EpiAct E{ACT, A->b_e_gate, A->b_e_up, (const float*)(ws + WS_CS), (const float*)(ws + WS_CS + CS_SLOT)};
        pg8::gemm_phase<EpiAct, pg8::MoeOrder<true>, true>(lds, g, S, E);
    }
    SEAM(10);

    if (IN(11)) {
        PH_BEGIN;
        const int ntiles = *ntiles_p;
        { const int nrows = ntiles * 256; u32x2 v[8], vn[8];
          if (gw < nrows) { const bf16* ar = ACT + (size_t)gw * FF + 4 * lane;
#pragma unroll
              for (int j = 0; j < 8; ++j) v[j] = *(const u32x2*)(ar + 256 * j); }
          for (int m = gw; m < nrows; m += NGW) {
              if (m + NGW < nrows) { const bf16* an = ACT + (size_t)(m + NGW) * FF + 4 * lane;
#pragma unroll
                  for (int j = 0; j < 8; ++j) vn[j] = *(const u32x2*)(an + 256 * j); }
              float am = 0.f;
#pragma unroll
              for (int j = 0; j < 8; ++j) am = fmaxf(am, fmaxf(fmaxf(fabsf(bflo(v[j].x)), fabsf(bfhi(v[j].x))), fmaxf(fabsf(bflo(v[j].y)), fabsf(bfhi(v[j].y)))));
#pragma unroll
              for (int o = 1; o < 64; o <<= 1) am = fmaxf(am, __shfl_xor(am, o));
              if (!(am > 0.f)) am = 1.f;
              const float qi = 127.0f / am;
              if (lane == 0) ((float*)(ws + WS_ROUTE + RT_ARS))[m] = am * (1.0f / 127.0f);
              unsigned* aq = (unsigned*)((signed char*)(ws + WS_ACT8) + (size_t)m * FF + 4 * lane);
#pragma unroll
              for (int j = 0; j < 8; ++j) { const int q0 = (int)rintf(bflo(v[j].x) * qi), q1 = (int)rintf(bfhi(v[j].x) * qi), q2 = (int)rintf(bflo(v[j].y) * qi), q3 = (int)rintf(bfhi(v[j].y) * qi);
                  aq[64 * j] = ((unsigned)q0 & 0xffu) | (((unsigned)q1 & 0xffu) << 8) | (((unsigned)q2 & 0xffu) << 16) | (((unsigned)q3 & 0xffu) << 24); }
#pragma unroll
              for (int j = 0; j < 8; ++j) v[j] = vn[j];
          } }
        xcd_barrier(bar);
        pg8::Gemm g{(const bf16*)(ws + WS_ACT8), WDN, FF / 2}; pg8::MoeOrder<false> S; S.init(ntiles, D / 256, G, bx); S.K2 = FF; S.nper = D; S.texp = tile_expert; S.sroff = slot_rowoff;
        EpiDown E{YS, A->b_e_down, slot_gate, (const float*)(ws + WS_ROUTE + RT_ARS), (const float*)(ws + WS_DLOG + DL_CSD)};
        pg8::gemm_phase<EpiDown, pg8::MoeOrder<false>, true>(lds, g, S, E);
    }
    SEAM(11);

    if (IN(12)) {
        PH_BEGIN;
        f32x4 v[8], vn[8], y[8]; u32x2 yn[4][8]; int sl[4];
#define P12_LOAD(VV, M) do { const float* xr_ = X1 + (size_t)(M) * D + 4 * lane; \
            _Pragma("unroll") for (int j = 0; j < 8; ++j) VV[j] = *(const f32x4*)(xr_ + 256 * j); \
            _Pragma("unroll") for (int q = 0; q < 4; ++q) { const bf16* yp_ = YS + (size_t)sl[q] * D + 4 * lane; _Pragma("unroll") for (int j = 0; j < 8; ++j) yn[q][j] = *(const u32x2*)(yp_ + 256 * j); } } while (0)
#define P12_SUM() do { _Pragma("unroll") for (int j = 0; j < 8; ++j) { y[j] = (f32x4){0.f, 0.f, 0.f, 0.f}; \
            _Pragma("unroll") for (int q = 0; q < 4; ++q) { const u32x2 w_ = yn[q][j]; y[j][0] += bflo(w_.x); y[j][1] += bfhi(w_.x); y[j][2] += bflo(w_.y); y[j][3] += bfhi(w_.y); } } } while (0)
#pragma unroll
        for (int q = 0; q < 4; ++q) sl[q] = rt_s[gw * 4 + q];
        P12_LOAD(v, gw); P12_SUM();
        if (gw + NGW < NTOK) {
#pragma unroll
            for (int q = 0; q < 4; ++q) sl[q] = rt_s[(gw + NGW) * 4 + q];
        }
        for (int m = gw; m < NTOK; m += NGW) {
            const bool more = m + NGW < NTOK;
            if (more) { P12_LOAD(vn, m + NGW);
                if (m + 2 * NGW < NTOK) {
#pragma unroll
                    for (int q = 0; q < 4; ++q) sl[q] = rt_s[(m + 2 * NGW) * 4 + q]; } }
            float ss = 0.f;
#pragma unroll
            for (int j = 0; j < 8; ++j) { const f32x4 m5 = *(const f32x4*)(modl + 5 * 2048 + 4 * lane + 256 * j); v[j] = v[j] + m5 * y[j]; ss += v[j][0] * v[j][0] + v[j][1] * v[j][1] + v[j][2] * v[j][2] + v[j][3] * v[j][3]; }
            const float rstd = rsqrtf(wave_sum(ss) * (1.0f / D) + EPS);
            float* orow = A->out + (size_t)m * D + 4 * lane;
#pragma unroll
            for (int j = 0; j < 8; ++j) { const f32x4 fg = *(const f32x4*)(A->final_g + 4 * lane + 256 * j); *(f32x4*)(orow + 256 * j) = v[j] * rstd * fg; }
            if (more) { P12_SUM();
#pragma unroll
                for (int j = 0; j < 8; ++j) v[j] = vn[j]; }
        }
#undef P12_SUM
#undef P12_LOAD
    }
#undef IN
#undef SEAM
}

#undef modl
#undef modc
#undef rope
#undef lbf
#undef lbb
#undef wrp
#undef cvec
#undef tile_expert
#undef ntiles_p
#undef rt_e
#undef rt_g
#undef rt_r
#undef rt_s
#undef slot_rowoff
#undef slot_gate
#undef Dlog
#undef KR
#undef VTg
#undef Lbuf
#undef WIN
#undef WM
#undef WO
#undef WGU
#undef WDN
#undef H
#undef PROJ
#undef ACT
#undef YAB
#undef OSCR
#undef MERGED
#undef X1
#undef YS
extern "C" void kernel_launch(void* const* d_in, const int* in_sizes, int n_in, void* d_out, int out_size, void* d_ws, size_t ws_size, hipStream_t stream) {
    static int grid = 0;
    if (grid == 0) {
        if (n_in != 24 || out_size != NTOK * D || ws_size < WS_END) { fprintf(stderr, "kernel_launch: unexpected shapes (n_in %d out %d ws %zu)\n", n_in, out_size, ws_size); grid = -1; return; }
        int dev = 0, cus = 0, per_cu = 0;
        if (hipGetDevice(&dev) != hipSuccess || hipDeviceGetAttribute(&cus, hipDeviceAttributeMultiprocessorCount, dev) != hipSuccess) { grid = -1; return; }
        if (hipFuncSetAttribute((const void*)fwd_kernel, hipFuncAttributeMaxDynamicSharedMemorySize, LDS_BYTES) != hipSuccess) { fprintf(stderr, "kernel_launch: hipFuncSetAttribute failed\n"); grid = -1; return; }
        if (hipOccupancyMaxActiveBlocksPerMultiprocessor(&per_cu, (const void*)fwd_kernel, NWAVES * 64, LDS_BYTES) != hipSuccess || per_cu < 1) { fprintf(stderr, "kernel_launch: occupancy query says %d\n", per_cu); (void)hipGetLastError(); grid = -1; return; }
        grid = cus;
    }
    if (grid < 0) return;
    if (hipMemsetAsync((char*)d_ws + WS_CTL, 0, CTL_ZERO_BYTES, stream) != hipSuccess) return;
    Args a{};
    const float** p = (const float**)&a;
    for (int i = 0; i < 24; ++i) p[i] = (const float*)d_in[i];
    a.out = (float*)d_out; a.ws = (unsigned char*)d_ws; a.ph_lo = 0; a.ph_hi = 13;
    hipLaunchKernelGGL(fwd_kernel, dim3(grid), dim3(NWAVES * 64), LDS_BYTES, stream, a);
    const hipError_t le = hipPeekAtLastError();
    if (le != hipSuccess) fprintf(stderr, "kernel_launch: launch failed: %s\n", hipGetErrorName(le));
}
```

```cpp
#include <hip/hip_runtime.h>
#include <cstdio>
#include <cstdint>

#define DI __device__ __forceinline__
#define LAS __attribute__((address_space(3)))
typedef unsigned short bf16;
typedef short bf16x8 __attribute__((ext_vector_type(8)));
typedef float f32x2 __attribute__((ext_vector_type(2)));
typedef float f32x4 __attribute__((ext_vector_type(4)));
typedef float f32x16 __attribute__((ext_vector_type(16)));
typedef unsigned u32x2 __attribute__((ext_vector_type(2)));
typedef unsigned u32x4 __attribute__((ext_vector_type(4)));
typedef __bf16 bf16x2_t __attribute__((ext_vector_type(2)));
typedef int i32x4 __attribute__((ext_vector_type(4)));

DI unsigned pk2(float lo, float hi) { f32x2 v = {lo, hi}; bf16x2_t b = __builtin_convertvector(v, bf16x2_t); return __builtin_bit_cast(unsigned, b); }
DI float bf2f(unsigned short b) { return __uint_as_float(((unsigned)b) << 16); }
DI float bflo(unsigned w) { return __uint_as_float(w << 16); }
DI float bfhi(unsigned w) { return __uint_as_float(w & 0xffff0000u); }
DI unsigned short f2bf(float f) { return (unsigned short)(pk2(f, 0.f) & 0xffffu); }
DI float wave_sum(float v) {
#pragma unroll
    for (int o = 1; o < 64; o <<= 1) v += __shfl_xor(v, o);
    return v;
}
DI float sigmoidf_(float x) { return __builtin_amdgcn_rcpf(1.0f + __expf(-x)); }
#define LDS_WAIT() asm volatile("s_waitcnt lgkmcnt(0)" ::: "memory")
#define VM_WAIT() asm volatile("s_waitcnt vmcnt(0)" ::: "memory")

constexpr int D = 2048, NTOK = 16384, NCTX = 256, MROWS = NTOK + NCTX;
constexpr int INC = 10496;
constexpr int C_AQ = 0, C_AK = 1024, C_AV = 1152, C_BQ = 1280, C_ZF = 2304, C_ZB = 3328, C_BV = 4352, C_BG = 5376, C_GA = 6400, C_GB = 8448;
constexpr int NEXP = 32, FF = 2048;
constexpr int MAXTILES = 288, MAXSLOTS = MAXTILES * 256;
constexpr float EPS = 1e-6f;
constexpr int NSEG = 33;
constexpr int NWAVES = 8;

constexpr size_t MiB = 1u << 20;
constexpr size_t WS_CTL = 0, CTL_ZERO_BYTES = 1 * MiB;
constexpr size_t WS_SMALL = 1 * MiB;
constexpr size_t SM_MODL = 0, SM_MODC = 49152, SM_ROPE = 65536, SM_LB = 131072, SM_WRP = 262144, SM_CVEC = 524288, SM_TILE = 528384;
constexpr size_t WS_ROUTE = 2 * MiB;
constexpr size_t RT_E = 0, RT_G = 262144, RT_R = 524288, RT_S = 786432, RT_OFF = 1048576, RT_SG = 1048576 + 294912, RT_ARS = 1048576 + 2 * 294912;
static_assert(RT_ARS + (size_t)MAXSLOTS * 4 <= 2 * MiB, "route region");
constexpr size_t DL_CSD = 524288;
constexpr size_t WS_ACT8 = 1276 * MiB;
constexpr size_t WS_DLOG = 4 * MiB;
constexpr size_t WS_KR = 5 * MiB, WS_VT = 10 * MiB;
constexpr size_t WS_CS = 15 * MiB;
constexpr size_t CS_ROW = 524288, CS_SLOT = 524288 + 65536, CS_WIN = 917504, CS_HROW = 966656;
static_assert(CS_SLOT + (size_t)MAXSLOTS * 4 <= CS_WIN && CS_WIN + (size_t)INC * 4 <= CS_HROW && CS_HROW + (size_t)MROWS * 4 <= MiB, "scale arrays");
constexpr size_t WS_L = 16 * MiB;
constexpr size_t WS_WIN = 50 * MiB, WS_WM = 92 * MiB, WS_WO = 100 * MiB, WS_WGU = 108 * MiB, WS_WDN = 620 * MiB;
constexpr size_t WS_H = 876 * MiB, WS_PROJ = 942 * MiB, WS_ACT = WS_PROJ, WS_YAB = 1276 * MiB, WS_OSCR = 1340 * MiB, WS_MERGED = 1468 * MiB, WS_X1 = 1532 * MiB, WS_YS = 1660 * MiB, WS_END = 1948 * MiB;
constexpr size_t PO_AQ = 0, PO_AKV = PO_AQ + (size_t)16 * MROWS * 64, PO_BQ = PO_AKV + (size_t)MROWS * 256, PO_ZF = PO_BQ + (size_t)8 * MROWS * 128, PO_ZB = PO_ZF + (size_t)8 * MROWS * 128,
                 PO_BV = PO_ZB + (size_t)8 * MROWS * 128, PO_BG = PO_BV + (size_t)8 * MROWS * 128, PO_GA = PO_BG + (size_t)8 * MROWS * 128, PO_GB = PO_GA + (size_t)MROWS * 2048, PO_END = PO_GB + (size_t)MROWS * 2048;
static_assert(PO_END == (size_t)MROWS * INC, "projection layout");
static_assert(WS_L + (size_t)16 * NSEG * 65536 <= WS_WIN, "L");
static_assert(WS_PROJ + (size_t)MROWS * INC * 2 <= WS_YAB && WS_ACT + (size_t)MAXSLOTS * FF * 2 <= WS_YAB, "proj/act");
static_assert(WS_H + (size_t)MROWS * D * 2 <= WS_PROJ, "h");
constexpr int CW_BAR = 4096, CW_CNT = 8192, CW_Q = 9216;

constexpr int LDS_BYTES = 163840;
constexpr int MISC_OFF = 163840 - 256;
constexpr int XL_TEXP = 131072, XL_GO = 131072 + 2048, XL_EP = 131072 + 4096;

namespace pg8 {
constexpr int BM = 256, BK = 64, HALF = 128, HTB = HALF * BK * 2, STAGE_BYTES = 8 * HTB, NXCD = 8, WGM = 8;
__host__ __device__ __forceinline__ int lds_byte(int r, int c) { const int st = (r >> 4) * 2 + (c >> 5), rr = r & 15, cc = c & 31, ob = rr * 64 + cc * 2; return st * 1024 + (ob ^ (((ob >> 9) & 1) << 5)); }
__host__ __device__ __forceinline__ void stage_rc(int b, int& R, int& C) { const int st = b / 1024, sb = b % 1024, swz = sb ^ (((sb >> 9) & 1) << 5); R = (st >> 1) * 16 + swz / 64; C = (st & 1) * 32 + (swz % 64) / 2; }
__host__ __device__ __forceinline__ int perm32(int rho) { const int n = rho >> 4, i = rho & 15; return 8 * (i >> 2) + 4 * n + (i & 3); }

struct Unit { int pm, pn, e, brow; };
struct Gemm { const bf16* A; const bf16* Bt; int K; };

struct UnitIt { int L, gid, rem; };
struct OrderBase {
    int nM, nN, nwg, G, c, nig;
    DI void init(int nM_, int nN_, int G_, int c_) { nM = nM_; nN = nN_; nwg = nM * nN; G = G_; c = c_; nig = WGM * nN; }
    DI void locate(UnitIt& it) const {
        int wgid = it.L; { const int q = nwg / NXCD, r = nwg % NXCD, xcd = wgid % NXCD, off = wgid / NXCD; wgid = (xcd < r ? xcd * (q + 1) : r * (q + 1) + (xcd - r) * q) + off; }
        it.gid = wgid / nig; it.rem = wgid % nig;
    }
    DI void decode(const UnitIt& it, int& pm, int& pn) const {
        const int fm = it.gid * WGM, gsz = (nM - fm) < WGM ? (nM - fm) : WGM;
        if (gsz == WGM) { pm = fm + (it.rem & (WGM - 1)); pn = it.rem >> 3; } else { pm = fm + it.rem % gsz; pn = it.rem / gsz; }
    }
    DI bool first(UnitIt& it, int& pm, int& pn) const { it.L = c; if (it.L >= nwg) return false; locate(it); decode(it, pm, pn); return true; }
    DI bool step(UnitIt& it, int& pm, int& pn) const {
        it.L += G; if (it.L >= nwg) return false;
        if ((G & (NXCD - 1)) == 0) { it.rem += G / NXCD; while (it.rem >= nig) { it.rem -= nig; ++it.gid; } } else locate(it);
        decode(it, pm, pn); return true;
    }
};
struct PlainOrder : OrderBase {
    static constexpr bool GATHER = false;
    int K2;
    DI void fill(Unit& u) const { u.e = 0; u.brow = u.pn * BM; }
    DI unsigned rowoff(const Unit& u, int r) const { return (unsigned)(u.pm * BM + r) * (unsigned)K2; }
    DI void pref(const Unit&, LAS unsigned char*, int, int) const {}
};
template <bool GATHER_> struct MoeOrder : OrderBase {
    static constexpr bool GATHER = GATHER_;
    int K2, nper;
    const LAS int* texp; const unsigned* sroff;
    DI void fill(Unit& u) const { u.e = texp[u.pm]; u.brow = u.e * nper + u.pn * BM; }
    DI unsigned rowoff(const Unit& u, int r) const { if (GATHER) return sroff[u.pm * BM + r]; else return (unsigned)(u.pm * BM + r) * (unsigned)K2; }
    DI void pref(const Unit& u, LAS unsigned char* slot, int wid, int lane) const {
        if (GATHER && wid == 0) __builtin_amdgcn_global_load_lds((const unsigned*)(sroff + u.pm * BM + 4 * lane), (LAS unsigned*)slot, 16, 0, 0);
    }
};

template <class Epi, class Sched, bool I8 = false, bool ALIGN_EPI = true, bool SP2 = true>
__device__ __forceinline__ void gemm_phase(LAS unsigned char* lds, const Gemm g, const Sched& S, const Epi& E) {
    const int tid = threadIdx.x, wid = __builtin_amdgcn_readfirstlane(tid >> 6), lane = tid & 63, wr = wid >> 2, wc = wid & 3, fr = lane & 15, fq = lane >> 4;
    const int K = g.K, nt = K / BK;
    int stR[2]; unsigned stC2[2], voffB[2];
#pragma unroll
    for (int i = 0; i < 2; ++i) { int R, C; stage_rc(tid * 16 + i * 8192, R, C); const int Rb = Epi::PERM ? ((R & ~31) + perm32(R & 31)) : R;
        stR[i] = R; stC2[i] = (unsigned)C * 2u; voffB[i] = (unsigned)(Rb * K + C) * 2u; }
    const size_t kstep = (size_t)(BK * 2);
    const size_t hstep = (size_t)HALF * K * 2;
    const unsigned ldsw = (unsigned)wid * 1024u;
    const int aoffL = lds_byte(wr * 64 + fr, fq * 8), boffL = lds_byte(wc * 32 + fr, fq * 8);
#define PG8_SA(b, h) (((b) * 2 + (h)) * HTB)
#define PG8_SB(b, h) ((4 + (b) * 2 + (h)) * HTB)
#define PG8_STAGE(bufoff, gbase, voff) do { _Pragma("unroll") for (int _i = 0; _i < 2; ++_i) \
        __builtin_amdgcn_global_load_lds((const unsigned*)((const char*)(gbase) + (voff)[_i]), (LAS unsigned*)(lds + (bufoff) + ldsw + _i * 8192), 16, 0, 0); } while (0)
#define PG8_LDA(dst, b, h) do { _Pragma("unroll") for (int m = 0; m < 4; ++m) _Pragma("unroll") for (int k = 0; k < 2; ++k) dst[m][k] = *(const LAS bf16x8*)(lds + PG8_SA(b, h) + aoffL + m * 2048 + k * 1024); } while (0)
#define PG8_LDB(dst, b, h) do { _Pragma("unroll") for (int n = 0; n < 2; ++n) _Pragma("unroll") for (int k = 0; k < 2; ++k) dst[n][k] = *(const LAS bf16x8*)(lds + PG8_SB(b, h) + boffL + n * 2048 + k * 1024); } while (0)
#define PG8_MMA(ai, bj, At, Bt) do { __builtin_amdgcn_s_setprio(1); _Pragma("unroll") for (int m = 0; m < 4; ++m) _Pragma("unroll") for (int n = 0; n < 2; ++n) _Pragma("unroll") for (int k = 0; k < 2; ++k) \
        { if constexpr (I8) acc[ai][bj][m][n] = __builtin_bit_cast(f32x4, __builtin_amdgcn_mfma_i32_16x16x64_i8(__builtin_bit_cast(i32x4, Bt[n][k]), __builtin_bit_cast(i32x4, At[m][k]), __builtin_bit_cast(i32x4, acc[ai][bj][m][n]), 0, 0, 0)); \
          else acc[ai][bj][m][n] = __builtin_amdgcn_mfma_f32_16x16x32_bf16(Bt[n][k], At[m][k], acc[ai][bj][m][n], 0, 0, 0); } __builtin_amdgcn_s_setprio(0); } while (0)
#define PG8_WAIT_V(n) asm volatile("s_waitcnt vmcnt(" #n ")" ::: "memory")
#define PG8_WAIT_L(n) asm volatile("s_waitcnt lgkmcnt(" #n ")" ::: "memory")
#define PG8_BAR __builtin_amdgcn_s_barrier()
#define PG8_SCHED __builtin_amdgcn_sched_barrier(0)
    Unit cur, nxt; int ui = 0; UnitIt it;
    if (!S.first(it, cur.pm, cur.pn)) return;
    S.fill(cur);
    LAS unsigned char* const xgo = lds + XL_GO;
    LAS unsigned char* const xep = lds + XL_EP;
    E.prefetch(cur, xep, wid, lane);
    f32x4 acc[2][2][4][2];
#pragma unroll
    for (int a = 0; a < 2; ++a)
#pragma unroll
        for (int b = 0; b < 2; ++b)
#pragma unroll
            for (int m = 0; m < 4; ++m)
#pragma unroll
                for (int n = 0; n < 2; ++n) acc[a][b][m][n] = (f32x4){0.f, 0.f, 0.f, 0.f};
    bf16x8 At[4][2], B0[2][2], B1[2][2];
    unsigned ao0[2], ao1[2], no0[2], no1[2];
#pragma unroll
    for (int i = 0; i < 2; ++i) { ao0[i] = S.rowoff(cur, stR[i]) + stC2[i]; ao1[i] = S.rowoff(cur, HALF + stR[i]) + stC2[i]; no0[i] = ao0[i]; no1[i] = ao1[i]; }
    const char* Ab = (const char*)g.A;
    const char* cB = (const char*)g.Bt + (size_t)cur.brow * K * 2;
    if constexpr (SP2) {
        PG8_STAGE(PG8_SB(0, 0), cB, voffB); PG8_STAGE(PG8_SB(0, 1), cB + hstep, voffB); PG8_STAGE(PG8_SA(0, 0), Ab, ao0); PG8_STAGE(PG8_SA(0, 1), Ab, ao1);
        if (wr == 1) PG8_BAR;
        PG8_WAIT_V(2); PG8_BAR;
        PG8_STAGE(PG8_SB(1, 0), cB + kstep, voffB); PG8_STAGE(PG8_SA(1, 0), Ab + kstep, ao0); PG8_STAGE(PG8_SB(1, 1), cB + hstep + kstep, voffB);
        PG8_WAIT_V(6); PG8_BAR;
    } else {
        PG8_STAGE(PG8_SB(0, 0), cB, voffB); PG8_STAGE(PG8_SA(0, 0), Ab, ao0); PG8_STAGE(PG8_SB(0, 1), cB + hstep, voffB); PG8_STAGE(PG8_SA(0, 1), Ab, ao1);
        if (wr == 1) PG8_BAR;
        PG8_WAIT_V(4); PG8_BAR;
        PG8_STAGE(PG8_SB(1, 0), cB + kstep, voffB); PG8_STAGE(PG8_SA(1, 0), Ab + kstep, ao0); PG8_STAGE(PG8_SB(1, 1), cB + hstep + kstep, voffB);
        PG8_WAIT_V(6); PG8_BAR;
    }
    for (;;) {
        const bool has_next = S.step(it, nxt.pm, nxt.pn);
        if (has_next) { S.fill(nxt);
            if constexpr (Sched::GATHER) S.pref(nxt, xgo + ((ui + 1) & 1) * 1024, wid, lane);
            else {
#pragma unroll
                for (int i = 0; i < 2; ++i) { no0[i] = S.rowoff(nxt, stR[i]) + stC2[i]; no1[i] = S.rowoff(nxt, HALF + stR[i]) + stC2[i]; } }
        }
        const char* nB = has_next ? (const char*)g.Bt + (size_t)nxt.brow * K * 2 : cB;
        for (int t = 0; t < nt; t += 2) {
            const bool last = (t == nt - 2);
            if constexpr (Epi::HOOK) { if (t == nt / 2) E.hook(acc, cur, wr, wc, fr, fq); }
            const char* a1 = Ab + (size_t)(t + 1) * kstep;
            const char* a2 = last ? Ab : Ab + (size_t)(t + 2) * kstep; const char* b2 = last ? nB : cB + (size_t)(t + 2) * kstep;
            const char* a3 = a2 + kstep; const char* b3 = b2 + kstep;
            if constexpr (Sched::GATHER) { if (last && has_next) { const LAS unsigned char* gs = xgo + ((ui + 1) & 1) * 1024;
#pragma unroll
                for (int i = 0; i < 2; ++i) { no0[i] = *(const LAS unsigned*)(gs + 4 * stR[i]) + stC2[i]; no1[i] = *(const LAS unsigned*)(gs + 4 * (HALF + stR[i])) + stC2[i]; } } }
            unsigned x0[2], x1[2];
#pragma unroll
            for (int i = 0; i < 2; ++i) { x0[i] = last ? no0[i] : ao0[i]; x1[i] = last ? no1[i] : ao1[i]; }
            if constexpr (SP2) {
            PG8_LDB(B0, 0, 0); PG8_LDB(B1, 0, 1); PG8_SCHED; PG8_LDA(At, 0, 0); PG8_STAGE(PG8_SA(1, 1), a1, ao1);
            PG8_WAIT_V(8); PG8_WAIT_L(0); PG8_BAR; PG8_MMA(0, 0, At, B0); PG8_MMA(0, 1, At, B1); PG8_BAR; PG8_SCHED;
            PG8_LDA(At, 0, 1); PG8_STAGE(PG8_SB(0, 0), b2, voffB); PG8_STAGE(PG8_SB(0, 1), b2 + hstep, voffB); PG8_STAGE(PG8_SA(0, 0), a2, x0);
            PG8_WAIT_V(8); PG8_WAIT_L(0); PG8_BAR; PG8_MMA(1, 0, At, B0); PG8_MMA(1, 1, At, B1); PG8_BAR; PG8_SCHED;
            PG8_LDB(B0, 1, 0); PG8_LDB(B1, 1, 1); PG8_SCHED; PG8_LDA(At, 1, 0); PG8_STAGE(PG8_SA(0, 1), a2, x1);
            PG8_WAIT_V(8); PG8_WAIT_L(0); PG8_BAR; PG8_MMA(0, 0, At, B0); PG8_MMA(0, 1, At, B1); PG8_BAR; PG8_SCHED;
            PG8_LDA(At, 1, 1); PG8_STAGE(PG8_SB(1, 0), b3, voffB); PG8_STAGE(PG8_SB(1, 1), b3 + hstep, voffB); PG8_STAGE(PG8_SA(1, 0), a3, x0);
            PG8_WAIT_V(8); PG8_WAIT_L(0); PG8_BAR; PG8_MMA(1, 0, At, B0); PG8_MMA(1, 1, At, B1); PG8_BAR; PG8_SCHED;
            } else {
            PG8_LDB(B0, 0, 0); PG8_SCHED; PG8_LDA(At, 0, 0); PG8_STAGE(PG8_SA(1, 1), a1, ao1);
            PG8_WAIT_L(8); PG8_BAR; PG8_WAIT_L(0); PG8_MMA(0, 0, At, B0); PG8_BAR; PG8_SCHED;
            PG8_LDB(B1, 0, 1); PG8_STAGE(PG8_SB(0, 0), b2, voffB);
            PG8_BAR; PG8_WAIT_L(0); PG8_MMA(0, 1, At, B1); PG8_BAR;
            PG8_LDA(At, 0, 1); PG8_STAGE(PG8_SA(0, 0), a2, x0);
            PG8_BAR; PG8_WAIT_L(0); PG8_MMA(1, 0, At, B0); PG8_BAR; PG8_SCHED;
            PG8_STAGE(PG8_SB(0, 1), b2 + hstep, voffB);
            PG8_WAIT_V(6); PG8_BAR; PG8_MMA(1, 1, At, B1); PG8_BAR;
            PG8_LDB(B0, 1, 0); PG8_SCHED; PG8_LDA(At, 1, 0); PG8_STAGE(PG8_SA(0, 1), a2, x1);
            PG8_WAIT_L(8); PG8_BAR; PG8_WAIT_L(0); PG8_MMA(0, 0, At, B0); PG8_BAR; PG8_SCHED;
            PG8_LDB(B1, 1, 1); PG8_STAGE(PG8_SB(1, 0), b3, voffB);
            PG8_BAR; PG8_WAIT_L(0); PG8_MMA(0, 1, At, B1); PG8_BAR;
            PG8_LDA(At, 1, 1); PG8_STAGE(PG8_SA(1, 0), a3, x0);
            PG8_BAR; PG8_WAIT_L(0); PG8_MMA(1, 0, At, B0); PG8_BAR; PG8_SCHED;
            PG8_STAGE(PG8_SB(1, 1), b3 + hstep, voffB);
            PG8_WAIT_V(6); PG8_BAR; PG8_MMA(1, 1, At, B1); PG8_BAR;
            }
        }
        if constexpr (ALIGN_EPI) { if (wr == 0) PG8_BAR; }
        E(acc, cur, wr, wc, fr, fq, xep + (ui & 1) * 4096);
        if (!has_next) break;
#pragma unroll
        for (int a = 0; a < 2; ++a)
#pragma unroll
            for (int b = 0; b < 2; ++b)
#pragma unroll
                for (int m = 0; m < 4; ++m)
#pragma unroll
                    for (int n = 0; n < 2; ++n) acc[a][b][m][n] = (f32x4){0.f, 0.f, 0.f, 0.f};
        cur = nxt; cB = nB; ++ui;
        E.prefetch(cur, xep + (ui & 1) * 4096, wid, lane);
#pragma unroll
        for (int i = 0; i < 2; ++i) { ao0[i] = no0[i]; ao1[i] = no1[i]; }
        if constexpr (ALIGN_EPI) { if (wr == 1) PG8_BAR; }
    }
    PG8_WAIT_V(0);
    if constexpr (!ALIGN_EPI) { if (wr == 0) PG8_BAR; }
    PG8_BAR;
#undef PG8_SA
#undef PG8_SB
#undef PG8_STAGE
#undef PG8_LDA
#undef PG8_LDB
#undef PG8_MMA
#undef PG8_WAIT_V
#undef PG8_WAIT_L
#undef PG8_BAR
#undef PG8_SCHED
}
}

using pg8::Unit; using pg8::HALF; using pg8::BM;
struct EpiProj {
    static constexpr bool PERM = true, HOOK = false;
    bf16* P; const float* lbf; const float* lbb; const float* hrs; const float* wcs;
    DI void hook(f32x4 (&)[2][2][4][2], const Unit&, int, int, int, int) const {}
    DI void prefetch(const Unit& u, LAS unsigned char* slot, int wid, int lane) const {
        if (wid != 0) return;
        __builtin_amdgcn_global_load_lds((const unsigned*)(hrs + u.pm * BM + 4 * lane), (LAS unsigned*)slot, 16, 0, 0);
        __builtin_amdgcn_global_load_lds((const unsigned*)(wcs + u.pn * BM + 4 * lane), (LAS unsigned*)(slot + 1024), 16, 0, 0);
        if (u.pn >= 9 && u.pn < 17) __builtin_amdgcn_global_load_lds((const unsigned*)((u.pn < 13 ? lbf + (u.pn - 9) * BM : lbb + (u.pn - 13) * BM) + 4 * lane), (LAS unsigned*)(slot + 2048), 16, 0, 0);
    }
    DI void operator()(const f32x4 (&acc)[2][2][4][2], const Unit& u, int wr, int wc, int fr, int fq, const LAS unsigned char* slot) const {
        const int pn = u.pn; int cls, cbase, hs, pitch; size_t po; const float* lb = lbf;
        if (pn < 4)       { cls = 0; cbase = C_AQ; po = PO_AQ;  hs = 6;  pitch = 64; }
        else if (pn < 5)  { cls = 0; cbase = C_AK; po = PO_AKV; hs = 30; pitch = 256; }
        else if (pn < 9)  { cls = 1; cbase = C_BQ; po = PO_BQ;  hs = 7;  pitch = 128; }
        else if (pn < 13) { cls = 2; cbase = C_ZF; po = PO_ZF;  hs = 7;  pitch = 128; }
        else if (pn < 17) { cls = 2; cbase = C_ZB; po = PO_ZB;  hs = 7;  pitch = 128; lb = lbb; }
        else if (pn < 21) { cls = 0; cbase = C_BV; po = PO_BV;  hs = 7;  pitch = 128; }
        else if (pn < 25) { cls = 1; cbase = C_BG; po = PO_BG;  hs = 7;  pitch = 128; }
        else if (pn < 33) { cls = 3; cbase = C_GA; po = PO_GA;  hs = 30; pitch = 2048; }
        else              { cls = 3; cbase = C_GB; po = PO_GB;  hs = 30; pitch = 2048; }
        int zz = 0; asm volatile("" : "+v"(zz));
        const int row0 = u.pm * BM + wr * 64 + fr + zz, cin0 = u.pn * BM + wc * 32 + 8 * fq - cbase;
        bf16* base = P + po;
        float rsv[2][4];
#pragma unroll
        for (int ai = 0; ai < 2; ++ai)
#pragma unroll
            for (int m = 0; m < 4; ++m) rsv[ai][m] = *(const LAS float*)(slot + 4 * (ai * HALF + wr * 64 + m * 16 + fr));
#pragma unroll
        for (int bj = 0; bj < 2; ++bj) {
            float lbv[8];
            const int cin = cin0 + bj * HALF;
            { const int lc = bj * HALF + wc * 32 + 8 * fq; const f32x4 a = *(const LAS f32x4*)(slot + 2048 + 4 * lc), b = *(const LAS f32x4*)(slot + 2048 + 4 * lc + 16);
#pragma unroll
              for (int j = 0; j < 4; ++j) { lbv[j] = (cls == 2) ? a[j] : 0.f; lbv[4 + j] = (cls == 2) ? b[j] : 0.f; } }
            bf16* colp = base + (size_t)(cin >> hs) * MROWS * pitch + (cin & ((1 << hs) - 1));
            float csv[8];
            { const int lc = bj * HALF + wc * 32 + 8 * fq; const f32x4 a = *(const LAS f32x4*)(slot + 1024 + 4 * lc), b = *(const LAS f32x4*)(slot + 1024 + 4 * lc + 16);
#pragma unroll
              for (int j = 0; j < 4; ++j) { csv[j] = a[j]; csv[4 + j] = b[j]; } }
#pragma unroll
            for (int ai = 0; ai < 2; ++ai)
#pragma unroll
                for (int m = 0; m < 4; ++m) { const int rr = row0 + ai * HALF + m * 16; const size_t ro = (size_t)rr * pitch; float v[8]; const float rs = rsv[ai][m];
#pragma unroll
                    for (int j = 0; j < 8; ++j) v[j] = (float)__builtin_bit_cast(i32x4, acc[ai][bj][m][j >> 2])[j & 3] * (rs * csv[j]);
                    if (cls != 0) {
#pragma unroll
                        for (int j = 0; j < 8; ++j) { const float sg = sigmoidf_(v[j]); v[j] = (cls == 1) ? v[j] * sg : sg; }
                        if (cls == 2) {
#pragma unroll
                            for (int j = 0; j < 8; ++j) { const float l = lbv[j]; v[j] = __logf(l + (1.0f - l) * v[j]); } }
                    }
                    u32x4 w; w.x = pk2(v[0], v[1]); w.y = pk2(v[2], v[3]); w.z = pk2(v[4], v[5]); w.w = pk2(v[6], v[7]);
                    *(u32x4*)(colp + ro) = w; }
        }
    }
};
struct EpiMerge {
    static constexpr bool PERM = true, HOOK = true;
    bf16* O; const bf16* proj;
    DI void hook(f32x4 (&acc)[2][2][4][2], const Unit& u, int wr, int wc, int fr, int fq) const {
        int zz = 0; asm volatile("" : "+v"(zz));
        const int row0 = u.pm * BM + wr * 64 + fr + zz, col0 = u.pn * BM + wc * 32 + 8 * fq;
#pragma unroll
        for (int ai = 0; ai < 2; ++ai)
#pragma unroll
            for (int m = 0; m < 4; ++m) { const size_t rowp = (size_t)(row0 + ai * HALF + m * 16) * D + col0;
#pragma unroll
                for (int bj = 0; bj < 2; ++bj) { const u32x4 ga = *(const u32x4*)(proj + PO_GA + rowp + bj * HALF), gb = *(const u32x4*)(proj + PO_GB + rowp + bj * HALF);
#pragma unroll
                    for (int q = 0; q < 4; ++q) { const float r0 = bflo(ga[q]) * __builtin_amdgcn_rcpf(bflo(gb[q])), r1 = bfhi(ga[q]) * __builtin_amdgcn_rcpf(bfhi(gb[q]));
                        acc[ai][bj][m][q >> 1][(q & 1) * 2] *= r0; acc[ai][bj][m][q >> 1][(q & 1) * 2 + 1] *= r1; } }
                asm volatile("" ::: "memory"); }
    }
    DI void prefetch(const Unit&, LAS unsigned char*, int, int) const {}
    DI void operator()(const f32x4 (&acc)[2][2][4][2], const Unit& u, int wr, int wc, int fr, int fq, const LAS unsigned char*) const {
        const int row0 = u.pm * BM + wr * 64 + fr, col0 = u.pn * BM + wc * 32 + 8 * fq;
#pragma unroll
        for (int ai = 0; ai < 2; ++ai)
#pragma unroll
            for (int m = 0; m < 4; ++m) { const size_t r = (size_t)(row0 + ai * HALF + m * 16);
#pragma unroll
                for (int bj = 0; bj < 2; ++bj) { const u32x4 gb = *(const u32x4*)(proj + PO_GB + r * D + col0 + bj * HALF); u32x4 w;
#pragma unroll
                    for (int q = 0; q < 4; ++q) w[q] = pk2(acc[ai][bj][m][q >> 1][(q & 1) * 2] * bflo(gb[q]), acc[ai][bj][m][q >> 1][(q & 1) * 2 + 1] * bfhi(gb[q]));
                    *(u32x4*)(O + r * D + col0 + bj * HALF) = w; } }
    }
};
struct EpiOut {
    static constexpr bool PERM = false, HOOK = false;
    float* X1; const float* x; const float* mod2;
    DI void hook(f32x4 (&)[2][2][4][2], const Unit&, int, int, int, int) const {}
    DI void prefetch(const Unit&, LAS unsigned char*, int, int) const {}
    DI void operator()(const f32x4 (&acc)[2][2][4][2], const Unit& u, int wr, int wc, int fr, int fq, const LAS unsigned char*) const {
        const int row0 = u.pm * BM + wr * 64 + fr, col0 = u.pn * BM + wc * 32 + 4 * fq;
        f32x4 mv[2][2];
#pragma unroll
        for (int bj = 0; bj < 2; ++bj)
#pragma unroll
            for (int n = 0; n < 2; ++n) mv[bj][n] = *(const f32x4*)(mod2 + col0 + bj * HALF + n * 16);
#pragma unroll
        for (int ai = 0; ai < 2; ++ai)
#pragma unroll
            for (int m = 0; m < 4; ++m) { const size_t off = (size_t)(row0 + ai * HALF + m * 16) * D + col0;
#pragma unroll
                for (int bj = 0; bj < 2; ++bj)
#pragma unroll
                    for (int n = 0; n < 2; ++n) { const f32x4 xv = *(const f32x4*)(x + off + bj * HALF + n * 16);
                        *(f32x4*)(X1 + off + bj * HALF + n * 16) = xv + mv[bj][n] * acc[ai][bj][m][n]; } }
    }
};
struct EpiAct {
    static constexpr bool PERM = true, HOOK = false;
    bf16* ACTp; const float* bg; const float* bu; const float* cs; const float* srs;
    DI void hook(f32x4 (&)[2][2][4][2], const Unit&, int, int, int, int) const {}
    DI void prefetch(const Unit& u, LAS unsigned char* slot, int wid, int lane) const {
        if (wid != 0) return;
        __builtin_amdgcn_global_load_lds((const unsigned*)(srs + u.pm * BM + 4 * lane), (LAS unsigned*)slot, 16, 0, 0);
        __builtin_amdgcn_global_load_lds((const unsigned*)(cs + u.e * 4096 + u.pn * BM + 4 * lane), (LAS unsigned*)(slot + 1024), 16, 0, 0);
        __builtin_amdgcn_global_load_lds((const unsigned*)((lane < 32 ? bg : bu) + u.e * FF + u.pn * HALF + 4 * (lane & 31)), (LAS unsigned*)(slot + 2048), 16, 0, 0);
    }
    DI void operator()(const f32x4 (&acc)[2][2][4][2], const Unit& u, int wr, int wc, int fr, int fq, const LAS unsigned char* slot) const {
        int zz = 0; asm volatile("" : "+v"(zz));
        const int row0 = u.pm * BM + wr * 64 + fr + zz, col0 = u.pn * HALF + wc * 32 + 8 * fq, lc = wc * 32 + 8 * fq;
        float gbv[8], ubv[8], gsc[8], usc[8];
        { const f32x4 a = *(const LAS f32x4*)(slot + 2048 + 4 * lc), b = *(const LAS f32x4*)(slot + 2048 + 4 * lc + 16), c = *(const LAS f32x4*)(slot + 2560 + 4 * lc), d = *(const LAS f32x4*)(slot + 2560 + 4 * lc + 16);
          const f32x4 sa = *(const LAS f32x4*)(slot + 1024 + 4 * lc), sb = *(const LAS f32x4*)(slot + 1024 + 4 * lc + 16), sc = *(const LAS f32x4*)(slot + 1536 + 4 * lc), sd = *(const LAS f32x4*)(slot + 1536 + 4 * lc + 16);
#pragma unroll
          for (int j = 0; j < 4; ++j) { gbv[j] = a[j]; gbv[4 + j] = b[j]; ubv[j] = c[j]; ubv[4 + j] = d[j]; gsc[j] = sa[j]; gsc[4 + j] = sb[j]; usc[j] = sc[j]; usc[4 + j] = sd[j]; } }
        float rsv[2][4];
#pragma unroll
        for (int ai = 0; ai < 2; ++ai)
#pragma unroll
            for (int m = 0; m < 4; ++m) rsv[ai][m] = *(const LAS float*)(slot + 4 * (ai * HALF + wr * 64 + m * 16 + fr));
#pragma unroll
        for (int ai = 0; ai < 2; ++ai)
#pragma unroll
            for (int m = 0; m < 4; ++m) { float v[8]; const int r = row0 + ai * HALF + m * 16; const float rs = rsv[ai][m];
#pragma unroll
                for (int j = 0; j < 8; ++j) { const i32x4 ga = __builtin_bit_cast(i32x4, acc[ai][0][m][j >> 2]), ua = __builtin_bit_cast(i32x4, acc[ai][1][m][j >> 2]);
                    float gg = (float)ga[j & 3] * (rs * gsc[j]) + gbv[j], uu = (float)ua[j & 3] * (rs * usc[j]) + ubv[j];
                    gg = fminf(gg, 7.0f); uu = fminf(fmaxf(uu, -7.0f), 7.0f);
                    v[j] = gg * __builtin_amdgcn_rcpf(1.0f + __builtin_amdgcn_exp2f(gg * (-1.702f * 1.4426950408889634f))) * (uu + 1.0f); }
                u32x4 w; w.x = pk2(v[0], v[1]); w.y = pk2(v[2], v[3]); w.z = pk2(v[4], v[5]); w.w = pk2(v[6], v[7]);
                *(u32x4*)(ACTp + (size_t)r * FF + col0) = w; }
    }
};
struct EpiDown {
    static constexpr bool PERM = true, HOOK = false;
    bf16* YSp; const float* bd; const float* sgate; const float* ars; const float* csd;
    DI void hook(f32x4 (&)[2][2][4][2], const Unit&, int, int, int, int) const {}
    DI void prefetch(const Unit& u, LAS unsigned char* slot, int wid, int lane) const {
        if (wid != 0) return;
        __builtin_amdgcn_global_load_lds((const unsigned*)(sgate + u.pm * BM + 4 * lane), (LAS unsigned*)slot, 16, 0, 0);
        __builtin_amdgcn_global_load_lds((const unsigned*)(ars + u.pm * BM + 4 * lane), (LAS unsigned*)(slot + 1024), 16, 0, 0);
        __builtin_amdgcn_global_load_lds((const unsigned*)(bd + u.e * D + u.pn * BM + 4 * lane), (LAS unsigned*)(slot + 2048), 16, 0, 0);
        __builtin_amdgcn_global_load_lds((const unsigned*)(csd + u.e * D + u.pn * BM + 4 * lane), (LAS unsigned*)(slot + 3072), 16, 0, 0);
    }
    DI void operator()(const f32x4 (&acc)[2][2][4][2], const Unit& u, int wr, int wc, int fr, int fq, const LAS unsigned char* slot) const {
        int zz = 0; asm volatile("" : "+v"(zz));
        const int row0 = u.pm * BM + wr * 64 + fr + zz, col0 = u.pn * BM + wc * 32 + 8 * fq;
        float gtv[2][4], rsv[2][4];
#pragma unroll
        for (int ai = 0; ai < 2; ++ai)
#pragma unroll
            for (int m = 0; m < 4; ++m) { const int lr = ai * HALF + wr * 64 + m * 16 + fr; gtv[ai][m] = *(const LAS float*)(slot + 4 * lr); rsv[ai][m] = *(const LAS float*)(slot + 1024 + 4 * lr); }
#pragma unroll
        for (int bj = 0; bj < 2; ++bj) { float bv[8], cv[8];
            { const int lc = bj * HALF + wc * 32 + 8 * fq; const f32x4 a = *(const LAS f32x4*)(slot + 2048 + 4 * lc), b = *(const LAS f32x4*)(slot + 2048 + 4 * lc + 16), c = *(const LAS f32x4*)(slot + 3072 + 4 * lc), d = *(const LAS f32x4*)(slot + 3072 + 4 * lc + 16);
#pragma unroll
              for (int j = 0; j < 4; ++j) { bv[j] = a[j]; bv[4 + j] = b[j]; cv[j] = c[j]; cv[4 + j] = d[j]; } }
#pragma unroll
            for (int ai = 0; ai < 2; ++ai)
#pragma unroll
                for (int m = 0; m < 4; ++m) { const int r = row0 + ai * HALF + m * 16; const float gt = gtv[ai][m], rs = rsv[ai][m]; u32x4 w;
#pragma unroll
                    for (int q = 0; q < 4; ++q) { const i32x4 ia = __builtin_bit_cast(i32x4, acc[ai][bj][m][q >> 1]);
                        w[q] = pk2(((float)ia[(q & 1) * 2] * (rs * cv[2 * q]) + bv[2 * q]) * gt, ((float)ia[(q & 1) * 2 + 1] * (rs * cv[2 * q + 1]) + bv[2 * q + 1]) * gt); }
                    *(u32x4*)(YSp + (size_t)r * D + col0 + bj * HALF) = w; } }
    }
};

#define XB_TMO      128
#define XB_XCNT(j)  (256  + 64 * (j))
#define XB_XSUB(j)  (1280 + 64 * (j))
#define XB_XGEN(j)  (2304 + 64 * (j))
#define XB_TOP      3328
#define XB_TOPGEN   3392
#define XCD_BAR_WORDS 3456
#define XB_SPIN_CAP (1u << 22)
DI unsigned xb_ld(unsigned* p)              { return __hip_atomic_load(p, __ATOMIC_RELAXED, __HIP_MEMORY_SCOPE_AGENT); }
DI unsigned xb_add(unsigned* p, unsigned v) { return __hip_atomic_fetch_add(p, v, __ATOMIC_RELAXED, __HIP_MEMORY_SCOPE_AGENT); }
DI unsigned xb_xcc_id() { return (unsigned)__builtin_amdgcn_s_getreg((3 << 11) | 20) & 0xFu; }
#define XB_SPIN(cond, bar) do { unsigned _sp = 0; while (cond) { __builtin_amdgcn_s_sleep(1); \
    if ((++_sp & 255u) == 0u) { if (xb_ld(&(bar)[XB_TMO])) break; if (_sp > XB_SPIN_CAP) { atomicAdd(&(bar)[XB_TMO], 1u); break; } } } } while (0)
struct XcdBarrier { unsigned* bar; unsigned x; volatile LAS unsigned* st; };
DI XcdBarrier xcd_barrier_post(unsigned* bar, volatile LAS unsigned* st) {
    XcdBarrier b; b.bar = bar; b.x = xb_xcc_id(); b.st = st;
    if (threadIdx.x == 0) (void)xb_add(&bar[XB_XCNT(b.x)], 1u);
    return b;
}
DI void xcd_barrier_complete(unsigned* bar, unsigned x, unsigned& nloc, unsigned& nx) {
    const unsigned G = gridDim.x * gridDim.y * gridDim.z;
    unsigned sum, cnt, mine, sp = 0u;
    for (;;) {
        sum = 0u; cnt = 0u; mine = 0u;
#pragma unroll
        for (unsigned j = 0; j < 16; ++j) { const unsigned c = xb_ld(&bar[XB_XCNT(j)]); sum += c; cnt += (c > 0u) ? 1u : 0u; mine = (j == x) ? c : mine; }
        if (sum == G) break;
        __builtin_amdgcn_s_sleep(1);
        if ((++sp & 255u) == 0u) { if (xb_ld(&bar[XB_TMO])) break; if (sp > XB_SPIN_CAP) { atomicAdd(&bar[XB_TMO], 1u); break; } }
    }
    nloc = mine > 0u ? mine : 1u; nx = cnt > 0u ? cnt : 1u;
}
DI void xcd_barrier(const XcdBarrier& b) {
    asm volatile("s_waitcnt vmcnt(0)" ::: "memory");
    __syncthreads();
    if (threadIdx.x == 0) {
        unsigned* bar = b.bar;
        __builtin_amdgcn_s_waitcnt(0);
        unsigned nloc = b.st[0], nx = b.st[1];
        if (nloc == 0u) { xcd_barrier_complete(bar, b.x, nloc, nx); b.st[0] = nloc; b.st[1] = nx; }
        const unsigned old = xb_add(&bar[XB_XSUB(b.x)], 1u);
        const unsigned gen = old / nloc;
        if (old + 1u == (gen + 1u) * nloc) {
            __builtin_amdgcn_fence(__ATOMIC_RELEASE, "agent");
            asm volatile("s_waitcnt vmcnt(0)" ::: "memory");
            const unsigned og = xb_add(&bar[XB_TOP], 1u);
            const unsigned tg = og / nx;
            if (og + 1u == (tg + 1u) * nx) xb_add(&bar[XB_TOPGEN], 1u);
            else XB_SPIN(xb_ld(&bar[XB_TOPGEN]) == tg, bar);
            __builtin_amdgcn_fence(__ATOMIC_ACQUIRE, "agent");
            xb_add(&bar[XB_XGEN(b.x)], 1u);
            asm volatile("s_waitcnt vmcnt(0)" ::: "memory");
        } else {
            XB_SPIN(xb_ld(&bar[XB_XGEN(b.x)]) == gen, bar);
            __builtin_amdgcn_fence(__ATOMIC_ACQUIRE, "agent");
            asm volatile("s_waitcnt vmcnt(0)" ::: "memory");
        }
    }
    __syncthreads();
}

struct Args {
    const float *x, *c, *ctx, *c_ctx, *norm_mix_g, *norm_ffn_g, *w_mod, *b_mod, *w_in, *sinks, *lbf_logits, *lbb_logits, *hgrn_g, *w_branch, *w_out,
                *w_router, *b_router, *w_e_gate, *b_e_gate, *w_e_up, *b_e_up, *w_e_down, *b_e_down, *final_g;
    float* out; unsigned char* ws; int ph_lo, ph_hi;
};

DI void p0_transpose64(const float* W, int ldw, bf16* WT, int ldt, LAS unsigned char* scr, int lane) {
    const int kq = lane >> 4, n4 = lane & 15;
    f32x4 v[16];
#pragma unroll
    for (int i = 0; i < 16; ++i) v[i] = *(const f32x4*)(W + (size_t)(16 * kq + i) * ldw + 4 * n4);
#pragma unroll
    for (int c = 0; c < 4; ++c)
#pragma unroll
        for (int h = 0; h < 2; ++h) { u32x4 w; w.x = pk2(v[8 * h][c], v[8 * h + 1][c]); w.y = pk2(v[8 * h + 2][c], v[8 * h + 3][c]); w.z = pk2(v[8 * h + 4][c], v[8 * h + 5][c]); w.w = pk2(v[8 * h + 6][c], v[8 * h + 7][c]);
            *(LAS u32x4*)(scr + (4 * n4 + c) * 144 + (16 * kq + 8 * h) * 2) = w; }
    LDS_WAIT(); asm volatile("" ::: "memory");
#pragma unroll
    for (int j = 0; j < 8; ++j) { const int row = (lane >> 3) + 8 * j, pc = lane & 7; const u32x4 o = *(const LAS u32x4*)(scr + row * 144 + pc * 16); *(u32x4*)(WT + (size_t)row * ldt + pc * 8) = o; }
    LDS_WAIT(); asm volatile("" ::: "memory");
}
DI void p0_quant_item(const float* W  , int ldw, signed char* Q  , float* csp  , LAS unsigned char* lds, int tid) {
    const int lane = tid & 63, w = tid >> 6, n4 = lane & 7, kr = lane >> 3;
    LAS float* smax = (LAS float*)(lds + 32 * 2064);
    f32x4 v[8][4]; f32x4 mx = {0.f, 0.f, 0.f, 0.f};
#pragma unroll
    for (int g = 0; g < 8; ++g)
#pragma unroll
        for (int r = 0; r < 4; ++r) { v[g][r] = *(const f32x4*)(W + (size_t)(256 * g + 32 * w + 4 * kr + r) * ldw + 4 * n4);
            mx[0] = fmaxf(mx[0], fabsf(v[g][r][0])); mx[1] = fmaxf(mx[1], fabsf(v[g][r][1])); mx[2] = fmaxf(mx[2], fabsf(v[g][r][2])); mx[3] = fmaxf(mx[3], fabsf(v[g][r][3])); }
#pragma unroll
    for (int c = 0; c < 4; ++c) { float m = mx[c]; m = fmaxf(m, __shfl_xor(m, 8)); m = fmaxf(m, __shfl_xor(m, 16)); m = fmaxf(m, __shfl_xor(m, 32)); mx[c] = m; }
    __syncthreads();
    if (kr == 0) *(LAS f32x4*)(smax + w * 32 + 4 * n4) = mx;
    __syncthreads();
    f32x4 cm = *(const LAS f32x4*)(smax + 4 * n4);
#pragma unroll
    for (int ww = 1; ww < 8; ++ww) { const f32x4 o = *(const LAS f32x4*)(smax + ww * 32 + 4 * n4); cm[0] = fmaxf(cm[0], o[0]); cm[1] = fmaxf(cm[1], o[1]); cm[2] = fmaxf(cm[2], o[2]); cm[3] = fmaxf(cm[3], o[3]); }
    f32x4 inv;
#pragma unroll
    for (int c = 0; c < 4; ++c) { if (cm[c] == 0.f) cm[c] = 1.f; inv[c] = 127.0f / cm[c]; }
    if (w == 0 && kr == 0) { f32x4 sc; sc[0] = cm[0] * (1.0f / 127.0f); sc[1] = cm[1] * (1.0f / 127.0f); sc[2] = cm[2] * (1.0f / 127.0f); sc[3] = cm[3] * (1.0f / 127.0f); *(f32x4*)(csp + 4 * n4) = sc; }
#pragma unroll
    for (int g = 0; g < 8; ++g)
#pragma unroll
        for (int c = 0; c < 4; ++c) { unsigned pk = 0u;
#pragma unroll
            for (int r = 0; r < 4; ++r) { const int q = (int)rintf(v[g][r][c] * inv[c]); pk |= ((unsigned)q & 0xffu) << (8 * r); }
            *(LAS unsigned*)(lds + (4 * n4 + c) * 2064 + 4 * (64 * g + 8 * w + kr)) = pk; }
    __syncthreads();
#pragma unroll
    for (int i = 0; i < 8; ++i) { const int p = tid + 512 * i, row = p >> 7, pc = p & 127; const u32x4 o = *(const LAS u32x4*)(lds + row * 2064 + pc * 16); *(u32x4*)(Q + (size_t)row * 2048 + pc * 16) = o; }
}

constexpr int SC_QH = 0, SC_KH = 8448, SC_KT = 16896, SC_VT = 26112, SC_FAC = 35328, SC_RZ = 35840, SC_RV = 44032, SC_RQ = 52224, SC_GRP = 60416;
constexpr int RSQ = 264, RST = 72;
DI int crow(int i, int h) { return (i & 3) + 8 * (i >> 2) + 4 * h; }
DI bf16x8 pack8(float a0, float a1, float a2, float a3, float a4, float a5, float a6, float a7) {
    u32x4 p; p.x = pk2(a0, a1); p.y = pk2(a2, a3); p.z = pk2(a4, a5); p.w = pk2(a6, a7); return __builtin_bit_cast(bf16x8, p);
}
DI bf16x8 lds_frag2(const LAS unsigned char* p0, const LAS unsigned char* p1) {
    const u32x2 lo = *(const LAS u32x2*)p0, hi = *(const LAS u32x2*)p1; u32x4 v; v.x = lo.x; v.y = lo.y; v.z = hi.x; v.w = hi.y; return __builtin_bit_cast(bf16x8, v);
}
#define MFMA32(a, b, c) __builtin_amdgcn_mfma_f32_32x32x16_bf16((a), (b), (c), 0, 0, 0)

template <bool OUT>
DI void scan_segment(LAS unsigned char* ldsb, const bf16* proj, int hh, int segF, int segB, float* Lbuf, float* Dlog, bf16* oscr) {
    const int tid = threadIdx.x, lane = tid & 63, wave = __builtin_amdgcn_readfirstlane(tid >> 6);
    const int dir = wave >> 2, w4 = wave & 3, half = w4 >> 1, d = tid & 127, r = lane & 31, h5 = lane >> 5, e0 = 32 * w4;
    const int seg = dir ? segB : segF, scan = dir * 8 + hh;
    const int ntok = (seg == 0) ? NCTX : 512, sgn = dir ? -1 : 1;
    const int r0 = (seg == 0) ? (dir ? MROWS - 1 : NTOK) : (dir ? NTOK - 1 - (seg - 1) * 512 : (seg - 1) * 512);
    LAS unsigned char* G = ldsb + dir * SC_GRP;
    LAS unsigned char* QH = G + SC_QH; LAS unsigned char* KH = G + SC_KH; LAS unsigned char* KT = G + SC_KT; LAS unsigned char* VT = G + SC_VT; LAS float* FAC = (LAS float*)(G + SC_FAC);
    float* Lslot = Lbuf + (size_t)(scan * NSEG + seg) * 16384;
    f32x16 acc[4];
    if (OUT) {
        const float* Sin = Lbuf + (size_t)(scan * NSEG + seg - 1) * 16384;
#pragma unroll
        for (int dt = 0; dt < 4; ++dt)
#pragma unroll
            for (int i = 0; i < 16; ++i) acc[dt][i] = Sin[(32 * dt + crow(i, h5)) * 128 + e0 + r];
    } else {
#pragma unroll
        for (int dt = 0; dt < 4; ++dt)
#pragma unroll
            for (int i = 0; i < 16; ++i) acc[dt][i] = 0.f;
    }
    float tail_prev = 0.f, dlog_tot = 0.f;
    const bf16* zsrc = proj + (dir ? PO_ZB : PO_ZF) + (size_t)hh * MROWS * 128; const bf16* vsrc = proj + PO_BV + (size_t)hh * MROWS * 128; const bf16* qsrc = proj + PO_BQ + (size_t)hh * MROWS * 128;
    const int nch = ntok / 32;
    LAS unsigned char* RZ = G + SC_RZ; LAS unsigned char* RV = G + SC_RV; LAS unsigned char* RQ = G + SC_RQ;
#define SC_SETZ(k) (OUT ? RZ : ((k) == 0 ? RZ : (k) == 1 ? G + SC_QH : ldsb + 2 * SC_GRP + dir * 16384))
#define SC_SETV(k) (OUT ? RV : ((k) == 0 ? RV : (k) == 1 ? G + SC_KH : ldsb + 2 * SC_GRP + dir * 16384 + 8192))
#define SC_DMA(cc) do { const int rb_ = r0 + sgn * 32 * (cc); LAS unsigned char* dz_ = SC_SETZ((cc) % 3); LAS unsigned char* dv_ = SC_SETV((cc) % 3); \
        _Pragma("unroll") for (int i_ = 0; i_ < 2; ++i_) { const int s_ = 8 * w4 + 4 * i_ + (lane >> 4); const size_t so_ = (size_t)(rb_ + sgn * s_) * 128 + 8 * (lane & 15); \
            __builtin_amdgcn_global_load_lds((const unsigned*)(zsrc + so_), (LAS unsigned*)(dz_ + (8 * w4 + 4 * i_) * 256), 16, 0, 0); \
            __builtin_amdgcn_global_load_lds((const unsigned*)(vsrc + so_), (LAS unsigned*)(dv_ + (8 * w4 + 4 * i_) * 256), 16, 0, 0); \
            if (OUT) __builtin_amdgcn_global_load_lds((const unsigned*)(qsrc + so_), (LAS unsigned*)(RQ + (8 * w4 + 4 * i_) * 256), 16, 0, 0); } } while (0)
    SC_DMA(0);
    if (!OUT) SC_DMA(1);
    if (OUT) asm volatile("s_waitcnt vmcnt(0)" ::: "memory"); else asm volatile("s_waitcnt vmcnt(4)" ::: "memory");
    asm volatile("s_waitcnt lgkmcnt(0)" ::: "memory"); __builtin_amdgcn_s_barrier(); asm volatile("" ::: "memory");
    for (int k = 0; k < 2 * nch + 1; ++k) {
      const int kk = k - dir;
      if (kk >= 0 && kk < 2 * nch) {
        const int c = kk >> 1;
        const int rb = r0 + sgn * 32 * c;
        const LAS unsigned char* RZc = SC_SETZ(c % 3); const LAS unsigned char* RVc = SC_SETV(c % 3);
        if ((kk & 1) == 0) {
        float rsum = 0.f, lf[16], vv[16], qq[16];
        if (half) {
#pragma unroll
            for (int s = 0; s < 16; ++s) rsum += bf2f(*(const LAS unsigned short*)(RZc + s * 256 + d * 2));
        }
#pragma unroll
        for (int i = 0; i < 16; ++i) { const int so = (16 * half + i) * 256 + d * 2;
            lf[i] = bf2f(*(const LAS unsigned short*)(RZc + so)); vv[i] = bf2f(*(const LAS unsigned short*)(RVc + so)); if (OUT) qq[i] = bf2f(*(const LAS unsigned short*)(RQ + so)); }
        if (!half) {
#pragma unroll
            for (int i = 0; i < 16; ++i) rsum += lf[i];
        }
        float b = half ? rsum : 0.f, kh[16], qh[16];
#pragma unroll
        for (int i = 0; i < 16; ++i) { b += lf[i]; const float x = b - rsum;
            kh[i] = (1.0f - __expf(lf[i])) * __expf(fminf(-x, 60.f));
            if (OUT) qh[i] = qq[i] * __expf(fminf(x, 60.f)); }
        const float tail = b - rsum;
#pragma unroll
        for (int j = 0; j < 4; ++j) {
            u32x2 w; w.x = pk2(kh[4 * j], kh[4 * j + 1]); w.y = pk2(kh[4 * j + 2], kh[4 * j + 3]); *(LAS u32x2*)(KT + d * RST + 32 * half + 8 * j) = w;
            u32x2 v; v.x = pk2(vv[4 * j], vv[4 * j + 1]); v.y = pk2(vv[4 * j + 2], vv[4 * j + 3]); *(LAS u32x2*)(VT + d * RST + 32 * half + 8 * j) = v;
        }
        if (OUT) {
#pragma unroll
            for (int i = 0; i < 16; ++i) { const int s = 16 * half + i;
                *(LAS unsigned short*)(KH + s * RSQ + d * 2) = f2bf(kh[i]); *(LAS unsigned short*)(QH + s * RSQ + d * 2) = f2bf(qh[i]); }
        }
        if (half) { FAC[d] = __expf(tail_prev + rsum); tail_prev = tail; dlog_tot += rsum + tail; }
        } else {
        if (OUT) { if (c + 1 < nch) SC_DMA(c + 1); } else { if (c + 2 < nch) SC_DMA(c + 2); }
        asm volatile("" ::: "memory");
#pragma unroll
        for (int dt = 0; dt < 4; ++dt)
#pragma unroll
            for (int g4 = 0; g4 < 4; ++g4) { const f32x4 f = *(const LAS f32x4*)(FAC + 32 * dt + 8 * g4 + 4 * h5);
#pragma unroll
                for (int j = 0; j < 4; ++j) acc[dt][4 * g4 + j] *= f[j]; }
        if (OUT) {
            bf16x8 qf[8];
            f32x16 pT, oT;
#pragma unroll
            for (int i = 0; i < 16; ++i) { pT[i] = 0.f; oT[i] = 0.f; }
#pragma unroll
            for (int kk = 0; kk < 8; ++kk) {
                qf[kk] = lds_frag2(QH + r * RSQ + (16 * kk + 4 * h5) * 2, QH + r * RSQ + (16 * kk + 8 + 4 * h5) * 2);
                const bf16x8 kf = lds_frag2(KH + r * RSQ + (16 * kk + 4 * h5) * 2, KH + r * RSQ + (16 * kk + 8 + 4 * h5) * 2);
                pT = MFMA32(kf, qf[kk], pT);
            }
#pragma unroll
            for (int i = 0; i < 16; ++i) if (crow(i, h5) > r) pT[i] = 0.f;
#pragma unroll
            for (int dt = 0; dt < 4; ++dt)
#pragma unroll
                for (int ks = 0; ks < 2; ++ks) {
                    const bf16x8 sa = pack8(acc[dt][8 * ks], acc[dt][8 * ks + 1], acc[dt][8 * ks + 2], acc[dt][8 * ks + 3], acc[dt][8 * ks + 4], acc[dt][8 * ks + 5], acc[dt][8 * ks + 6], acc[dt][8 * ks + 7]);
                    oT = MFMA32(sa, qf[2 * dt + ks], oT);
                }
#pragma unroll
            for (int ks = 0; ks < 2; ++ks) {
                const bf16x8 pf = pack8(pT[8 * ks], pT[8 * ks + 1], pT[8 * ks + 2], pT[8 * ks + 3], pT[8 * ks + 4], pT[8 * ks + 5], pT[8 * ks + 6], pT[8 * ks + 7]);
                const bf16x8 va = lds_frag2(VT + (e0 + r) * RST + (16 * ks + 4 * h5) * 2, VT + (e0 + r) * RST + (16 * ks + 8 + 4 * h5) * 2);
                oT = MFMA32(va, pf, oT);
            }
            bf16* orow = oscr + ((size_t)(dir * 8 + hh) * NTOK + (rb + sgn * r)) * 128 + e0 + 4 * h5;
#pragma unroll
            for (int g4 = 0; g4 < 4; ++g4) { u32x2 o; o.x = pk2(oT[4 * g4], oT[4 * g4 + 1]); o.y = pk2(oT[4 * g4 + 2], oT[4 * g4 + 3]); *(u32x2*)(orow + 8 * g4) = o; }
        }
#pragma unroll
        for (int ks = 0; ks < 2; ++ks) {
            const bf16x8 vb = lds_frag2(VT + (e0 + r) * RST + (16 * ks + 8 * h5) * 2, VT + (e0 + r) * RST + (16 * ks + 8 * h5) * 2 + 8);
#pragma unroll
            for (int dt = 0; dt < 4; ++dt) {
                const bf16x8 ka = lds_frag2(KT + (32 * dt + r) * RST + (16 * ks + 8 * h5) * 2, KT + (32 * dt + r) * RST + (16 * ks + 8 * h5) * 2 + 8);
                acc[dt] = MFMA32(ka, vb, acc[dt]);
            }
        }
        if (OUT) { if (c + 1 < nch) asm volatile("s_waitcnt vmcnt(4)" ::: "memory"); }
        else { if (c + 2 < nch) asm volatile("s_waitcnt vmcnt(4)" ::: "memory"); else if (c + 1 < nch) asm volatile("s_waitcnt vmcnt(0)" ::: "memory"); }
        }
      }
      asm volatile("s_waitcnt lgkmcnt(0)" ::: "memory"); __builtin_amdgcn_s_barrier(); asm volatile("" ::: "memory");
    }
#undef SC_DMA
#undef SC_SETZ
#undef SC_SETV
    if (!OUT) {
        __syncthreads();
        if (half) { FAC[d] = __expf(tail_prev); Dlog[(size_t)(scan * NSEG + seg) * 128 + d] = dlog_tot; }
        __syncthreads();
#pragma unroll
        for (int dt = 0; dt < 4; ++dt)
#pragma unroll
            for (int g4 = 0; g4 < 4; ++g4) { const f32x4 f = *(const LAS f32x4*)(FAC + 32 * dt + 8 * g4 + 4 * h5);
#pragma unroll
                for (int j = 0; j < 4; ++j) Lslot[(32 * dt + 8 * g4 + 4 * h5 + j) * 128 + e0 + r] = acc[dt][4 * g4 + j] * f[j]; }
    }
    __syncthreads();
}

constexpr int AT_KC = 0, AT_VC = 36864, AT_KL = 70144, AT_VL = 116224, AT_END = 157696;
constexpr int KRS = 144, VCRS = 520, VLRS = 648, NSLOT = 10;
static_assert(AT_END <= MISC_OFF, "attention LDS");
static_assert(2 * SC_GRP + 2 * 16384 <= MISC_OFF, "scan LDS");
DI void attn_unit(LAS unsigned char* ldsb, const bf16* proj, const bf16* KR, const bf16* VTg, const float* rope, const float* sinks, bf16* yab, int kvh, int ab) {
    const int tid = threadIdx.x, lane = tid & 63, wave = __builtin_amdgcn_readfirstlane(tid >> 6), r = lane & 31, h5 = lane >> 5;
    const int head = kvh * 8 + wave;
    LAS unsigned char* KC = ldsb + AT_KC; LAS unsigned char* VC = ldsb + AT_VC; LAS unsigned char* KL = ldsb + AT_KL; LAS unsigned char* VL = ldsb + AT_VL;
    const float* rowcos = rope, *rowsin = rope + 4096, *colcos = rope + 8192, *colsin = rope + 8192 + 1024;
    __syncthreads();
    for (int p = tid; p < 2048; p += 512) {
        { const int key = p >> 3, c8 = p & 7; const u32x4 v = *(const u32x4*)(KR + ((size_t)(kvh * MROWS + NTOK + key)) * 64 + c8 * 8); *(LAS u32x4*)(KC + key * KRS + c8 * 16) = v; }
        { const int dd = p >> 5, c = p & 31; const u32x4 v = *(const u32x4*)(VTg + ((size_t)(kvh * 64 + dd)) * MROWS + NTOK + c * 8);
          u32x2 a; a.x = v.x; a.y = v.y; u32x2 b; b.x = v.z; b.y = v.w; *(LAS u32x2*)(VC + dd * VCRS + c * 16) = a; *(LAS u32x2*)(VC + dd * VCRS + c * 16 + 8) = b; }
    }
    const int T0 = ab * 4 - 4;
    for (int p = tid; p < 2304; p += 512) {
        { const int key = p >> 3, c8 = p & 7, T = T0 + (key >> 5), slot = (T + 2 * NSLOT) % NSLOT;
          if (T >= 0 && T < NTOK / 32) { const u32x4 v = *(const u32x4*)(KR + ((size_t)(kvh * MROWS + T * 32 + (key & 31))) * 64 + c8 * 8); *(LAS u32x4*)(KL + (slot * 32 + (key & 31)) * KRS + c8 * 16) = v; } }
        { const int dd = p / 36, c = p % 36, T = T0 + (c >> 2), slot = (T + 2 * NSLOT) % NSLOT;
          if (T >= 0 && T < NTOK / 32) { const u32x4 v = *(const u32x4*)(VTg + ((size_t)(kvh * 64 + dd)) * MROWS + T * 32 + (c & 3) * 8);
            u32x2 a; a.x = v.x; a.y = v.y; u32x2 b; b.x = v.z; b.y = v.w; LAS unsigned char* dst = VL + dd * VLRS + slot * 64 + (c & 3) * 16; *(LAS u32x2*)dst = a; *(LAS u32x2*)(dst + 8) = b; } }
    }
    const float sc = 0.125f * 1.4426950408889634f;
    u32x4 raw[4]; float cs[2][8], sn[2][8];
#define AT_LOADQ(P0) do { const int qp_ = (P0) + r; const bf16* qrow_ = proj + PO_AQ + ((size_t)head * MROWS + qp_) * 64 + 8 * h5; \
        _Pragma("unroll") for (int ks = 0; ks < 4; ++ks) raw[ks] = *(const u32x4*)(qrow_ + 16 * ks); \
        const float* c0_ = rowcos + (qp_ >> 6) * 16 + 8 * h5; const float* s0_ = rowsin + (qp_ >> 6) * 16 + 8 * h5; \
        const float* c1_ = colcos + (qp_ & 63) * 16 + 8 * h5; const float* s1_ = colsin + (qp_ & 63) * 16 + 8 * h5; \
        _Pragma("unroll") for (int j = 0; j < 8; ++j) { cs[0][j] = c0_[j]; sn[0][j] = s0_[j]; cs[1][j] = c1_[j]; sn[1][j] = s1_[j]; } } while (0)
    AT_LOADQ(ab * 128);
    __syncthreads();
    for (int qt = 0; qt < 4; ++qt) {
        const int p0 = ab * 128 + 32 * qt, kb0 = p0 - 128, qp = p0 + r, Tq = ab * 4 + qt - 4;
        bf16x8 qf[4];
#pragma unroll
        for (int ks = 0; ks < 2; ++ks) { float o1[8], o2[8];
#pragma unroll
            for (int q = 0; q < 4; ++q) {
                const float a0 = bflo(raw[ks][q]), a1 = bfhi(raw[ks][q]), b0 = bflo(raw[ks + 2][q]), b1 = bfhi(raw[ks + 2][q]);
                o1[2 * q] = a0 * cs[ks][2 * q] - b0 * sn[ks][2 * q]; o2[2 * q] = b0 * cs[ks][2 * q] + a0 * sn[ks][2 * q];
                o1[2 * q + 1] = a1 * cs[ks][2 * q + 1] - b1 * sn[ks][2 * q + 1]; o2[2 * q + 1] = b1 * cs[ks][2 * q + 1] + a1 * sn[ks][2 * q + 1]; }
            qf[ks] = pack8(o1[0], o1[1], o1[2], o1[3], o1[4], o1[5], o1[6], o1[7]);
            qf[ks + 2] = pack8(o2[0], o2[1], o2[2], o2[3], o2[4], o2[5], o2[6], o2[7]); }
        const int Tn = Tq + 9; const bool pre = (qt < 3) && Tn >= 0 && Tn < NTOK / 32; u32x4 nk = {0u, 0u, 0u, 0u};
        if (pre) { if (tid < 256) nk = *(const u32x4*)(KR + ((size_t)(kvh * MROWS + Tn * 32 + (tid >> 3))) * 64 + (tid & 7) * 8);
                   else { const int t2 = tid - 256; nk = *(const u32x4*)(VTg + ((size_t)(kvh * 64 + (t2 >> 2))) * MROWS + Tn * 32 + (t2 & 3) * 8); } }
        if (qt < 3) AT_LOADQ(p0 + 32);
        float m_run = sinks[head] * 1.4426950408889634f, l_run = h5 ? 0.f : 1.f;
        f32x16 o0, o1;
#pragma unroll
        for (int i = 0; i < 16; ++i) { o0[i] = 0.f; o1[i] = 0.f; }
        for (int kt = 0; kt < 17; ++kt) {
            const bool lat = kt >= 8; const int j = kt - 8, T = Tq + j, kb = kb0 + 32 * j, slot = (T + 2 * NSLOT) % NSLOT;
            if (lat && (T < 0 || T >= NTOK / 32)) continue;
            const LAS unsigned char* Kb = lat ? KL + (32 * slot + r) * KRS : KC + (32 * kt + r) * KRS;
            const LAS unsigned char* Vb = lat ? VL + r * VLRS + 64 * slot : VC + r * VCRS + 64 * kt;
            const int vrs32 = 32 * (lat ? VLRS : VCRS); const bool edge = lat && (j == 0 || j == 8);
            f32x16 s;
#pragma unroll
            for (int i = 0; i < 16; ++i) s[i] = 0.f;
#pragma unroll
            for (int ks = 0; ks < 4; ++ks) { const bf16x8 kf = *(const LAS bf16x8*)(Kb + (16 * ks + 8 * h5) * 2); s = MFMA32(kf, qf[ks], s); }
            float mt = -INFINITY;
#pragma unroll
            for (int i = 0; i < 16; ++i) { float v = s[i];
                if (edge) { const int dk = kb + crow(i, h5) - qp; if (dk > 128 || dk < -128) v = -INFINITY; }
                s[i] = v; mt = fmaxf(mt, v); }
            mt = fmaxf(mt, __shfl_xor(mt, 32));
            const float mn = fmaxf(m_run, mt * sc);
            if (__any(mn > m_run)) { const float alpha = __builtin_amdgcn_exp2f(m_run - mn); l_run *= alpha;
#pragma unroll
                for (int i = 0; i < 16; ++i) { o0[i] *= alpha; o1[i] *= alpha; } }
            m_run = mn;
            float ps = 0.f;
#pragma unroll
            for (int i = 0; i < 16; ++i) { const float p = __builtin_amdgcn_exp2f(__builtin_fmaf(s[i], sc, -mn)); s[i] = p; ps += p; }
            l_run += ps;
#pragma unroll
            for (int ks = 0; ks < 2; ++ks) {
                const bf16x8 pf = pack8(s[8 * ks], s[8 * ks + 1], s[8 * ks + 2], s[8 * ks + 3], s[8 * ks + 4], s[8 * ks + 5], s[8 * ks + 6], s[8 * ks + 7]);
                const bf16x8 v0 = lds_frag2(Vb + (16 * ks + 4 * h5) * 2, Vb + (16 * ks + 8 + 4 * h5) * 2);
                const bf16x8 v1 = lds_frag2(Vb + vrs32 + (16 * ks + 4 * h5) * 2, Vb + vrs32 + (16 * ks + 8 + 4 * h5) * 2);
                o0 = MFMA32(v0, pf, o0);
                o1 = MFMA32(v1, pf, o1);
            }
        }
        const float l = l_run + __shfl_xor(l_run, 32), inv = 1.0f / l;
        bf16* orow = yab + (size_t)qp * D + head * 64 + 4 * h5;
#pragma unroll
        for (int g4 = 0; g4 < 4; ++g4) {
            u32x2 a; a.x = pk2(o0[4 * g4] * inv, o0[4 * g4 + 1] * inv); a.y = pk2(o0[4 * g4 + 2] * inv, o0[4 * g4 + 3] * inv); *(u32x2*)(orow + 8 * g4) = a;
            u32x2 b; b.x = pk2(o1[4 * g4] * inv, o1[4 * g4 + 1] * inv); b.y = pk2(o1[4 * g4 + 2] * inv, o1[4 * g4 + 3] * inv); *(u32x2*)(orow + 32 + 8 * g4) = b;
        }
        if (pre) { const int slot = (Tn + 2 * NSLOT) % NSLOT;
            if (tid < 256) *(LAS u32x4*)(KL + (slot * 32 + (tid >> 3)) * KRS + (tid & 7) * 16) = nk;
            else { const int t2 = tid - 256; u32x2 a; a.x = nk.x; a.y = nk.y; u32x2 b; b.x = nk.z; b.y = nk.w; LAS unsigned char* dst = VL + (t2 >> 2) * VLRS + slot * 64 + (t2 & 3) * 16; *(LAS u32x2*)dst = a; *(LAS u32x2*)(dst + 8) = b; } }
        __syncthreads();
    }
#undef AT_LOADQ
}

typedef const Args __attribute__((address_space(4))) ArgsC;
DI ArgsC* args_ptr() { ArgsC* p = (ArgsC*)__builtin_amdgcn_kernarg_segment_ptr(); asm volatile("" : "+s"(p)); return p; }
#define PH_BEGIN ArgsC* A = args_ptr(); unsigned char* const ws = A->ws; (void)ws
#define modl ((float*)(ws + WS_SMALL + SM_MODL))
#define modc ((float*)(ws + WS_SMALL + SM_MODC))
#define rope ((float*)(ws + WS_SMALL + SM_ROPE))
#define lbf ((float*)(ws + WS_SMALL + SM_LB))
#define lbb (lbf + 1024)
#define wrp ((float*)(ws + WS_SMALL + SM_WRP))
#define cvec ((float*)(ws + WS_SMALL + SM_CVEC))
#define tile_expert ((int*)(ws + WS_SMALL + SM_TILE))
#define ntiles_p (tile_expert + 512)
#define rt_e ((int*)(ws + WS_ROUTE + RT_E))
#define rt_g ((float*)(ws + WS_ROUTE + RT_G))
#define rt_r ((int*)(ws + WS_ROUTE + RT_R))
#define rt_s ((int*)(ws + WS_ROUTE + RT_S))
#define slot_rowoff ((unsigned*)(ws + WS_ROUTE + RT_OFF))
#define slot_gate ((float*)(ws + WS_ROUTE + RT_SG))
#define Dlog ((float*)(ws + WS_DLOG))
#define KR ((bf16*)(ws + WS_KR))
#define VTg ((bf16*)(ws + WS_VT))
#define Lbuf ((float*)(ws + WS_L))
#define WIN ((bf16*)(ws + WS_WIN))
#define WM ((bf16*)(ws + WS_WM))
#define WO ((bf16*)(ws + WS_WO))
#define WGU ((bf16*)(ws + WS_WGU))
#define WDN ((bf16*)(ws + WS_WDN))
#define H ((bf16*)(ws + WS_H))
#define PROJ ((bf16*)(ws + WS_PROJ))
#define ACT ((bf16*)(ws + WS_ACT))
#define YAB ((bf16*)(ws + WS_YAB))
#define OSCR ((bf16*)(ws + WS_OSCR))
#define MERGED ((bf16*)(ws + WS_MERGED))
#define X1 ((float*)(ws + WS_X1))
#define YS ((bf16*)(ws + WS_YS))

__global__ void __launch_bounds__(NWAVES * 64, 2) fwd_kernel(Args a_unused) {
    extern __shared__ __attribute__((aligned(16))) unsigned char lds_raw[];
    LAS unsigned char* lds = (LAS unsigned char*)lds_raw;
    volatile LAS unsigned* MISC = (volatile LAS unsigned*)(lds + MISC_OFF);
    const int tid = threadIdx.x, lane = tid & 63, wave = __builtin_amdgcn_readfirstlane(tid >> 6);
    const int G = gridDim.x, bx = blockIdx.x, vcu = (G % 8 == 0) ? (bx % 8) * (G / 8) + bx / 8 : bx;
    const int gw = vcu * NWAVES + wave, NGW = G * NWAVES;
    const int gtid = vcu * 512 + tid, NGT = G * 512;
    unsigned* ctl; { const ArgsC* A0 = args_ptr(); ctl = (unsigned*)(A0->ws + WS_CTL); }
    if (tid < 64) MISC[tid] = 0u;
    __syncthreads();
    XcdBarrier bar = xcd_barrier_post(ctl + CW_BAR, MISC);
    int lo, hi; { const ArgsC* A0 = args_ptr(); lo = A0->ph_lo; hi = A0->ph_hi; }
#ifndef PH_MASK
#define PH_MASK 0x1fff
#endif
#define IN(k) ((((PH_MASK) >> (k)) & 1) && lo <= (k) && (k) < hi)
#define SEAM(k) do { if (IN(k) && IN((k) + 1)) xcd_barrier(bar); } while (0)

    if (IN(0)) {
        PH_BEGIN;
        if (vcu < 48) {
            LAS float* sc = (LAS float*)lds; LAS float* scc = sc + 2048; LAS f32x4* red = (LAS f32x4*)(lds + 16384);
            for (int k = tid; k < 2048; k += 512) { const float v = A->c[k], u = A->c_ctx[k]; sc[k] = v * sigmoidf_(v); scc[k] = u * sigmoidf_(u); }
            __syncthreads();
            const int cb = vcu, col = 256 * cb + 4 * lane; const bool hasc = cb < 16;
            f32x4 al = {0.f, 0.f, 0.f, 0.f}, ac = {0.f, 0.f, 0.f, 0.f};
#pragma unroll 8
            for (int k = wave; k < 2048; k += 8) { const f32x4 wv = *(const f32x4*)(A->w_mod + (size_t)k * 12288 + col); al += sc[k] * wv; ac += scc[k] * wv; }
            red[wave * 64 + lane] = al; red[512 + wave * 64 + lane] = ac;
            __syncthreads();
            if (wave == 0) { f32x4 s = *(const f32x4*)(A->b_mod + col), t = s;
#pragma unroll
                for (int w = 0; w < 8; ++w) { s += red[w * 64 + lane]; t += red[512 + w * 64 + lane]; }
                *(f32x4*)(modl + col) = s; if (hasc) *(f32x4*)(modc + col) = t; }
            __syncthreads();
        } else if (vcu == 48) {
            for (int i = tid; i < 4096 + 1024; i += 512) { const bool isrow = i < 4096; const int ii = isrow ? i : i - 4096, p = ii >> 4, j = ii & 15;
                const float inv = powf(10000.0f, -(float)j / 16.0f), ang = (float)p * inv; float s, c; sincosf(ang, &s, &c);
                if (isrow) { rope[ii] = c; rope[4096 + ii] = s; } else { rope[8192 + ii] = c; rope[9216 + ii] = s; } }
            for (int i = tid; i < 2048; i += 512) { const float* lg = (i < 1024) ? A->lbf_logits : A->lbb_logits; const int ch = i & 1023;
                const float v = 1.0f / (1.0f + expf(lg[1024 + ch] - lg[ch])); if (i < 1024) lbf[ch] = v; else lbb[ch] = v; }
            __syncthreads();
        }
        { LAS unsigned char* scr = lds + wave * 9216;
          for (int r = gw; r < 2048; r += NGW) {
              if (r < 1024) { const int br = r >> 9, r2 = r & 511, kb = r2 >> 5, nb = r2 & 31;
                  p0_transpose64(A->w_branch + (size_t)br * 1024 * D + (size_t)(64 * kb) * D + 64 * nb, D, WM + (size_t)(64 * nb) * D + br * 1024 + 64 * kb, D, scr, lane); }
              else { const int r2 = r - 1024, kb = r2 >> 5, nb = r2 & 31; p0_transpose64(A->w_out + (size_t)(64 * kb) * D + 64 * nb, D, WO + (size_t)(64 * nb) * D + 64 * kb, D, scr, lane); } }
          __syncthreads(); }
        { constexpr int NQ = INC / 32 + 4096 + 2048;
          const int n4 = lane & 7, kr = lane >> 3;
          LAS float* smax = (LAS float*)(lds + 32 * 2064);
          f32x4 v[8][4];
          const float* Wp; int ldw; signed char* Qp; float* csp;
#define Q_ITEM(idx) do { int it_ = (idx); \
              if (it_ < INC / 32) { Wp = A->w_in + 32 * it_; ldw = INC; Qp = (signed char*)(ws + WS_WIN) + (size_t)(32 * it_) * 2048; csp = (float*)(ws + WS_CS + CS_WIN) + 32 * it_; } \
              else if (it_ < INC / 32 + 4096) { it_ -= INC / 32; const int e_ = it_ >> 7, wh_ = (it_ >> 6) & 1, n0_ = 32 * (it_ & 63), np_ = e_ * 4096 + (n0_ >> 7) * 256 + wh_ * 128 + (n0_ & 127); \
                  Wp = (wh_ ? A->w_e_up : A->w_e_gate) + (size_t)e_ * D * FF + n0_; ldw = FF; Qp = (signed char*)(ws + WS_WGU) + (size_t)np_ * 2048; csp = (float*)(ws + WS_CS) + np_; } \
              else { it_ -= INC / 32 + 4096; const int e_ = it_ >> 6, n0_ = 32 * (it_ & 63); \
                  Wp = A->w_e_down + (size_t)e_ * FF * D + n0_; ldw = D; Qp = (signed char*)(ws + WS_WDN) + ((size_t)e_ * D + n0_) * 2048; csp = (float*)(ws + WS_DLOG + DL_CSD) + e_ * D + n0_; } } while (0)
#define Q_LOAD() do { _Pragma("unroll") for (int g = 0; g < 8; ++g) _Pragma("unroll") for (int r = 0; r < 4; ++r) v[g][r] = *(const f32x4*)(Wp + (size_t)(256 * g + 32 * wave + 4 * kr + r) * ldw + 4 * n4); } while (0)
          int cur = vcu;
          if (cur < NQ) { Q_ITEM(cur); Q_LOAD(); }
          while (cur < NQ) {
              unsigned nxt = 0u; if (tid == 0) nxt = (unsigned)G + atomicAdd(ctl + CW_Q, 1u);
              signed char* Qc = Qp; float* csc = csp;
              f32x4 mx = {0.f, 0.f, 0.f, 0.f};
#pragma unroll
              for (int g = 0; g < 8; ++g)
#pragma unroll
                  for (int r = 0; r < 4; ++r) { mx[0] = fmaxf(mx[0], fabsf(v[g][r][0])); mx[1] = fmaxf(mx[1], fabsf(v[g][r][1])); mx[2] = fmaxf(mx[2], fabsf(v[g][r][2])); mx[3] = fmaxf(mx[3], fabsf(v[g][r][3])); }
#pragma unroll
              for (int c = 0; c < 4; ++c) { float m = mx[c]; m = fmaxf(m, __shfl_xor(m, 8)); m = fmaxf(m, __shfl_xor(m, 16)); m = fmaxf(m, __shfl_xor(m, 32)); mx[c] = m; }
              __syncthreads();
              if (kr == 0) *(LAS f32x4*)(smax + wave * 32 + 4 * n4) = mx;
              __syncthreads();
              f32x4 cm = *(const LAS f32x4*)(smax + 4 * n4);
#pragma unroll
              for (int ww = 1; ww < 8; ++ww) { const f32x4 o = *(const LAS f32x4*)(smax + ww * 32 + 4 * n4); cm[0] = fmaxf(cm[0], o[0]); cm[1] = fmaxf(cm[1], o[1]); cm[2] = fmaxf(cm[2], o[2]); cm[3] = fmaxf(cm[3], o[3]); }
              f32x4 inv;
#pragma unroll
              for (int c = 0; c < 4; ++c) { if (cm[c] == 0.f) cm[c] = 1.f; inv[c] = 127.0f / cm[c]; }
              if (wave == 0 && kr == 0) { f32x4 sc; sc[0] = cm[0] * (1.0f / 127.0f); sc[1] = cm[1] * (1.0f / 127.0f); sc[2] = cm[2] * (1.0f / 127.0f); sc[3] = cm[3] * (1.0f / 127.0f); *(f32x4*)(csc + 4 * n4) = sc; }
#pragma unroll
              for (int g = 0; g < 8; ++g)
#pragma unroll
                  for (int c = 0; c < 4; ++c) { unsigned pk = 0u;
#pragma unroll
                      for (int r = 0; r < 4; ++r) { const int q = (int)rintf(v[g][r][c] * inv[c]); pk |= ((unsigned)q & 0xffu) << (8 * r); }
                      *(LAS unsigned*)(lds + (4 * n4 + c) * 2064 + 4 * (64 * g + 8 * wave + kr)) = pk; }
              if (tid == 0) MISC[2] = nxt;
              __syncthreads();
              const int nx = (int)MISC[2];
              if (nx < NQ) { Q_ITEM(nx); Q_LOAD(); }
#pragma unroll
              for (int i = 0; i < 8; ++i) { const int p = tid + 512 * i, row = p >> 7, pc = p & 127; const u32x4 o = *(const LAS u32x4*)(lds + row * 2064 + pc * 16); *(u32x4*)(Qc + (size_t)row * 2048 + pc * 16) = o; }
              cur = nx;
          }
#undef Q_ITEM
#undef Q_LOAD
        }
    }
    SEAM(0);

    if (IN(1)) {
        PH_BEGIN;
        {
            f32x4 ca[8], cb[8];
#pragma unroll
            for (int j = 0; j < 8; ++j) { const int k = 4 * lane + 256 * j; const f32x4 g = *(const f32x4*)(A->norm_mix_g + k), s1 = *(const f32x4*)(modl + 2048 + k); ca[j] = g * (1.0f + s1); cb[j] = *(const f32x4*)(modl + k); }
            f32x4 v[8], vn[8];
            { const float* xr = A->x + (size_t)gw * D + 4 * lane;
#pragma unroll
              for (int j = 0; j < 8; ++j) v[j] = *(const f32x4*)(xr + 256 * j); }
            for (int m = gw; m < NTOK; m += NGW) {
                if (m + NGW < NTOK) { const float* xn = A->x + (size_t)(m + NGW) * D + 4 * lane;
#pragma unroll
                    for (int j = 0; j < 8; ++j) vn[j] = *(const f32x4*)(xn + 256 * j); }
                float ss = 0.f;
#pragma unroll
                for (int j = 0; j < 8; ++j) ss += v[j][0] * v[j][0] + v[j][1] * v[j][1] + v[j][2] * v[j][2] + v[j][3] * v[j][3];
                const float rstd = rsqrtf(wave_sum(ss) * (1.0f / D) + EPS);
                float am = 0.f;
#pragma unroll
                for (int j = 0; j < 8; ++j) { v[j] = v[j] * rstd * ca[j] + cb[j]; am = fmaxf(am, fmaxf(fmaxf(fabsf(v[j][0]), fabsf(v[j][1])), fmaxf(fabsf(v[j][2]), fabsf(v[j][3])))); }
#pragma unroll
                for (int o = 1; o < 64; o <<= 1) am = fmaxf(am, __shfl_xor(am, o));
                if (am == 0.f) am = 1.f;
                const float qi = 127.0f / am;
                if (lane == 0) ((float*)(ws + WS_CS + CS_HROW))[m] = am * (1.0f / 127.0f);
                unsigned* hq = (unsigned*)((signed char*)(ws + WS_H) + (size_t)m * D + 4 * lane);
#pragma unroll
                for (int j = 0; j < 8; ++j) { const int q0 = (int)rintf(v[j][0] * qi), q1 = (int)rintf(v[j][1] * qi), q2 = (int)rintf(v[j][2] * qi), q3 = (int)rintf(v[j][3] * qi);
                    hq[64 * j] = ((unsigned)q0 & 0xffu) | (((unsigned)q1 & 0xffu) << 8) | (((unsigned)q2 & 0xffu) << 16) | (((unsigned)q3 & 0xffu) << 24); }
#pragma unroll
                for (int j = 0; j < 8; ++j) v[j] = vn[j];
            }
        }
        if (gw < NCTX) {
            const int m = gw; const float* xr = A->ctx + (size_t)m * D + 4 * lane; f32x4 v[8]; float ss = 0.f;
#pragma unroll
            for (int j = 0; j < 8; ++j) { v[j] = *(const f32x4*)(xr + 256 * j); ss += v[j][0] * v[j][0] + v[j][1] * v[j][1] + v[j][2] * v[j][2] + v[j][3] * v[j][3]; }
            const float rstd = rsqrtf(wave_sum(ss) * (1.0f / D) + EPS);
            float am = 0.f;
#pragma unroll
            for (int j = 0; j < 8; ++j) { const int k = 4 * lane + 256 * j; const f32x4 g = *(const f32x4*)(A->norm_mix_g + k), s1 = *(const f32x4*)(modc + 2048 + k), s0 = *(const f32x4*)(modc + k);
                v[j] = v[j] * rstd * (g * (1.0f + s1)) + s0; am = fmaxf(am, fmaxf(fmaxf(fabsf(v[j][0]), fabsf(v[j][1])), fmaxf(fabsf(v[j][2]), fabsf(v[j][3])))); }
#pragma unroll
            for (int o = 1; o < 64; o <<= 1) am = fmaxf(am, __shfl_xor(am, o));
            if (am == 0.f) am = 1.f;
            const float qi = 127.0f / am;
            if (lane == 0) ((float*)(ws + WS_CS + CS_HROW))[NTOK + m] = am * (1.0f / 127.0f);
            unsigned* hq = (unsigned*)((signed char*)(ws + WS_H) + (size_t)(NTOK + m) * D + 4 * lane);
#pragma unroll
            for (int j = 0; j < 8; ++j) { const int q0 = (int)rintf(v[j][0] * qi), q1 = (int)rintf(v[j][1] * qi), q2 = (int)rintf(v[j][2] * qi), q3 = (int)rintf(v[j][3] * qi);
                hq[64 * j] = ((unsigned)q0 & 0xffu) | (((unsigned)q1 & 0xffu) << 8) | (((unsigned)q2 & 0xffu) << 16) | (((unsigned)q3 & 0xffu) << 24); }
        }
        for (int i = gtid; i < 2048 * 32; i += NGT) { const int k = i >> 5; wrp[i] = A->norm_ffn_g[k] * (1.0f + modl[4 * 2048 + k]) * A->w_router[i]; }
        if (vcu == G - 1) {
            for (int e = wave * 4; e < wave * 4 + 4; ++e) { float s = 0.f; for (int k = lane; k < 2048; k += 64) s += modl[3 * 2048 + k] * A->w_router[k * 32 + e];
                s = wave_sum(s); if (lane == 0) cvec[e] = s + A->b_router[e]; }
        }
    }
    SEAM(1);

    if (IN(2)) {
        PH_BEGIN;
        pg8::Gemm g{H, WIN, D / 2}; pg8::PlainOrder S; S.init(MROWS / 256, INC / 256, G, bx); S.K2 = D;
        EpiProj E{PROJ, lbf, lbb, (const float*)(ws + WS_CS + CS_HROW), (const float*)(ws + WS_CS + CS_WIN)};
        pg8::gemm_phase<EpiProj, pg8::PlainOrder, true>(lds, g, S, E);
    }
    SEAM(2);

    if (IN(3)) {
        PH_BEGIN;
        for (int i = gtid; i < MROWS * 8; i += NGT) { const int jg = i & 3, kvh = (i >> 2) & 1, pos = i >> 3, j0 = 8 * jg;
            const bf16* kr = PROJ + PO_AKV + (size_t)pos * 256 + kvh * 64 + j0; const u32x4 a1 = *(const u32x4*)kr, a2 = *(const u32x4*)(kr + 32); u32x4 w1 = a1, w2 = a2;
            if (pos < NTOK) { const float* ct = (jg < 2) ? rope + (pos >> 6) * 16 + j0 : rope + 8192 + (pos & 63) * 16 + j0 - 16; const float* st = ct + ((jg < 2) ? 4096 : 1024);
                const f32x4 c0 = *(const f32x4*)ct, c1 = *(const f32x4*)(ct + 4), s0 = *(const f32x4*)st, s1 = *(const f32x4*)(st + 4);
#pragma unroll
                for (int q = 0; q < 4; ++q) { const float cl = q < 2 ? c0[2 * q] : c1[2 * q - 4], ch = q < 2 ? c0[2 * q + 1] : c1[2 * q - 3], sl = q < 2 ? s0[2 * q] : s1[2 * q - 4], sh = q < 2 ? s0[2 * q + 1] : s1[2 * q - 3];
                    const float k1l = bflo(a1[q]), k1h = bfhi(a1[q]), k2l = bflo(a2[q]), k2h = bfhi(a2[q]);
                    w1[q] = pk2(k1l * cl - k2l * sl, k1h * ch - k2h * sh); w2[q] = pk2(k2l * cl + k1l * sl, k2h * ch + k1h * sh); } }
            bf16* ko = KR + ((size_t)kvh * MROWS + pos) * 64 + j0; *(u32x4*)ko = w1; *(u32x4*)(ko + 32) = w2; }
        for (int i = gtid; i < 2 * (MROWS / 8) * 64; i += NGT) { const int dd = i & 63, pb = (i >> 6) % (MROWS / 8), kvh = (i >> 6) / (MROWS / 8);
            const bf16* vr = PROJ + PO_AKV + (size_t)(pb * 8) * 256 + 128 + kvh * 64 + dd; unsigned short t[8];
#pragma unroll
            for (int q = 0; q < 8; ++q) t[q] = vr[(size_t)q * 256];
            u32x4 w; w.x = t[0] | ((unsigned)t[1] << 16); w.y = t[2] | ((unsigned)t[3] << 16); w.z = t[4] | ((unsigned)t[5] << 16); w.w = t[6] | ((unsigned)t[7] << 16);
            *(u32x4*)(VTg + ((size_t)kvh * 64 + dd) * MROWS + pb * 8) = w; }
        for (int it = vcu; it < 8 * (NSEG - 1); it += G) { const int hh = it >> 5, seg = it & 31; scan_segment<false>(lds, PROJ, hh, seg, seg, Lbuf, Dlog, (bf16*)nullptr); }
    }
    SEAM(3);

    if (IN(4)) {
        PH_BEGIN;
        for (int i = gtid; i < 16 * 16384; i += NGT) { const int scan = i >> 14, el = i & 16383, dd = el >> 7; float s = 0.f, lv[NSEG - 1], dv[NSEG - 1];
#pragma unroll
            for (int j = 0; j < NSEG - 1; ++j) { lv[j] = Lbuf[(size_t)(scan * NSEG + j) * 16384 + el]; dv[j] = Dlog[(scan * NSEG + j) * 128 + dd]; }
#pragma unroll
            for (int j = 0; j < NSEG - 1; ++j) { s = __expf(dv[j]) * s + lv[j]; Lbuf[(size_t)(scan * NSEG + j) * 16384 + el] = s; } }
        for (int u = vcu; u < 256; u += G) attn_unit(lds, PROJ, KR, VTg, rope, A->sinks, YAB, u >> 7, u & 127);
    }
    SEAM(4);

    if (IN(5)) {
        PH_BEGIN;
        for (int it = vcu; it < 8 * 32; it += G) { const int hh = it >> 5, segF = 1 + (it & 31);
            scan_segment<true>(lds, PROJ, hh, segF, NSEG - segF, Lbuf, Dlog, OSCR);
            VM_WAIT(); __syncthreads();
            { const int l16 = lane & 15, tq = lane >> 4; const f32x4 hg0 = *(const f32x4*)(A->hgrn_g + hh * 128 + 8 * l16), hg1 = *(const f32x4*)(A->hgrn_g + hh * 128 + 8 * l16 + 4);
              for (int i0 = wave * 64; i0 < wave * 64 + 64; i0 += 16) {
                u32x4 fw[4], bw[4], gq[4];
#pragma unroll
                for (int b = 0; b < 4; ++b) { const int row = (segF - 1) * 512 + i0 + 4 * b + tq;
                    fw[b] = *(const u32x4*)(OSCR + ((size_t)hh * NTOK + row) * 128 + 8 * l16); bw[b] = *(const u32x4*)(OSCR + ((size_t)(8 + hh) * NTOK + row) * 128 + 8 * l16);
                    gq[b] = *(const u32x4*)(PROJ + PO_BG + ((size_t)hh * MROWS + row) * 128 + 8 * l16); }
#pragma unroll
                for (int b = 0; b < 4; ++b) { const int row = (segF - 1) * 512 + i0 + 4 * b + tq;
                    f32x4 o0, o1; o0[0] = bflo(fw[b].x) + bflo(bw[b].x); o0[1] = bfhi(fw[b].x) + bfhi(bw[b].x); o0[2] = bflo(fw[b].y) + bflo(bw[b].y); o0[3] = bfhi(fw[b].y) + bfhi(bw[b].y);
                    o1[0] = bflo(fw[b].z) + bflo(bw[b].z); o1[1] = bfhi(fw[b].z) + bfhi(bw[b].z); o1[2] = bflo(fw[b].w) + bflo(bw[b].w); o1[3] = bfhi(fw[b].w) + bfhi(bw[b].w);
                    float ss = o0[0] * o0[0] + o0[1] * o0[1] + o0[2] * o0[2] + o0[3] * o0[3] + o1[0] * o1[0] + o1[1] * o1[1] + o1[2] * o1[2] + o1[3] * o1[3];
                    ss += __shfl_xor(ss, 1); ss += __shfl_xor(ss, 2); ss += __shfl_xor(ss, 4); ss += __shfl_xor(ss, 8);
                    const float rstd = rsqrtf(ss * (1.0f / 128.0f) + EPS);
                    u32x4 w; w.x = pk2(o0[0] * rstd * hg0[0] * bflo(gq[b].x), o0[1] * rstd * hg0[1] * bfhi(gq[b].x)); w.y = pk2(o0[2] * rstd * hg0[2] * bflo(gq[b].y), o0[3] * rstd * hg0[3] * bfhi(gq[b].y));
                    w.z = pk2(o1[0] * rstd * hg1[0] * bflo(gq[b].z), o1[1] * rstd * hg1[1] * bfhi(gq[b].z)); w.w = pk2(o1[2] * rstd * hg1[2] * bflo(gq[b].w), o1[3] * rstd * hg1[3] * bfhi(gq[b].w));
                    *(u32x4*)(YAB + (size_t)row * D + 1024 + hh * 128 + 8 * l16) = w; } } }
            __syncthreads();
        }
    }
    SEAM(5);

    if (IN(6)) {
        PH_BEGIN;
        pg8::Gemm g{YAB, WM, D}; pg8::PlainOrder S; S.init(NTOK / 256, D / 256, G, bx); S.K2 = D * 2;
        EpiMerge E{MERGED, PROJ};
        pg8::gemm_phase<EpiMerge, pg8::PlainOrder>(lds, g, S, E);
    }
    SEAM(6);

    if (IN(7)) {
        PH_BEGIN;
        pg8::Gemm g{MERGED, WO, D}; pg8::PlainOrder S; S.init(NTOK / 256, D / 256, G, bx); S.K2 = D * 2;
        EpiOut E{X1, A->x, modl + 2 * 2048};
        pg8::gemm_phase<EpiOut, pg8::PlainOrder>(lds, g, S, E);
    }
    SEAM(7);

    if (IN(8)) {
        PH_BEGIN;
        LAS float* part = (LAS float*)lds;
        LAS float* rsd = (LAS float*)(lds + 16384);
        const int r16 = lane & 15, kk = lane >> 4;
        for (int tl = vcu; tl < NTOK / 16; tl += G) {
            const int row0 = tl * 16;
#pragma unroll
            for (int q = 0; q < 2; ++q) { const int m = row0 + 2 * wave + q; const float* xr = X1 + (size_t)m * D + 4 * lane; f32x4 v[8]; float ss = 0.f;
#pragma unroll
                for (int j = 0; j < 8; ++j) { v[j] = *(const f32x4*)(xr + 256 * j); ss += v[j][0] * v[j][0] + v[j][1] * v[j][1] + v[j][2] * v[j][2] + v[j][3] * v[j][3]; }
                const float rstd = rsqrtf(wave_sum(ss) * (1.0f / D) + EPS);
                if (lane == 0) rsd[2 * wave + q] = rstd;
                float am = 0.f;
#pragma unroll
                for (int j = 0; j < 8; ++j) { const int k = 4 * lane + 256 * j; const f32x4 g = *(const f32x4*)(A->norm_ffn_g + k), s1 = *(const f32x4*)(modl + 4 * 2048 + k), s0 = *(const f32x4*)(modl + 3 * 2048 + k);
                    v[j] = v[j] * rstd * (g * (1.0f + s1)) + s0; am = fmaxf(am, fmaxf(fmaxf(fabsf(v[j][0]), fabsf(v[j][1])), fmaxf(fabsf(v[j][2]), fabsf(v[j][3])))); }
#pragma unroll
                for (int o = 1; o < 64; o <<= 1) am = fmaxf(am, __shfl_xor(am, o));
                if (am == 0.f) am = 1.f;
                const float qi = 127.0f / am;
                if (lane == 0) ((float*)(ws + WS_CS + CS_ROW))[m] = am * (1.0f / 127.0f);
                unsigned* hq = (unsigned*)((signed char*)(ws + WS_H) + (size_t)m * D + 4 * lane);
#pragma unroll
                for (int j = 0; j < 8; ++j) { const int q0 = (int)rintf(v[j][0] * qi), q1 = (int)rintf(v[j][1] * qi), q2 = (int)rintf(v[j][2] * qi), q3 = (int)rintf(v[j][3] * qi);
                    hq[64 * j] = ((unsigned)q0 & 0xffu) | (((unsigned)q1 & 0xffu) << 8) | (((unsigned)q2 & 0xffu) << 16) | (((unsigned)q3 & 0xffu) << 24); } }
            float bw[16][4][2];
            { int zz = 0; asm volatile("" : "+v"(zz));
#pragma unroll
              for (int kg = 0; kg < 16; ++kg)
#pragma unroll
                for (int m = 0; m < 4; ++m)
#pragma unroll
                    for (int eh = 0; eh < 2; ++eh) bw[kg][m][eh] = wrp[(256 * wave + 16 * kg + 4 * kk + m) * 32 + 16 * eh + r16 + zz]; }
            f32x4 acc0 = {0.f, 0.f, 0.f, 0.f}, acc1 = {0.f, 0.f, 0.f, 0.f};
            const float* xa = X1 + (size_t)(row0 + r16) * D + 256 * wave + 4 * kk;
#pragma unroll
            for (int kg = 0; kg < 16; ++kg) { const f32x4 av = *(const f32x4*)(xa + 16 * kg);
#pragma unroll
                for (int m = 0; m < 4; ++m) { acc0 = __builtin_amdgcn_mfma_f32_16x16x4f32(av[m], bw[kg][m][0], acc0, 0, 0, 0); acc1 = __builtin_amdgcn_mfma_f32_16x16x4f32(av[m], bw[kg][m][1], acc1, 0, 0, 0); } }
#pragma unroll
            for (int q = 0; q < 4; ++q) { part[(wave * 16 + 4 * kk + q) * 32 + r16] = acc0[q]; part[(wave * 16 + 4 * kk + q) * 32 + 16 + r16] = acc1[q]; }
            __syncthreads();
            { const int row = tid >> 5, e = tid & 31; float s = 0.f;
#pragma unroll
              for (int w = 0; w < 8; ++w) s += part[(w * 16 + row) * 32 + e];
              float val = rsd[row] * s + cvec[e];
              float tv[4]; int ti[4];
#pragma unroll
              for (int j = 0; j < 4; ++j) { float bv = val; int bi = e;
#pragma unroll
                  for (int off = 16; off >= 1; off >>= 1) { const float ov = __shfl_xor(bv, off); const int oi = __shfl_xor(bi, off); if (ov > bv || (ov == bv && oi < bi)) { bv = ov; bi = oi; } }
                  tv[j] = bv; ti[j] = bi; if (e == bi) val = -INFINITY; }
              const float e1 = __expf(tv[1] - tv[0]), e2 = __expf(tv[2] - tv[0]), e3 = __expf(tv[3] - tv[0]), inv = 1.0f / (1.0f + e1 + e2 + e3);
              const float gt[4] = {inv, e1 * inv, e2 * inv, e3 * inv};
#pragma unroll
              for (int j = 0; j < 4; ++j) if (e == ti[j]) { const int ai = (row0 + row) * 4 + j; const unsigned rk = atomicAdd(ctl + CW_CNT + 16 * e, 1u);
                  rt_e[ai] = e; rt_g[ai] = gt[j]; rt_r[ai] = (int)rk; } }
            __syncthreads();
        }
    }
    SEAM(8);

    if (IN(9)) {
        PH_BEGIN;
        LAS int* tb = (LAS int*)lds;
        if (tid == 0) { int acc = 0; for (int e = 0; e < NEXP; ++e) { tb[e] = acc; acc += (int)((ctl[CW_CNT + 16 * e] + 255u) >> 8); } tb[NEXP] = acc; }
        __syncthreads();
        for (int i = gtid; i < NTOK * 4; i += NGT) { const int e = rt_e[i], slot = tb[e] * 256 + rt_r[i]; rt_s[i] = slot; slot_rowoff[slot] = (unsigned)(i >> 2) * (unsigned)D; slot_gate[slot] = rt_g[i]; ((float*)(ws + WS_CS + CS_SLOT))[slot] = ((const float*)(ws + WS_CS + CS_ROW))[i >> 2]; }
        if (vcu == 0) {
            for (int e = 0; e < NEXP; ++e) { const int cnt = (int)ctl[CW_CNT + 16 * e], s0 = tb[e] * 256 + cnt, s1 = tb[e + 1] * 256;
                for (int s = s0 + tid; s < s1; s += 512) { slot_rowoff[s] = 0u; slot_gate[s] = 0.f; ((float*)(ws + WS_CS + CS_SLOT))[s] = 0.f; }
                for (int t = tb[e] + tid; t < tb[e + 1]; t += 512) tile_expert[t] = e; }
            if (tid == 0) *ntiles_p = tb[NEXP];
        }
        __syncthreads();
    }
    SEAM(9);

    if (IN(10)) {
        PH_BEGIN;
        const int ntiles = *ntiles_p;
        for (int i = tid; i < ntiles; i += 512) ((LAS int*)(lds + XL_TEXP))[i] = tile_expert[i];
        __syncthreads();
        pg8::Gemm g{H, WGU, D / 2}; pg8::MoeOrder<true> S; S.init(ntiles, 4096 / 256, G, bx); S.K2 = D; S.nper = 4096; S.texp = (const LAS int*)(lds + XL_TEXP); S.sroff = slot_rowoff;
        EpiAct E{ACT, A->b_e_gate, A->b_e_up, (const float*)(ws + WS_CS), (const float*)(ws + WS_CS + CS_SLOT)};
        pg8::gemm_phase<EpiAct, pg8::MoeOrder<true>, true>(lds, g, S, E);
    }
    SEAM(10);

    if (IN(11)) {
        PH_BEGIN;
        const int ntiles = *ntiles_p;
        { const int nrows = ntiles * 256; u32x2 v[8], vn[8];
          if (gw < nrows) { const bf16* ar = ACT + (size_t)gw * FF + 4 * lane;
#pragma unroll
              for (int j = 0; j < 8; ++j) v[j] = *(const u32x2*)(ar + 256 * j); }
          for (int m = gw; m < nrows; m += NGW) {
              if (m + NGW < nrows) { const bf16* an = ACT + (size_t)(m + NGW) * FF + 4 * lane;
#pragma unroll
                  for (int j = 0; j < 8; ++j) vn[j] = *(const u32x2*)(an + 256 * j); }
              float am = 0.f;
#pragma unroll
              for (int j = 0; j < 8; ++j) am = fmaxf(am, fmaxf(fmaxf(fabsf(bflo(v[j].x)), fabsf(bfhi(v[j].x))), fmaxf(fabsf(bflo(v[j].y)), fabsf(bfhi(v[j].y)))));
#pragma unroll
              for (int o = 1; o < 64; o <<= 1) am = fmaxf(am, __shfl_xor(am, o));
              if (!(am > 0.f)) am = 1.f;
              const float qi = 127.0f / am;
              if (lane == 0) ((float*)(ws + WS_ROUTE + RT_ARS))[m] = am * (1.0f / 127.0f);
              unsigned* aq = (unsigned*)((signed char*)(ws + WS_ACT8) + (size_t)m * FF + 4 * lane);
#pragma unroll
              for (int j = 0; j < 8; ++j) { const int q0 = (int)rintf(bflo(v[j].x) * qi), q1 = (int)rintf(bfhi(v[j].x) * qi), q2 = (int)rintf(bflo(v[j].y) * qi), q3 = (int)rintf(bfhi(v[j].y) * qi);
                  aq[64 * j] = ((unsigned)q0 & 0xffu) | (((unsigned)q1 & 0xffu) << 8) | (((unsigned)q2 & 0xffu) << 16) | (((unsigned)q3 & 0xffu) << 24); }
#pragma unroll
              for (int j = 0; j < 8; ++j) v[j] = vn[j];
          } }
        xcd_barrier(bar);
        for (int i = tid; i < ntiles; i += 512) ((LAS int*)(lds + XL_TEXP))[i] = tile_expert[i];
        __syncthreads();
        pg8::Gemm g{(const bf16*)(ws + WS_ACT8), WDN, FF / 2}; pg8::MoeOrder<false> S; S.init(ntiles, D / 256, G, bx); S.K2 = FF; S.nper = D; S.texp = (const LAS int*)(lds + XL_TEXP); S.sroff = slot_rowoff;
        EpiDown E{YS, A->b_e_down, slot_gate, (const float*)(ws + WS_ROUTE + RT_ARS), (const float*)(ws + WS_DLOG + DL_CSD)};
        pg8::gemm_phase<EpiDown, pg8::MoeOrder<false>, true>(lds, g, S, E);
    }
    SEAM(11);

    if (IN(12)) {
        PH_BEGIN;
        f32x4 v[8], vn[8], y[8]; u32x2 yn[4][8]; int sl[4];
#define P12_LOAD(VV, M) do { const float* xr_ = X1 + (size_t)(M) * D + 4 * lane; \
            _Pragma("unroll") for (int j = 0; j < 8; ++j) VV[j] = *(const f32x4*)(xr_ + 256 * j); \
            _Pragma("unroll") for (int q = 0; q < 4; ++q) { const bf16* yp_ = YS + (size_t)sl[q] * D + 4 * lane; _Pragma("unroll") for (int j = 0; j < 8; ++j) yn[q][j] = *(const u32x2*)(yp_ + 256 * j); } } while (0)
#define P12_SUM() do { _Pragma("unroll") for (int j = 0; j < 8; ++j) { y[j] = (f32x4){0.f, 0.f, 0.f, 0.f}; \
            _Pragma("unroll") for (int q = 0; q < 4; ++q) { const u32x2 w_ = yn[q][j]; y[j][0] += bflo(w_.x); y[j][1] += bfhi(w_.x); y[j][2] += bflo(w_.y); y[j][3] += bfhi(w_.y); } } } while (0)
#pragma unroll
        for (int q = 0; q < 4; ++q) sl[q] = rt_s[gw * 4 + q];
        P12_LOAD(v, gw); P12_SUM();
        if (gw + NGW < NTOK) {
#pragma unroll
            for (int q = 0; q < 4; ++q) sl[q] = rt_s[(gw + NGW) * 4 + q];
        }
        for (int m = gw; m < NTOK; m += NGW) {
            const bool more = m + NGW < NTOK;
            if (more) { P12_LOAD(vn, m + NGW);
                if (m + 2 * NGW < NTOK) {
#pragma unroll
                    for (int q = 0; q < 4; ++q) sl[q] = rt_s[(m + 2 * NGW) * 4 + q]; } }
            float ss = 0.f;
#pragma unroll
            for (int j = 0; j < 8; ++j) { const f32x4 m5 = *(const f32x4*)(modl + 5 * 2048 + 4 * lane + 256 * j); v[j] = v[j] + m5 * y[j]; ss += v[j][0] * v[j][0] + v[j][1] * v[j][1] + v[j][2] * v[j][2] + v[j][3] * v[j][3]; }
            const float rstd = rsqrtf(wave_sum(ss) * (1.0f / D) + EPS);
            float* orow = A->out + (size_t)m * D + 4 * lane;
#pragma unroll
            for (int j = 0; j < 8; ++j) { const f32x4 fg = *(const f32x4*)(A->final_g + 4 * lane + 256 * j); *(f32x4*)(orow + 256 * j) = v[j] * rstd * fg; }
            if (more) { P12_SUM();
#pragma unroll
                for (int j = 0; j < 8; ++j) v[j] = vn[j]; }
        }
#undef P12_SUM
#undef P12_LOAD
    }
#undef IN
#undef SEAM
}

#undef modl
#undef modc
#undef rope
#undef lbf
#undef lbb
#undef wrp
#undef cvec
#undef tile_expert
#undef ntiles_p
#undef rt_e
#undef rt_g
#undef rt_r
#undef rt_s
#undef slot_rowoff
#undef slot_gate
#undef Dlog
#undef KR
#undef VTg
#undef Lbuf
#undef WIN
#undef WM
#undef WO
#undef WGU
#undef WDN
#undef H
#undef PROJ
#undef ACT
#undef YAB
#undef OSCR
#undef MERGED
#undef X1
#undef YS
extern "C" void kernel_launch(void* const* d_in, const int* in_sizes, int n_in, void* d_out, int out_size, void* d_ws, size_t ws_size, hipStream_t stream) {
    static int grid = 0;
    if (grid == 0) {
        if (n_in != 24 || out_size != NTOK * D || ws_size < WS_END) { fprintf(stderr, "kernel_launch: unexpected shapes (n_in %d out %d ws %zu)\n", n_in, out_size, ws_size); grid = -1; return; }
        int dev = 0, cus = 0, per_cu = 0;
        if (hipGetDevice(&dev) != hipSuccess || hipDeviceGetAttribute(&cus, hipDeviceAttributeMultiprocessorCount, dev) != hipSuccess) { grid = -1; return; }
        if (hipFuncSetAttribute((const void*)fwd_kernel, hipFuncAttributeMaxDynamicSharedMemorySize, LDS_BYTES) != hipSuccess) { fprintf(stderr, "kernel_launch: hipFuncSetAttribute failed\n"); grid = -1; return; }
        if (hipOccupancyMaxActiveBlocksPerMultiprocessor(&per_cu, (const void*)fwd_kernel, NWAVES * 64, LDS_BYTES) != hipSuccess || per_cu < 1) { fprintf(stderr, "kernel_launch: occupancy query says %d\n", per_cu); (void)hipGetLastError(); grid = -1; return; }
        grid = cus;
    }
    if (grid < 0) return;
    if (hipMemsetAsync((char*)d_ws + WS_CTL, 0, CTL_ZERO_BYTES, stream) != hipSuccess) return;
    Args a{};
    const float** p = (const float**)&a;
    for (int i = 0; i < 24; ++i) p[i] = (const float*)d_in[i];
    a.out = (float*)d_out; a.ws = (unsigned char*)d_ws; a.ph_lo = 0; a.ph_hi = 13;
    hipLaunchKernelGGL(fwd_kernel, dim3(grid), dim3(NWAVES * 64), LDS_BYTES, stream, a);
    const hipError_t le = hipPeekAtLastError();
    if (le != hipSuccess) fprintf(stderr, "kernel_launch: launch failed: %s\n", hipGetErrorName(le));
}
```

```cpp
#include <hip/hip_runtime.h>
#include <cstdio>
#include <cstdint>

#define DI __device__ __forceinline__
#define LAS __attribute__((address_space(3)))
typedef unsigned short bf16;
typedef short bf16x8 __attribute__((ext_vector_type(8)));
typedef float f32x2 __attribute__((ext_vector_type(2)));
typedef float f32x4 __attribute__((ext_vector_type(4)));
typedef float f32x16 __attribute__((ext_vector_type(16)));
typedef unsigned u32x2 __attribute__((ext_vector_type(2)));
typedef unsigned u32x4 __attribute__((ext_vector_type(4)));
typedef __bf16 bf16x2_t __attribute__((ext_vector_type(2)));
typedef int i32x4 __attribute__((ext_vector_type(4)));

DI unsigned pk2(float lo, float hi) { f32x2 v = {lo, hi}; bf16x2_t b = __builtin_convertvector(v, bf16x2_t); return __builtin_bit_cast(unsigned, b); }
DI float bf2f(unsigned short b) { return __uint_as_float(((unsigned)b) << 16); }
DI float bflo(unsigned w) { return __uint_as_float(w << 16); }
DI float bfhi(unsigned w) { return __uint_as_float(w & 0xffff0000u); }
DI unsigned short f2bf(float f) { return (unsigned short)(pk2(f, 0.f) & 0xffffu); }
DI float wave_sum(float v) {
#pragma unroll
    for (int o = 1; o < 64; o <<= 1) v += __shfl_xor(v, o);
    return v;
}
DI float sigmoidf_(float x) { return __builtin_amdgcn_rcpf(1.0f + __expf(-x)); }
#define LDS_WAIT() asm volatile("s_waitcnt lgkmcnt(0)" ::: "memory")
#define VM_WAIT() asm volatile("s_waitcnt vmcnt(0)" ::: "memory")

constexpr int D = 2048, NTOK = 16384, NCTX = 256, MROWS = NTOK + NCTX;
constexpr int INC = 10496;
constexpr int C_AQ = 0, C_AK = 1024, C_AV = 1152, C_BQ = 1280, C_ZF = 2304, C_ZB = 3328, C_BV = 4352, C_BG = 5376, C_GA = 6400, C_GB = 8448;
constexpr int NEXP = 32, FF = 2048;
constexpr int MAXTILES = 288, MAXSLOTS = MAXTILES * 256;
constexpr float EPS = 1e-6f;
constexpr int NSEG = 33;
constexpr int NWAVES = 8;

constexpr size_t MiB = 1u << 20;
constexpr size_t WS_CTL = 0, CTL_ZERO_BYTES = 1 * MiB;
constexpr size_t WS_SMALL = 1 * MiB;
constexpr size_t SM_MODL = 0, SM_MODC = 49152, SM_ROPE = 65536, SM_LB = 131072, SM_WRP = 262144, SM_CVEC = 524288, SM_TILE = 528384;
constexpr size_t WS_ROUTE = 2 * MiB;
constexpr size_t RT_E = 0, RT_G = 262144, RT_R = 524288, RT_S = 786432, RT_OFF = 1048576, RT_SG = 1048576 + 294912, RT_ARS = 1048576 + 2 * 294912;
static_assert(RT_ARS + (size_t)MAXSLOTS * 4 <= 2 * MiB, "route region");
constexpr size_t DL_CSD = 524288;
constexpr size_t WS_ACT8 = 1276 * MiB;
constexpr size_t WS_DLOG = 4 * MiB;
constexpr size_t WS_KR = 5 * MiB, WS_VT = 10 * MiB;
constexpr size_t WS_CS = 15 * MiB;
constexpr size_t CS_ROW = 524288, CS_SLOT = 524288 + 65536, CS_WIN = 917504, CS_HROW = 966656;
static_assert(CS_SLOT + (size_t)MAXSLOTS * 4 <= CS_WIN && CS_WIN + (size_t)INC * 4 <= CS_HROW && CS_HROW + (size_t)MROWS * 4 <= MiB, "scale arrays");
constexpr size_t WS_L = 16 * MiB;
constexpr size_t WS_WIN = 50 * MiB, WS_WM = 92 * MiB, WS_WO = 100 * MiB, WS_WGU = 108 * MiB, WS_WDN = 620 * MiB;
constexpr size_t WS_H = 876 * MiB, WS_PROJ = 942 * MiB, WS_ACT = WS_PROJ, WS_YAB = 1276 * MiB, WS_OSCR = 1340 * MiB, WS_MERGED = 1468 * MiB, WS_X1 = 1532 * MiB, WS_YS = 1660 * MiB, WS_END = 1948 * MiB;
constexpr size_t PO_AQ = 0, PO_AKV = PO_AQ + (size_t)16 * MROWS * 64, PO_BQ = PO_AKV + (size_t)MROWS * 256, PO_ZF = PO_BQ + (size_t)8 * MROWS * 128, PO_ZB = PO_ZF + (size_t)8 * MROWS * 128,
                 PO_BV = PO_ZB + (size_t)8 * MROWS * 128, PO_BG = PO_BV + (size_t)8 * MROWS * 128, PO_GA = PO_BG + (size_t)8 * MROWS * 128, PO_GB = PO_GA + (size_t)MROWS * 2048, PO_END = PO_GB + (size_t)MROWS * 2048;
static_assert(PO_END == (size_t)MROWS * INC, "projection layout");
static_assert(WS_L + (size_t)16 * NSEG * 65536 <= WS_WIN, "L");
static_assert(WS_PROJ + (size_t)MROWS * INC * 2 <= WS_YAB && WS_ACT + (size_t)MAXSLOTS * FF * 2 <= WS_YAB, "proj/act");
static_assert(WS_H + (size_t)MROWS * D * 2 <= WS_PROJ, "h");
constexpr int CW_BAR = 4096, CW_CNT = 8192, CW_Q = 9216;

constexpr int LDS_BYTES = 163840;
constexpr int MISC_OFF = 163840 - 256;
constexpr int XL_TEXP = 131072, XL_GO = 131072 + 2048, XL_EP = 131072 + 4096;

namespace pg8 {
constexpr int BM = 256, BK = 64, HALF = 128, HTB = HALF * BK * 2, STAGE_BYTES = 8 * HTB, NXCD = 8, WGM = 8;
__host__ __device__ __forceinline__ int lds_byte(int r, int c) { const int st = (r >> 4) * 2 + (c >> 5), rr = r & 15, cc = c & 31, ob = rr * 64 + cc * 2; return st * 1024 + (ob ^ (((ob >> 9) & 1) << 5)); }
__host__ __device__ __forceinline__ void stage_rc(int b, int& R, int& C) { const int st = b / 1024, sb = b % 1024, swz = sb ^ (((sb >> 9) & 1) << 5); R = (st >> 1) * 16 + swz / 64; C = (st & 1) * 32 + (swz % 64) / 2; }
__host__ __device__ __forceinline__ int perm32(int rho) { const int n = rho >> 4, i = rho & 15; return 8 * (i >> 2) + 4 * n + (i & 3); }

struct Unit { int pm, pn, e, brow; };
struct Gemm { const bf16* A; const bf16* Bt; int K; };

struct UnitIt { int L, gid, rem; };
struct OrderBase {
    int nM, nN, nwg, G, c, nig;
    DI void init(int nM_, int nN_, int G_, int c_) { nM = nM_; nN = nN_; nwg = nM * nN; G = G_; c = c_; nig = WGM * nN; }
    DI void locate(UnitIt& it) const {
        int wgid = it.L; { const int q = nwg / NXCD, r = nwg % NXCD, xcd = wgid % NXCD, off = wgid / NXCD; wgid = (xcd < r ? xcd * (q + 1) : r * (q + 1) + (xcd - r) * q) + off; }
        it.gid = wgid / nig; it.rem = wgid % nig;
    }
    DI void decode(const UnitIt& it, int& pm, int& pn) const {
        const int fm = it.gid * WGM, gsz = (nM - fm) < WGM ? (nM - fm) : WGM;
        if (gsz == WGM) { pm = fm + (it.rem & (WGM - 1)); pn = it.rem >> 3; } else { pm = fm + it.rem % gsz; pn = it.rem / gsz; }
    }
    DI bool first(UnitIt& it, int& pm, int& pn) const { it.L = c; if (it.L >= nwg) return false; locate(it); decode(it, pm, pn); return true; }
    DI bool step(UnitIt& it, int& pm, int& pn) const {
        it.L += G; if (it.L >= nwg) return false;
        if ((G & (NXCD - 1)) == 0) { it.rem += G / NXCD; while (it.rem >= nig) { it.rem -= nig; ++it.gid; } } else locate(it);
        decode(it, pm, pn); return true;
    }
};
struct PlainOrder : OrderBase {
    static constexpr bool GATHER = false;
    int K2;
    DI void fill(Unit& u) const { u.e = 0; u.brow = u.pn * BM; }
    DI unsigned rowoff(const Unit& u, int r) const { return (unsigned)(u.pm * BM + r) * (unsigned)K2; }
    DI void pref(const Unit&, LAS unsigned char*, int, int) const {}
};
template <bool GATHER_> struct MoeOrder : OrderBase {
    static constexpr bool GATHER = GATHER_;
    int K2, nper;
    const LAS int* texp; const unsigned* sroff;
    DI void fill(Unit& u) const { u.e = texp[u.pm]; u.brow = u.e * nper + u.pn * BM; }
    DI unsigned rowoff(const Unit& u, int r) const { if (GATHER) return sroff[u.pm * BM + r]; else return (unsigned)(u.pm * BM + r) * (unsigned)K2; }
    DI void pref(const Unit& u, LAS unsigned char* slot, int wid, int lane) const {
        if (GATHER && wid == 0) __builtin_amdgcn_global_load_lds((const unsigned*)(sroff + u.pm * BM + 4 * lane), (LAS unsigned*)slot, 16, 0, 0);
    }
};

template <class Epi, class Sched, bool I8 = false, bool ALIGN_EPI = true, bool SP2 = true>
__device__ __forceinline__ void gemm_phase(LAS unsigned char* lds, const Gemm g, const Sched& S, const Epi& E) {
    const int tid = threadIdx.x, wid = __builtin_amdgcn_readfirstlane(tid >> 6), lane = tid & 63, wr = wid >> 2, wc = wid & 3, fr = lane & 15, fq = lane >> 4;
    const int K = g.K, nt = K / BK;
    int stR[2]; unsigned stC2[2], voffB[2];
#pragma unroll
    for (int i = 0; i < 2; ++i) { int R, C; stage_rc(tid * 16 + i * 8192, R, C); const int Rb = Epi::PERM ? ((R & ~31) + perm32(R & 31)) : R;
        stR[i] = R; stC2[i] = (unsigned)C * 2u; voffB[i] = (unsigned)(Rb * K + C) * 2u; }
    const size_t kstep = (size_t)(BK * 2);
    const size_t hstep = (size_t)HALF * K * 2;
    const unsigned ldsw = (unsigned)wid * 1024u;
    const int aoffL = lds_byte(wr * 64 + fr, fq * 8), boffL = lds_byte(wc * 32 + fr, fq * 8);
#define PG8_SA(b, h) (((b) * 2 + (h)) * HTB)
#define PG8_SB(b, h) ((4 + (b) * 2 + (h)) * HTB)
#define PG8_STAGE(bufoff, gbase, voff) do { _Pragma("unroll") for (int _i = 0; _i < 2; ++_i) \
        __builtin_amdgcn_global_load_lds((const unsigned*)((const char*)(gbase) + (voff)[_i]), (LAS unsigned*)(lds + (bufoff) + ldsw + _i * 8192), 16, 0, 0); } while (0)
#define PG8_LDA(dst, b, h) do { _Pragma("unroll") for (int m = 0; m < 4; ++m) _Pragma("unroll") for (int k = 0; k < 2; ++k) dst[m][k] = *(const LAS bf16x8*)(lds + PG8_SA(b, h) + aoffL + m * 2048 + k * 1024); } while (0)
#define PG8_LDB(dst, b, h) do { _Pragma("unroll") for (int n = 0; n < 2; ++n) _Pragma("unroll") for (int k = 0; k < 2; ++k) dst[n][k] = *(const LAS bf16x8*)(lds + PG8_SB(b, h) + boffL + n * 2048 + k * 1024); } while (0)
#define PG8_MMA(ai, bj, At, Bt) do { __builtin_amdgcn_s_setprio(1); _Pragma("unroll") for (int m = 0; m < 4; ++m) _Pragma("unroll") for (int n = 0; n < 2; ++n) _Pragma("unroll") for (int k = 0; k < 2; ++k) \
        { if constexpr (I8) acc[ai][bj][m][n] = __builtin_bit_cast(f32x4, __builtin_amdgcn_mfma_i32_16x16x64_i8(__builtin_bit_cast(i32x4, Bt[n][k]), __builtin_bit_cast(i32x4, At[m][k]), __builtin_bit_cast(i32x4, acc[ai][bj][m][n]), 0, 0, 0)); \
          else acc[ai][bj][m][n] = __builtin_amdgcn_mfma_f32_16x16x32_bf16(Bt[n][k], At[m][k], acc[ai][bj][m][n], 0, 0, 0); } __builtin_amdgcn_s_setprio(0); } while (0)
#define PG8_WAIT_V(n) asm volatile("s_waitcnt vmcnt(" #n ")" ::: "memory")
#define PG8_WAIT_L(n) asm volatile("s_waitcnt lgkmcnt(" #n ")" ::: "memory")
#define PG8_BAR __builtin_amdgcn_s_barrier()
#define PG8_SCHED __builtin_amdgcn_sched_barrier(0)
    Unit cur, nxt; int ui = 0; UnitIt it;
    if (!S.first(it, cur.pm, cur.pn)) return;
    S.fill(cur);
    LAS unsigned char* const xgo = lds + XL_GO;
    LAS unsigned char* const xep = lds + XL_EP;
    E.prefetch(cur, xep, wid, lane);
    f32x4 acc[2][2][4][2];
#pragma unroll
    for (int a = 0; a < 2; ++a)
#pragma unroll
        for (int b = 0; b < 2; ++b)
#pragma unroll
            for (int m = 0; m < 4; ++m)
#pragma unroll
                for (int n = 0; n < 2; ++n) acc[a][b][m][n] = (f32x4){0.f, 0.f, 0.f, 0.f};
    bf16x8 At[4][2], B0[2][2], B1[2][2];
    unsigned ao0[2], ao1[2], no0[2], no1[2];
#pragma unroll
    for (int i = 0; i < 2; ++i) { ao0[i] = S.rowoff(cur, stR[i]) + stC2[i]; ao1[i] = S.rowoff(cur, HALF + stR[i]) + stC2[i]; no0[i] = ao0[i]; no1[i] = ao1[i]; }
    const char* Ab = (const char*)g.A;
    const char* cB = (const char*)g.Bt + (size_t)cur.brow * K * 2;
    if constexpr (SP2) {
        PG8_STAGE(PG8_SB(0, 0), cB, voffB); PG8_STAGE(PG8_SB(0, 1), cB + hstep, voffB); PG8_STAGE(PG8_SA(0, 0), Ab, ao0); PG8_STAGE(PG8_SA(0, 1), Ab, ao1);
        if (wr == 1) PG8_BAR;
        PG8_WAIT_V(2); PG8_BAR;
        PG8_STAGE(PG8_SB(1, 0), cB + kstep, voffB); PG8_STAGE(PG8_SA(1, 0), Ab + kstep, ao0); PG8_STAGE(PG8_SB(1, 1), cB + hstep + kstep, voffB);
        PG8_WAIT_V(6); PG8_BAR;
    } else {
        PG8_STAGE(PG8_SB(0, 0), cB, voffB); PG8_STAGE(PG8_SA(0, 0), Ab, ao0); PG8_STAGE(PG8_SB(0, 1), cB + hstep, voffB); PG8_STAGE(PG8_SA(0, 1), Ab, ao1);
        if (wr == 1) PG8_BAR;
        PG8_WAIT_V(4); PG8_BAR;
        PG8_STAGE(PG8_SB(1, 0), cB + kstep, voffB); PG8_STAGE(PG8_SA(1, 0), Ab + kstep, ao0); PG8_STAGE(PG8_SB(1, 1), cB + hstep + kstep, voffB);
        PG8_WAIT_V(6); PG8_BAR;
    }
    for (;;) {
        const bool has_next = S.step(it, nxt.pm, nxt.pn);
        if (has_next) { S.fill(nxt);
            if constexpr (Sched::GATHER) S.pref(nxt, xgo + ((ui + 1) & 1) * 1024, wid, lane);
            else {
#pragma unroll
                for (int i = 0; i < 2; ++i) { no0[i] = S.rowoff(nxt, stR[i]) + stC2[i]; no1[i] = S.rowoff(nxt, HALF + stR[i]) + stC2[i]; } }
        }
        const char* nB = has_next ? (const char*)g.Bt + (size_t)nxt.brow * K * 2 : cB;
        for (int t = 0; t < nt; t += 2) {
            const bool last = (t == nt - 2);
            if constexpr (Epi::HOOK) { if (t == nt / 2) E.hook(acc, cur, wr, wc, fr, fq); }
            const char* a1 = Ab + (size_t)(t + 1) * kstep;
            const char* a2 = last ? Ab : Ab + (size_t)(t + 2) * kstep; const char* b2 = last ? nB : cB + (size_t)(t + 2) * kstep;
            const char* a3 = a2 + kstep; const char* b3 = b2 + kstep;
            if constexpr (Sched::GATHER) { if (last && has_next) { const LAS unsigned char* gs = xgo + ((ui + 1) & 1) * 1024;
#pragma unroll
                for (int i = 0; i < 2; ++i) { no0[i] = *(const LAS unsigned*)(gs + 4 * stR[i]) + stC2[i]; no1[i] = *(const LAS unsigned*)(gs + 4 * (HALF + stR[i])) + stC2[i]; } } }
            unsigned x0[2], x1[2];
#pragma unroll
            for (int i = 0; i < 2; ++i) { x0[i] = last ? no0[i] : ao0[i]; x1[i] = last ? no1[i] : ao1[i]; }
            if constexpr (SP2) {
            PG8_LDB(B0, 0, 0); PG8_LDB(B1, 0, 1); PG8_SCHED; PG8_LDA(At, 0, 0); PG8_STAGE(PG8_SA(1, 1), a1, ao1);
            PG8_WAIT_V(8); PG8_WAIT_L(0); PG8_BAR; PG8_MMA(0, 0, At, B0); PG8_MMA(0, 1, At, B1); PG8_BAR; PG8_SCHED;
            PG8_LDA(At, 0, 1); PG8_STAGE(PG8_SB(0, 0), b2, voffB); PG8_STAGE(PG8_SB(0, 1), b2 + hstep, voffB); PG8_STAGE(PG8_SA(0, 0), a2, x0);
            PG8_WAIT_V(8); PG8_WAIT_L(0); PG8_BAR; PG8_MMA(1, 0, At, B0); PG8_MMA(1, 1, At, B1); PG8_BAR; PG8_SCHED;
            PG8_LDB(B0, 1, 0); PG8_LDB(B1, 1, 1); PG8_SCHED; PG8_LDA(At, 1, 0); PG8_STAGE(PG8_SA(0, 1), a2, x1);
            PG8_WAIT_V(8); PG8_WAIT_L(0); PG8_BAR; PG8_MMA(0, 0, At, B0); PG8_MMA(0, 1, At, B1); PG8_BAR; PG8_SCHED;
            PG8_LDA(At, 1, 1); PG8_STAGE(PG8_SB(1, 0), b3, voffB); PG8_STAGE(PG8_SB(1, 1), b3 + hstep, voffB); PG8_STAGE(PG8_SA(1, 0), a3, x0);
            PG8_WAIT_V(8); PG8_WAIT_L(0); PG8_BAR; PG8_MMA(1, 0, At, B0); PG8_MMA(1, 1, At, B1); PG8_BAR; PG8_SCHED;
            } else {
            PG8_LDB(B0, 0, 0); PG8_SCHED; PG8_LDA(At, 0, 0); PG8_STAGE(PG8_SA(1, 1), a1, ao1);
            PG8_WAIT_L(8); PG8_BAR; PG8_WAIT_L(0); PG8_MMA(0, 0, At, B0); PG8_BAR; PG8_SCHED;
            PG8_LDB(B1, 0, 1); PG8_STAGE(PG8_SB(0, 0), b2, voffB);
            PG8_BAR; PG8_WAIT_L(0); PG8_MMA(0, 1, At, B1); PG8_BAR;
            PG8_LDA(At, 0, 1); PG8_STAGE(PG8_SA(0, 0), a2, x0);
            PG8_BAR; PG8_WAIT_L(0); PG8_MMA(1, 0, At, B0); PG8_BAR; PG8_SCHED;
            PG8_STAGE(PG8_SB(0, 1), b2 + hstep, voffB);
            PG8_WAIT_V(6); PG8_BAR; PG8_MMA(1, 1, At, B1); PG8_BAR;
            PG8_LDB(B0, 1, 0); PG8_SCHED; PG8_LDA(At, 1, 0); PG8_STAGE(PG8_SA(0, 1), a2, x1);
            PG8_WAIT_L(8); PG8_BAR; PG8_WAIT_L(0); PG8_MMA(0, 0, At, B0); PG8_BAR; PG8_SCHED;
            PG8_LDB(B1, 1, 1); PG8_STAGE(PG8_SB(1, 0), b3, voffB);
            PG8_BAR; PG8_WAIT_L(0); PG8_MMA(0, 1, At, B1); PG8_BAR;
            PG8_LDA(At, 1, 1); PG8_STAGE(PG8_SA(1, 0), a3, x0);
            PG8_BAR; PG8_WAIT_L(0); PG8_MMA(1, 0, At, B0); PG8_BAR; PG8_SCHED;
            PG8_STAGE(PG8_SB(1, 1), b3 + hstep, voffB);
            PG8_WAIT_V(6); PG8_BAR; PG8_MMA(1, 1, At, B1); PG8_BAR;
            }
        }
        if constexpr (ALIGN_EPI) { if (wr == 0) PG8_BAR; }
        E(acc, cur, wr, wc, fr, fq, xep + (ui & 1) * 4096);
        if (!has_next) break;
#pragma unroll
        for (int a = 0; a < 2; ++a)
#pragma unroll
            for (int b = 0; b < 2; ++b)
#pragma unroll
                for (int m = 0; m < 4; ++m)
#pragma unroll
                    for (int n = 0; n < 2; ++n) acc[a][b][m][n] = (f32x4){0.f, 0.f, 0.f, 0.f};
        cur = nxt; cB = nB; ++ui;
        E.prefetch(cur, xep + (ui & 1) * 4096, wid, lane);
#pragma unroll
        for (int i = 0; i < 2; ++i) { ao0[i] = no0[i]; ao1[i] = no1[i]; }
        if constexpr (ALIGN_EPI) { if (wr == 1) PG8_BAR; }
    }
    PG8_WAIT_V(0);
    if constexpr (!ALIGN_EPI) { if (wr == 0) PG8_BAR; }
    PG8_BAR;
#undef PG8_SA
#undef PG8_SB
#undef PG8_STAGE
#undef PG8_LDA
#undef PG8_LDB
#undef PG8_MMA
#undef PG8_WAIT_V
#undef PG8_WAIT_L
#undef PG8_BAR
#undef PG8_SCHED
}
}

using pg8::Unit; using pg8::HALF; using pg8::BM;
struct EpiProj {
    static constexpr bool PERM = true, HOOK = false;
    bf16* P; const float* lbf; const float* lbb; const float* hrs; const float* wcs;
    DI void hook(f32x4 (&)[2][2][4][2], const Unit&, int, int, int, int) const {}
    DI void prefetch(const Unit& u, LAS unsigned char* slot, int wid, int lane) const {
        if (wid != 0) return;
        __builtin_amdgcn_global_load_lds((const unsigned*)(hrs + u.pm * BM + 4 * lane), (LAS unsigned*)slot, 16, 0, 0);
        __builtin_amdgcn_global_load_lds((const unsigned*)(wcs + u.pn * BM + 4 * lane), (LAS unsigned*)(slot + 1024), 16, 0, 0);
        if (u.pn >= 9 && u.pn < 17) __builtin_amdgcn_global_load_lds((const unsigned*)((u.pn < 13 ? lbf + (u.pn - 9) * BM : lbb + (u.pn - 13) * BM) + 4 * lane), (LAS unsigned*)(slot + 2048), 16, 0, 0);
    }
    DI void operator()(const f32x4 (&acc)[2][2][4][2], const Unit& u, int wr, int wc, int fr, int fq, const LAS unsigned char* slot) const {
        const int pn = u.pn; int cls, cbase, hs, pitch; size_t po; const float* lb = lbf;
        if (pn < 4)       { cls = 0; cbase = C_AQ; po = PO_AQ;  hs = 6;  pitch = 64; }
        else if (pn < 5)  { cls = 0; cbase = C_AK; po = PO_AKV; hs = 30; pitch = 256; }
        else if (pn < 9)  { cls = 1; cbase = C_BQ; po = PO_BQ;  hs = 7;  pitch = 128; }
        else if (pn < 13) { cls = 2; cbase = C_ZF; po = PO_ZF;  hs = 7;  pitch = 128; }
        else if (pn < 17) { cls = 2; cbase = C_ZB; po = PO_ZB;  hs = 7;  pitch = 128; lb = lbb; }
        else if (pn < 21) { cls = 0; cbase = C_BV; po = PO_BV;  hs = 7;  pitch = 128; }
        else if (pn < 25) { cls = 1; cbase = C_BG; po = PO_BG;  hs = 7;  pitch = 128; }
        else if (pn < 33) { cls = 3; cbase = C_GA; po = PO_GA;  hs = 30; pitch = 2048; }
        else              { cls = 3; cbase = C_GB; po = PO_GB;  hs = 30; pitch = 2048; }
        int zz = 0; asm volatile("" : "+v"(zz));
        const int row0 = u.pm * BM + wr * 64 + fr + zz, cin0 = u.pn * BM + wc * 32 + 8 * fq - cbase;
        bf16* base = P + po;
        float rsv[2][4];
#pragma unroll
        for (int ai = 0; ai < 2; ++ai)
#pragma unroll
            for (int m = 0; m < 4; ++m) rsv[ai][m] = *(const LAS float*)(slot + 4 * (ai * HALF + wr * 64 + m * 16 + fr));
#pragma unroll
        for (int bj = 0; bj < 2; ++bj) {
            float lbv[8];
            const int cin = cin0 + bj * HALF;
            { const int lc = bj * HALF + wc * 32 + 8 * fq; const f32x4 a = *(const LAS f32x4*)(slot + 2048 + 4 * lc), b = *(const LAS f32x4*)(slot + 2048 + 4 * lc + 16);
#pragma unroll
              for (int j = 0; j < 4; ++j) { lbv[j] = (cls == 2) ? a[j] : 0.f; lbv[4 + j] = (cls == 2) ? b[j] : 0.f; } }
            bf16* colp = base + (size_t)(cin >> hs) * MROWS * pitch + (cin & ((1 << hs) - 1));
            float csv[8];
            { const int lc = bj * HALF + wc * 32 + 8 * fq; const f32x4 a = *(const LAS f32x4*)(slot + 1024 + 4 * lc), b = *(const LAS f32x4*)(slot + 1024 + 4 * lc + 16);
#pragma unroll
              for (int j = 0; j < 4; ++j) { csv[j] = a[j]; csv[4 + j] = b[j]; } }
#pragma unroll
            for (int ai = 0; ai < 2; ++ai)
#pragma unroll
                for (int m = 0; m < 4; ++m) { const int rr = row0 + ai * HALF + m * 16; const size_t ro = (size_t)rr * pitch; float v[8]; const float rs = rsv[ai][m];
#pragma unroll
                    for (int j = 0; j < 8; ++j) v[j] = (float)__builtin_bit_cast(i32x4, acc[ai][bj][m][j >> 2])[j & 3] * (rs * csv[j]);
                    if (cls != 0) {
#pragma unroll
                        for (int j = 0; j < 8; ++j) { const float sg = sigmoidf_(v[j]); v[j] = (cls == 1) ? v[j] * sg : sg; }
                        if (cls == 2) {
#pragma unroll
                            for (int j = 0; j < 8; ++j) { const float l = lbv[j]; v[j] = __logf(l + (1.0f - l) * v[j]); } }
                    }
                    u32x4 w; w.x = pk2(v[0], v[1]); w.y = pk2(v[2], v[3]); w.z = pk2(v[4], v[5]); w.w = pk2(v[6], v[7]);
                    *(u32x4*)(colp + ro) = w; }
        }
    }
};
struct EpiMerge {
    static constexpr bool PERM = true, HOOK = true;
    bf16* O; const bf16* proj;
    DI void hook(f32x4 (&acc)[2][2][4][2], const Unit& u, int wr, int wc, int fr, int fq) const {
        int zz = 0; asm volatile("" : "+v"(zz));
        const int row0 = u.pm * BM + wr * 64 + fr + zz, col0 = u.pn * BM + wc * 32 + 8 * fq;
#pragma unroll
        for (int ai = 0; ai < 2; ++ai)
#pragma unroll
            for (int m = 0; m < 4; ++m) { const size_t rowp = (size_t)(row0 + ai * HALF + m * 16) * D + col0;
#pragma unroll
                for (int bj = 0; bj < 2; ++bj) { const u32x4 ga = *(const u32x4*)(proj + PO_GA + rowp + bj * HALF), gb = *(const u32x4*)(proj + PO_GB + rowp + bj * HALF);
#pragma unroll
                    for (int q = 0; q < 4; ++q) { const float r0 = bflo(ga[q]) * __builtin_amdgcn_rcpf(bflo(gb[q])), r1 = bfhi(ga[q]) * __builtin_amdgcn_rcpf(bfhi(gb[q]));
                        acc[ai][bj][m][q >> 1][(q & 1) * 2] *= r0; acc[ai][bj][m][q >> 1][(q & 1) * 2 + 1] *= r1; } }
                asm volatile("" ::: "memory"); }
    }
    DI void prefetch(const Unit&, LAS unsigned char*, int, int) const {}
    DI void operator()(const f32x4 (&acc)[2][2][4][2], const Unit& u, int wr, int wc, int fr, int fq, const LAS unsigned char*) const {
        const int row0 = u.pm * BM + wr * 64 + fr, col0 = u.pn * BM + wc * 32 + 8 * fq;
#pragma unroll
        for (int ai = 0; ai < 2; ++ai)
#pragma unroll
            for (int m = 0; m < 4; ++m) { const size_t r = (size_t)(row0 + ai * HALF + m * 16);
#pragma unroll
                for (int bj = 0; bj < 2; ++bj) { const u32x4 gb = *(const u32x4*)(proj + PO_GB + r * D + col0 + bj * HALF); u32x4 w;
#pragma unroll
                    for (int q = 0; q < 4; ++q) w[q] = pk2(acc[ai][bj][m][q >> 1][(q & 1) * 2] * bflo(gb[q]), acc[ai][bj][m][q >> 1][(q & 1) * 2 + 1] * bfhi(gb[q]));
                    *(u32x4*)(O + r * D + col0 + bj * HALF) = w; } }
    }
};
struct EpiOut {
    static constexpr bool PERM = false, HOOK = false;
    float* X1; const float* x; const float* mod2;
    DI void hook(f32x4 (&)[2][2][4][2], const Unit&, int, int, int, int) const {}
    DI void prefetch(const Unit&, LAS unsigned char*, int, int) const {}
    DI void operator()(const f32x4 (&acc)[2][2][4][2], const Unit& u, int wr, int wc, int fr, int fq, const LAS unsigned char*) const {
        const int row0 = u.pm * BM + wr * 64 + fr, col0 = u.pn * BM + wc * 32 + 4 * fq;
        f32x4 mv[2][2];
#pragma unroll
        for (int bj = 0; bj < 2; ++bj)
#pragma unroll
            for (int n = 0; n < 2; ++n) mv[bj][n] = *(const f32x4*)(mod2 + col0 + bj * HALF + n * 16);
#pragma unroll
        for (int ai = 0; ai < 2; ++ai)
#pragma unroll
            for (int m = 0; m < 4; ++m) { const size_t off = (size_t)(row0 + ai * HALF + m * 16) * D + col0;
#pragma unroll
                for (int bj = 0; bj < 2; ++bj)
#pragma unroll
                    for (int n = 0; n < 2; ++n) { const f32x4 xv = *(const f32x4*)(x + off + bj * HALF + n * 16);
                        *(f32x4*)(X1 + off + bj * HALF + n * 16) = xv + mv[bj][n] * acc[ai][bj][m][n]; } }
    }
};
struct EpiAct {
    static constexpr bool PERM = true, HOOK = false;
    bf16* ACTp; const float* bg; const float* bu; const float* cs; const float* srs;
    DI void hook(f32x4 (&)[2][2][4][2], const Unit&, int, int, int, int) const {}
    DI void prefetch(const Unit& u, LAS unsigned char* slot, int wid, int lane) const {
        if (wid != 0) return;
        __builtin_amdgcn_global_load_lds((const unsigned*)(srs + u.pm * BM + 4 * lane), (LAS unsigned*)slot, 16, 0, 0);
        __builtin_amdgcn_global_load_lds((const unsigned*)(cs + u.e * 4096 + u.pn * BM + 4 * lane), (LAS unsigned*)(slot + 1024), 16, 0, 0);
        __builtin_amdgcn_global_load_lds((const unsigned*)((lane < 32 ? bg : bu) + u.e * FF + u.pn * HALF + 4 * (lane & 31)), (LAS unsigned*)(slot + 2048), 16, 0, 0);
    }
    DI void operator()(const f32x4 (&acc)[2][2][4][2], const Unit& u, int wr, int wc, int fr, int fq, const LAS unsigned char* slot) const {
        int zz = 0; asm volatile("" : "+v"(zz));
        const int row0 = u.pm * BM + wr * 64 + fr + zz, col0 = u.pn * HALF + wc * 32 + 8 * fq, lc = wc * 32 + 8 * fq;
        float gbv[8], ubv[8], gsc[8], usc[8];
        { const f32x4 a = *(const LAS f32x4*)(slot + 2048 + 4 * lc), b = *(const LAS f32x4*)(slot + 2048 + 4 * lc + 16), c = *(const LAS f32x4*)(slot + 2560 + 4 * lc), d = *(const LAS f32x4*)(slot + 2560 + 4 * lc + 16);
          const f32x4 sa = *(const LAS f32x4*)(slot + 1024 + 4 * lc), sb = *(const LAS f32x4*)(slot + 1024 + 4 * lc + 16), sc = *(const LAS f32x4*)(slot + 1536 + 4 * lc), sd = *(const LAS f32x4*)(slot + 1536 + 4 * lc + 16);
#pragma unroll
          for (int j = 0; j < 4; ++j) { gbv[j] = a[j]; gbv[4 + j] = b[j]; ubv[j] = c[j]; ubv[4 + j] = d[j]; gsc[j] = sa[j]; gsc[4 + j] = sb[j]; usc[j] = sc[j]; usc[4 + j] = sd[j]; } }
        float rsv[2][4];
#pragma unroll
        for (int ai = 0; ai < 2; ++ai)
#pragma unroll
            for (int m = 0; m < 4; ++m) rsv[ai][m] = *(const LAS float*)(slot + 4 * (ai * HALF + wr * 64 + m * 16 + fr));
#pragma unroll
        for (int ai = 0; ai < 2; ++ai)
#pragma unroll
            for (int m = 0; m < 4; ++m) { float v[8]; const int r = row0 + ai * HALF + m * 16; const float rs = rsv[ai][m];
#pragma unroll
                for (int j = 0; j < 8; ++j) { const i32x4 ga = __builtin_bit_cast(i32x4, acc[ai][0][m][j >> 2]), ua = __builtin_bit_cast(i32x4, acc[ai][1][m][j >> 2]);
                    float gg = (float)ga[j & 3] * (rs * gsc[j]) + gbv[j], uu = (float)ua[j & 3] * (rs * usc[j]) + ubv[j];
                    gg = fminf(gg, 7.0f); uu = fminf(fmaxf(uu, -7.0f), 7.0f);
                    v[j] = gg * sigmoidf_(1.702f * gg) * (uu + 1.0f); }
                u32x4 w; w.x = pk2(v[0], v[1]); w.y = pk2(v[2], v[3]); w.z = pk2(v[4], v[5]); w.w = pk2(v[6], v[7]);
                *(u32x4*)(ACTp + (size_t)r * FF + col0) = w; }
    }
};
struct EpiDown {
    static constexpr bool PERM = true, HOOK = false;
    signed char* YQ; float* YSC; const float* bd; const float* sgate; const float* ars; const float* csd;
    DI void hook(f32x4 (&)[2][2][4][2], const Unit&, int, int, int, int) const {}
    DI void prefetch(const Unit& u, LAS unsigned char* slot, int wid, int lane) const {
        if (wid != 0) return;
        __builtin_amdgcn_global_load_lds((const unsigned*)(sgate + u.pm * BM + 4 * lane), (LAS unsigned*)slot, 16, 0, 0);
        __builtin_amdgcn_global_load_lds((const unsigned*)(ars + u.pm * BM + 4 * lane), (LAS unsigned*)(slot + 1024), 16, 0, 0);
        __builtin_amdgcn_global_load_lds((const unsigned*)(bd + u.e * D + u.pn * BM + 4 * lane), (LAS unsigned*)(slot + 2048), 16, 0, 0);
        __builtin_amdgcn_global_load_lds((const unsigned*)(csd + u.e * D + u.pn * BM + 4 * lane), (LAS unsigned*)(slot + 3072), 16, 0, 0);
    }
    DI void operator()(f32x4 (&acc)[2][2][4][2], const Unit& u, int wr, int wc, int fr, int fq, const LAS unsigned char* slot) const {
        int zz = 0; asm volatile("" : "+v"(zz));
        const int row0 = u.pm * BM + wr * 64 + fr + zz, col0 = u.pn * BM + wc * 32 + 8 * fq;
        float gtv[2][4], rsv[2][4], rmx[2][4];
#pragma unroll
        for (int ai = 0; ai < 2; ++ai)
#pragma unroll
            for (int m = 0; m < 4; ++m) { const int lr = ai * HALF + wr * 64 + m * 16 + fr; gtv[ai][m] = *(const LAS float*)(slot + 4 * lr); rsv[ai][m] = *(const LAS float*)(slot + 1024 + 4 * lr); rmx[ai][m] = 0.f; }
#pragma unroll
        for (int bj = 0; bj < 2; ++bj) { float bv[8], cv[8];
            { const int lc = bj * HALF + wc * 32 + 8 * fq; const f32x4 a = *(const LAS f32x4*)(slot + 2048 + 4 * lc), b = *(const LAS f32x4*)(slot + 2048 + 4 * lc + 16), c = *(const LAS f32x4*)(slot + 3072 + 4 * lc), d = *(const LAS f32x4*)(slot + 3072 + 4 * lc + 16);
#pragma unroll
              for (int j = 0; j < 4; ++j) { bv[j] = a[j]; bv[4 + j] = b[j]; cv[j] = c[j]; cv[4 + j] = d[j]; } }
#pragma unroll
            for (int ai = 0; ai < 2; ++ai)
#pragma unroll
                for (int m = 0; m < 4; ++m) { const float gt = gtv[ai][m], rs = rsv[ai][m];
#pragma unroll
                    for (int n = 0; n < 2; ++n) { const i32x4 ia = __builtin_bit_cast(i32x4, acc[ai][bj][m][n]); f32x4 v;
#pragma unroll
                        for (int k = 0; k < 4; ++k) { v[k] = ((float)ia[k] * (rs * cv[4 * n + k]) + bv[4 * n + k]) * gt; rmx[ai][m] = fmaxf(rmx[ai][m], fabsf(v[k])); }
                        acc[ai][bj][m][n] = v; } } }
        LAS float* xch = (LAS float*)(slot + 8192);
#pragma unroll
        for (int ai = 0; ai < 2; ++ai)
#pragma unroll
            for (int m = 0; m < 4; ++m) { float x = rmx[ai][m]; x = fmaxf(x, __shfl_xor(x, 16)); x = fmaxf(x, __shfl_xor(x, 32));
                if (fq == 0) xch[(ai * HALF + wr * 64 + m * 16 + fr) * 4 + wc] = x; }
        asm volatile("s_waitcnt lgkmcnt(0)" ::: "memory"); __builtin_amdgcn_s_barrier(); asm volatile("" ::: "memory");
#pragma unroll
        for (int ai = 0; ai < 2; ++ai)
#pragma unroll
            for (int m = 0; m < 4; ++m) { const int lr = ai * HALF + wr * 64 + m * 16 + fr, r = row0 + ai * HALF + m * 16; const f32x4 p = *(const LAS f32x4*)(xch + lr * 4);
                float mx = fmaxf(fmaxf(p[0], p[1]), fmaxf(p[2], p[3])); if (!(mx > 0.f)) mx = 1.f;
                const float inv = 127.0f / mx;
                if (wc == 0 && fq == 0) YSC[(size_t)r * 8 + u.pn] = mx * (1.0f / 127.0f);
#pragma unroll
                for (int bj = 0; bj < 2; ++bj) { u32x2 w;
#pragma unroll
                    for (int n = 0; n < 2; ++n) { const f32x4 v = acc[ai][bj][m][n]; unsigned pk = 0u;
#pragma unroll
                        for (int k = 0; k < 4; ++k) pk |= ((unsigned)(int)rintf(v[k] * inv) & 0xffu) << (8 * k);
                        w[n] = pk; }
                    *(u32x2*)(YQ + (size_t)r * D + col0 + bj * HALF) = w; } }
    }
};

#define XB_TMO      128
#define XB_XCNT(j)  (256  + 64 * (j))
#define XB_XSUB(j)  (1280 + 64 * (j))
#define XB_XGEN(j)  (2304 + 64 * (j))
#define XB_TOP      3328
#define XB_TOPGEN   3392
#define XCD_BAR_WORDS 3456
#define XB_SPIN_CAP (1u << 22)
DI unsigned xb_ld(unsigned* p)              { return __hip_atomic_load(p, __ATOMIC_RELAXED, __HIP_MEMORY_SCOPE_AGENT); }
DI unsigned xb_add(unsigned* p, unsigned v) { return __hip_atomic_fetch_add(p, v, __ATOMIC_RELAXED, __HIP_MEMORY_SCOPE_AGENT); }
DI unsigned xb_xcc_id() { return (unsigned)__builtin_amdgcn_s_getreg((3 << 11) | 20) & 0xFu; }
#define XB_SPIN(cond, bar) do { unsigned _sp = 0; while (cond) { __builtin_amdgcn_s_sleep(1); \
    if ((++_sp & 255u) == 0u) { if (xb_ld(&(bar)[XB_TMO])) break; if (_sp > XB_SPIN_CAP) { atomicAdd(&(bar)[XB_TMO], 1u); break; } } } } while (0)
struct XcdBarrier { unsigned* bar; unsigned x; volatile LAS unsigned* st; };
DI XcdBarrier xcd_barrier_post(unsigned* bar, volatile LAS unsigned* st) {
    XcdBarrier b; b.bar = bar; b.x = xb_xcc_id(); b.st = st;
    if (threadIdx.x == 0) (void)xb_add(&bar[XB_XCNT(b.x)], 1u);
    return b;
}
DI void xcd_barrier_complete(unsigned* bar, unsigned x, unsigned& nloc, unsigned& nx) {
    const unsigned G = gridDim.x * gridDim.y * gridDim.z;
    unsigned sum, cnt, mine, sp = 0u;
    for (;;) {
        sum = 0u; cnt = 0u; mine = 0u;
#pragma unroll
        for (unsigned j = 0; j < 16; ++j) { const unsigned c = xb_ld(&bar[XB_XCNT(j)]); sum += c; cnt += (c > 0u) ? 1u : 0u; mine = (j == x) ? c : mine; }
        if (sum == G) break;
        __builtin_amdgcn_s_sleep(1);
        if ((++sp & 255u) == 0u) { if (xb_ld(&bar[XB_TMO])) break; if (sp > XB_SPIN_CAP) { atomicAdd(&bar[XB_TMO], 1u); break; } }
    }
    nloc = mine > 0u ? mine : 1u; nx = cnt > 0u ? cnt : 1u;
}
DI void xcd_barrier(const XcdBarrier& b) {
    asm volatile("s_waitcnt vmcnt(0)" ::: "memory");
    __syncthreads();
    if (threadIdx.x == 0) {
        unsigned* bar = b.bar;
        __builtin_amdgcn_s_waitcnt(0);
        unsigned nloc = b.st[0], nx = b.st[1];
        if (nloc == 0u) { xcd_barrier_complete(bar, b.x, nloc, nx); b.st[0] = nloc; b.st[1] = nx; }
        const unsigned old = xb_add(&bar[XB_XSUB(b.x)], 1u);
        const unsigned gen = old / nloc;
        if (old + 1u == (gen + 1u) * nloc) {
            __builtin_amdgcn_fence(__ATOMIC_RELEASE, "agent");
            asm volatile("s_waitcnt vmcnt(0)" ::: "memory");
            const unsigned og = xb_add(&bar[XB_TOP], 1u);
            const unsigned tg = og / nx;
            if (og + 1u == (tg + 1u) * nx) xb_add(&bar[XB_TOPGEN], 1u);
            else XB_SPIN(xb_ld(&bar[XB_TOPGEN]) == tg, bar);
            __builtin_amdgcn_fence(__ATOMIC_ACQUIRE, "agent");
            xb_add(&bar[XB_XGEN(b.x)], 1u);
            asm volatile("s_waitcnt vmcnt(0)" ::: "memory");
        } else {
            XB_SPIN(xb_ld(&bar[XB_XGEN(b.x)]) == gen, bar);
            __builtin_amdgcn_fence(__ATOMIC_ACQUIRE, "agent");
            asm volatile("s_waitcnt vmcnt(0)" ::: "memory");
        }
    }
    __syncthreads();
}

struct Args {
    const float *x, *c, *ctx, *c_ctx, *norm_mix_g, *norm_ffn_g, *w_mod, *b_mod, *w_in, *sinks, *lbf_logits, *lbb_logits, *hgrn_g, *w_branch, *w_out,
                *w_router, *b_router, *w_e_gate, *b_e_gate, *w_e_up, *b_e_up, *w_e_down, *b_e_down, *final_g;
    float* out; unsigned char* ws; int ph_lo, ph_hi;
};

DI void p0_transpose64(const float* W, int ldw, bf16* WT, int ldt, LAS unsigned char* scr, int lane) {
    const int kq = lane >> 4, n4 = lane & 15;
    f32x4 v[16];
#pragma unroll
    for (int i = 0; i < 16; ++i) v[i] = *(const f32x4*)(W + (size_t)(16 * kq + i) * ldw + 4 * n4);
#pragma unroll
    for (int c = 0; c < 4; ++c)
#pragma unroll
        for (int h = 0; h < 2; ++h) { u32x4 w; w.x = pk2(v[8 * h][c], v[8 * h + 1][c]); w.y = pk2(v[8 * h + 2][c], v[8 * h + 3][c]); w.z = pk2(v[8 * h + 4][c], v[8 * h + 5][c]); w.w = pk2(v[8 * h + 6][c], v[8 * h + 7][c]);
            *(LAS u32x4*)(scr + (4 * n4 + c) * 144 + (16 * kq + 8 * h) * 2) = w; }
    LDS_WAIT(); asm volatile("" ::: "memory");
#pragma unroll
    for (int j = 0; j < 8; ++j) { const int row = (lane >> 3) + 8 * j, pc = lane & 7; const u32x4 o = *(const LAS u32x4*)(scr + row * 144 + pc * 16); *(u32x4*)(WT + (size_t)row * ldt + pc * 8) = o; }
    LDS_WAIT(); asm volatile("" ::: "memory");
}
DI void p0_quant_item(const float* W  , int ldw, signed char* Q  , float* csp  , LAS unsigned char* lds, int tid) {
    const int lane = tid & 63, w = tid >> 6, n4 = lane & 7, kr = lane >> 3;
    LAS float* smax = (LAS float*)(lds + 32 * 2064);
    f32x4 v[8][4]; f32x4 mx = {0.f, 0.f, 0.f, 0.f};
#pragma unroll
    for (int g = 0; g < 8; ++g)
#pragma unroll
        for (int r = 0; r < 4; ++r) { v[g][r] = *(const f32x4*)(W + (size_t)(256 * g + 32 * w + 4 * kr + r) * ldw + 4 * n4);
            mx[0] = fmaxf(mx[0], fabsf(v[g][r][0])); mx[1] = fmaxf(mx[1], fabsf(v[g][r][1])); mx[2] = fmaxf(mx[2], fabsf(v[g][r][2])); mx[3] = fmaxf(mx[3], fabsf(v[g][r][3])); }
#pragma unroll
    for (int c = 0; c < 4; ++c) { float m = mx[c]; m = fmaxf(m, __shfl_xor(m, 8)); m = fmaxf(m, __shfl_xor(m, 16)); m = fmaxf(m, __shfl_xor(m, 32)); mx[c] = m; }
    __syncthreads();
    if (kr == 0) *(LAS f32x4*)(smax + w * 32 + 4 * n4) = mx;
    __syncthreads();
    f32x4 cm = *(const LAS f32x4*)(smax + 4 * n4);
#pragma unroll
    for (int ww = 1; ww < 8; ++ww) { const f32x4 o = *(const LAS f32x4*)(smax + ww * 32 + 4 * n4); cm[0] = fmaxf(cm[0], o[0]); cm[1] = fmaxf(cm[1], o[1]); cm[2] = fmaxf(cm[2], o[2]); cm[3] = fmaxf(cm[3], o[3]); }
    f32x4 inv;
#pragma unroll
    for (int c = 0; c < 4; ++c) { if (cm[c] == 0.f) cm[c] = 1.f; inv[c] = 127.0f / cm[c]; }
    if (w == 0 && kr == 0) { f32x4 sc; sc[0] = cm[0] * (1.0f / 127.0f); sc[1] = cm[1] * (1.0f / 127.0f); sc[2] = cm[2] * (1.0f / 127.0f); sc[3] = cm[3] * (1.0f / 127.0f); *(f32x4*)(csp + 4 * n4) = sc; }
#pragma unroll
    for (int g = 0; g < 8; ++g)
#pragma unroll
        for (int c = 0; c < 4; ++c) { unsigned pk = 0u;
#pragma unroll
            for (int r = 0; r < 4; ++r) { const int q = (int)rintf(v[g][r][c] * inv[c]); pk |= ((unsigned)q & 0xffu) << (8 * r); }
            *(LAS unsigned*)(lds + (4 * n4 + c) * 2064 + 4 * (64 * g + 8 * w + kr)) = pk; }
    __syncthreads();
#pragma unroll
    for (int i = 0; i < 8; ++i) { const int p = tid + 512 * i, row = p >> 7, pc = p & 127; const u32x4 o = *(const LAS u32x4*)(lds + row * 2064 + pc * 16); *(u32x4*)(Q + (size_t)row * 2048 + pc * 16) = o; }
}

constexpr int SC_QH = 0, SC_KH = 8448, SC_KT = 16896, SC_VT = 26112, SC_FAC = 35328, SC_RZ = 35840, SC_RV = 44032, SC_RQ = 52224, SC_GRP = 60416;
constexpr int RSQ = 264, RST = 72;
DI int crow(int i, int h) { return (i & 3) + 8 * (i >> 2) + 4 * h; }
DI bf16x8 pack8(float a0, float a1, float a2, float a3, float a4, float a5, float a6, float a7) {
    u32x4 p; p.x = pk2(a0, a1); p.y = pk2(a2, a3); p.z = pk2(a4, a5); p.w = pk2(a6, a7); return __builtin_bit_cast(bf16x8, p);
}
DI bf16x8 lds_frag2(const LAS unsigned char* p0, const LAS unsigned char* p1) {
    const u32x2 lo = *(const LAS u32x2*)p0, hi = *(const LAS u32x2*)p1; u32x4 v; v.x = lo.x; v.y = lo.y; v.z = hi.x; v.w = hi.y; return __builtin_bit_cast(bf16x8, v);
}
#define MFMA32(a, b, c) __builtin_amdgcn_mfma_f32_32x32x16_bf16((a), (b), (c), 0, 0, 0)

template <bool OUT>
DI void scan_segment(LAS unsigned char* ldsb, const bf16* proj, int hh, int segF, int segB, float* Lbuf, float* Dlog, bf16* oscr) {
    const int tid = threadIdx.x, lane = tid & 63, wave = __builtin_amdgcn_readfirstlane(tid >> 6);
    const int dir = wave >> 2, w4 = wave & 3, half = w4 >> 1, d = tid & 127, r = lane & 31, h5 = lane >> 5, e0 = 32 * w4;
    const int seg = dir ? segB : segF, scan = dir * 8 + hh;
    const int ntok = (seg == 0) ? NCTX : 512, sgn = dir ? -1 : 1;
    const int r0 = (seg == 0) ? (dir ? MROWS - 1 : NTOK) : (dir ? NTOK - 1 - (seg - 1) * 512 : (seg - 1) * 512);
    LAS unsigned char* G = ldsb + dir * SC_GRP;
    LAS unsigned char* QH = G + SC_QH; LAS unsigned char* KH = G + SC_KH; LAS unsigned char* KT = G + SC_KT; LAS unsigned char* VT = G + SC_VT; LAS float* FAC = (LAS float*)(G + SC_FAC);
    float* Lslot = Lbuf + (size_t)(scan * NSEG + seg) * 16384;
    f32x16 acc[4];
    if (OUT) {
        const float* Sin = Lbuf + (size_t)(scan * NSEG + seg - 1) * 16384;
#pragma unroll
        for (int dt = 0; dt < 4; ++dt)
#pragma unroll
            for (int i = 0; i < 16; ++i) acc[dt][i] = Sin[(32 * dt + crow(i, h5)) * 128 + e0 + r];
    } else {
#pragma unroll
        for (int dt = 0; dt < 4; ++dt)
#pragma unroll
            for (int i = 0; i < 16; ++i) acc[dt][i] = 0.f;
    }
    float tail_prev = 0.f, dlog_tot = 0.f;
    const bf16* zsrc = proj + (dir ? PO_ZB : PO_ZF) + (size_t)hh * MROWS * 128; const bf16* vsrc = proj + PO_BV + (size_t)hh * MROWS * 128; const bf16* qsrc = proj + PO_BQ + (size_t)hh * MROWS * 128;
    const int nch = ntok / 32;
    LAS unsigned char* RZ = G + SC_RZ; LAS unsigned char* RV = G + SC_RV; LAS unsigned char* RQ = G + SC_RQ;
#define SC_SETZ(k) (OUT ? RZ : ((k) == 0 ? RZ : (k) == 1 ? G + SC_QH : ldsb + 2 * SC_GRP + dir * 16384))
#define SC_SETV(k) (OUT ? RV : ((k) == 0 ? RV : (k) == 1 ? G + SC_KH : ldsb + 2 * SC_GRP + dir * 16384 + 8192))
#define SC_DMA(cc) do { const int rb_ = r0 + sgn * 32 * (cc); LAS unsigned char* dz_ = SC_SETZ((cc) % 3); LAS unsigned char* dv_ = SC_SETV((cc) % 3); \
        _Pragma("unroll") for (int i_ = 0; i_ < 2; ++i_) { const int s_ = 8 * w4 + 4 * i_ + (lane >> 4); const size_t so_ = (size_t)(rb_ + sgn * s_) * 128 + 8 * (lane & 15); \
            __builtin_amdgcn_global_load_lds((const unsigned*)(zsrc + so_), (LAS unsigned*)(dz_ + (8 * w4 + 4 * i_) * 256), 16, 0, 0); \
            __builtin_amdgcn_global_load_lds((const unsigned*)(vsrc + so_), (LAS unsigned*)(dv_ + (8 * w4 + 4 * i_) * 256), 16, 0, 0); \
            if (OUT) __builtin_amdgcn_global_load_lds((const unsigned*)(qsrc + so_), (LAS unsigned*)(RQ + (8 * w4 + 4 * i_) * 256), 16, 0, 0); } } while (0)
    SC_DMA(0);
    if (!OUT) SC_DMA(1);
    if (OUT) asm volatile("s_waitcnt vmcnt(0)" ::: "memory"); else asm volatile("s_waitcnt vmcnt(4)" ::: "memory");
    asm volatile("s_waitcnt lgkmcnt(0)" ::: "memory"); __builtin_amdgcn_s_barrier(); asm volatile("" ::: "memory");
    for (int k = 0; k < 2 * nch + 1; ++k) {
      const int kk = k - dir;
      if (kk >= 0 && kk < 2 * nch) {
        const int c = kk >> 1;
        const int rb = r0 + sgn * 32 * c;
        const LAS unsigned char* RZc = SC_SETZ(c % 3); const LAS unsigned char* RVc = SC_SETV(c % 3);
        if ((kk & 1) == 0) {
        float rsum = 0.f, lf[16], vv[16], qq[16];
        if (half) {
#pragma unroll
            for (int s = 0; s < 16; ++s) rsum += bf2f(*(const LAS unsigned short*)(RZc + s * 256 + d * 2));
        }
#pragma unroll
        for (int i = 0; i < 16; ++i) { const int so = (16 * half + i) * 256 + d * 2;
            lf[i] = bf2f(*(const LAS unsigned short*)(RZc + so)); vv[i] = bf2f(*(const LAS unsigned short*)(RVc + so)); if (OUT) qq[i] = bf2f(*(const LAS unsigned short*)(RQ + so)); }
        if (!half) {
#pragma unroll
            for (int i = 0; i < 16; ++i) rsum += lf[i];
        }
        float b = half ? rsum : 0.f, kh[16], qh[16];
#pragma unroll
        for (int i = 0; i < 16; ++i) { b += lf[i]; const float x = b - rsum;
            kh[i] = (1.0f - __expf(lf[i])) * __expf(fminf(-x, 60.f));
            if (OUT) qh[i] = qq[i] * __expf(fminf(x, 60.f)); }
        const float tail = b - rsum;
#pragma unroll
        for (int j = 0; j < 4; ++j) {
            u32x2 w; w.x = pk2(kh[4 * j], kh[4 * j + 1]); w.y = pk2(kh[4 * j + 2], kh[4 * j + 3]); *(LAS u32x2*)(KT + d * RST + 32 * half + 8 * j) = w;
            u32x2 v; v.x = pk2(vv[4 * j], vv[4 * j + 1]); v.y = pk2(vv[4 * j + 2], vv[4 * j + 3]); *(LAS u32x2*)(VT + d * RST + 32 * half + 8 * j) = v;
        }
        if (OUT) {
#pragma unroll
            for (int i = 0; i < 16; ++i) { const int s = 16 * half + i;
                *(LAS unsigned short*)(KH + s * RSQ + d * 2) = f2bf(kh[i]); *(LAS unsigned short*)(QH + s * RSQ + d * 2) = f2bf(qh[i]); }
        }
        if (half) { FAC[d] = __expf(tail_prev + rsum); tail_prev = tail; dlog_tot += rsum + tail; }
        } else {
        if (OUT) { if (c + 1 < nch) SC_DMA(c + 1); } else { if (c + 2 < nch) SC_DMA(c + 2); }
        asm volatile("" ::: "memory");
#pragma unroll
        for (int dt = 0; dt < 4; ++dt)
#pragma unroll
            for (int g4 = 0; g4 < 4; ++g4) { const f32x4 f = *(const LAS f32x4*)(FAC + 32 * dt + 8 * g4 + 4 * h5);
#pragma unroll
                for (int j = 0; j < 4; ++j) acc[dt][4 * g4 + j] *= f[j]; }
        if (OUT) {
            bf16x8 qf[8];
            f32x16 pT, oT;
#pragma unroll
            for (int i = 0; i < 16; ++i) { pT[i] = 0.f; oT[i] = 0.f; }
#pragma unroll
            for (int kk = 0; kk < 8; ++kk) {
                qf[kk] = lds_frag2(QH + r * RSQ + (16 * kk + 4 * h5) * 2, QH + r * RSQ + (16 * kk + 8 + 4 * h5) * 2);
                const bf16x8 kf = lds_frag2(KH + r * RSQ + (16 * kk + 4 * h5) * 2, KH + r * RSQ + (16 * kk + 8 + 4 * h5) * 2);
                pT = MFMA32(kf, qf[kk], pT);
            }
#pragma unroll
            for (int i = 0; i < 16; ++i) if (crow(i, h5) > r) pT[i] = 0.f;
#pragma unroll
            for (int dt = 0; dt < 4; ++dt)
#pragma unroll
                for (int ks = 0; ks < 2; ++ks) {
                    const bf16x8 sa = pack8(acc[dt][8 * ks], acc[dt][8 * ks + 1], acc[dt][8 * ks + 2], acc[dt][8 * ks + 3], acc[dt][8 * ks + 4], acc[dt][8 * ks + 5], acc[dt][8 * ks + 6], acc[dt][8 * ks + 7]);
                    oT = MFMA32(sa, qf[2 * dt + ks], oT);
                }
#pragma unroll
            for (int ks = 0; ks < 2; ++ks) {
                const bf16x8 pf = pack8(pT[8 * ks], pT[8 * ks + 1], pT[8 * ks + 2], pT[8 * ks + 3], pT[8 * ks + 4], pT[8 * ks + 5], pT[8 * ks + 6], pT[8 * ks + 7]);
                const bf16x8 va = lds_frag2(VT + (e0 + r) * RST + (16 * ks + 4 * h5) * 2, VT + (e0 + r) * RST + (16 * ks + 8 + 4 * h5) * 2);
                oT = MFMA32(va, pf, oT);
            }
            bf16* orow = oscr + ((size_t)(dir * 8 + hh) * NTOK + (rb + sgn * r)) * 128 + e0 + 4 * h5;
#pragma unroll
            for (int g4 = 0; g4 < 4; ++g4) { u32x2 o; o.x = pk2(oT[4 * g4], oT[4 * g4 + 1]); o.y = pk2(oT[4 * g4 + 2], oT[4 * g4 + 3]); *(u32x2*)(orow + 8 * g4) = o; }
        }
#pragma unroll
        for (int ks = 0; ks < 2; ++ks) {
            const bf16x8 vb = lds_frag2(VT + (e0 + r) * RST + (16 * ks + 8 * h5) * 2, VT + (e0 + r) * RST + (16 * ks + 8 * h5) * 2 + 8);
#pragma unroll
            for (int dt = 0; dt < 4; ++dt) {
                const bf16x8 ka = lds_frag2(KT + (32 * dt + r) * RST + (16 * ks + 8 * h5) * 2, KT + (32 * dt + r) * RST + (16 * ks + 8 * h5) * 2 + 8);
                acc[dt] = MFMA32(ka, vb, acc[dt]);
            }
        }
        if (OUT) { if (c + 1 < nch) asm volatile("s_waitcnt vmcnt(4)" ::: "memory"); }
        else { if (c + 2 < nch) asm volatile("s_waitcnt vmcnt(4)" ::: "memory"); else if (c + 1 < nch) asm volatile("s_waitcnt vmcnt(0)" ::: "memory"); }
        }
      }
      asm volatile("s_waitcnt lgkmcnt(0)" ::: "memory"); __builtin_amdgcn_s_barrier(); asm volatile("" ::: "memory");
    }
#undef SC_DMA
#undef SC_SETZ
#undef SC_SETV
    if (!OUT) {
        __syncthreads();
        if (half) { FAC[d] = __expf(tail_prev); Dlog[(size_t)(scan * NSEG + seg) * 128 + d] = dlog_tot; }
        __syncthreads();
#pragma unroll
        for (int dt = 0; dt < 4; ++dt)
#pragma unroll
            for (int g4 = 0; g4 < 4; ++g4) { const f32x4 f = *(const LAS f32x4*)(FAC + 32 * dt + 8 * g4 + 4 * h5);
#pragma unroll
                for (int j = 0; j < 4; ++j) Lslot[(32 * dt + 8 * g4 + 4 * h5 + j) * 128 + e0 + r] = acc[dt][4 * g4 + j] * f[j]; }
    }
    __syncthreads();
}

constexpr int AT_KC = 0, AT_VC = 36864, AT_KL = 70144, AT_VL = 116224, AT_END = 157696;
constexpr int KRS = 144, VCRS = 520, VLRS = 648, NSLOT = 10;
static_assert(AT_END <= MISC_OFF, "attention LDS");
static_assert(2 * SC_GRP + 2 * 16384 <= MISC_OFF, "scan LDS");
DI void attn_unit(LAS unsigned char* ldsb, const bf16* proj, const bf16* KR, const bf16* VTg, const float* rope, const float* sinks, bf16* yab, int kvh, int ab) {
    const int tid = threadIdx.x, lane = tid & 63, wave = __builtin_amdgcn_readfirstlane(tid >> 6), r = lane & 31, h5 = lane >> 5;
    const int head = kvh * 8 + wave;
    LAS unsigned char* KC = ldsb + AT_KC; LAS unsigned char* VC = ldsb + AT_VC; LAS unsigned char* KL = ldsb + AT_KL; LAS unsigned char* VL = ldsb + AT_VL;
    const float* rowcos = rope, *rowsin = rope + 4096, *colcos = rope + 8192, *colsin = rope + 8192 + 1024;
    __syncthreads();
    for (int p = tid; p < 2048; p += 512) {
        { const int key = p >> 3, c8 = p & 7; const u32x4 v = *(const u32x4*)(KR + ((size_t)(kvh * MROWS + NTOK + key)) * 64 + c8 * 8); *(LAS u32x4*)(KC + key * KRS + c8 * 16) = v; }
        { const int dd = p >> 5, c = p & 31; const u32x4 v = *(const u32x4*)(VTg + ((size_t)(kvh * 64 + dd)) * MROWS + NTOK + c * 8);
          u32x2 a; a.x = v.x; a.y = v.y; u32x2 b; b.x = v.z; b.y = v.w; *(LAS u32x2*)(VC + dd * VCRS + c * 16) = a; *(LAS u32x2*)(VC + dd * VCRS + c * 16 + 8) = b; }
    }
    const int T0 = ab * 4 - 4;
    for (int p = tid; p < 2304; p += 512) {
        { const int key = p >> 3, c8 = p & 7, T = T0 + (key >> 5), slot = (T + 2 * NSLOT) % NSLOT;
          if (T >= 0 && T < NTOK / 32) { const u32x4 v = *(const u32x4*)(KR + ((size_t)(kvh * MROWS + T * 32 + (key & 31))) * 64 + c8 * 8); *(LAS u32x4*)(KL + (slot * 32 + (key & 31)) * KRS + c8 * 16) = v; } }
        { const int dd = p / 36, c = p % 36, T = T0 + (c >> 2), slot = (T + 2 * NSLOT) % NSLOT;
          if (T >= 0 && T < NTOK / 32) { const u32x4 v = *(const u32x4*)(VTg + ((size_t)(kvh * 64 + dd)) * MROWS + T * 32 + (c & 3) * 8);
            u32x2 a; a.x = v.x; a.y = v.y; u32x2 b; b.x = v.z; b.y = v.w; LAS unsigned char* dst = VL + dd * VLRS + slot * 64 + (c & 3) * 16; *(LAS u32x2*)dst = a; *(LAS u32x2*)(dst + 8) = b; } }
    }
    const float sc = 0.125f * 1.4426950408889634f;
    u32x4 raw[4]; float cs[2][8], sn[2][8];
#define AT_LOADQ(P0) do { const int qp_ = (P0) + r; const bf16* qrow_ = proj + PO_AQ + ((size_t)head * MROWS + qp_) * 64 + 8 * h5; \
        _Pragma("unroll") for (int ks = 0; ks < 4; ++ks) raw[ks] = *(const u32x4*)(qrow_ + 16 * ks); \
        const float* c0_ = rowcos + (qp_ >> 6) * 16 + 8 * h5; const float* s0_ = rowsin + (qp_ >> 6) * 16 + 8 * h5; \
        const float* c1_ = colcos + (qp_ & 63) * 16 + 8 * h5; const float* s1_ = colsin + (qp_ & 63) * 16 + 8 * h5; \
        _Pragma("unroll") for (int j = 0; j < 8; ++j) { cs[0][j] = c0_[j]; sn[0][j] = s0_[j]; cs[1][j] = c1_[j]; sn[1][j] = s1_[j]; } } while (0)
    AT_LOADQ(ab * 128);
    __syncthreads();
    for (int qt = 0; qt < 4; ++qt) {
        const int p0 = ab * 128 + 32 * qt, kb0 = p0 - 128, qp = p0 + r, Tq = ab * 4 + qt - 4;
        bf16x8 qf[4];
#pragma unroll
        for (int ks = 0; ks < 2; ++ks) { float o1[8], o2[8];
#pragma unroll
            for (int q = 0; q < 4; ++q) {
                const float a0 = bflo(raw[ks][q]), a1 = bfhi(raw[ks][q]), b0 = bflo(raw[ks + 2][q]), b1 = bfhi(raw[ks + 2][q]);
                o1[2 * q] = a0 * cs[ks][2 * q] - b0 * sn[ks][2 * q]; o2[2 * q] = b0 * cs[ks][2 * q] + a0 * sn[ks][2 * q];
                o1[2 * q + 1] = a1 * cs[ks][2 * q + 1] - b1 * sn[ks][2 * q + 1]; o2[2 * q + 1] = b1 * cs[ks][2 * q + 1] + a1 * sn[ks][2 * q + 1]; }
            qf[ks] = pack8(o1[0], o1[1], o1[2], o1[3], o1[4], o1[5], o1[6], o1[7]);
            qf[ks + 2] = pack8(o2[0], o2[1], o2[2], o2[3], o2[4], o2[5], o2[6], o2[7]); }
        const int Tn = Tq + 9; const bool pre = (qt < 3) && Tn >= 0 && Tn < NTOK / 32; u32x4 nk = {0u, 0u, 0u, 0u};
        if (pre) { if (tid < 256) nk = *(const u32x4*)(KR + ((size_t)(kvh * MROWS + Tn * 32 + (tid >> 3))) * 64 + (tid & 7) * 8);
                   else { const int t2 = tid - 256; nk = *(const u32x4*)(VTg + ((size_t)(kvh * 64 + (t2 >> 2))) * MROWS + Tn * 32 + (t2 & 3) * 8); } }
        if (qt < 3) AT_LOADQ(p0 + 32);
        float m_run = sinks[head] * 1.4426950408889634f, l_run = h5 ? 0.f : 1.f;
        f32x16 o0, o1;
#pragma unroll
        for (int i = 0; i < 16; ++i) { o0[i] = 0.f; o1[i] = 0.f; }
        for (int kt = 0; kt < 17; ++kt) {
            const bool lat = kt >= 8; const int j = kt - 8, T = Tq + j, kb = kb0 + 32 * j, slot = (T + 2 * NSLOT) % NSLOT;
            if (lat && (T < 0 || T >= NTOK / 32)) continue;
            const LAS unsigned char* Kb = lat ? KL + (32 * slot + r) * KRS : KC + (32 * kt + r) * KRS;
            const LAS unsigned char* Vb = lat ? VL + r * VLRS + 64 * slot : VC + r * VCRS + 64 * kt;
            const int vrs32 = 32 * (lat ? VLRS : VCRS); const bool edge = lat && (j == 0 || j == 8);
            f32x16 s;
#pragma unroll
            for (int i = 0; i < 16; ++i) s[i] = 0.f;
#pragma unroll
            for (int ks = 0; ks < 4; ++ks) { const bf16x8 kf = *(const LAS bf16x8*)(Kb + (16 * ks + 8 * h5) * 2); s = MFMA32(kf, qf[ks], s); }
            float mt = -INFINITY;
#pragma unroll
            for (int i = 0; i < 16; ++i) { float v = s[i] * sc;
                if (edge) { const int dk = kb + crow(i, h5) - qp; if (dk > 128 || dk < -128) v = -INFINITY; }
                s[i] = v; mt = fmaxf(mt, v); }
            mt = fmaxf(mt, __shfl_xor(mt, 32));
            const float mn = fmaxf(m_run, mt);
            if (__any(mn > m_run)) { const float alpha = __builtin_amdgcn_exp2f(m_run - mn); l_run *= alpha;
#pragma unroll
                for (int i = 0; i < 16; ++i) { o0[i] *= alpha; o1[i] *= alpha; } }
            m_run = mn;
            float ps = 0.f;
#pragma unroll
            for (int i = 0; i < 16; ++i) { const float p = __builtin_amdgcn_exp2f(s[i] - mn); s[i] = p; ps += p; }
            l_run += ps;
#pragma unroll
            for (int ks = 0; ks < 2; ++ks) {
                const bf16x8 pf = pack8(s[8 * ks], s[8 * ks + 1], s[8 * ks + 2], s[8 * ks + 3], s[8 * ks + 4], s[8 * ks + 5], s[8 * ks + 6], s[8 * ks + 7]);
                const bf16x8 v0 = lds_frag2(Vb + (16 * ks + 4 * h5) * 2, Vb + (16 * ks + 8 + 4 * h5) * 2);
                const bf16x8 v1 = lds_frag2(Vb + vrs32 + (16 * ks + 4 * h5) * 2, Vb + vrs32 + (16 * ks + 8 + 4 * h5) * 2);
                o0 = MFMA32(v0, pf, o0);
                o1 = MFMA32(v1, pf, o1);
            }
        }
        const float l = l_run + __shfl_xor(l_run, 32), inv = 1.0f / l;
        bf16* orow = yab + (size_t)qp * D + head * 64 + 4 * h5;
#pragma unroll
        for (int g4 = 0; g4 < 4; ++g4) {
            u32x2 a; a.x = pk2(o0[4 * g4] * inv, o0[4 * g4 + 1] * inv); a.y = pk2(o0[4 * g4 + 2] * inv, o0[4 * g4 + 3] * inv); *(u32x2*)(orow + 8 * g4) = a;
            u32x2 b; b.x = pk2(o1[4 * g4] * inv, o1[4 * g4 + 1] * inv); b.y = pk2(o1[4 * g4 + 2] * inv, o1[4 * g4 + 3] * inv); *(u32x2*)(orow + 32 + 8 * g4) = b;
        }
        if (pre) { const int slot = (Tn + 2 * NSLOT) % NSLOT;
            if (tid < 256) *(LAS u32x4*)(KL + (slot * 32 + (tid >> 3)) * KRS + (tid & 7) * 16) = nk;
            else { const int t2 = tid - 256; u32x2 a; a.x = nk.x; a.y = nk.y; u32x2 b; b.x = nk.z; b.y = nk.w; LAS unsigned char* dst = VL + (t2 >> 2) * VLRS + slot * 64 + (t2 & 3) * 16; *(LAS u32x2*)dst = a; *(LAS u32x2*)(dst + 8) = b; } }
        __syncthreads();
    }
#undef AT_LOADQ
}

typedef const Args __attribute__((address_space(4))) ArgsC;
DI ArgsC* args_ptr() { ArgsC* p = (ArgsC*)__builtin_amdgcn_kernarg_segment_ptr(); asm volatile("" : "+s"(p)); return p; }
#define PH_BEGIN ArgsC* A = args_ptr(); unsigned char* const ws = A->ws; (void)ws
#define modl ((float*)(ws + WS_SMALL + SM_MODL))
#define modc ((float*)(ws + WS_SMALL + SM_MODC))
#define rope ((float*)(ws + WS_SMALL + SM_ROPE))
#define lbf ((float*)(ws + WS_SMALL + SM_LB))
#define lbb (lbf + 1024)
#define wrp ((float*)(ws + WS_SMALL + SM_WRP))
#define cvec ((float*)(ws + WS_SMALL + SM_CVEC))
#define tile_expert ((int*)(ws + WS_SMALL + SM_TILE))
#define ntiles_p (tile_expert + 512)
#define rt_e ((int*)(ws + WS_ROUTE + RT_E))
#define rt_g ((float*)(ws + WS_ROUTE + RT_G))
#define rt_r ((int*)(ws + WS_ROUTE + RT_R))
#define rt_s ((int*)(ws + WS_ROUTE + RT_S))
#define slot_rowoff ((unsigned*)(ws + WS_ROUTE + RT_OFF))
#define slot_gate ((float*)(ws + WS_ROUTE + RT_SG))
#define Dlog ((float*)(ws + WS_DLOG))
#define KR ((bf16*)(ws + WS_KR))
#define VTg ((bf16*)(ws + WS_VT))
#define Lbuf ((float*)(ws + WS_L))
#define WIN ((bf16*)(ws + WS_WIN))
#define WM ((bf16*)(ws + WS_WM))
#define WO ((bf16*)(ws + WS_WO))
#define WGU ((bf16*)(ws + WS_WGU))
#define WDN ((bf16*)(ws + WS_WDN))
#define H ((bf16*)(ws + WS_H))
#define PROJ ((bf16*)(ws + WS_PROJ))
#define ACT ((bf16*)(ws + WS_ACT))
#define YAB ((bf16*)(ws + WS_YAB))
#define OSCR ((bf16*)(ws + WS_OSCR))
#define MERGED ((bf16*)(ws + WS_MERGED))
#define X1 ((float*)(ws + WS_X1))
#define YS ((bf16*)(ws + WS_YS))

__global__ void __launch_bounds__(NWAVES * 64, 2) fwd_kernel(Args a_unused) {
    extern __shared__ __attribute__((aligned(16))) unsigned char lds_raw[];
    LAS unsigned char* lds = (LAS unsigned char*)lds_raw;
    volatile LAS unsigned* MISC = (volatile LAS unsigned*)(lds + MISC_OFF);
    const int tid = threadIdx.x, lane = tid & 63, wave = __builtin_amdgcn_readfirstlane(tid >> 6);
    const int G = gridDim.x, bx = blockIdx.x, vcu = (G % 8 == 0) ? (bx % 8) * (G / 8) + bx / 8 : bx;
    const int gw = vcu * NWAVES + wave, NGW = G * NWAVES;
    const int gtid = vcu * 512 + tid, NGT = G * 512;
    unsigned* ctl; { const ArgsC* A0 = args_ptr(); ctl = (unsigned*)(A0->ws + WS_CTL); }
    if (tid < 64) MISC[tid] = 0u;
    __syncthreads();
    XcdBarrier bar = xcd_barrier_post(ctl + CW_BAR, MISC);
    int lo, hi; { const ArgsC* A0 = args_ptr(); lo = A0->ph_lo; hi = A0->ph_hi; }
#ifndef PH_MASK
#define PH_MASK 0x1fff
#endif
#define IN(k) ((((PH_MASK) >> (k)) & 1) && lo <= (k) && (k) < hi)
#define SEAM(k) do { if (IN(k) && IN((k) + 1)) xcd_barrier(bar); } while (0)

    if (IN(0)) {
        PH_BEGIN;
        if (vcu < 48) {
            LAS float* sc = (LAS float*)lds; LAS float* scc = sc + 2048; LAS f32x4* red = (LAS f32x4*)(lds + 16384);
            for (int k = tid; k < 2048; k += 512) { const float v = A->c[k], u = A->c_ctx[k]; sc[k] = v * sigmoidf_(v); scc[k] = u * sigmoidf_(u); }
            __syncthreads();
            const int cb = vcu, col = 256 * cb + 4 * lane; const bool hasc = cb < 16;
            f32x4 al = {0.f, 0.f, 0.f, 0.f}, ac = {0.f, 0.f, 0.f, 0.f};
#pragma unroll 8
            for (int k = wave; k < 2048; k += 8) { const f32x4 wv = *(const f32x4*)(A->w_mod + (size_t)k * 12288 + col); al += sc[k] * wv; ac += scc[k] * wv; }
            red[wave * 64 + lane] = al; red[512 + wave * 64 + lane] = ac;
            __syncthreads();
            if (wave == 0) { f32x4 s = *(const f32x4*)(A->b_mod + col), t = s;
#pragma unroll
                for (int w = 0; w < 8; ++w) { s += red[w * 64 + lane]; t += red[512 + w * 64 + lane]; }
                *(f32x4*)(modl + col) = s; if (hasc) *(f32x4*)(modc + col) = t; }
            __syncthreads();
        } else if (vcu == 48) {
            for (int i = tid; i < 4096 + 1024; i += 512) { const bool isrow = i < 4096; const int ii = isrow ? i : i - 4096, p = ii >> 4, j = ii & 15;
                const float inv = powf(10000.0f, -(float)j / 16.0f), ang = (float)p * inv; float s, c; sincosf(ang, &s, &c);
                if (isrow) { rope[ii] = c; rope[4096 + ii] = s; } else { rope[8192 + ii] = c; rope[9216 + ii] = s; } }
            for (int i = tid; i < 2048; i += 512) { const float* lg = (i < 1024) ? A->lbf_logits : A->lbb_logits; const int ch = i & 1023;
                const float v = 1.0f / (1.0f + expf(lg[1024 + ch] - lg[ch])); if (i < 1024) lbf[ch] = v; else lbb[ch] = v; }
            __syncthreads();
        }
        { LAS unsigned char* scr = lds + wave * 9216;
          for (int r = gw; r < 2048; r += NGW) {
              if (r < 1024) { const int br = r >> 9, r2 = r & 511, kb = r2 >> 5, nb = r2 & 31;
                  p0_transpose64(A->w_branch + (size_t)br * 1024 * D + (size_t)(64 * kb) * D + 64 * nb, D, WM + (size_t)(64 * nb) * D + br * 1024 + 64 * kb, D, scr, lane); }
              else { const int r2 = r - 1024, kb = r2 >> 5, nb = r2 & 31; p0_transpose64(A->w_out + (size_t)(64 * kb) * D + 64 * nb, D, WO + (size_t)(64 * nb) * D + 64 * kb, D, scr, lane); } }
          __syncthreads(); }
        { constexpr int NQ = INC / 32 + 4096 + 2048;
          const int n4 = lane & 7, kr = lane >> 3;
          LAS float* smax = (LAS float*)(lds + 32 * 2064);
          f32x4 v[8][4];
          const float* Wp; int ldw; signed char* Qp; float* csp;
#define Q_ITEM(idx) do { int it_ = (idx); \
              if (it_ < INC / 32) { Wp = A->w_in + 32 * it_; ldw = INC; Qp = (signed char*)(ws + WS_WIN) + (size_t)(32 * it_) * 2048; csp = (float*)(ws + WS_CS + CS_WIN) + 32 * it_; } \
              else if (it_ < INC / 32 + 4096) { it_ -= INC / 32; const int e_ = it_ >> 7, wh_ = (it_ >> 6) & 1, n0_ = 32 * (it_ & 63), np_ = e_ * 4096 + (n0_ >> 7) * 256 + wh_ * 128 + (n0_ & 127); \
                  Wp = (wh_ ? A->w_e_up : A->w_e_gate) + (size_t)e_ * D * FF + n0_; ldw = FF; Qp = (signed char*)(ws + WS_WGU) + (size_t)np_ * 2048; csp = (float*)(ws + WS_CS) + np_; } \
              else { it_ -= INC / 32 + 4096; const int e_ = it_ >> 6, n0_ = 32 * (it_ & 63); \
                  Wp = A->w_e_down + (size_t)e_ * FF * D + n0_; ldw = D; Qp = (signed char*)(ws + WS_WDN) + ((size_t)e_ * D + n0_) * 2048; csp = (float*)(ws + WS_DLOG + DL_CSD) + e_ * D + n0_; } } while (0)
#define Q_LOAD() do { _Pragma("unroll") for (int g = 0; g < 8; ++g) _Pragma("unroll") for (int r = 0; r < 4; ++r) v[g][r] = *(const f32x4*)(Wp + (size_t)(256 * g + 32 * wave + 4 * kr + r) * ldw + 4 * n4); } while (0)
          int cur = vcu;
          if (cur < NQ) { Q_ITEM(cur); Q_LOAD(); }
          while (cur < NQ) {
              unsigned nxt = 0u; if (tid == 0) nxt = (unsigned)G + atomicAdd(ctl + CW_Q, 1u);
              signed char* Qc = Qp; float* csc = csp;
              f32x4 mx = {0.f, 0.f, 0.f, 0.f};
#pragma unroll
              for (int g = 0; g < 8; ++g)
#pragma unroll
                  for (int r = 0; r < 4; ++r) { mx[0] = fmaxf(mx[0], fabsf(v[g][r][0])); mx[1] = fmaxf(mx[1], fabsf(v[g][r][1])); mx[2] = fmaxf(mx[2], fabsf(v[g][r][2])); mx[3] = fmaxf(mx[3], fabsf(v[g][r][3])); }
#pragma unroll
              for (int c = 0; c < 4; ++c) { float m = mx[c]; m = fmaxf(m, __shfl_xor(m, 8)); m = fmaxf(m, __shfl_xor(m, 16)); m = fmaxf(m, __shfl_xor(m, 32)); mx[c] = m; }
              __syncthreads();
              if (kr == 0) *(LAS f32x4*)(smax + wave * 32 + 4 * n4) = mx;
              __syncthreads();
              f32x4 cm = *(const LAS f32x4*)(smax + 4 * n4);
#pragma unroll
              for (int ww = 1; ww < 8; ++ww) { const f32x4 o = *(const LAS f32x4*)(smax + ww * 32 + 4 * n4); cm[0] = fmaxf(cm[0], o[0]); cm[1] = fmaxf(cm[1], o[1]); cm[2] = fmaxf(cm[2], o[2]); cm[3] = fmaxf(cm[3], o[3]); }
              f32x4 inv;
#pragma unroll
              for (int c = 0; c < 4; ++c) { if (cm[c] == 0.f) cm[c] = 1.f; inv[c] = 127.0f / cm[c]; }
              if (wave == 0 && kr == 0) { f32x4 sc; sc[0] = cm[0] * (1.0f / 127.0f); sc[1] = cm[1] * (1.0f / 127.0f); sc[2] = cm[2] * (1.0f / 127.0f); sc[3] = cm[3] * (1.0f / 127.0f); *(f32x4*)(csc + 4 * n4) = sc; }
#pragma unroll
              for (int g = 0; g < 8; ++g)
#pragma unroll
                  for (int c = 0; c < 4; ++c) { unsigned pk = 0u;
#pragma unroll
                      for (int r = 0; r < 4; ++r) { const int q = (int)rintf(v[g][r][c] * inv[c]); pk |= ((unsigned)q & 0xffu) << (8 * r); }
                      *(LAS unsigned*)(lds + (4 * n4 + c) * 2064 + 4 * (64 * g + 8 * wave + kr)) = pk; }
              if (tid == 0) MISC[2] = nxt;
              __syncthreads();
              const int nx = (int)MISC[2];
              if (nx < NQ) { Q_ITEM(nx); Q_LOAD(); }
#pragma unroll
              for (int i = 0; i < 8; ++i) { const int p = tid + 512 * i, row = p >> 7, pc = p & 127; const u32x4 o = *(const LAS u32x4*)(lds + row * 2064 + pc * 16); *(u32x4*)(Qc + (size_t)row * 2048 + pc * 16) = o; }
              cur = nx;
          }
#undef Q_ITEM
#undef Q_LOAD
        }
    }
    SEAM(0);

    if (IN(1)) {
        PH_BEGIN;
        {
            f32x4 ca[8], cb[8];
#pragma unroll
            for (int j = 0; j < 8; ++j) { const int k = 4 * lane + 256 * j; const f32x4 g = *(const f32x4*)(A->norm_mix_g + k), s1 = *(const f32x4*)(modl + 2048 + k); ca[j] = g * (1.0f + s1); cb[j] = *(const f32x4*)(modl + k); }
            f32x4 v[8], vn[8];
            { const float* xr = A->x + (size_t)gw * D + 4 * lane;
#pragma unroll
              for (int j = 0; j < 8; ++j) v[j] = *(const f32x4*)(xr + 256 * j); }
            for (int m = gw; m < NTOK; m += NGW) {
                if (m + NGW < NTOK) { const float* xn = A->x + (size_t)(m + NGW) * D + 4 * lane;
#pragma unroll
                    for (int j = 0; j < 8; ++j) vn[j] = *(const f32x4*)(xn + 256 * j); }
                float ss = 0.f;
#pragma unroll
                for (int j = 0; j < 8; ++j) ss += v[j][0] * v[j][0] + v[j][1] * v[j][1] + v[j][2] * v[j][2] + v[j][3] * v[j][3];
                const float rstd = rsqrtf(wave_sum(ss) * (1.0f / D) + EPS);
                float am = 0.f;
#pragma unroll
                for (int j = 0; j < 8; ++j) { v[j] = v[j] * rstd * ca[j] + cb[j]; am = fmaxf(am, fmaxf(fmaxf(fabsf(v[j][0]), fabsf(v[j][1])), fmaxf(fabsf(v[j][2]), fabsf(v[j][3])))); }
#pragma unroll
                for (int o = 1; o < 64; o <<= 1) am = fmaxf(am, __shfl_xor(am, o));
                if (am == 0.f) am = 1.f;
                const float qi = 127.0f / am;
                if (lane == 0) ((float*)(ws + WS_CS + CS_HROW))[m] = am * (1.0f / 127.0f);
                unsigned* hq = (unsigned*)((signed char*)(ws + WS_H) + (size_t)m * D + 4 * lane);
#pragma unroll
                for (int j = 0; j < 8; ++j) { const int q0 = (int)rintf(v[j][0] * qi), q1 = (int)rintf(v[j][1] * qi), q2 = (int)rintf(v[j][2] * qi), q3 = (int)rintf(v[j][3] * qi);
                    hq[64 * j] = ((unsigned)q0 & 0xffu) | (((unsigned)q1 & 0xffu) << 8) | (((unsigned)q2 & 0xffu) << 16) | (((unsigned)q3 & 0xffu) << 24); }
#pragma unroll
                for (int j = 0; j < 8; ++j) v[j] = vn[j];
            }
        }
        if (gw < NCTX) {
            const int m = gw; const float* xr = A->ctx + (size_t)m * D + 4 * lane; f32x4 v[8]; float ss = 0.f;
#pragma unroll
            for (int j = 0; j < 8; ++j) { v[j] = *(const f32x4*)(xr + 256 * j); ss += v[j][0] * v[j][0] + v[j][1] * v[j][1] + v[j][2] * v[j][2] + v[j][3] * v[j][3]; }
            const float rstd = rsqrtf(wave_sum(ss) * (1.0f / D) + EPS);
            float am = 0.f;
#pragma unroll
            for (int j = 0; j < 8; ++j) { const int k = 4 * lane + 256 * j; const f32x4 g = *(const f32x4*)(A->norm_mix_g + k), s1 = *(const f32x4*)(modc + 2048 + k), s0 = *(const f32x4*)(modc + k);
                v[j] = v[j] * rstd * (g * (1.0f + s1)) + s0; am = fmaxf(am, fmaxf(fmaxf(fabsf(v[j][0]), fabsf(v[j][1])), fmaxf(fabsf(v[j][2]), fabsf(v[j][3])))); }
#pragma unroll
            for (int o = 1; o < 64; o <<= 1) am = fmaxf(am, __shfl_xor(am, o));
            if (am == 0.f) am = 1.f;
            const float qi = 127.0f / am;
            if (lane == 0) ((float*)(ws + WS_CS + CS_HROW))[NTOK + m] = am * (1.0f / 127.0f);
            unsigned* hq = (unsigned*)((signed char*)(ws + WS_H) + (size_t)(NTOK + m) * D + 4 * lane);
#pragma unroll
            for (int j = 0; j < 8; ++j) { const int q0 = (int)rintf(v[j][0] * qi), q1 = (int)rintf(v[j][1] * qi), q2 = (int)rintf(v[j][2] * qi), q3 = (int)rintf(v[j][3] * qi);
                hq[64 * j] = ((unsigned)q0 & 0xffu) | (((unsigned)q1 & 0xffu) << 8) | (((unsigned)q2 & 0xffu) << 16) | (((unsigned)q3 & 0xffu) << 24); }
        }
        for (int i = gtid; i < 2048 * 32; i += NGT) { const int k = i >> 5; wrp[i] = A->norm_ffn_g[k] * (1.0f + modl[4 * 2048 + k]) * A->w_router[i]; }
        if (vcu == G - 1) {
            for (int e = wave * 4; e < wave * 4 + 4; ++e) { float s = 0.f; for (int k = lane; k < 2048; k += 64) s += modl[3 * 2048 + k] * A->w_router[k * 32 + e];
                s = wave_sum(s); if (lane == 0) cvec[e] = s + A->b_router[e]; }
        }
    }
    SEAM(1);

    if (IN(2)) {
        PH_BEGIN;
        pg8::Gemm g{H, WIN, D / 2}; pg8::PlainOrder S; S.init(MROWS / 256, INC / 256, G, bx); S.K2 = D;
        EpiProj E{PROJ, lbf, lbb, (const float*)(ws + WS_CS + CS_HROW), (const float*)(ws + WS_CS + CS_WIN)};
        pg8::gemm_phase<EpiProj, pg8::PlainOrder, true>(lds, g, S, E);
    }
    SEAM(2);

    if (IN(3)) {
        PH_BEGIN;
        for (int i = gtid; i < MROWS * 8; i += NGT) { const int jg = i & 3, kvh = (i >> 2) & 1, pos = i >> 3, j0 = 8 * jg;
            const bf16* kr = PROJ + PO_AKV + (size_t)pos * 256 + kvh * 64 + j0; const u32x4 a1 = *(const u32x4*)kr, a2 = *(const u32x4*)(kr + 32); u32x4 w1 = a1, w2 = a2;
            if (pos < NTOK) { const float* ct = (jg < 2) ? rope + (pos >> 6) * 16 + j0 : rope + 8192 + (pos & 63) * 16 + j0 - 16; const float* st = ct + ((jg < 2) ? 4096 : 1024);
                const f32x4 c0 = *(const f32x4*)ct, c1 = *(const f32x4*)(ct + 4), s0 = *(const f32x4*)st, s1 = *(const f32x4*)(st + 4);
#pragma unroll
                for (int q = 0; q < 4; ++q) { const float cl = q < 2 ? c0[2 * q] : c1[2 * q - 4], ch = q < 2 ? c0[2 * q + 1] : c1[2 * q - 3], sl = q < 2 ? s0[2 * q] : s1[2 * q - 4], sh = q < 2 ? s0[2 * q + 1] : s1[2 * q - 3];
                    const float k1l = bflo(a1[q]), k1h = bfhi(a1[q]), k2l = bflo(a2[q]), k2h = bfhi(a2[q]);
                    w1[q] = pk2(k1l * cl - k2l * sl, k1h * ch - k2h * sh); w2[q] = pk2(k2l * cl + k1l * sl, k2h * ch + k1h * sh); } }
            bf16* ko = KR + ((size_t)kvh * MROWS + pos) * 64 + j0; *(u32x4*)ko = w1; *(u32x4*)(ko + 32) = w2; }
        for (int i = gtid; i < 2 * (MROWS / 8) * 64; i += NGT) { const int dd = i & 63, pb = (i >> 6) % (MROWS / 8), kvh = (i >> 6) / (MROWS / 8);
            const bf16* vr = PROJ + PO_AKV + (size_t)(pb * 8) * 256 + 128 + kvh * 64 + dd; unsigned short t[8];
#pragma unroll
            for (int q = 0; q < 8; ++q) t[q] = vr[(size_t)q * 256];
            u32x4 w; w.x = t[0] | ((unsigned)t[1] << 16); w.y = t[2] | ((unsigned)t[3] << 16); w.z = t[4] | ((unsigned)t[5] << 16); w.w = t[6] | ((unsigned)t[7] << 16);
            *(u32x4*)(VTg + ((size_t)kvh * 64 + dd) * MROWS + pb * 8) = w; }
        for (int it = vcu; it < 8 * (NSEG - 1); it += G) { const int hh = it >> 5, seg = it & 31; scan_segment<false>(lds, PROJ, hh, seg, seg, Lbuf, Dlog, (bf16*)nullptr); }
    }
    SEAM(3);

    if (IN(4)) {
        PH_BEGIN;
        for (int i = gtid; i < 16 * 16384; i += NGT) { const int scan = i >> 14, el = i & 16383, dd = el >> 7; float s = 0.f, lv[NSEG - 1], dv[NSEG - 1];
#pragma unroll
            for (int j = 0; j < NSEG - 1; ++j) { lv[j] = Lbuf[(size_t)(scan * NSEG + j) * 16384 + el]; dv[j] = Dlog[(scan * NSEG + j) * 128 + dd]; }
#pragma unroll
            for (int j = 0; j < NSEG - 1; ++j) { s = __expf(dv[j]) * s + lv[j]; Lbuf[(size_t)(scan * NSEG + j) * 16384 + el] = s; } }
        for (int u = vcu; u < 256; u += G) attn_unit(lds, PROJ, KR, VTg, rope, A->sinks, YAB, u >> 7, u & 127);
    }
    SEAM(4);

    if (IN(5)) {
        PH_BEGIN;
        for (int it = vcu; it < 8 * 32; it += G) { const int hh = it >> 5, segF = 1 + (it & 31);
            scan_segment<true>(lds, PROJ, hh, segF, NSEG - segF, Lbuf, Dlog, OSCR);
            VM_WAIT(); __syncthreads();
            { const int l16 = lane & 15, tq = lane >> 4; const f32x4 hg0 = *(const f32x4*)(A->hgrn_g + hh * 128 + 8 * l16), hg1 = *(const f32x4*)(A->hgrn_g + hh * 128 + 8 * l16 + 4);
              for (int i0 = wave * 64; i0 < wave * 64 + 64; i0 += 16) {
                u32x4 fw[4], bw[4], gq[4];
#pragma unroll
                for (int b = 0; b < 4; ++b) { const int row = (segF - 1) * 512 + i0 + 4 * b + tq;
                    fw[b] = *(const u32x4*)(OSCR + ((size_t)hh * NTOK + row) * 128 + 8 * l16); bw[b] = *(const u32x4*)(OSCR + ((size_t)(8 + hh) * NTOK + row) * 128 + 8 * l16);
                    gq[b] = *(const u32x4*)(PROJ + PO_BG + ((size_t)hh * MROWS + row) * 128 + 8 * l16); }
#pragma unroll
                for (int b = 0; b < 4; ++b) { const int row = (segF - 1) * 512 + i0 + 4 * b + tq;
                    f32x4 o0, o1; o0[0] = bflo(fw[b].x) + bflo(bw[b].x); o0[1] = bfhi(fw[b].x) + bfhi(bw[b].x); o0[2] = bflo(fw[b].y) + bflo(bw[b].y); o0[3] = bfhi(fw[b].y) + bfhi(bw[b].y);
                    o1[0] = bflo(fw[b].z) + bflo(bw[b].z); o1[1] = bfhi(fw[b].z) + bfhi(bw[b].z); o1[2] = bflo(fw[b].w) + bflo(bw[b].w); o1[3] = bfhi(fw[b].w) + bfhi(bw[b].w);
                    float ss = o0[0] * o0[0] + o0[1] * o0[1] + o0[2] * o0[2] + o0[3] * o0[3] + o1[0] * o1[0] + o1[1] * o1[1] + o1[2] * o1[2] + o1[3] * o1[3];
                    ss += __shfl_xor(ss, 1); ss += __shfl_xor(ss, 2); ss += __shfl_xor(ss, 4); ss += __shfl_xor(ss, 8);
                    const float rstd = rsqrtf(ss * (1.0f / 128.0f) + EPS);
                    u32x4 w; w.x = pk2(o0[0] * rstd * hg0[0] * bflo(gq[b].x), o0[1] * rstd * hg0[1] * bfhi(gq[b].x)); w.y = pk2(o0[2] * rstd * hg0[2] * bflo(gq[b].y), o0[3] * rstd * hg0[3] * bfhi(gq[b].y));
                    w.z = pk2(o1[0] * rstd * hg1[0] * bflo(gq[b].z), o1[1] * rstd * hg1[1] * bfhi(gq[b].z)); w.w = pk2(o1[2] * rstd * hg1[2] * bflo(gq[b].w), o1[3] * rstd * hg1[3] * bfhi(gq[b].w));
                    *(u32x4*)(YAB + (size_t)row * D + 1024 + hh * 128 + 8 * l16) = w; } } }
            __syncthreads();
        }
    }
    SEAM(5);

    if (IN(6)) {
        PH_BEGIN;
        pg8::Gemm g{YAB, WM, D}; pg8::PlainOrder S; S.init(NTOK / 256, D / 256, G, bx); S.K2 = D * 2;
        EpiMerge E{MERGED, PROJ};
        pg8::gemm_phase<EpiMerge, pg8::PlainOrder>(lds, g, S, E);
    }
    SEAM(6);

    if (IN(7)) {
        PH_BEGIN;
        pg8::Gemm g{MERGED, WO, D}; pg8::PlainOrder S; S.init(NTOK / 256, D / 256, G, bx); S.K2 = D * 2;
        EpiOut E{X1, A->x, modl + 2 * 2048};
        pg8::gemm_phase<EpiOut, pg8::PlainOrder>(lds, g, S, E);
    }
    SEAM(7);

    if (IN(8)) {
        PH_BEGIN;
        LAS float* part = (LAS float*)lds;
        LAS float* rsd = (LAS float*)(lds + 16384);
        const int r16 = lane & 15, kk = lane >> 4;
        for (int tl = vcu; tl < NTOK / 16; tl += G) {
            const int row0 = tl * 16;
#pragma unroll
            for (int q = 0; q < 2; ++q) { const int m = row0 + 2 * wave + q; const float* xr = X1 + (size_t)m * D + 4 * lane; f32x4 v[8]; float ss = 0.f;
#pragma unroll
                for (int j = 0; j < 8; ++j) { v[j] = *(const f32x4*)(xr + 256 * j); ss += v[j][0] * v[j][0] + v[j][1] * v[j][1] + v[j][2] * v[j][2] + v[j][3] * v[j][3]; }
                const float rstd = rsqrtf(wave_sum(ss) * (1.0f / D) + EPS);
                if (lane == 0) rsd[2 * wave + q] = rstd;
                float am = 0.f;
#pragma unroll
                for (int j = 0; j < 8; ++j) { const int k = 4 * lane + 256 * j; const f32x4 g = *(const f32x4*)(A->norm_ffn_g + k), s1 = *(const f32x4*)(modl + 4 * 2048 + k), s0 = *(const f32x4*)(modl + 3 * 2048 + k);
                    v[j] = v[j] * rstd * (g * (1.0f + s1)) + s0; am = fmaxf(am, fmaxf(fmaxf(fabsf(v[j][0]), fabsf(v[j][1])), fmaxf(fabsf(v[j][2]), fabsf(v[j][3])))); }
#pragma unroll
                for (int o = 1; o < 64; o <<= 1) am = fmaxf(am, __shfl_xor(am, o));
                if (am == 0.f) am = 1.f;
                const float qi = 127.0f / am;
                if (lane == 0) ((float*)(ws + WS_CS + CS_ROW))[m] = am * (1.0f / 127.0f);
                unsigned* hq = (unsigned*)((signed char*)(ws + WS_H) + (size_t)m * D + 4 * lane);
#pragma unroll
                for (int j = 0; j < 8; ++j) { const int q0 = (int)rintf(v[j][0] * qi), q1 = (int)rintf(v[j][1] * qi), q2 = (int)rintf(v[j][2] * qi), q3 = (int)rintf(v[j][3] * qi);
                    hq[64 * j] = ((unsigned)q0 & 0xffu) | (((unsigned)q1 & 0xffu) << 8) | (((unsigned)q2 & 0xffu) << 16) | (((unsigned)q3 & 0xffu) << 24); } }
            float bw[16][4][2];
            { int zz = 0; asm volatile("" : "+v"(zz));
#pragma unroll
              for (int kg = 0; kg < 16; ++kg)
#pragma unroll
                for (int m = 0; m < 4; ++m)
#pragma unroll
                    for (int eh = 0; eh < 2; ++eh) bw[kg][m][eh] = wrp[(256 * wave + 16 * kg + 4 * kk + m) * 32 + 16 * eh + r16 + zz]; }
            f32x4 acc0 = {0.f, 0.f, 0.f, 0.f}, acc1 = {0.f, 0.f, 0.f, 0.f};
            const float* xa = X1 + (size_t)(row0 + r16) * D + 256 * wave + 4 * kk;
#pragma unroll
            for (int kg = 0; kg < 16; ++kg) { const f32x4 av = *(const f32x4*)(xa + 16 * kg);
#pragma unroll
                for (int m = 0; m < 4; ++m) { acc0 = __builtin_amdgcn_mfma_f32_16x16x4f32(av[m], bw[kg][m][0], acc0, 0, 0, 0); acc1 = __builtin_amdgcn_mfma_f32_16x16x4f32(av[m], bw[kg][m][1], acc1, 0, 0, 0); } }
#pragma unroll
            for (int q = 0; q < 4; ++q) { part[(wave * 16 + 4 * kk + q) * 32 + r16] = acc0[q]; part[(wave * 16 + 4 * kk + q) * 32 + 16 + r16] = acc1[q]; }
            __syncthreads();
            { const int row = tid >> 5, e = tid & 31; float s = 0.f;
#pragma unroll
              for (int w = 0; w < 8; ++w) s += part[(w * 16 + row) * 32 + e];
              float val = rsd[row] * s + cvec[e];
              float tv[4]; int ti[4];
#pragma unroll
              for (int j = 0; j < 4; ++j) { float bv = val; int bi = e;
#pragma unroll
                  for (int off = 16; off >= 1; off >>= 1) { const float ov = __shfl_xor(bv, off); const int oi = __shfl_xor(bi, off); if (ov > bv || (ov == bv && oi < bi)) { bv = ov; bi = oi; } }
                  tv[j] = bv; ti[j] = bi; if (e == bi) val = -INFINITY; }
              const float e1 = __expf(tv[1] - tv[0]), e2 = __expf(tv[2] - tv[0]), e3 = __expf(tv[3] - tv[0]), inv = 1.0f / (1.0f + e1 + e2 + e3);
              const float gt[4] = {inv, e1 * inv, e2 * inv, e3 * inv};
#pragma unroll
              for (int j = 0; j < 4; ++j) if (e == ti[j]) { const int ai = (row0 + row) * 4 + j; const unsigned rk = atomicAdd(ctl + CW_CNT + 16 * e, 1u);
                  rt_e[ai] = e; rt_g[ai] = gt[j]; rt_r[ai] = (int)rk; } }
            __syncthreads();
        }
    }
    SEAM(8);

    if (IN(9)) {
        PH_BEGIN;
        LAS int* tb = (LAS int*)lds;
        if (tid == 0) { int acc = 0; for (int e = 0; e < NEXP; ++e) { tb[e] = acc; acc += (int)((ctl[CW_CNT + 16 * e] + 255u) >> 8); } tb[NEXP] = acc; }
        __syncthreads();
        for (int i = gtid; i < NTOK * 4; i += NGT) { const int e = rt_e[i], slot = tb[e] * 256 + rt_r[i]; rt_s[i] = slot; slot_rowoff[slot] = (unsigned)(i >> 2) * (unsigned)D; slot_gate[slot] = rt_g[i]; ((float*)(ws + WS_CS + CS_SLOT))[slot] = ((const float*)(ws + WS_CS + CS_ROW))[i >> 2]; }
        if (vcu == 0) {
            for (int e = 0; e < NEXP; ++e) { const int cnt = (int)ctl[CW_CNT + 16 * e], s0 = tb[e] * 256 + cnt, s1 = tb[e + 1] * 256;
                for (int s = s0 + tid; s < s1; s += 512) { slot_rowoff[s] = 0u; slot_gate[s] = 0.f; ((float*)(ws + WS_CS + CS_SLOT))[s] = 0.f; }
                for (int t = tb[e] + tid; t < tb[e + 1]; t += 512) tile_expert[t] = e; }
            if (tid == 0) *ntiles_p = tb[NEXP];
        }
        __syncthreads();
    }
    SEAM(9);

    if (IN(10)) {
        PH_BEGIN;
        const int ntiles = *ntiles_p;
        for (int i = tid; i < ntiles; i += 512) ((LAS int*)(lds + XL_TEXP))[i] = tile_expert[i];
        __syncthreads();
        pg8::Gemm g{H, WGU, D / 2}; pg8::MoeOrder<true> S; S.init(ntiles, 4096 / 256, G, bx); S.K2 = D; S.nper = 4096; S.texp = (const LAS int*)(lds + XL_TEXP); S.sroff = slot_rowoff;
        EpiAct E{ACT, A->b_e_gate, A->b_e_up, (const float*)(ws + WS_CS), (const float*)(ws + WS_CS + CS_SLOT)};
        pg8::gemm_phase<EpiAct, pg8::MoeOrder<true>, true>(lds, g, S, E);
    }
    SEAM(10);

    if (IN(11)) {
        PH_BEGIN;
        const int ntiles = *ntiles_p;
        { const int nrows = ntiles * 256; u32x2 v[8], vn[8];
          if (gw < nrows) { const bf16* ar = ACT + (size_t)gw * FF + 4 * lane;
#pragma unroll
              for (int j = 0; j < 8; ++j) v[j] = *(const u32x2*)(ar + 256 * j); }
          for (int m = gw; m < nrows; m += NGW) {
              if (m + NGW < nrows) { const bf16* an = ACT + (size_t)(m + NGW) * FF + 4 * lane;
#pragma unroll
                  for (int j = 0; j < 8; ++j) vn[j] = *(const u32x2*)(an + 256 * j); }
              float am = 0.f;
#pragma unroll
              for (int j = 0; j < 8; ++j) am = fmaxf(am, fmaxf(fmaxf(fabsf(bflo(v[j].x)), fabsf(bfhi(v[j].x))), fmaxf(fabsf(bflo(v[j].y)), fabsf(bfhi(v[j].y)))));
#pragma unroll
              for (int o = 1; o < 64; o <<= 1) am = fmaxf(am, __shfl_xor(am, o));
              if (!(am > 0.f)) am = 1.f;
              const float qi = 127.0f / am;
              if (lane == 0) ((float*)(ws + WS_ROUTE + RT_ARS))[m] = am * (1.0f / 127.0f);
              unsigned* aq = (unsigned*)((signed char*)(ws + WS_ACT8) + (size_t)m * FF + 4 * lane);
#pragma unroll
              for (int j = 0; j < 8; ++j) { const int q0 = (int)rintf(bflo(v[j].x) * qi), q1 = (int)rintf(bfhi(v[j].x) * qi), q2 = (int)rintf(bflo(v[j].y) * qi), q3 = (int)rintf(bfhi(v[j].y) * qi);
                  aq[64 * j] = ((unsigned)q0 & 0xffu) | (((unsigned)q1 & 0xffu) << 8) | (((unsigned)q2 & 0xffu) << 16) | (((unsigned)q3 & 0xffu) << 24); }
#pragma unroll
              for (int j = 0; j < 8; ++j) v[j] = vn[j];
          } }
        xcd_barrier(bar);
        for (int i = tid; i < ntiles; i += 512) ((LAS int*)(lds + XL_TEXP))[i] = tile_expert[i];
        __syncthreads();
        pg8::Gemm g{(const bf16*)(ws + WS_ACT8), WDN, FF / 2}; pg8::MoeOrder<false> S; S.init(ntiles, D / 256, G, bx); S.K2 = FF; S.nper = D; S.texp = (const LAS int*)(lds + XL_TEXP); S.sroff = slot_rowoff;
        EpiDown E{(signed char*)(ws + WS_YS), (float*)(ws + WS_YS + (size_t)MAXSLOTS * D), A->b_e_down, slot_gate, (const float*)(ws + WS_ROUTE + RT_ARS), (const float*)(ws + WS_DLOG + DL_CSD)};
        pg8::gemm_phase<EpiDown, pg8::MoeOrder<false>, true>(lds, g, S, E);
    }
    SEAM(11);

    if (IN(12)) {
        PH_BEGIN;
        f32x4 v[8], vn[8], y[8]; unsigned yn[4][8]; float ysn[4][8]; int sl[4];
        const signed char* YQ = (const signed char*)(ws + WS_YS); const float* YSC = (const float*)(ws + WS_YS + (size_t)MAXSLOTS * D);
#define P12_LOAD(VV, M) do { const float* xr_ = X1 + (size_t)(M) * D + 4 * lane; \
            _Pragma("unroll") for (int j = 0; j < 8; ++j) VV[j] = *(const f32x4*)(xr_ + 256 * j); \
            _Pragma("unroll") for (int q = 0; q < 4; ++q) { const signed char* yp_ = YQ + (size_t)sl[q] * D + 4 * lane; const float* sp_ = YSC + (size_t)sl[q] * 8; \
                _Pragma("unroll") for (int j = 0; j < 8; ++j) { yn[q][j] = *(const unsigned*)(yp_ + 256 * j); ysn[q][j] = sp_[j]; } } } while (0)
#define P12_SUM() do { _Pragma("unroll") for (int j = 0; j < 8; ++j) { y[j] = (f32x4){0.f, 0.f, 0.f, 0.f}; \
            _Pragma("unroll") for (int q = 0; q < 4; ++q) { const int w_ = (int)yn[q][j]; const float s_ = ysn[q][j]; \
                y[j][0] += (float)((w_ << 24) >> 24) * s_; y[j][1] += (float)((w_ << 16) >> 24) * s_; y[j][2] += (float)((w_ << 8) >> 24) * s_; y[j][3] += (float)(w_ >> 24) * s_; } } } while (0)
#pragma unroll
        for (int q = 0; q < 4; ++q) sl[q] = rt_s[gw * 4 + q];
        P12_LOAD(v, gw); P12_SUM();
        if (gw + NGW < NTOK) {
#pragma unroll
            for (int q = 0; q < 4; ++q) sl[q] = rt_s[(gw + NGW) * 4 + q];
        }
        for (int m = gw; m < NTOK; m += NGW) {
            const bool more = m + NGW < NTOK;
            if (more) { P12_LOAD(vn, m + NGW);
                if (m + 2 * NGW < NTOK) {
#pragma unroll
                    for (int q = 0; q < 4; ++q) sl[q] = rt_s[(m + 2 * NGW) * 4 + q]; } }
            float ss = 0.f;
#pragma unroll
            for (int j = 0; j < 8; ++j) { const f32x4 m5 = *(const f32x4*)(modl + 5 * 2048 + 4 * lane + 256 * j); v[j] = v[j] + m5 * y[j]; ss += v[j][0] * v[j][0] + v[j][1] * v[j][1] + v[j][2] * v[j][2] + v[j][3] * v[j][3]; }
            const float rstd = rsqrtf(wave_sum(ss) * (1.0f / D) + EPS);
            float* orow = A->out + (size_t)m * D + 4 * lane;
#pragma unroll
            for (int j = 0; j < 8; ++j) { const f32x4 fg = *(const f32x4*)(A->final_g + 4 * lane + 256 * j); *(f32x4*)(orow + 256 * j) = v[j] * rstd * fg; }
            if (more) { P12_SUM();
#pragma unroll
                for (int j = 0; j < 8; ++j) v[j] = vn[j]; }
        }
#undef P12_SUM
#undef P12_LOAD
    }
#undef IN
#undef SEAM
}

#undef modl
#undef modc
#undef rope
#undef lbf
#undef lbb
#undef wrp
#undef cvec
#undef tile_expert
#undef ntiles_p
#undef rt_e
#undef rt_g
#undef rt_r
#undef rt_s
#undef slot_rowoff
#undef slot_gate
#undef Dlog
#undef KR
#undef VTg
#undef Lbuf
#undef WIN
#undef WM
#undef WO
#undef WGU
#undef WDN
#undef H
#undef PROJ
#undef ACT
#undef YAB
#undef OSCR
#undef MERGED
#undef X1
#undef YS
extern "C" void kernel_launch(void* const* d_in, const int* in_sizes, int n_in, void* d_out, int out_size, void* d_ws, size_t ws_size, hipStream_t stream) {
    static int grid = 0;
    if (grid == 0) {
        if (n_in != 24 || out_size != NTOK * D || ws_size < WS_END) { fprintf(stderr, "kernel_launch: unexpected shapes (n_in %d out %d ws %zu)\n", n_in, out_size, ws_size); grid = -1; return; }
        int dev = 0, cus = 0, per_cu = 0;
        if (hipGetDevice(&dev) != hipSuccess || hipDeviceGetAttribute(&cus, hipDeviceAttributeMultiprocessorCount, dev) != hipSuccess) { grid = -1; return; }
        if (hipFuncSetAttribute((const void*)fwd_kernel, hipFuncAttributeMaxDynamicSharedMemorySize, LDS_BYTES) != hipSuccess) { fprintf(stderr, "kernel_launch: hipFuncSetAttribute failed\n"); grid = -1; return; }
        if (hipOccupancyMaxActiveBlocksPerMultiprocessor(&per_cu, (const void*)fwd_kernel, NWAVES * 64, LDS_BYTES) != hipSuccess || per_cu < 1) { fprintf(stderr, "kernel_launch: occupancy query says %d\n", per_cu); (void)hipGetLastError(); grid = -1; return; }
        grid = cus;
    }
    if (grid < 0) return;
    if (hipMemsetAsync((char*)d_ws + WS_CTL, 0, CTL_ZERO_BYTES, stream) != hipSuccess) return;
    Args a{};
    const float** p = (const float**)&a;
    for (int i = 0; i < 24; ++i) p[i] = (const float*)d_in[i];
    a.out = (float*)d_out; a.ws = (unsigned char*)d_ws; a.ph_lo = 0; a.ph_hi = 13;
    hipLaunchKernelGGL(fwd_kernel, dim3(grid), dim3(NWAVES * 64), LDS_BYTES, stream, a);
    const hipError_t le = hipPeekAtLastError();
    if (le != hipSuccess) fprintf(stderr, "kernel_launch: launch failed: %s\n", hipGetErrorName(le));
}
```
